# Optimizing an MI355X kernel written in HIP

```python
import math
import jax, jax.numpy as jnp
from jax import lax
import numpy as np

D_MODEL = 1024
BATCH = 2
SEQ = 16384
DEPTH = 4

N_A = DEPTH // 2
N_B = DEPTH - N_A
A_HEAD = 64
A_HEADS = D_MODEL // A_HEAD
LORA_W = 64
LORA_A = 64
LORA_V = 32
GN_EPS = 64e-5
B_QK = 64
B_HEADS = D_MODEL // (2 * B_QK)
B_V = 2 * B_QK
B_WIDTH = B_HEADS * B_V
ROT_DIM = B_QK // 4
ROPE_THETA = 500000.0
Q_BLOCK = 128
NORM_EPS = 1e-6
SUBLN_EPS = 1e-5

kernel_name = "yoco_rwkv7_diffattn_hybrid"


def rmsnorm(x, g, eps=NORM_EPS):
    xf = x.astype(jnp.float32)
    y = xf * lax.rsqrt(jnp.mean(xf * xf, axis=-1, keepdims=True) + eps)
    return (y * g.astype(jnp.float32)).astype(x.dtype)


def partial_rope(t, positions):
    half = ROT_DIM // 2
    inv_freq = ROPE_THETA ** (-jnp.arange(0, ROT_DIM, 2, dtype=jnp.float32) / ROT_DIM)
    ang = positions.astype(jnp.float32)[:, :, None] * inv_freq[None, None, :]
    cos = jnp.cos(ang)[:, :, None, None, :]
    sin = jnp.sin(ang)[:, :, None, None, :]
    tf = t.astype(jnp.float32)
    t1, t2, rest = tf[..., :half], tf[..., half:ROT_DIM], tf[..., ROT_DIM:]
    out = jnp.concatenate([t1 * cos - t2 * sin, t2 * cos + t1 * sin, rest], axis=-1)
    return out.astype(t.dtype)


def wkv7_scan(r, w, k, v, a, b):
    Bn, _, H, N = r.shape

    def step(state, inp):
        r_t, w_t, k_t, v_t, a_t, b_t = inp
        sa = jnp.einsum('bhij,bhj->bhi', state, a_t)
        state = (state * w_t[:, :, None, :] + sa[..., None] * b_t[:, :, None, :]
                 + v_t[..., None] * k_t[:, :, None, :])
        y_t = jnp.einsum('bhij,bhj->bhi', state, r_t)
        return state, y_t

    xs = (jnp.moveaxis(r, 1, 0), jnp.moveaxis(w, 1, 0), jnp.moveaxis(k, 1, 0),
          jnp.moveaxis(v, 1, 0), jnp.moveaxis(a, 1, 0), jnp.moveaxis(b, 1, 0))
    s0 = jnp.zeros((Bn, H, N, N), jnp.float32)
    _, y = lax.scan(step, s0, xs)
    return jnp.moveaxis(y, 0, 1)


def rwkv7_mixer(xn, mu, w_in, w0, w1, w2, a0, a1, a2, k_k, k_a, r_k, ln_w, ln_b, w_out,
                v_first, v_res):
    Bn, S, D = xn.shape
    f32 = jnp.float32
    x_prev = jnp.pad(xn, ((0, 0), (1, 0), (0, 0)))[:, :-1]
    xx = x_prev - xn
    xm = xn[:, :, None, :] + xx[:, :, None, :] * mu[:4]
    rkvg = jnp.einsum('bspd,pde->bspe', xm, w_in)
    r, k, v, g = rkvg[:, :, 0], rkvg[:, :, 1], rkvg[:, :, 2], rkvg[:, :, 3]
    xw = xn + xx * mu[4]
    xa = xn + xx * mu[5]
    w = -jax.nn.softplus(-(w0 + jnp.tanh(xw @ w1) @ w2)) - 0.5
    a = jax.nn.sigmoid(a0 + (xa @ a1) @ a2)
    if v_res is None:
        v_first = v
    else:
        v0, v1, v2 = v_res
        v = v + (v_first - v) * jax.nn.sigmoid(v0 + (xm[:, :, 2] @ v1) @ v2)

    def hd(t):
        return t.reshape(Bn, S, A_HEADS, A_HEAD).astype(f32)

    kk = hd(k * k_k)
    kk = kk / jnp.maximum(jnp.sqrt(jnp.sum(kk * kk, axis=-1, keepdims=True)), 1e-12)
    kmod = hd(k * (1.0 + (a - 1.0) * k_a))
    ah = hd(a)
    rh = hd(r)
    vh = hd(v)
    decay = jnp.exp(-jnp.exp(hd(w)))
    y = wkv7_scan(rh, decay, kmod, vh, -kk, kk * ah)
    mean = jnp.mean(y, axis=-1, keepdims=True)
    var = jnp.mean(jnp.square(y - mean), axis=-1, keepdims=True)
    yn = (y - mean) * lax.rsqrt(var + GN_EPS)
    yn = yn * ln_w.reshape(A_HEADS, A_HEAD).astype(f32) + ln_b.reshape(A_HEADS, A_HEAD).astype(f32)
    bonus = jnp.sum(rh * kmod * r_k.astype(f32), axis=-1, keepdims=True) * vh
    o = (yn + bonus).reshape(Bn, S, D).astype(xn.dtype) * jax.nn.silu(g)
    return o @ w_out, v_first


def diff_attention(q, k, v, lam):
    Bn, S, H = q.shape[:3]
    scale = B_QK ** -0.5
    qh = q.transpose(0, 2, 3, 1, 4)
    kh = k.transpose(0, 2, 3, 1, 4)
    vh = v.transpose(0, 2, 1, 3)
    n_blk = S // Q_BLOCK
    kpos = jnp.arange(S)

    def one_block(i):
        q0 = i * Q_BLOCK
        qb = lax.dynamic_slice_in_dim(qh, q0, Q_BLOCK, axis=3)
        s = jnp.einsum('bhmqd,bhmkd->bhmqk', qb, kh, preferred_element_type=jnp.float32) * scale
        qpos = q0 + jnp.arange(Q_BLOCK)
        s = jnp.where(kpos[None, :] <= qpos[:, None], s, -jnp.inf)
        p = jax.nn.softmax(s, axis=-1)
        attn = p[:, :, 0] - lam * p[:, :, 1]
        return jnp.einsum('bhqk,bhkd->bhqd', attn.astype(vh.dtype), vh)

    o = lax.map(one_block, jnp.arange(n_blk))
    return o.transpose(1, 0, 3, 2, 4).reshape(Bn, S, H, B_V)


def setup_inputs(seed: int = 0) -> dict:
    key = jax.random.key(seed)
    ks = iter(jax.random.split(key, 40))
    f32 = jnp.float32
    D = D_MODEL

    def nrm(shape, scale):
        return jax.random.normal(next(ks), shape, f32) * scale

    def unif(shape, lo, hi):
        return jax.random.uniform(next(ks), shape, f32, lo, hi)

    x = jax.random.normal(next(ks), (BATCH, SEQ, D), f32)
    positions = jnp.broadcast_to(jnp.arange(SEQ, dtype=jnp.int32)[None, :], (BATCH, SEQ))
    inp = {
        "x": x,
        "positions": positions,
        "a_norm": 1.0 + nrm((N_A, D), 0.02),
        "a_mu": unif((N_A, 6, D), 0.0, 1.0),
        "a_w_in": nrm((N_A, 4, D, D), D ** -0.5),
        "a_w0": unif((N_A, D), -6.0, -1.0),
        "a_w1": nrm((N_A, D, LORA_W), D ** -0.5),
        "a_w2": nrm((N_A, LORA_W, D), 0.1 * LORA_W ** -0.5),
        "a_a0": nrm((N_A, D), 0.1),
        "a_a1": nrm((N_A, D, LORA_A), D ** -0.5),
        "a_a2": nrm((N_A, LORA_A, D), 0.1 * LORA_A ** -0.5),
        "a_v0": nrm((N_A - 1, D), 0.1),
        "a_v1": nrm((N_A - 1, D, LORA_V), D ** -0.5),
        "a_v2": nrm((N_A - 1, LORA_V, D), 0.1 * LORA_V ** -0.5),
        "a_k_k": 0.85 + nrm((N_A, D), 0.05),
        "a_k_a": 1.0 + nrm((N_A, D), 0.05),
        "a_r_k": nrm((N_A, A_HEADS, A_HEAD), 0.1),
        "a_ln_w": 1.0 + nrm((N_A, D), 0.02),
        "a_ln_b": nrm((N_A, D), 0.02),
        "a_w_out": nrm((N_A, D, D), D ** -0.5),
        "kv_norm": 1.0 + nrm((D,), 0.02),
        "w_kv": nrm((D, B_HEADS * 2 * B_QK + B_WIDTH), D ** -0.5),
        "b_norm": 1.0 + nrm((N_B, D), 0.02),
        "b_w_in": nrm((N_B, D, B_HEADS * 2 * B_QK + B_WIDTH), D ** -0.5),
        "b_lq1": nrm((N_B, B_QK), 0.1),
        "b_lk1": nrm((N_B, B_QK), 0.1),
        "b_lq2": nrm((N_B, B_QK), 0.1),
        "b_lk2": nrm((N_B, B_QK), 0.1),
        "b_subln": 1.0 + nrm((N_B, B_V), 0.02),
        "b_w_out": nrm((N_B, B_WIDTH, D), B_WIDTH ** -0.5),
        "final_norm": 1.0 + nrm((D,), 0.02),
    }
    return inp


def reference(x, positions, a_norm, a_mu, a_w_in, a_w0, a_w1, a_w2, a_a0, a_a1, a_a2,
              a_v0, a_v1, a_v2, a_k_k, a_k_a, a_r_k, a_ln_w, a_ln_b, a_w_out,
              kv_norm, w_kv, b_norm, b_w_in, b_lq1, b_lk1, b_lq2, b_lk2, b_subln, b_w_out,
              final_norm):
    Bn, S, D = x.shape
    nq = B_HEADS * 2 * B_QK
    v_first = None
    k_shared = None
    v_shared = None
    for layer in range(DEPTH):
        if layer < N_A:
            xn = rmsnorm(x, a_norm[layer])
            v_res = None if layer == 0 else (a_v0[layer - 1], a_v1[layer - 1], a_v2[layer - 1])
            o, v_first = rwkv7_mixer(xn, a_mu[layer], a_w_in[layer], a_w0[layer], a_w1[layer],
                                     a_w2[layer], a_a0[layer], a_a1[layer], a_a2[layer],
                                     a_k_k[layer], a_k_a[layer], a_r_k[layer], a_ln_w[layer],
                                     a_ln_b[layer], a_w_out[layer], v_first, v_res)
            x = x + o
        else:
            j = layer - N_A
            if k_shared is None:
                h = rmsnorm(x, kv_norm)
                kv = h @ w_kv
                k_shared = partial_rope(kv[..., :nq].reshape(Bn, S, B_HEADS, 2, B_QK), positions)
                v_shared = kv[..., nq:].reshape(Bn, S, B_HEADS, B_V)
            xn = rmsnorm(x, b_norm[j])
            proj = xn @ b_w_in[j]
            q = partial_rope(proj[..., :nq].reshape(Bn, S, B_HEADS, 2, B_QK), positions)
            gate = proj[..., nq:]
            lam_init = 0.8 - 0.6 * math.exp(-0.3 * layer)
            lam = (jnp.exp(jnp.sum(b_lq1[j].astype(jnp.float32) * b_lk1[j].astype(jnp.float32)))
                   - jnp.exp(jnp.sum(b_lq2[j].astype(jnp.float32) * b_lk2[j].astype(jnp.float32)))
                   + lam_init)
            o = diff_attention(q, k_shared, v_shared, lam)
            o = rmsnorm(o, b_subln[j], SUBLN_EPS) * (1.0 - lam_init)
            o = o.reshape(Bn, S, B_WIDTH).astype(x.dtype) * jax.nn.silu(gate)
            x = x + o @ b_w_out[j]
    return rmsnorm(x, final_norm)
```

```cpp
#include <hip/hip_runtime.h>
#include <hip/hip_cooperative_groups.h>
#include <cstdio>
#include <cstdint>
namespace cg = cooperative_groups;
namespace pg8 {
#define PG8_LAS __attribute__((address_space(3)))
typedef unsigned short bf16_t;
typedef short bf16x8 __attribute__((ext_vector_type(8)));
typedef float f32x4 __attribute__((ext_vector_type(4)));
typedef unsigned u32x4 __attribute__((ext_vector_type(4)));
constexpr int BM = 256, BK = 64, HALF = 128, HTB = HALF * BK * 2  , STAGE_BYTES = 8 * HTB, NXCD = 8, WGM = 8;

__host__ __device__ __forceinline__ int lds_byte(int r, int c) { const int st = (r >> 4) * 2 + (c >> 5), rr = r & 15, cc = c & 31, ob = rr * 64 + cc * 2; return st * 1024 + (ob ^ (((ob >> 9) & 1) << 5)); }
__host__ __device__ __forceinline__ void stage_rc(int b, int& R, int& C) { const int st = b / 1024, sb = b % 1024, swz = sb ^ (((sb >> 9) & 1) << 5); R = (st >> 1) * 16 + swz / 64; C = (st & 1) * 32 + (swz % 64) / 2; }
__host__ __device__ __forceinline__ int perm32(int rho) { const int n = rho >> 4, i = rho & 15; return 8 * (i >> 2) + 4 * n + (i & 3); }

struct Unit { int pm, pn; };
struct Gemm { const bf16_t* A; const bf16_t* Bt; int M, N, K; };

struct StaticOrder {
    int nM, nN, nwg, G, c;
    __host__ __device__ void init(int M, int N, int G_, int c_) { nM = M / BM; nN = N / BM; nwg = nM * nN; G = G_; c = c_; }
    __host__ __device__ bool next(int i, Unit& u) const {
        const long L = (long)i * G + c; if (L >= nwg) return false;
        int wgid = (int)L; { const int q = nwg / NXCD, r = nwg % NXCD, xcd = wgid % NXCD, off = wgid / NXCD; wgid = (xcd < r ? xcd * (q + 1) : r * (q + 1) + (xcd - r) * q) + off; }
        const int nig = WGM * nN, gid = wgid / nig, fm = gid * WGM, gsz = (nM - fm) < WGM ? (nM - fm) : WGM;
        u.pm = fm + ((wgid % nig) % gsz); u.pn = (wgid % nig) / gsz; return true;
    }
    __device__ __forceinline__ void a_ready(const Unit&) const {}
    __device__ __forceinline__ void done(const Unit&) const {}
};

__device__ __forceinline__ unsigned cvt_pk_bf16(float lo, float hi) { unsigned r; asm volatile("v_cvt_pk_bf16_f32 %0, %1, %2" : "=v"(r) : "v"(lo), "v"(hi)); return r; }
typedef float f32x2 __attribute__((ext_vector_type(2)));
typedef _Float16 h16x4 __attribute__((ext_vector_type(4)));
typedef unsigned u32x2 __attribute__((ext_vector_type(2)));
__device__ __forceinline__ float sigmoidf_(float z) { return 1.0f / (1.0f + __expf(-z)); }
__device__ __forceinline__ float tanhf_(float x) { const float t = __expf(-2.0f * fabsf(x)); const float r = (1.0f - t) / (1.0f + t); return x < 0.f ? -r : r; }
__device__ __forceinline__ float bf_lo(unsigned w) { return __uint_as_float(w << 16); }
__device__ __forceinline__ float bf_hi(unsigned w) { return __uint_as_float(w & 0xffff0000u); }

struct EpiFold {
    static constexpr bool PERM = true, AFTER_DRAIN = false;
    bf16_t *R, *Kb, *V, *G, *H;
    __device__ __forceinline__ void operator()(const f32x4 (&acc)[2][2][4][2], const Unit& u, int wr, int wc, int fr, int fq) const {
        const int row0 = u.pm * BM + wr * 64 + fr;
        const int t = u.pn >> 2;
        bf16_t* base; int ldc, colt;
        if (u.pn < 16) { base = (t == 0) ? R : (t == 1) ? Kb : (t == 2) ? V : G; ldc = 1024; colt = (u.pn & 3) * 256; }
        else { base = H; ldc = 256; colt = 0; }
        const int col0 = colt + wc * 32 + 8 * fq;
        const bool th = (u.pn == 16) && (wc < 2);
#pragma unroll
        for (int ai = 0; ai < 2; ++ai)
#pragma unroll
            for (int m = 0; m < 4; ++m) { bf16_t* rowp = base + (size_t)(row0 + ai * HALF + m * 16) * ldc + col0;
#pragma unroll
                for (int bj = 0; bj < 2; ++bj) { f32x4 v0 = acc[ai][bj][m][0], v1 = acc[ai][bj][m][1];
                    if (th && bj == 0) {
#pragma unroll
                        for (int i = 0; i < 4; ++i) { v0[i] = tanhf_(v0[i]); v1[i] = tanhf_(v1[i]); } }
                    u32x4 w; w.x = cvt_pk_bf16(v0[0], v0[1]); w.y = cvt_pk_bf16(v0[2], v0[3]); w.z = cvt_pk_bf16(v1[0], v1[1]); w.w = cvt_pk_bf16(v1[2], v1[3]);
                    *(u32x4*)(rowp + bj * HALF) = w; }
                asm volatile("" ::: "memory"); }
    }
};

struct EpiLoraUp {
    static constexpr bool PERM = false, AFTER_DRAIN = false;
    const float* bias3; _Float16 *Wb, *Ab; bf16_t* Vb; const bf16_t* Vf;
    __device__ __forceinline__ void operator()(const f32x4 (&acc)[2][2][4][2], const Unit& u, int wr, int wc, int fr_unused, int fq_unused) const {
        int t_ = threadIdx.x; asm volatile("" : "+v"(t_)); const int fr = t_ & 15, fq = (t_ >> 4) & 3;
        const int row0 = u.pm * BM + wr * 64 + fr;
        const int t = u.pn >> 2;
        const int cc0 = (u.pn & 3) * 256 + wc * 32 + 4 * fq;
        const float* bias = bias3 + t * 1024;
#pragma unroll
        for (int bj = 0; bj < 2; ++bj)
#pragma unroll
            for (int n = 0; n < 2; ++n) { const int c = cc0 + bj * HALF + n * 16; const f32x4 bv = *(const f32x4*)(bias + c);
#pragma unroll
                for (int ai = 0; ai < 2; ++ai)
#pragma unroll
                    for (int m = 0; m < 4; ++m) { const size_t off = (size_t)(row0 + ai * HALF + m * 16) * 1024 + c; const f32x4 z = acc[ai][bj][m][n] + bv;
                        if (t == 0) { h16x4 o;
#pragma unroll
                            for (int i = 0; i < 4; ++i) { const float zz = -z[i]; const float sp = fmaxf(zz, 0.f) + __logf(1.0f + __expf(-fabsf(zz))); o[i] = (_Float16)(-sp - 0.5f); }
                            *(h16x4*)(Wb + off) = o; }
                        else if (t == 1) { h16x4 o;
#pragma unroll
                            for (int i = 0; i < 4; ++i) o[i] = (_Float16)sigmoidf_(z[i]);
                            *(h16x4*)(Ab + off) = o; }
                        else { const u32x2 vv = *(const u32x2*)(Vb + off), vf = *(const u32x2*)(Vf + off);
                            const float v_0 = bf_lo(vv.x), v_1 = bf_hi(vv.x), v_2 = bf_lo(vv.y), v_3 = bf_hi(vv.y);
                            const float f_0 = bf_lo(vf.x), f_1 = bf_hi(vf.x), f_2 = bf_lo(vf.y), f_3 = bf_hi(vf.y);
                            u32x2 o; o.x = cvt_pk_bf16(v_0 + (f_0 - v_0) * sigmoidf_(z[0]), v_1 + (f_1 - v_1) * sigmoidf_(z[1]));
                            o.y = cvt_pk_bf16(v_2 + (f_2 - v_2) * sigmoidf_(z[2]), v_3 + (f_3 - v_3) * sigmoidf_(z[3]));
                            *(u32x2*)(Vb + off) = o; }
                        asm volatile("" ::: "memory"); } }
    }
};

struct EpiProj {
    static constexpr bool PERM = true, AFTER_DRAIN = false;
    bf16_t *d0, *d1, *d2, *d3; int ropemask, scalemask; float sc; const float* rc; const float* rs;
    __device__ __forceinline__ void operator()(const f32x4 (&acc)[2][2][4][2], const Unit& u, int wr, int wc, int fr, int fq) const {
        const int row0 = u.pm * BM + wr * 64 + fr;
        const int t = u.pn >> 2;
        bf16_t* base = (t == 0) ? d0 : (t == 1) ? d1 : (t == 2) ? d2 : d3;
        const int col0 = (u.pn & 3) * 256 + wc * 32 + 8 * fq;
        const bool rope = (((ropemask >> t) & 1) != 0) && ((wc & 1) == 0);
        const float s = ((scalemask >> t) & 1) ? sc : 1.0f;
        const float sgn = (fq == 0) ? -1.0f : 1.0f;
#pragma unroll
        for (int ai = 0; ai < 2; ++ai)
#pragma unroll
            for (int m = 0; m < 4; ++m) { const int row = row0 + ai * HALF + m * 16; bf16_t* rowp = base + (size_t)row * 1024 + col0;
                f32x4 c0 = {1.f, 1.f, 1.f, 1.f}, c1 = c0, s0 = {0.f, 0.f, 0.f, 0.f}, s1 = s0;
                if (rope) { c0 = *(const f32x4*)(rc + (size_t)row * 8); c1 = *(const f32x4*)(rc + (size_t)row * 8 + 4); s0 = *(const f32x4*)(rs + (size_t)row * 8); s1 = *(const f32x4*)(rs + (size_t)row * 8 + 4); }
#pragma unroll
                for (int bj = 0; bj < 2; ++bj) { f32x4 v0 = acc[ai][bj][m][0], v1 = acc[ai][bj][m][1];
                    if (rope) { f32x4 p0, p1;
#pragma unroll
                        for (int i = 0; i < 4; ++i) { p0[i] = __shfl_xor(v0[i], 16); p1[i] = __shfl_xor(v1[i], 16); }
                        if (fq < 2) { v0 = v0 * c0 + (p0 * s0) * sgn; v1 = v1 * c1 + (p1 * s1) * sgn; } }
                    v0 = v0 * s; v1 = v1 * s;
                    u32x4 w; w.x = cvt_pk_bf16(v0[0], v0[1]); w.y = cvt_pk_bf16(v0[2], v0[3]); w.z = cvt_pk_bf16(v1[0], v1[1]); w.w = cvt_pk_bf16(v1[2], v1[3]);
                    *(u32x4*)(rowp + bj * HALF) = w; }
                asm volatile("" ::: "memory"); }
    }
};

struct EpiResid {
    static constexpr bool PERM = false, AFTER_DRAIN = false;
    const float* base; float* out;
    __device__ __forceinline__ void operator()(const f32x4 (&acc)[2][2][4][2], const Unit& u, int wr, int wc, int fr, int fq) const {
        const int row0 = u.pm * BM + wr * 64 + fr;
        const int col0 = u.pn * BM + wc * 32 + 4 * fq;
#pragma unroll
        for (int ai = 0; ai < 2; ++ai)
#pragma unroll
            for (int m = 0; m < 4; ++m) { const size_t off = (size_t)(row0 + ai * HALF + m * 16) * 1024 + col0;
#pragma unroll
                for (int bj = 0; bj < 2; ++bj)
#pragma unroll
                    for (int n = 0; n < 2; ++n) { const f32x4 b = *(const f32x4*)(base + off + bj * HALF + n * 16); *(f32x4*)(out + off + bj * HALF + n * 16) = b + acc[ai][bj][m][n]; }
                asm volatile("" ::: "memory"); }
    }
};
template <class Epi, class Sched, bool ALIGN_EPI = false, bool SP2 = false>
__device__ __forceinline__ void gemm_phase(PG8_LAS unsigned char* lds, const Gemm g, const Sched& S, const Epi& E) {
    int tid_ = threadIdx.x; asm volatile("" : "+v"(tid_));
    const int tid = tid_, wid = __builtin_amdgcn_readfirstlane(tid >> 6), lane = tid & 63, wr = wid >> 2, wc = wid & 3, fr = lane & 15, fq = lane >> 4;
    const int K = g.K, nt = K / BK;
    unsigned voffA[2], voffB[2];
#pragma unroll
    for (int i = 0; i < 2; ++i) { int R, C; stage_rc(tid * 16 + i * 8192, R, C); const int Rb = Epi::PERM ? ((R & ~31) + perm32(R & 31)) : R;
        voffA[i] = (unsigned)(R * K + C) * 2u; voffB[i] = (unsigned)(Rb * K + C) * 2u; }
    const size_t kstep = (size_t)(BK * 2);
    const size_t hstep = (size_t)HALF * K * 2;
    const size_t tstep = 2 * hstep;
    const unsigned ldsw = (unsigned)wid * 1024u;
    const int aoff = lds_byte(wr * 64 + fr, fq * 8), boff = lds_byte(wc * 32 + fr, fq * 8);
#define PG8_SA(b, h) (((b) * 2 + (h)) * HTB)
#define PG8_SB(b, h) ((4 + (b) * 2 + (h)) * HTB)
#define PG8_STAGE(bufoff, gbase, voff) do { _Pragma("unroll") for (int _i = 0; _i < 2; ++_i) \
        __builtin_amdgcn_global_load_lds((const unsigned*)((const char*)(gbase) + (voff)[_i]), (PG8_LAS unsigned*)(lds + (bufoff) + ldsw + _i * 8192), 16, 0, 0); } while (0)
#define PG8_LDA(dst, b, h) do { _Pragma("unroll") for (int m = 0; m < 4; ++m) _Pragma("unroll") for (int k = 0; k < 2; ++k) dst[m][k] = *(const PG8_LAS bf16x8*)(lds + PG8_SA(b, h) + aoff + m * 2048 + k * 1024); } while (0)
#define PG8_LDB(dst, b, h) do { _Pragma("unroll") for (int n = 0; n < 2; ++n) _Pragma("unroll") for (int k = 0; k < 2; ++k) dst[n][k] = *(const PG8_LAS bf16x8*)(lds + PG8_SB(b, h) + boff + n * 2048 + k * 1024); } while (0)
#define PG8_MMA(ai, bj, At, Bt) do { __builtin_amdgcn_s_setprio(1); _Pragma("unroll") for (int m = 0; m < 4; ++m) _Pragma("unroll") for (int n = 0; n < 2; ++n) _Pragma("unroll") for (int k = 0; k < 2; ++k) \
        acc[ai][bj][m][n] = __builtin_amdgcn_mfma_f32_16x16x32_bf16(Bt[n][k], At[m][k], acc[ai][bj][m][n], 0, 0, 0); __builtin_amdgcn_s_setprio(0); } while (0)
#define PG8_WAIT_V(n) asm volatile("s_waitcnt vmcnt(" #n ")" ::: "memory")
#define PG8_WAIT_L(n) asm volatile("s_waitcnt lgkmcnt(" #n ")" ::: "memory")
#define PG8_BAR __builtin_amdgcn_s_barrier()
#define PG8_SCHED __builtin_amdgcn_sched_barrier(0)
    Unit cur, nxt; int ui = 0;
    if (!S.next(0, cur)) return;
    f32x4 acc[2][2][4][2];
#pragma unroll
    for (int a = 0; a < 2; ++a)
#pragma unroll
        for (int b = 0; b < 2; ++b)
#pragma unroll
            for (int m = 0; m < 4; ++m)
#pragma unroll
                for (int n = 0; n < 2; ++n) acc[a][b][m][n] = (f32x4){0.f, 0.f, 0.f, 0.f};
    bf16x8 At[4][2], B0[2][2], B1[2][2];
    const char* cA = (const char*)g.A + (size_t)cur.pm * tstep; const char* cB = (const char*)g.Bt + (size_t)cur.pn * tstep;
    S.a_ready(cur);
    if constexpr (SP2) {
        PG8_STAGE(PG8_SB(0, 0), cB, voffB); PG8_STAGE(PG8_SB(0, 1), cB + hstep, voffB); PG8_STAGE(PG8_SA(0, 0), cA, voffA); PG8_STAGE(PG8_SA(0, 1), cA + hstep, voffA);
        if (wr == 1) PG8_BAR;
        PG8_WAIT_V(2); PG8_BAR;
        PG8_STAGE(PG8_SB(1, 0), cB + kstep, voffB); PG8_STAGE(PG8_SA(1, 0), cA + kstep, voffA); PG8_STAGE(PG8_SB(1, 1), cB + hstep + kstep, voffB);
        PG8_WAIT_V(6); PG8_BAR;
    } else {
        PG8_STAGE(PG8_SB(0, 0), cB, voffB); PG8_STAGE(PG8_SA(0, 0), cA, voffA); PG8_STAGE(PG8_SB(0, 1), cB + hstep, voffB); PG8_STAGE(PG8_SA(0, 1), cA + hstep, voffA);
        if (wr == 1) PG8_BAR;
        PG8_WAIT_V(4); PG8_BAR;
        PG8_STAGE(PG8_SB(1, 0), cB + kstep, voffB); PG8_STAGE(PG8_SA(1, 0), cA + kstep, voffA); PG8_STAGE(PG8_SB(1, 1), cB + hstep + kstep, voffB);
        PG8_WAIT_V(6); PG8_BAR;
    }
    for (;;) {
        const bool has_next = S.next(ui + 1, nxt);
        const char* nA = has_next ? (const char*)g.A + (size_t)nxt.pm * tstep : cA; const char* nB = has_next ? (const char*)g.Bt + (size_t)nxt.pn * tstep : cB;
        for (int t = 0; t < nt; t += 2) {
            const bool last = (t == nt - 2);
            const char* a1 = cA + (size_t)(t + 1) * kstep;
            const char* a2 = last ? nA : cA + (size_t)(t + 2) * kstep; const char* b2 = last ? nB : cB + (size_t)(t + 2) * kstep;
            const char* a3 = a2 + kstep; const char* b3 = b2 + kstep;
            if (last && has_next) S.a_ready(nxt);
            if constexpr (SP2) {
            PG8_LDB(B0, 0, 0); PG8_LDB(B1, 0, 1); PG8_SCHED; PG8_LDA(At, 0, 0); PG8_STAGE(PG8_SA(1, 1), a1 + hstep, voffA);
            PG8_WAIT_V(8); PG8_WAIT_L(0); PG8_BAR; PG8_MMA(0, 0, At, B0); PG8_MMA(0, 1, At, B1); PG8_BAR; PG8_SCHED;
            PG8_LDA(At, 0, 1); PG8_STAGE(PG8_SB(0, 0), b2, voffB); PG8_STAGE(PG8_SB(0, 1), b2 + hstep, voffB); PG8_STAGE(PG8_SA(0, 0), a2, voffA);
            PG8_WAIT_V(8); PG8_WAIT_L(0); PG8_BAR; PG8_MMA(1, 0, At, B0); PG8_MMA(1, 1, At, B1); PG8_BAR; PG8_SCHED;
            PG8_LDB(B0, 1, 0); PG8_LDB(B1, 1, 1); PG8_SCHED; PG8_LDA(At, 1, 0); PG8_STAGE(PG8_SA(0, 1), a2 + hstep, voffA);
            PG8_WAIT_V(8); PG8_WAIT_L(0); PG8_BAR; PG8_MMA(0, 0, At, B0); PG8_MMA(0, 1, At, B1); PG8_BAR; PG8_SCHED;
            PG8_LDA(At, 1, 1); PG8_STAGE(PG8_SB(1, 0), b3, voffB); PG8_STAGE(PG8_SB(1, 1), b3 + hstep, voffB); PG8_STAGE(PG8_SA(1, 0), a3, voffA);
            PG8_WAIT_V(8); PG8_WAIT_L(0); PG8_BAR; PG8_MMA(1, 0, At, B0); PG8_MMA(1, 1, At, B1); PG8_BAR; PG8_SCHED;
            } else {
            PG8_LDB(B0, 0, 0); PG8_SCHED; PG8_LDA(At, 0, 0); PG8_STAGE(PG8_SA(1, 1), a1 + hstep, voffA);
            PG8_WAIT_L(8); PG8_BAR; PG8_WAIT_L(0); PG8_MMA(0, 0, At, B0); PG8_BAR; PG8_SCHED;
            PG8_LDB(B1, 0, 1); PG8_STAGE(PG8_SB(0, 0), b2, voffB);
            PG8_BAR; PG8_WAIT_L(0); PG8_MMA(0, 1, At, B1); PG8_BAR;
            PG8_LDA(At, 0, 1); PG8_STAGE(PG8_SA(0, 0), a2, voffA);
            PG8_BAR; PG8_WAIT_L(0); PG8_MMA(1, 0, At, B0); PG8_BAR; PG8_SCHED;
            PG8_STAGE(PG8_SB(0, 1), b2 + hstep, voffB);
            PG8_WAIT_V(6); PG8_BAR; PG8_MMA(1, 1, At, B1); PG8_BAR;
            PG8_LDB(B0, 1, 0); PG8_SCHED; PG8_LDA(At, 1, 0); PG8_STAGE(PG8_SA(0, 1), a2 + hstep, voffA);
            PG8_WAIT_L(8); PG8_BAR; PG8_WAIT_L(0); PG8_MMA(0, 0, At, B0); PG8_BAR; PG8_SCHED;
            PG8_LDB(B1, 1, 1); PG8_STAGE(PG8_SB(1, 0), b3, voffB);
            PG8_BAR; PG8_WAIT_L(0); PG8_MMA(0, 1, At, B1); PG8_BAR;
            PG8_LDA(At, 1, 1); PG8_STAGE(PG8_SA(1, 0), a3, voffA);
            PG8_BAR; PG8_WAIT_L(0); PG8_MMA(1, 0, At, B0); PG8_BAR; PG8_SCHED;
            PG8_STAGE(PG8_SB(1, 1), b3 + hstep, voffB);
            PG8_WAIT_V(6); PG8_BAR; PG8_MMA(1, 1, At, B1); PG8_BAR;
            }
        }
        if constexpr (ALIGN_EPI) { if (wr == 0) PG8_BAR; }
        if constexpr (!Epi::AFTER_DRAIN) { E(acc, cur, wr, wc, fr, fq); S.done(cur); }
        if (!has_next) break;
#pragma unroll
        for (int a = 0; a < 2; ++a)
#pragma unroll
            for (int b = 0; b < 2; ++b)
#pragma unroll
                for (int m = 0; m < 4; ++m)
#pragma unroll
                    for (int n = 0; n < 2; ++n) acc[a][b][m][n] = (f32x4){0.f, 0.f, 0.f, 0.f};
        cur = nxt; cA = nA; cB = nB; ++ui;
        if constexpr (ALIGN_EPI) { if (wr == 1) PG8_BAR; }
    }
    PG8_WAIT_V(0);
    if constexpr (!ALIGN_EPI) { if (wr == 0) PG8_BAR; }
    PG8_BAR;
    if constexpr (Epi::AFTER_DRAIN) { E.fused(acc, cur, wr, wc, fr, fq, lds, wid, lane); S.done(cur); }
#undef PG8_SA
#undef PG8_SB
#undef PG8_STAGE
#undef PG8_LDA
#undef PG8_LDB
#undef PG8_MMA
#undef PG8_WAIT_V
#undef PG8_WAIT_L
#undef PG8_BAR
#undef PG8_SCHED
}
}

#include <hip/hip_bf16.h>
#include <cmath>
namespace attn_body {
using bf16=__hip_bfloat16;
using bf16x8=__attribute__((ext_vector_type(8)))short;
using s16x4=__attribute__((ext_vector_type(4)))short;
using f32x16=__attribute__((ext_vector_type(16)))float;
using u32x4=__attribute__((ext_vector_type(4)))unsigned;
constexpr int BATCH=2,NHEAD=16,SEQ=16384,D=64,DM=NHEAD*D;
constexpr int NW=8,QBLK=32,QB=QBLK*NW,KVBLK=64,NQB=SEQ/QB;
constexpr int ATTN_PITCH=DM, ATTN_UNIT_ROWS=QB;
__device__ __forceinline__ int crow(int r,int hi){return (r&3)+8*(r>>2)+4*hi;}
#define SBAR() __builtin_amdgcn_sched_barrier(0)
__device__ __forceinline__ void cmask(f32x16&p0,f32x16&p1,int jb,int qrel,int hi){
  const float NEG=-INFINITY; int kb=64*jb+4*hi;
  #pragma unroll
  for(int r=0;r<16;++r){int kv=kb+(r&3)+8*(r>>2); if(kv>qrel)p0[r]=NEG; if(kv+32>qrel)p1[r]=NEG;}
}

constexpr int NSLOT=3, SLOTB=8192;
constexpr int LDS_K=0, LDS_V=NSLOT*SLOTB, LDS_WS=2*NSLOT*SLOTB, LDS_OST=LDS_WS+NW*64*4, LDS_BYTES=LDS_OST+NW*4096;
constexpr float C2=0.125f*1.4426950408889634f;
__device__ __forceinline__ void glds16(const void*gsrc,unsigned lds_dst){unsigned keep;
  asm volatile("s_mov_b32 %0, m0\n\ts_mov_b32 m0, %2\n\ts_nop 0\n\tglobal_load_lds_dwordx4 %1, off\n\ts_mov_b32 m0, %0":"=&s"(keep):"v"(gsrc),"s"(lds_dst):"memory");}
__device__ __forceinline__ float max3f(float a,float b,float c){float r;asm("v_max3_f32 %0, %1, %2, %3":"=v"(r):"v"(a),"v"(b),"v"(c));return r;}
__device__ __forceinline__ float max2f(float a,float b){float r;asm("v_max_f32_e32 %0, %1, %2":"=v"(r):"v"(a),"v"(b));return r;}
__device__ __forceinline__ float fadd_s(float a,float b){float r;asm("v_add_f32_e32 %0, %1, %2":"=v"(r):"v"(a),"v"(b));return r;}
__device__ __forceinline__ float fsub_s(float a,float b){float r;asm("v_sub_f32_e32 %0, %1, %2":"=v"(r):"v"(a),"v"(b));return r;}
typedef float f32x2_t __attribute__((ext_vector_type(2))); typedef __bf16 bf16x2_t __attribute__((ext_vector_type(2)));
__device__ __forceinline__ unsigned cvtpk_s(float lo,float hi){f32x2_t v={lo,hi};bf16x2_t b=__builtin_convertvector(v,bf16x2_t);return __builtin_bit_cast(unsigned,b);}
#define WAIT_BAR(N) asm volatile("s_waitcnt vmcnt(" #N ") lgkmcnt(0)\n\ts_barrier":::"memory")

__device__ __forceinline__ void qkt(f32x16&p0,f32x16&p1,const char*Kslot,const bf16x8*qr,const f32x16&negm,int r32,int hi){
  const char*kb=Kslot+hi*1024+r32*16;
  #pragma unroll
  for(int d0=0;d0<4;++d0){
    const bf16x8 b0=*reinterpret_cast<const bf16x8*>(kb+d0*2048);
    const bf16x8 b1=*reinterpret_cast<const bf16x8*>(kb+d0*2048+512);
    if(d0==0){p0=__builtin_amdgcn_mfma_f32_32x32x16_bf16(b0,qr[0],negm,0,0,0);p1=__builtin_amdgcn_mfma_f32_32x32x16_bf16(b1,qr[0],negm,0,0,0);}
    else{p0=__builtin_amdgcn_mfma_f32_32x32x16_bf16(b0,qr[d0],p0,0,0,0);p1=__builtin_amdgcn_mfma_f32_32x32x16_bf16(b1,qr[d0],p1,0,0,0);}}
}
typedef __attribute__((address_space(3))) const char* lds_cptr;
typedef short v4i16_t __attribute__((ext_vector_type(4)));
__device__ __forceinline__ void kload8(bf16x8*kf,lds_cptr kp){
  kf[0]=*(const __attribute__((address_space(3))) bf16x8*)(kp);      kf[1]=*(const __attribute__((address_space(3))) bf16x8*)(kp+512);
  kf[2]=*(const __attribute__((address_space(3))) bf16x8*)(kp+2048); kf[3]=*(const __attribute__((address_space(3))) bf16x8*)(kp+2560);
  kf[4]=*(const __attribute__((address_space(3))) bf16x8*)(kp+4096); kf[5]=*(const __attribute__((address_space(3))) bf16x8*)(kp+4608);
  kf[6]=*(const __attribute__((address_space(3))) bf16x8*)(kp+6144); kf[7]=*(const __attribute__((address_space(3))) bf16x8*)(kp+6656);
}
__device__ __forceinline__ void kload2(bf16x8*kf,lds_cptr kp,int j){ kf[2*j]=*(const __attribute__((address_space(3))) bf16x8*)(kp+j*2048); kf[2*j+1]=*(const __attribute__((address_space(3))) bf16x8*)(kp+j*2048+512); }
__device__ __forceinline__ s16x4 vtr(lds_cptr p){ return __builtin_bit_cast(s16x4,__builtin_amdgcn_ds_read_tr16_b64_v4i16((__attribute__((address_space(3))) v4i16_t*)p)); }
__device__ __forceinline__ float rowmax(const f32x16&p0,const f32x16&p1){
  float a=max3f(p0[0],p0[1],p1[0]),b=max3f(p0[2],p0[3],p1[1]);a=max3f(a,p1[2],p1[3]);
  #pragma unroll
  for(int r=4;r<16;r+=4){a=max3f(a,p0[r],p0[r+1]);b=max3f(b,p0[r+2],p0[r+3]);a=max3f(a,p1[r],p1[r+1]);b=max3f(b,p1[r+2],p1[r+3]);}
  const float m=max2f(a,b);
  auto rr=__builtin_amdgcn_permlane32_swap(__float_as_uint(m),__float_as_uint(m),false,false);
  return max2f(__uint_as_float(rr[0]),__uint_as_float(rr[1]));
}
__device__ __forceinline__ void pv(f32x16*o,int vb,bf16x8 pa0,bf16x8 pa1,bf16x8 pa2,bf16x8 pa3){
  #pragma unroll
  for(int d0=0;d0<2;++d0){s16x4 lo[4],hi[4];
    #pragma unroll
    for(int ks=0;ks<4;++ks){
      asm volatile("ds_read_b64_tr_b16 %0,%1 offset:%c2":"=&v"(lo[ks]):"v"(vb),"i"(d0*4096+ks*1024):"memory");
      asm volatile("ds_read_b64_tr_b16 %0,%1 offset:%c2":"=&v"(hi[ks]):"v"(vb),"i"(d0*4096+ks*1024+512):"memory");}
    asm volatile("s_waitcnt lgkmcnt(0)":::"memory");SBAR();
    #define PK(k) (bf16x8){lo[k][0],lo[k][1],lo[k][2],lo[k][3],hi[k][0],hi[k][1],hi[k][2],hi[k][3]}
    o[d0]=__builtin_amdgcn_mfma_f32_32x32x16_bf16(pa0,PK(0),o[d0],0,0,0);
    o[d0]=__builtin_amdgcn_mfma_f32_32x32x16_bf16(pa1,PK(1),o[d0],0,0,0);
    o[d0]=__builtin_amdgcn_mfma_f32_32x32x16_bf16(pa2,PK(2),o[d0],0,0,0);
    o[d0]=__builtin_amdgcn_mfma_f32_32x32x16_bf16(pa3,PK(3),o[d0],0,0,0);
    #undef PK
  }
}

#ifndef ATTN_STORE16
#define ATTN_STORE16(p,v) (*(u32x4*)(p)=(v))
#endif
template<int THRL> __device__ __forceinline__ void attn_unit(int b,int cq,int cv,int qb,const bf16*Q,const bf16*__restrict__ K,const bf16*__restrict__ V,bf16*O,char*shm){
  int tid_=threadIdx.x; asm volatile("":"+v"(tid_)); const int tid=tid_,lane=tid&63,r32=lane&31,hi=lane>>5; const int wid=__builtin_amdgcn_readfirstlane(tid>>6);
  const long rowbase=(long)b*SEQ; const int q0=qb*QB;
  const bf16*Qw=Q+(rowbase+q0+wid*QBLK)*DM+cq;
  const bf16*Kh=K+rowbase*DM+cq,*Vh=V+rowbase*DM+cv;
  const unsigned lds0=(unsigned)(uintptr_t)shm;
  float*wsf=(float*)(shm+LDS_WS)+wid*64;
  const bf16*ksrc=Kh+(long)lane*DM+wid*8;
  const bf16*vsrc=Vh+(long)(16*(wid&3)+(lane>>2))*DM+(wid>>2)*32+(lane&3)*8;
  const unsigned kdst=lds0+LDS_K+wid*1024, vdst=lds0+LDS_V+wid*1024;
  #define DMA_K(t,slot) glds16(ksrc+(long)(t)*KVBLK*DM,(unsigned)__builtin_amdgcn_readfirstlane(kdst+(slot)))
  #define DMA_V(t,slot) glds16(vsrc+(long)(t)*KVBLK*DM,(unsigned)__builtin_amdgcn_readfirstlane(vdst+(slot)))
  const int vb0=(int)(lds0+LDS_V)+((lane>>4)&1)*32+(lane&3)*8+(4*hi+((lane&15)>>2))*64;
  const char*Kbase=shm+LDS_K; bf16x8 kf[8];
  const lds_cptr shm3=(lds_cptr)shm; const lds_cptr kp0=shm3+LDS_K+hi*1024+r32*16; const lds_cptr vp0=shm3+LDS_V+((lane>>4)&1)*32+(lane&3)*8+(4*hi+((lane&15)>>2))*64;
  const int NT=(q0+QB)/KVBLK;
  DMA_K(0,0);DMA_V(0,0);DMA_K(1,SLOTB);
  bf16x8 qr[4];
  #pragma unroll
  for(int d0=0;d0<4;++d0)qr[d0]=*reinterpret_cast<const bf16x8*>(&Qw[(long)r32*DM+d0*16+hi*8]);
  float mhat=0.f,l_reg=0.f;f32x16 o[2];o[0]=f32x16{};o[1]=f32x16{};f32x16 negm=f32x16{};asm volatile("":"+v"(negm));
  const int qrel=wid*QBLK+r32;
  #define CMASK(P0,P1,t) do{int jb_=(t)-(NT-4); if(jb_>=0)cmask(P0,P1,jb_,qrel,hi);}while(0)
  bool resc=false;
  #define START(P0,P1) do{ const float rm=rowmax(P0,P1); resc=false; \
    { const float dl=rm; mhat=fadd_s(mhat,dl); \
      _Pragma("unroll") for(int r=0;r<16;++r){P0[r]=fsub_s(P0[r],dl);P1[r]=fsub_s(P1[r],dl);} \
      _Pragma("unroll") for(int r=0;r<16;++r)negm[r]=-mhat; asm volatile("":"+v"(negm)); } \
    _Pragma("unroll") for(int r=0;r<16;++r)P0[r]=__builtin_amdgcn_exp2f(P0[r]); }while(0)
  #define RESC() do{ if(resc){ asm volatile("s_waitcnt lgkmcnt(0)":::"memory"); \
      _Pragma("unroll") for(int d_=0;d_<2;++d_) _Pragma("unroll") for(int r=0;r<16;++r)o[d_][r]*=wsf[crow(r,hi)]; } }while(0)
  f32x16 pA0,pA1,pB0,pB1;
  int sl_prev=0,sl_cur=0,sl_next=SLOTB;
  #define ROT() do{sl_prev=sl_cur;sl_cur=sl_next;sl_next=(sl_next==(NSLOT-1)*SLOTB)?0:sl_next+SLOTB;}while(0)
  DMA_K(2,2*SLOTB);
  WAIT_BAR(3);
  qkt(pA0,pA1,Kbase,qr,negm,r32,hi);asm volatile("s_nop 15\n\ts_nop 7":"+v"(pA0),"+v"(pA1));CMASK(pA0,pA1,0);
  START(pA0,pA1);
  _Pragma("unroll") for(int r=0;r<16;++r)pA1[r]=__builtin_amdgcn_exp2f(pA1[r]);
  WAIT_BAR(0);
  DMA_K(3,0);DMA_V(1,SLOTB);
  ROT();
  kload8(kf,kp0+sl_cur);
  WAIT_BAR(2);
  s16x4 vlo[8],vhi[8]; u32x4 pw0,pw1,pw2,pw3;
  #define PKW(P,B) cvtpk_s(P[B],P[B+1])
  #define PAF(k) __builtin_bit_cast(bf16x8,pw##k)
  #define VFR(i) (bf16x8){vlo[i][0],vlo[i][1],vlo[i][2],vlo[i][3],vhi[i][0],vhi[i][1],vhi[i][2],vhi[i][3]}
  #define PIN(x) asm volatile("":"+v"(x))
  #define MX3(a,b,c) __builtin_fmaxf(__builtin_fmaxf((a),(b)),(c))
  #define GAPA(MF,A0,A1,A2,A3,W0,W1,PW) do{ MF; sacc+=A0; sacc+=A1; sacc+=A2; sacc+=A3; PIN(sacc); W0; W1; PIN(PW); SBAR(); }while(0)
  #define EX(v) __builtin_amdgcn_exp2f(v)
  #define GAPB(MF,X,B) do{ MF; X[B]=EX(X[B]); X[B+1]=EX(X[B+1]); X[B+2]=EX(X[B+2]); X[B+3]=EX(X[B+3]); PIN(X); SBAR(); }while(0)
  #define VRD(i) do{ vlo[i]=vtr(vp_+(((i)>>2)*4096+((i)&3)*1024)); vhi[i]=vtr(vp_+(((i)>>2)*4096+((i)&3)*1024+512)); }while(0)
  #define KRD(G,j) do{ if(G){ kload2(kf,kp0+sl_next,j); SBAR(); } }while(0)
  #define STEP(C0,C1,P0,P1,t,GK,GV,GL) do{ SBAR(); \
    const lds_cptr vp_=vp0+sl_prev; \
    VRD(0); SBAR(); float sacc=(P0[0]+P0[1]); \
    GAPA(C0=__builtin_amdgcn_mfma_f32_32x32x16_bf16(kf[0],qr[0],negm,0,0,0), P0[2],P0[3],P0[4],P0[5],     pw0[0]=PKW(P0,0), pw0[1]=PKW(P0,2), pw0); \
    VRD(4); SBAR(); GAPA(C1=__builtin_amdgcn_mfma_f32_32x32x16_bf16(kf[1],qr[0],negm,0,0,0), P0[6],P0[7],P0[8],P0[9],     pw0[2]=PKW(P0,4), pw0[3]=PKW(P0,6), pw0); \
    VRD(1); SBAR(); GAPA(C0=__builtin_amdgcn_mfma_f32_32x32x16_bf16(kf[2],qr[1],C0,0,0,0),   P0[10],P0[11],P0[12],P0[13], pw1[0]=PKW(P0,8), pw1[1]=PKW(P0,10), pw1); \
    VRD(5); SBAR(); GAPA(C1=__builtin_amdgcn_mfma_f32_32x32x16_bf16(kf[3],qr[1],C1,0,0,0),   P0[14],P0[15],P1[0],P1[1],   pw1[2]=PKW(P0,12),pw1[3]=PKW(P0,14), pw1); \
    VRD(2); SBAR(); GAPA(C0=__builtin_amdgcn_mfma_f32_32x32x16_bf16(kf[4],qr[2],C0,0,0,0),   P1[2],P1[3],P1[4],P1[5],     pw2[0]=PKW(P1,0), pw2[1]=PKW(P1,2), pw2); \
    VRD(6); SBAR(); GAPA(C1=__builtin_amdgcn_mfma_f32_32x32x16_bf16(kf[5],qr[2],C1,0,0,0),   P1[6],P1[7],P1[8],P1[9],     pw2[2]=PKW(P1,4), pw2[3]=PKW(P1,6), pw2); \
    VRD(3); SBAR(); GAPA(C0=__builtin_amdgcn_mfma_f32_32x32x16_bf16(kf[6],qr[3],C0,0,0,0),   P1[10],P1[11],P1[12],P1[13], pw3[0]=PKW(P1,8), pw3[1]=PKW(P1,10), pw3); \
    VRD(7); SBAR(); GAPA(C1=__builtin_amdgcn_mfma_f32_32x32x16_bf16(kf[7],qr[3],C1,0,0,0),   P1[14],P1[15],0.f,0.f,       pw3[2]=PKW(P1,12),pw3[3]=PKW(P1,14), pw3); \
    l_reg+=sacc; \
    if(GK){DMA_K((t)+3,sl_cur);} if(GV){DMA_V((t)+1,sl_next);} \
    CMASK(C0,C1,t); \
    { float a=MX3(C0[0],C0[1],C1[0]),b=MX3(C0[2],C0[3],C1[1]); a=MX3(a,C1[2],C1[3]); \
      _Pragma("unroll") for(int r=4;r<16;r+=4){a=MX3(a,C0[r],C0[r+1]);b=MX3(b,C0[r+2],C0[r+3]);a=MX3(a,C1[r],C1[r+1]);b=MX3(b,C1[r+2],C1[r+3]);} \
      float rm=__builtin_fmaxf(a,b); { auto rr=__builtin_amdgcn_permlane32_swap(__float_as_uint(rm),__float_as_uint(rm),false,false); rm=__builtin_fmaxf(__uint_as_float(rr[0]),__uint_as_float(rr[1])); } \
      resc=false; \
      if(__builtin_expect(__any(rm>(float)THRL),0)){ const float dl=__builtin_fmaxf(rm,0.f); mhat+=dl; \
        _Pragma("unroll") for(int r=0;r<16;++r){C0[r]-=dl;C1[r]-=dl;} \
        _Pragma("unroll") for(int r=0;r<16;++r)negm[r]=-mhat; asm volatile("":"+v"(negm)); \
        const float f=__builtin_amdgcn_exp2f(-dl); l_reg*=f; if(hi==0)wsf[r32]=f; resc=true; } } \
    SBAR(); \
    GAPB(o[0]=__builtin_amdgcn_mfma_f32_32x32x16_bf16(PAF(0),VFR(0),o[0],0,0,0), C0,0); \
    GAPB(o[1]=__builtin_amdgcn_mfma_f32_32x32x16_bf16(PAF(0),VFR(4),o[1],0,0,0), C0,4); \
    KRD(GL,0); GAPB(o[0]=__builtin_amdgcn_mfma_f32_32x32x16_bf16(PAF(1),VFR(1),o[0],0,0,0), C0,8); \
    KRD(GL,1); GAPB(o[1]=__builtin_amdgcn_mfma_f32_32x32x16_bf16(PAF(1),VFR(5),o[1],0,0,0), C0,12); \
    KRD(GL,2); GAPB(o[0]=__builtin_amdgcn_mfma_f32_32x32x16_bf16(PAF(2),VFR(2),o[0],0,0,0), C1,0); \
    KRD(GL,3); GAPB(o[1]=__builtin_amdgcn_mfma_f32_32x32x16_bf16(PAF(2),VFR(6),o[1],0,0,0), C1,4); \
    GAPB(o[0]=__builtin_amdgcn_mfma_f32_32x32x16_bf16(PAF(3),VFR(3),o[0],0,0,0), C1,8); \
    GAPB(o[1]=__builtin_amdgcn_mfma_f32_32x32x16_bf16(PAF(3),VFR(7),o[1],0,0,0), C1,12); \
    }while(0)
  int t=1;
  #undef CMASK
  #define CMASK(P0,P1,t) do{}while(0)
  for(;t+5<NT;t+=2){
    STEP(pB0,pB1,pA0,pA1,t,true,true,true);     WAIT_BAR(2); RESC(); ROT();
    STEP(pA0,pA1,pB0,pB1,t+1,true,true,true);   WAIT_BAR(2); RESC(); ROT();
  }
  #undef CMASK
  #define CMASK(P0,P1,t) do{int jb_=(t)-(NT-4); if(jb_>=0)cmask(P0,P1,jb_,qrel,hi);}while(0)
  #define ENDW(tt) do{ if((tt)+3<NT){WAIT_BAR(2);} else if((tt)+2<NT){WAIT_BAR(1);} else {WAIT_BAR(0);} }while(0)
  for(;t+1<NT;t+=2){
    STEP(pB0,pB1,pA0,pA1,t,(t+3<NT),(t+1<NT),(t+1<NT));       ENDW(t);   RESC(); ROT();
    STEP(pA0,pA1,pB0,pB1,t+1,(t+4<NT),(t+2<NT),(t+2<NT));     ENDW(t+1); RESC(); ROT();
  }
  STEP(pB0,pB1,pA0,pA1,NT-1,false,false,false); RESC();
  { float sacc=pB0[0]+pB0[1]; _Pragma("unroll") for(int r=2;r<16;++r)sacc+=pB0[r]; _Pragma("unroll") for(int r=0;r<16;++r)sacc+=pB1[r]; l_reg+=sacc;
    pw0=(u32x4){PKW(pB0,0),PKW(pB0,2),PKW(pB0,4),PKW(pB0,6)};pw1=(u32x4){PKW(pB0,8),PKW(pB0,10),PKW(pB0,12),PKW(pB0,14)};pw2=(u32x4){PKW(pB1,0),PKW(pB1,2),PKW(pB1,4),PKW(pB1,6)};pw3=(u32x4){PKW(pB1,8),PKW(pB1,10),PKW(pB1,12),PKW(pB1,14)};
    SBAR(); pv(o,vb0+sl_cur,PAF(0),PAF(1),PAF(2),PAF(3)); }
  #undef PKW
  #undef PAF
  #undef VFR
  #undef PIN
  #undef MX3
  #undef GAPA
  #undef GAPB
  #undef EX
  #undef VRD
  #undef KRD
  #undef STEP
  #undef ENDW
  {auto rr=__builtin_amdgcn_permlane32_swap(__float_as_uint(l_reg),__float_as_uint(l_reg),false,false);l_reg=__uint_as_float(rr[0])+__uint_as_float(rr[1]);}
  if(hi==0)wsf[32+r32]=l_reg;asm volatile("s_waitcnt lgkmcnt(0)":::"memory");
  float rli[16];
  #pragma unroll
  for(int r=0;r<16;++r)rli[r]=__builtin_amdgcn_rcpf(wsf[32+crow(r,hi)]);
  bf16*Ow=O+(rowbase+q0+wid*QBLK)*DM+cv;
  { bf16*stg=(bf16*)(shm+LDS_OST)+wid*2048;
    #pragma unroll
    for(int r=0;r<16;++r){const int orow=crow(r,hi);
      #pragma unroll
      for(int d0=0;d0<2;++d0)stg[orow*64+d0*32+r32]=__float2bfloat16(o[d0][r]*rli[r]);}
    asm volatile("s_waitcnt lgkmcnt(0)":::"memory");
    #pragma unroll
    for(int i=0;i<4;++i){const int row=i*8+(lane>>3),ch=lane&7; const u32x4 v=*(const u32x4*)(stg+row*64+ch*8); ATTN_STORE16(Ow+(long)row*DM+ch*8,v);} }
  asm volatile("s_waitcnt lgkmcnt(0)\n\ts_barrier":::"memory");
  #undef DMA_K
  #undef DMA_V
  #undef CMASK
  #undef START
  #undef RESC
  #undef ROT
}
constexpr int ATTN_LDS_BYTES=LDS_BYTES;
struct AttnTensors { const bf16* Q; const bf16* K; const bf16* V; bf16* O0; bf16* O1; };
template<int THRL> __device__ __forceinline__ void attn_phase(char*lds,const AttnTensors&T,int vcu,int G){
  for(int v=vcu;v<256;v+=G){
    const int e=v>>2,s=v&3; const int b=e>>5,rem=e&31,h=rem>>2,m=(rem>>1)&1,vh=rem&1;
    const int cq=(2*h+m)*64,cv=(2*h+vh)*64; bf16*O=m?T.O1:T.O0;
    for(int i=0;i<16;++i){ const int j=i>>1; const int qb=(i&1)?(8*j+7-s):(8*j+s); attn_unit<THRL>(b,cq,cv,qb,T.Q,T.K,T.V,O,lds); }
  }
}
#undef SBAR
#undef WAIT_BAR
}

#define GAS __attribute__((address_space(1)))
#define LAS __attribute__((address_space(3)))
typedef unsigned short bf16;
typedef unsigned v4u __attribute__((ext_vector_type(4)));
typedef float f32x4 __attribute__((ext_vector_type(4)));
typedef short bf16x8 __attribute__((ext_vector_type(8)));
typedef GAS unsigned gu32;
typedef GAS unsigned long long gu64;
#define RLX_AGENT __ATOMIC_RELAXED, __HIP_MEMORY_SCOPE_AGENT
#define LDS_WAIT() asm volatile("s_waitcnt lgkmcnt(0)" ::: "memory")
#define VM_WAIT() asm volatile("s_waitcnt vmcnt(0)" ::: "memory")
__device__ __forceinline__ unsigned long long rt() { return __builtin_amdgcn_s_memrealtime(); }

constexpr int NWAVES = 8;
constexpr int BATCH = 2, SEQ = 16384, D = 1024, M = BATCH * SEQ;
constexpr size_t MiB = 1u << 20;
constexpr size_t WS_ROPE_C = 1 * MiB, WS_ROPE_S = 2 * MiB, WS_S = 3 * MiB, WS_BIAS = 5 * MiB, WS_W = 6 * MiB, WS_U = 32 * MiB, UNIT = 64 * MiB, WS_H = WS_U + 7 * UNIT, WS_END = WS_H + 16 * MiB;
constexpr size_t W_FOLD = 0, W_UP = 17 * MiB, W_OUT = 19 * MiB;
constexpr size_t W_PROJ = 0, W_BOUT = 8 * MiB;
constexpr int LDS_BYTES = 147456;
constexpr float C2F = 0.125f * 1.4426950408889634f;

typedef _Float16 h16x4 __attribute__((ext_vector_type(4)));
typedef unsigned u32x2 __attribute__((ext_vector_type(2)));
typedef float f32x2 __attribute__((ext_vector_type(2)));
__device__ __forceinline__ unsigned f2bf(float f) { unsigned u = __builtin_bit_cast(unsigned, f); return (u + 0x7fffu + ((u >> 16) & 1u)) >> 16; }
__device__ __forceinline__ unsigned pk2(float lo, float hi) { return f2bf(lo) | (f2bf(hi) << 16); }
__device__ __forceinline__ float bflo(unsigned w) { return __uint_as_float(w << 16); }
__device__ __forceinline__ float bfhi(unsigned w) { return __uint_as_float(w & 0xffff0000u); }
__device__ __forceinline__ float wave_sum(float v) {
#pragma unroll
    for (int o = 1; o < 64; o <<= 1) v += __shfl_xor(v, o);
    return v;
}
template <int CTRL> __device__ __forceinline__ float dpp_mov(float x) { return __builtin_bit_cast(float, __builtin_amdgcn_update_dpp(0, __builtin_bit_cast(int, x), CTRL, 0xf, 0xf, false)); }
__device__ __forceinline__ float allreduce16(float x) { x += dpp_mov<0x128>(x); x += dpp_mov<0x124>(x); x += dpp_mov<0x122>(x); x += dpp_mov<0x121>(x); return x; }

__device__ __forceinline__ void conv_tile(const float* src, int ldsrc, int k0s, int n0s, int kvalid, const float* sc, int smode, bf16* dst, int pitch, int n0d, int k0d, LAS float* scr, int lane) {
#pragma unroll 8
    for (int i = 0; i < 32; ++i) { const int kk = 2 * i + (lane >> 5), n = lane & 31; float v = 0.f;
        if (kk < kvalid) { v = src[(size_t)(k0s + kk) * ldsrc + n0s + n]; if (smode) { const float s = sc[k0s + kk]; v *= (smode == 1) ? s : (1.0f - s); } }
        scr[kk * 33 + n] = v; }
    LDS_WAIT(); asm volatile("" ::: "memory");
    const int c = lane & 7;
#pragma unroll
    for (int j = 0; j < 4; ++j) { const int n = (lane >> 3) + 8 * j; const LAS float* s = scr + (8 * c) * 33 + n;
        v4u o; o.x = pk2(s[0 * 33], s[1 * 33]); o.y = pk2(s[2 * 33], s[3 * 33]); o.z = pk2(s[4 * 33], s[5 * 33]); o.w = pk2(s[6 * 33], s[7 * 33]);
        *(v4u*)(dst + (size_t)(n0d + n) * pitch + k0d + 8 * c) = o; }
    LDS_WAIT(); asm volatile("" ::: "memory");
}

struct In {
    const float* x; const int* pos; const float *a_norm, *a_mu, *a_w_in, *a_w0, *a_w1, *a_w2, *a_a0, *a_a1, *a_a2, *a_v0, *a_v1, *a_v2, *a_k_k, *a_k_a, *a_r_k, *a_ln_w, *a_ln_b, *a_w_out;
    const float *kv_norm, *w_kv, *b_norm, *b_w_in, *b_lq1, *b_lk1, *b_lq2, *b_lk2, *b_subln, *b_w_out, *final_norm;
};

__device__ __forceinline__ void conv_rwkv(const In& I, int l, unsigned char* wreg, float* bias3, LAS float* scr, int gw, int NGW, int lane) {
    if (gw < 48) { const int i = gw * 64 + lane; const int t = i >> 10, c = i & 1023; bias3[i] = (t == 0) ? I.a_w0[l * 1024 + c] : (t == 1) ? I.a_a0[l * 1024 + c] : I.a_v0[c]; }
    bf16* Wf = (bf16*)(wreg + W_FOLD); bf16* Wu = (bf16*)(wreg + W_UP); bf16* Wo = (bf16*)(wreg + W_OUT);
    const int NUPB = (l == 0 ? 2048 : 3072) / 32;
    const int I_F = 136 * 32, I_U = NUPB * 4, I_O = 32 * 16;
    for (int it = gw; it < I_F + I_U + I_O; it += NGW) {
        int r = it;
        if (r < I_F) { const int nb = r >> 5, kb = r & 31; const int n0d = nb * 32, k0d = kb * 64, half = kb >> 4, k0s = (kb & 15) * 64;
            const float* mu = I.a_mu + (size_t)l * 6 * 1024;
            if (n0d < 4096) { const int p = n0d >> 10; conv_tile(I.a_w_in + (size_t)(l * 4 + p) * 1024 * 1024, 1024, k0s, n0d & 1023, 64, mu + p * 1024, half ? 1 : 2, Wf, 2048, n0d, k0d, scr, lane); }
            else { const int c0 = n0d - 4096;
                if (c0 < 64) conv_tile(I.a_w1 + (size_t)l * 1024 * 64, 64, k0s, c0, 64, mu + 4 * 1024, half ? 1 : 2, Wf, 2048, n0d, k0d, scr, lane);
                else if (c0 < 128) conv_tile(I.a_a1 + (size_t)l * 1024 * 64, 64, k0s, c0 - 64, 64, mu + 5 * 1024, half ? 1 : 2, Wf, 2048, n0d, k0d, scr, lane);
                else if (c0 < 160 && l == 1) conv_tile(I.a_v1, 32, k0s, 0, 64, mu + 2 * 1024, half ? 1 : 2, Wf, 2048, n0d, k0d, scr, lane);
                else conv_tile(I.a_w1, 64, 0, 0, 0, mu, 0, Wf, 2048, n0d, k0d, scr, lane); }
            continue; }
        r -= I_F;
        if (r < I_U) { const int nb = r >> 2, kb = r & 3; const int n0d = nb * 32, k0d = kb * 64, t = n0d >> 10;
            if (kb == t) { if (t == 0) conv_tile(I.a_w2 + (size_t)l * 64 * 1024, 1024, 0, n0d, 64, I.a_mu, 0, Wu, 256, n0d, k0d, scr, lane);
                else if (t == 1) conv_tile(I.a_a2 + (size_t)l * 64 * 1024, 1024, 0, n0d - 1024, 64, I.a_mu, 0, Wu, 256, n0d, k0d, scr, lane);
                else conv_tile(I.a_v2, 1024, 0, n0d - 2048, 32, I.a_mu, 0, Wu, 256, n0d, k0d, scr, lane); }
            else conv_tile(I.a_w2, 1024, 0, 0, 0, I.a_mu, 0, Wu, 256, n0d, k0d, scr, lane);
            continue; }
        r -= I_U;
        { const int nb = r >> 4, kb = r & 15; conv_tile(I.a_w_out + (size_t)l * 1024 * 1024, 1024, kb * 64, nb * 32, 64, I.a_mu, 0, Wo, 1024, nb * 32, kb * 64, scr, lane); }
    }
}
__device__ __forceinline__ void conv_attn(const In& I, int j, unsigned char* wreg, LAS float* scr, int gw, int NGW, int lane) {
    bf16* Wp = (bf16*)(wreg + W_PROJ); bf16* Wo = (bf16*)(wreg + W_BOUT);
    const int NPB = (j == 0 ? 4096 : 2048) / 32;
    const int I_P = NPB * 16, I_O = 32 * 16;
    for (int it = gw; it < I_P + I_O; it += NGW) {
        int r = it;
        if (r < I_P) { const int nb = r >> 4, kb = r & 15; const int n0d = nb * 32, k0 = kb * 64;
            if (j == 0) { if (n0d < 2048) conv_tile(I.w_kv, 2048, k0, n0d, 64, I.kv_norm, 1, Wp, 1024, n0d, k0, scr, lane);
                else conv_tile(I.b_w_in, 2048, k0, n0d - 2048, 64, I.b_norm, 1, Wp, 1024, n0d, k0, scr, lane); }
            else conv_tile(I.b_w_in + (size_t)1024 * 2048, 2048, k0, n0d, 64, I.b_norm + 1024, 1, Wp, 1024, n0d, k0, scr, lane);
            continue; }
        r -= I_P;
        { const int nb = r >> 4, kb = r & 15; conv_tile(I.b_w_out + (size_t)j * 1024 * 1024, 1024, kb * 64, nb * 32, 64, I.kv_norm, 0, Wo, 1024, nb * 32, kb * 64, scr, lane); }
    }
}

__device__ __forceinline__ void rope_tables(const int* pos, float* rc, float* rs, int gtid, int nthr) {
    for (int idx = gtid; idx < M * 8; idx += nthr) { const int m = idx >> 3, i = idx & 7;
        const float inv = (i == 0) ? 1.0f : (i == 1) ? 0.1939227432012558f : (i == 2) ? 0.03760603070259094f : (i == 3) ? 0.007292664609849453f : (i == 4) ? 0.0014142135623842478f : (i == 5) ? 0.00027424818836152554f : (i == 6) ? 5.3182957344688475e-05f : 1.0313385246263351e-05f;
        const float ang = (float)pos[m] * inv;
        const double x = (double)ang; const double k = __builtin_rint(x * 0.15915494309189535); const double r = x - k * 6.283185307179586476925;
        const double r2 = r * r; double sn = 0.0, cs = 0.0;
#pragma unroll
        for (int t = 12; t >= 1; --t) { sn = (1.0 - sn) * r2 / (double)((2 * t) * (2 * t + 1)); cs = (1.0 - cs) * r2 / (double)((2 * t - 1) * (2 * t)); }
        rs[idx] = (float)(r * (1.0 - sn)); rc[idx] = (float)(1.0 - cs); }
}

__device__ __forceinline__ void pre_rwkv(const float* x, const float* g, bf16* XN2, int gw, int NGW, int lane) {
    f32x4 gv[4];
#pragma unroll
    for (int j = 0; j < 4; ++j) gv[j] = *((const f32x4*)g + lane + 64 * j);
    for (int c = gw; c < M / 16; c += NGW) { const int m0 = c * 16;
        f32x4 prev[4];
#pragma unroll
        for (int j = 0; j < 4; ++j) prev[j] = (f32x4){0.f, 0.f, 0.f, 0.f};
        if ((m0 % SEQ) != 0) { const f32x4* xr = (const f32x4*)(x + (size_t)(m0 - 1) * D) + lane; f32x4 v[4]; float s = 0.f;
#pragma unroll
            for (int j = 0; j < 4; ++j) { v[j] = xr[64 * j]; s += (v[j].x * v[j].x + v[j].y * v[j].y) + (v[j].z * v[j].z + v[j].w * v[j].w); }
            const float rstd = 1.0f / sqrtf(wave_sum(s) * (1.0f / D) + 1e-6f);
#pragma unroll
            for (int j = 0; j < 4; ++j) prev[j] = v[j] * rstd * gv[j]; }
        for (int r = 0; r < 16; ++r) { const int m = m0 + r; const f32x4* xr = (const f32x4*)(x + (size_t)m * D) + lane; f32x4 v[4]; float s = 0.f;
#pragma unroll
            for (int j = 0; j < 4; ++j) { v[j] = xr[64 * j]; s += (v[j].x * v[j].x + v[j].y * v[j].y) + (v[j].z * v[j].z + v[j].w * v[j].w); }
            const float rstd = 1.0f / sqrtf(wave_sum(s) * (1.0f / D) + 1e-6f);
            unsigned long long* o8 = (unsigned long long*)(XN2 + (size_t)m * 2048) + lane;
#pragma unroll
            for (int j = 0; j < 4; ++j) { const f32x4 xn = v[j] * rstd * gv[j];
                o8[64 * j] = (unsigned long long)pk2(xn.x, xn.y) | ((unsigned long long)pk2(xn.z, xn.w) << 32);
                o8[256 + 64 * j] = (unsigned long long)pk2(prev[j].x, prev[j].y) | ((unsigned long long)pk2(prev[j].z, prev[j].w) << 32);
                prev[j] = xn; } }
    }
}
__device__ __forceinline__ void pre_attn(const float* x, bf16* XH, int gw, int NGW, int lane) {
    for (int m = gw; m < M; m += NGW) { const f32x4* xr = (const f32x4*)(x + (size_t)m * D) + lane; f32x4 v[4]; float s = 0.f;
#pragma unroll
        for (int j = 0; j < 4; ++j) { v[j] = xr[64 * j]; s += (v[j].x * v[j].x + v[j].y * v[j].y) + (v[j].z * v[j].z + v[j].w * v[j].w); }
        const float rstd = 1.0f / sqrtf(wave_sum(s) * (1.0f / D) + 1e-6f);
        unsigned long long* o8 = (unsigned long long*)(XH + (size_t)m * D) + lane;
#pragma unroll
        for (int j = 0; j < 4; ++j) o8[64 * j] = (unsigned long long)pk2(v[j].x * rstd, v[j].y * rstd) | ((unsigned long long)pk2(v[j].z * rstd, v[j].w * rstd) << 32); }
}
__device__ __forceinline__ void final_norm_rows(const float* x, const float* g, float* out, int gw, int NGW, int lane) {
    f32x4 gv[4];
#pragma unroll
    for (int j = 0; j < 4; ++j) gv[j] = *((const f32x4*)g + lane + 64 * j);
    for (int m = gw; m < M; m += NGW) { const f32x4* xr = (const f32x4*)(x + (size_t)m * D) + lane; f32x4 v[4]; float s = 0.f;
#pragma unroll
        for (int j = 0; j < 4; ++j) { v[j] = xr[64 * j]; s += (v[j].x * v[j].x + v[j].y * v[j].y) + (v[j].z * v[j].z + v[j].w * v[j].w); }
        const float rstd = 1.0f / sqrtf(wave_sum(s) * (1.0f / D) + 1e-6f);
        f32x4* o = (f32x4*)(out + (size_t)m * D) + lane;
#pragma unroll
        for (int j = 0; j < 4; ++j) o[64 * j] = v[j] * rstd * gv[j]; }
}

__device__ __forceinline__ void ld16bf(const bf16* p, float (&f)[16]) { const v4u a = *(const v4u*)p, b = *(const v4u*)(p + 8);
    f[0] = bflo(a.x); f[1] = bfhi(a.x); f[2] = bflo(a.y); f[3] = bfhi(a.y); f[4] = bflo(a.z); f[5] = bfhi(a.z); f[6] = bflo(a.w); f[7] = bfhi(a.w);
    f[8] = bflo(b.x); f[9] = bfhi(b.x); f[10] = bflo(b.y); f[11] = bfhi(b.y); f[12] = bflo(b.z); f[13] = bfhi(b.z); f[14] = bflo(b.w); f[15] = bfhi(b.w); }
__device__ __forceinline__ void st16bf(bf16* p, const float (&f)[16]) { v4u a, b;
    a.x = pk2(f[0], f[1]); a.y = pk2(f[2], f[3]); a.z = pk2(f[4], f[5]); a.w = pk2(f[6], f[7]); b.x = pk2(f[8], f[9]); b.y = pk2(f[10], f[11]); b.z = pk2(f[12], f[13]); b.w = pk2(f[14], f[15]);
    *(v4u*)p = a; *(v4u*)(p + 8) = b; }

__device__ __forceinline__ void post_rwkv(const bf16* Y, const float* S, const bf16* V, const bf16* G, const float* ln_w, const float* ln_b, bf16* O, int gw, int NGW, int lane) {
    float lw[16], lb[16];
#pragma unroll
    for (int i = 0; i < 16; ++i) { lw[i] = ln_w[lane * 16 + i]; lb[i] = ln_b[lane * 16 + i]; }
    for (int m = gw; m < M; m += NGW) { const size_t off = (size_t)m * D + lane * 16;
        float y[16], v[16], g[16], o[16]; ld16bf(Y + off, y); ld16bf(V + off, v); ld16bf(G + off, g);
        const float sb = S[(size_t)m * 16 + (lane >> 2)];
        float sum = 0.f;
#pragma unroll
        for (int i = 0; i < 16; ++i) sum += y[i];
        sum += __shfl_xor(sum, 1); sum += __shfl_xor(sum, 2);
        const float mean = sum * (1.0f / 64.0f); float q = 0.f;
#pragma unroll
        for (int i = 0; i < 16; ++i) { const float d = y[i] - mean; q += d * d; }
        q += __shfl_xor(q, 1); q += __shfl_xor(q, 2);
        const float rstd = 1.0f / sqrtf(q * (1.0f / 64.0f) + 64e-5f);
#pragma unroll
        for (int i = 0; i < 16; ++i) { const float yn = (y[i] - mean) * rstd * lw[i] + lb[i]; o[i] = (yn + sb * v[i]) * (g[i] / (1.0f + __expf(-g[i]))); }
        st16bf(O + off, o); }
}
__device__ __forceinline__ void post_attn(const bf16* O0, const bf16* O1, const bf16* GT, const float* subln, float lam, float lam_init, bf16* O, int gw, int NGW, int lane) {
    float sw[16];
#pragma unroll
    for (int i = 0; i < 16; ++i) sw[i] = subln[(lane & 7) * 16 + i] * (1.0f - lam_init);
    for (int m = gw; m < M; m += NGW) { const size_t off = (size_t)m * D + lane * 16;
        float a[16], b[16], g[16], o[16]; ld16bf(O0 + off, a); ld16bf(O1 + off, b); ld16bf(GT + off, g);
        float q = 0.f;
#pragma unroll
        for (int i = 0; i < 16; ++i) { o[i] = a[i] - lam * b[i]; q += o[i] * o[i]; }
        q += __shfl_xor(q, 1); q += __shfl_xor(q, 2); q += __shfl_xor(q, 4);
        const float rstd = 1.0f / sqrtf(q * (1.0f / 128.0f) + 1e-5f);
#pragma unroll
        for (int i = 0; i < 16; ++i) o[i] = o[i] * rstd * sw[i] * (g[i] / (1.0f + __expf(-g[i])));
        st16bf(O + off, o); }
}

constexpr int SC_T = 16, SC_NB = SEQ / SC_T;
__device__ __forceinline__ void scan_phase(LAS unsigned char* lds, const bf16* R, const bf16* K, const bf16* V, const _Float16* W, const _Float16* A, const float* k_k, const float* k_a, const float* r_k,
                                           bf16* Y, float* S, int vcu, int G, int tid, int wave, int lane) {
    LAS float* OPS = (LAS float*)lds;
    LAS float* VB = (LAS float*)(lds + 40960);
    LAS float* YB = (LAS float*)(lds + 41984);
    for (int u = vcu; u < 256; u += G) {
        const int bh = u >> 3, rg = u & 7, b = bh >> 4, h = bh & 15;
        const size_t rowbase = (size_t)b * SEQ; const int cb = h * 64;
        const int p = tid - 128, ptt = (p >> 4) & 15, c4 = (p & 15) * 4;
        f32x4 kkw = {0.f, 0.f, 0.f, 0.f}, kaw = kkw, rkw = kkw;
        u32x2 raw_r = {0u, 0u}, raw_k = raw_r, raw_w = raw_r, raw_a = raw_r; v4u raw_v = {0u, 0u, 0u, 0u};
        const bool prod = (wave >= 2 && wave < 6), vld = (wave == 6 && lane < 16), ywr = (wave == 7 && lane < 16), cons = (wave < 2);
        if (prod) { kkw = *(const f32x4*)(k_k + cb + c4); kaw = *(const f32x4*)(k_a + cb + c4); rkw = *(const f32x4*)(r_k + cb + c4); }
        const int jq = lane & 15, rl = wave * 4 + (lane >> 4);
        float S0 = 0.f, S1 = 0.f, S2 = 0.f, S3 = 0.f;
#define SC_LOAD(nblk) do { if (prod) { const size_t o_ = (rowbase + (size_t)(nblk) * SC_T + ptt) * D + cb + c4; raw_r = *(const u32x2*)(R + o_); raw_k = *(const u32x2*)(K + o_); raw_w = *(const u32x2*)(W + o_); raw_a = *(const u32x2*)(A + o_); } \
        if (vld) { raw_v = *(const v4u*)(V + (rowbase + (size_t)(nblk) * SC_T + lane) * D + cb + rg * 8); } } while (0)
#define SC_DERIVE(nblk, buf) do { if (prod) { \
            const float r0 = bflo(raw_r.x), r1 = bfhi(raw_r.x), r2 = bflo(raw_r.y), r3 = bfhi(raw_r.y); \
            const float k0 = bflo(raw_k.x), k1 = bfhi(raw_k.x), k2 = bflo(raw_k.y), k3 = bfhi(raw_k.y); \
            const h16x4 wh = __builtin_bit_cast(h16x4, raw_w), ah = __builtin_bit_cast(h16x4, raw_a); \
            const float a0 = (float)ah[0], a1 = (float)ah[1], a2 = (float)ah[2], a3 = (float)ah[3]; \
            const float x0 = k0 * kkw.x, x1 = k1 * kkw.y, x2 = k2 * kkw.z, x3 = k3 * kkw.w; \
            const float ss = allreduce16((x0 * x0 + x1 * x1) + (x2 * x2 + x3 * x3)); \
            const float inv = 1.0f / fmaxf(sqrtf(ss), 1e-12f); \
            const f32x4 kn = {x0 * inv, x1 * inv, x2 * inv, x3 * inv}; \
            const f32x4 km = {k0 * (1.0f + (a0 - 1.0f) * kaw.x), k1 * (1.0f + (a1 - 1.0f) * kaw.y), k2 * (1.0f + (a2 - 1.0f) * kaw.z), k3 * (1.0f + (a3 - 1.0f) * kaw.w)}; \
            const float sp = allreduce16((r0 * km.x * rkw.x + r1 * km.y * rkw.y) + (r2 * km.z * rkw.z + r3 * km.w * rkw.w)); \
            LAS float* op_ = OPS + (buf) * 5120 + ptt * 320 + c4; \
            *(LAS f32x4*)(op_) = -kn; \
            *(LAS f32x4*)(op_ + 64) = (f32x4){kn.x * a0, kn.y * a1, kn.z * a2, kn.w * a3}; \
            *(LAS f32x4*)(op_ + 128) = (f32x4){__expf(-__expf((float)wh[0])), __expf(-__expf((float)wh[1])), __expf(-__expf((float)wh[2])), __expf(-__expf((float)wh[3]))}; \
            *(LAS f32x4*)(op_ + 192) = km; \
            *(LAS f32x4*)(op_ + 256) = (f32x4){r0, r1, r2, r3}; \
            if (rg == 0 && c4 == 0) S[(rowbase + (size_t)(nblk) * SC_T + ptt) * 16 + h] = sp; } \
        if (vld) { LAS float* vb_ = VB + (buf) * 128 + lane * 8; \
            *(LAS f32x4*)(vb_) = (f32x4){bflo(raw_v.x), bfhi(raw_v.x), bflo(raw_v.y), bfhi(raw_v.y)}; *(LAS f32x4*)(vb_ + 4) = (f32x4){bflo(raw_v.z), bfhi(raw_v.z), bflo(raw_v.w), bfhi(raw_v.w)}; } } while (0)
        SC_LOAD(0); SC_DERIVE(0, 0); SC_LOAD(1);
        __syncthreads();
        for (int n = 0; n < SC_NB; ++n) {
            const int buf = n & 1;
            if (cons) {
                const LAS float* ops = OPS + buf * 5120 + 4 * jq; const LAS float* vb = VB + buf * 128 + rl; LAS float* yb = YB + buf * 128 + rl;
#pragma unroll
                for (int tt = 0; tt < SC_T; ++tt) {
                    const f32x4 nk = *(const LAS f32x4*)(ops + tt * 320), bb = *(const LAS f32x4*)(ops + tt * 320 + 64), dw = *(const LAS f32x4*)(ops + tt * 320 + 128),
                                km = *(const LAS f32x4*)(ops + tt * 320 + 192), rr = *(const LAS f32x4*)(ops + tt * 320 + 256);
                    const float vi = vb[tt * 8];
                    float sa = (S0 * nk.x + S1 * nk.y) + (S2 * nk.z + S3 * nk.w);
                    sa = allreduce16(sa);
                    S0 = (S0 * dw.x + vi * km.x) + sa * bb.x; S1 = (S1 * dw.y + vi * km.y) + sa * bb.y; S2 = (S2 * dw.z + vi * km.z) + sa * bb.z; S3 = (S3 * dw.w + vi * km.w) + sa * bb.w;
                    float yv = (S0 * rr.x + S1 * rr.y) + (S2 * rr.z + S3 * rr.w);
                    yv = allreduce16(yv);
                    if (jq == 0) yb[tt * 8] = yv;
                }
            } else {
                if (n + 1 < SC_NB) { SC_DERIVE(n + 1, buf ^ 1); if (n + 2 < SC_NB) SC_LOAD(n + 2); }
                if (ywr && n >= 1) { const LAS float* yb = YB + (buf ^ 1) * 128 + lane * 8; const f32x4 y0 = *(const LAS f32x4*)yb, y1 = *(const LAS f32x4*)(yb + 4);
                    v4u o; o.x = pk2(y0.x, y0.y); o.y = pk2(y0.z, y0.w); o.z = pk2(y1.x, y1.y); o.w = pk2(y1.z, y1.w);
                    *(v4u*)(Y + (rowbase + (size_t)(n - 1) * SC_T + lane) * D + cb + rg * 8) = o; }
            }
            __syncthreads();
        }
        if (ywr) { const LAS float* yb = YB + ((SC_NB - 1) & 1) * 128 + lane * 8; const f32x4 y0 = *(const LAS f32x4*)yb, y1 = *(const LAS f32x4*)(yb + 4);
            v4u o; o.x = pk2(y0.x, y0.y); o.y = pk2(y0.z, y0.w); o.z = pk2(y1.x, y1.y); o.w = pk2(y1.z, y1.w);
            *(v4u*)(Y + (rowbase + (size_t)(SC_NB - 1) * SC_T + lane) * D + cb + rg * 8) = o; }
        __syncthreads();
#undef SC_LOAD
#undef SC_DERIVE
    }
}

struct Args { const void* in[31]; float* out; unsigned char* ws; };
__global__ void __launch_bounds__(NWAVES * 64, 2) mk_fwd(Args args) {
    extern __shared__ __attribute__((aligned(16))) unsigned char lds[];
    cg::grid_group grid = cg::this_grid();
    LAS unsigned char* L = (LAS unsigned char*)lds;
    const int G = gridDim.x; const int bx = blockIdx.x; const int vcu = (G % 8 == 0) ? (bx % 8) * (G / 8) + bx / 8 : bx;
    const int NGW = G * NWAVES;
#define PH_IDS() int tid_ = threadIdx.x; asm volatile("" : "+v"(tid_)); const int tid = tid_, lane = tid & 63, wave = __builtin_amdgcn_readfirstlane(tid >> 6); const int gw = vcu * NWAVES + wave; LAS float* scr = (LAS float*)(L + wave * 16384); (void)scr; (void)gw; (void)lane
    typedef const void* cvp_t; typedef const __attribute__((address_space(4))) cvp_t* kargp_t;
#define KP_(k) (((kargp_t)kp_)[k])
#define PH_PTRS() const __attribute__((address_space(4))) char* kp_ = (const __attribute__((address_space(4))) char*)__builtin_amdgcn_kernarg_segment_ptr(); asm volatile("" : "+s"(kp_)); \
    In I; I.x = (const float*)KP_(0); I.pos = (const int*)KP_(1); I.a_norm = (const float*)KP_(2); I.a_mu = (const float*)KP_(3); I.a_w_in = (const float*)KP_(4); I.a_w0 = (const float*)KP_(5); I.a_w1 = (const float*)KP_(6); I.a_w2 = (const float*)KP_(7); I.a_a0 = (const float*)KP_(8); I.a_a1 = (const float*)KP_(9); I.a_a2 = (const float*)KP_(10); I.a_v0 = (const float*)KP_(11); I.a_v1 = (const float*)KP_(12); I.a_v2 = (const float*)KP_(13); I.a_k_k = (const float*)KP_(14); I.a_k_a = (const float*)KP_(15); I.a_r_k = (const float*)KP_(16); I.a_ln_w = (const float*)KP_(17); I.a_ln_b = (const float*)KP_(18); I.a_w_out = (const float*)KP_(19); I.kv_norm = (const float*)KP_(20); I.w_kv = (const float*)KP_(21); I.b_norm = (const float*)KP_(22); I.b_w_in = (const float*)KP_(23); I.b_lq1 = (const float*)KP_(24); I.b_lk1 = (const float*)KP_(25); I.b_lq2 = (const float*)KP_(26); I.b_lk2 = (const float*)KP_(27); I.b_subln = (const float*)KP_(28); I.b_w_out = (const float*)KP_(29); I.final_norm = (const float*)KP_(30); \
    float* XS = (float*)KP_(31); unsigned char* ws = (unsigned char*)KP_(32); \
    float* rc = (float*)(ws + WS_ROPE_C); float* rs = (float*)(ws + WS_ROPE_S); float* SB = (float*)(ws + WS_S); unsigned char* wreg = ws + WS_W; \
    bf16* U0 = (bf16*)(ws + WS_U); bf16* U1 = (bf16*)(ws + WS_U + UNIT); bf16* U2 = (bf16*)(ws + WS_U + 2 * UNIT); bf16* U3 = (bf16*)(ws + WS_U + 3 * UNIT); \
    bf16* U4 = (bf16*)(ws + WS_U + 4 * UNIT); bf16* U5 = (bf16*)(ws + WS_U + 5 * UNIT); bf16* U6 = (bf16*)(ws + WS_U + 6 * UNIT); bf16* HB = (bf16*)(ws + WS_H); \
    (void)I; (void)XS; (void)rc; (void)rs; (void)SB; (void)wreg; (void)U0; (void)U1; (void)U2; (void)U3; (void)U4; (void)U5; (void)U6; (void)HB

    { PH_IDS(); PH_PTRS(); rope_tables(I.pos, rc, rs, vcu * 512 + tid, G * 512);
    conv_rwkv(I, 0, wreg, (float*)(ws + WS_BIAS), scr, gw, NGW, lane);
    pre_rwkv(I.x, I.a_norm, U0, gw, NGW, lane); }
    grid.sync();

#pragma nounroll
    for (int l = 0; l < 2; ++l) {
        {
            PH_PTRS(); bf16* Vl = (l == 0) ? U4 : U6;
            pg8::Gemm g{U0, (const bf16*)(wreg + W_FOLD), M, 4352, 2048}; pg8::StaticOrder S; S.init(M, 4352, G, bx);
            pg8::EpiFold E{U2, U3, Vl, U5, HB};
            pg8::gemm_phase<pg8::EpiFold, pg8::StaticOrder, true, true>(L, g, S, E);
        }
        grid.sync();
        {
            PH_PTRS(); bf16* Vl = (l == 0) ? U4 : U6;
            const int NUP = (l == 0) ? 2048 : 3072;
            pg8::Gemm g{HB, (const bf16*)(wreg + W_UP), M, NUP, 256}; pg8::StaticOrder S; S.init(M, NUP, G, bx);
            pg8::EpiLoraUp E{(const float*)(ws + WS_BIAS), (_Float16*)U0, (_Float16*)U1, Vl, U4};
            pg8::gemm_phase<pg8::EpiLoraUp, pg8::StaticOrder, true, true>(L, g, S, E);
        }
        grid.sync();
        { PH_IDS(); PH_PTRS(); bf16* Vl = (l == 0) ? U4 : U6; bf16* Yl = (l == 0) ? U6 : U4; scan_phase(L, U2, U3, Vl, (const _Float16*)U0, (const _Float16*)U1, I.a_k_k + l * 1024, I.a_k_a + l * 1024, I.a_r_k + l * 1024, Yl, SB, vcu, G, tid, wave, lane); }
        grid.sync();
        { PH_IDS(); PH_PTRS(); bf16* Vl = (l == 0) ? U4 : U6; bf16* Yl = (l == 0) ? U6 : U4; post_rwkv(Yl, SB, Vl, U5, I.a_ln_w + l * 1024, I.a_ln_b + l * 1024, U2, gw, NGW, lane); }
        grid.sync();
        {
            PH_PTRS(); const float* xin = (l == 0) ? I.x : XS;
            pg8::Gemm g{U2, (const bf16*)(wreg + W_OUT), M, 1024, 1024}; pg8::StaticOrder S; S.init(M, 1024, G, bx);
            pg8::EpiResid E{xin, XS};
            pg8::gemm_phase<pg8::EpiResid, pg8::StaticOrder, true, true>(L, g, S, E);
        }
        grid.sync();
        { PH_IDS(); PH_PTRS(); if (l == 0) { conv_rwkv(I, 1, wreg, (float*)(ws + WS_BIAS), scr, gw, NGW, lane); pre_rwkv(XS, I.a_norm + 1024, U0, gw, NGW, lane); }
        else { conv_attn(I, 0, wreg, scr, gw, NGW, lane); pre_attn(XS, U0, gw, NGW, lane); } }
        grid.sync();
    }

#pragma nounroll
    for (int j = 0; j < 2; ++j) {
        {
            PH_PTRS();
            const int NP = (j == 0) ? 4096 : 2048;
            pg8::Gemm g{U0, (const bf16*)(wreg + W_PROJ), M, NP, 1024}; pg8::StaticOrder S; S.init(M, NP, G, bx);
            pg8::EpiProj E;
            if (j == 0) { E.d0 = U1; E.d1 = U2; E.d2 = U3; E.d3 = U4; E.ropemask = 0x5; E.scalemask = 0x4; }
            else { E.d0 = U3; E.d1 = U4; E.d2 = U3; E.d3 = U4; E.ropemask = 0x1; E.scalemask = 0x1; }
            E.sc = C2F; E.rc = rc; E.rs = rs;
            pg8::gemm_phase<pg8::EpiProj, pg8::StaticOrder, true, true>(L, g, S, E);
        }
        grid.sync();
        {
            PH_PTRS();
            const attn_body::AttnTensors AT{(const attn_body::bf16*)U3, (const attn_body::bf16*)U1, (const attn_body::bf16*)U2, (attn_body::bf16*)U5, (attn_body::bf16*)U6};
            attn_body::attn_phase<8>((char*)lds, AT, vcu, G);
        }
        grid.sync();
        {
            PH_IDS(); PH_PTRS();
            const float e1 = __expf(wave_sum(I.b_lq1[j * 64 + lane] * I.b_lk1[j * 64 + lane])), e2 = __expf(wave_sum(I.b_lq2[j * 64 + lane] * I.b_lk2[j * 64 + lane]));
            const float lam_init = (j == 0) ? 0.4707130183435842f : 0.5560582041556406f;
            post_attn(U5, U6, U4, I.b_subln + j * 128, e1 - e2 + lam_init, lam_init, U0, gw, NGW, lane);
        }
        grid.sync();
        {
            PH_PTRS();
            pg8::Gemm g{U0, (const bf16*)(wreg + W_BOUT), M, 1024, 1024}; pg8::StaticOrder S; S.init(M, 1024, G, bx);
            pg8::EpiResid E{XS, XS};
            pg8::gemm_phase<pg8::EpiResid, pg8::StaticOrder, true, true>(L, g, S, E);
        }
        grid.sync();
        if (j == 0) { { PH_IDS(); PH_PTRS(); conv_attn(I, 1, wreg, scr, gw, NGW, lane); pre_attn(XS, U0, gw, NGW, lane); } grid.sync(); }
    }
    { PH_IDS(); PH_PTRS(); final_norm_rows(XS, I.final_norm, XS, gw, NGW, lane); }
}

extern "C" void kernel_launch(void* const* d_in, const int* in_sizes, int n_in, void* d_out, int out_size, void* d_ws, size_t ws_size, hipStream_t stream) {
    static int grid = 0;
    if (grid == 0) {
        if (n_in != 31 || in_sizes[0] != M * D || out_size != M * D || ws_size < WS_END) { fprintf(stderr, "kernel_launch: unexpected shapes (n_in %d, in0 %d, out %d, ws %zu < %zu)\n", n_in, n_in > 0 ? in_sizes[0] : -1, out_size, ws_size, (size_t)WS_END); grid = -1; return; }
        int dev = 0, cus = 0, per_cu = 0;
        hipGetDevice(&dev); hipDeviceGetAttribute(&cus, hipDeviceAttributeMultiprocessorCount, dev);
        if (hipFuncSetAttribute((const void*)mk_fwd, hipFuncAttributeMaxDynamicSharedMemorySize, LDS_BYTES) != hipSuccess) { fprintf(stderr, "kernel_launch: hipFuncSetAttribute failed\n"); grid = -1; return; }
        if (hipOccupancyMaxActiveBlocksPerMultiprocessor(&per_cu, (const void*)mk_fwd, NWAVES * 64, LDS_BYTES) != hipSuccess || per_cu < 1) { fprintf(stderr, "kernel_launch: occupancy query says %d\n", per_cu); per_cu = 1; }
        (void)hipGetLastError();
        grid = cus;
    }
    if (grid < 0) return;
    Args a{};
    for (int i = 0; i < 31; ++i) a.in[i] = d_in[i];
    a.out = (float*)d_out; a.ws = (unsigned char*)d_ws;
    void* kargs[] = {&a};
    hipError_t e = hipLaunchCooperativeKernel((const void*)mk_fwd, dim3(grid), dim3(NWAVES * 64), kargs, LDS_BYTES, stream);
    if (e != hipSuccess) fprintf(stderr, "kernel_launch: cooperative launch failed: %s (grid %d)\n", hipGetErrorString(e), grid);
}
```

```cpp
#include <hip/hip_runtime.h>
#include <hip/hip_cooperative_groups.h>
#include <cstdio>
#include <cstdint>
namespace cg = cooperative_groups;
namespace pg8 {
#define PG8_LAS __attribute__((address_space(3)))
typedef unsigned short bf16_t;
typedef short bf16x8 __attribute__((ext_vector_type(8)));
typedef float f32x4 __attribute__((ext_vector_type(4)));
typedef unsigned u32x4 __attribute__((ext_vector_type(4)));
constexpr int BM = 256, BK = 64, HALF = 128, HTB = HALF * BK * 2  , STAGE_BYTES = 8 * HTB, NXCD = 8, WGM = 8;

__host__ __device__ __forceinline__ int lds_byte(int r, int c) { const int st = (r >> 4) * 2 + (c >> 5), rr = r & 15, cc = c & 31, ob = rr * 64 + cc * 2; return st * 1024 + (ob ^ (((ob >> 9) & 1) << 5)); }
__host__ __device__ __forceinline__ void stage_rc(int b, int& R, int& C) { const int st = b / 1024, sb = b % 1024, swz = sb ^ (((sb >> 9) & 1) << 5); R = (st >> 1) * 16 + swz / 64; C = (st & 1) * 32 + (swz % 64) / 2; }
__host__ __device__ __forceinline__ int perm32(int rho) { const int n = rho >> 4, i = rho & 15; return 8 * (i >> 2) + 4 * n + (i & 3); }

struct Unit { int pm, pn; };
struct Gemm { const bf16_t* A; const bf16_t* Bt; int M, N, K; };

struct StaticOrder {
    int nM, nN, nwg, G, c;
    __host__ __device__ void init(int M, int N, int G_, int c_) { nM = M / BM; nN = N / BM; nwg = nM * nN; G = G_; c = c_; }
    __host__ __device__ bool next(int i, Unit& u) const {
        const long L = (long)i * G + c; if (L >= nwg) return false;
        int wgid = (int)L; { const int q = nwg / NXCD, r = nwg % NXCD, xcd = wgid % NXCD, off = wgid / NXCD; wgid = (xcd < r ? xcd * (q + 1) : r * (q + 1) + (xcd - r) * q) + off; }
        const int nig = WGM * nN, gid = wgid / nig, fm = gid * WGM, gsz = (nM - fm) < WGM ? (nM - fm) : WGM;
        u.pm = fm + ((wgid % nig) % gsz); u.pn = (wgid % nig) / gsz; return true;
    }
    __device__ __forceinline__ void a_ready(const Unit&) const {}
    __device__ __forceinline__ void done(const Unit&) const {}
};

__device__ __forceinline__ unsigned cvt_pk_bf16(float lo, float hi) { unsigned r; asm volatile("v_cvt_pk_bf16_f32 %0, %1, %2" : "=v"(r) : "v"(lo), "v"(hi)); return r; }
typedef float f32x2 __attribute__((ext_vector_type(2)));
typedef _Float16 h16x4 __attribute__((ext_vector_type(4)));
typedef unsigned u32x2 __attribute__((ext_vector_type(2)));
__device__ __forceinline__ float sigmoidf_(float z) { return 1.0f / (1.0f + __expf(-z)); }
__device__ __forceinline__ float tanhf_(float x) { const float t = __expf(-2.0f * fabsf(x)); const float r = (1.0f - t) / (1.0f + t); return x < 0.f ? -r : r; }
__device__ __forceinline__ float bf_lo(unsigned w) { return __uint_as_float(w << 16); }
__device__ __forceinline__ float bf_hi(unsigned w) { return __uint_as_float(w & 0xffff0000u); }

struct EpiFold {
    static constexpr bool PERM = true, AFTER_DRAIN = false;
    bf16_t *R, *Kb, *V, *G, *H;
    __device__ __forceinline__ void operator()(const f32x4 (&acc)[2][2][4][2], const Unit& u, int wr, int wc, int fr, int fq) const {
        const int row0 = u.pm * BM + wr * 64 + fr;
        const int t = u.pn >> 2;
        bf16_t* base; int ldc, colt;
        if (u.pn < 16) { base = (t == 0) ? R : (t == 1) ? Kb : (t == 2) ? V : G; ldc = 1024; colt = (u.pn & 3) * 256; }
        else { base = H; ldc = 256; colt = 0; }
        const int col0 = colt + wc * 32 + 8 * fq;
        const bool th = (u.pn == 16) && (wc < 2);
#pragma unroll
        for (int ai = 0; ai < 2; ++ai)
#pragma unroll
            for (int m = 0; m < 4; ++m) { bf16_t* rowp = base + (size_t)(row0 + ai * HALF + m * 16) * ldc + col0;
#pragma unroll
                for (int bj = 0; bj < 2; ++bj) { f32x4 v0 = acc[ai][bj][m][0], v1 = acc[ai][bj][m][1];
                    if (th && bj == 0) {
#pragma unroll
                        for (int i = 0; i < 4; ++i) { v0[i] = tanhf_(v0[i]); v1[i] = tanhf_(v1[i]); } }
                    u32x4 w; w.x = cvt_pk_bf16(v0[0], v0[1]); w.y = cvt_pk_bf16(v0[2], v0[3]); w.z = cvt_pk_bf16(v1[0], v1[1]); w.w = cvt_pk_bf16(v1[2], v1[3]);
                    *(u32x4*)(rowp + bj * HALF) = w; }
                asm volatile("" ::: "memory"); }
    }
};

struct EpiLoraUp {
    static constexpr bool PERM = false, AFTER_DRAIN = false;
    const float* bias3; _Float16 *Wb, *Ab; bf16_t* Vb; const bf16_t* Vf;
    __device__ __forceinline__ void operator()(const f32x4 (&acc)[2][2][4][2], const Unit& u, int wr, int wc, int fr_unused, int fq_unused) const {
        int t_ = threadIdx.x; asm volatile("" : "+v"(t_)); const int fr = t_ & 15, fq = (t_ >> 4) & 3;
        const int row0 = u.pm * BM + wr * 64 + fr;
        const int t = u.pn >> 2;
        const int cc0 = (u.pn & 3) * 256 + wc * 32 + 4 * fq;
        const float* bias = bias3 + t * 1024;
#pragma unroll
        for (int bj = 0; bj < 2; ++bj)
#pragma unroll
            for (int n = 0; n < 2; ++n) { const int c = cc0 + bj * HALF + n * 16; const f32x4 bv = *(const f32x4*)(bias + c);
#pragma unroll
                for (int ai = 0; ai < 2; ++ai)
#pragma unroll
                    for (int m = 0; m < 4; ++m) { const size_t off = (size_t)(row0 + ai * HALF + m * 16) * 1024 + c; const f32x4 z = acc[ai][bj][m][n] + bv;
                        if (t == 0) { h16x4 o;
#pragma unroll
                            for (int i = 0; i < 4; ++i) { const float zz = -z[i]; const float sp = fmaxf(zz, 0.f) + __logf(1.0f + __expf(-fabsf(zz))); o[i] = (_Float16)(-sp - 0.5f); }
                            *(h16x4*)(Wb + off) = o; }
                        else if (t == 1) { h16x4 o;
#pragma unroll
                            for (int i = 0; i < 4; ++i) o[i] = (_Float16)sigmoidf_(z[i]);
                            *(h16x4*)(Ab + off) = o; }
                        else { const u32x2 vv = *(const u32x2*)(Vb + off), vf = *(const u32x2*)(Vf + off);
                            const float v_0 = bf_lo(vv.x), v_1 = bf_hi(vv.x), v_2 = bf_lo(vv.y), v_3 = bf_hi(vv.y);
                            const float f_0 = bf_lo(vf.x), f_1 = bf_hi(vf.x), f_2 = bf_lo(vf.y), f_3 = bf_hi(vf.y);
                            u32x2 o; o.x = cvt_pk_bf16(v_0 + (f_0 - v_0) * sigmoidf_(z[0]), v_1 + (f_1 - v_1) * sigmoidf_(z[1]));
                            o.y = cvt_pk_bf16(v_2 + (f_2 - v_2) * sigmoidf_(z[2]), v_3 + (f_3 - v_3) * sigmoidf_(z[3]));
                            *(u32x2*)(Vb + off) = o; }
                        asm volatile("" ::: "memory"); } }
    }
};

struct EpiProj {
    static constexpr bool PERM = true, AFTER_DRAIN = false;
    bf16_t *d0, *d1, *d2, *d3; int ropemask, scalemask; float sc; const float* rc; const float* rs;
    __device__ __forceinline__ void operator()(const f32x4 (&acc)[2][2][4][2], const Unit& u, int wr, int wc, int fr, int fq) const {
        const int row0 = u.pm * BM + wr * 64 + fr;
        const int t = u.pn >> 2;
        bf16_t* base = (t == 0) ? d0 : (t == 1) ? d1 : (t == 2) ? d2 : d3;
        const int col0 = (u.pn & 3) * 256 + wc * 32 + 8 * fq;
        const bool rope = (((ropemask >> t) & 1) != 0) && ((wc & 1) == 0);
        const float s = ((scalemask >> t) & 1) ? sc : 1.0f;
        const float sgn = (fq == 0) ? -1.0f : 1.0f;
#pragma unroll
        for (int ai = 0; ai < 2; ++ai)
#pragma unroll
            for (int m = 0; m < 4; ++m) { const int row = row0 + ai * HALF + m * 16; bf16_t* rowp = base + (size_t)row * 1024 + col0;
                f32x4 c0 = {1.f, 1.f, 1.f, 1.f}, c1 = c0, s0 = {0.f, 0.f, 0.f, 0.f}, s1 = s0;
                if (rope) { c0 = *(const f32x4*)(rc + (size_t)row * 8); c1 = *(const f32x4*)(rc + (size_t)row * 8 + 4); s0 = *(const f32x4*)(rs + (size_t)row * 8); s1 = *(const f32x4*)(rs + (size_t)row * 8 + 4); }
#pragma unroll
                for (int bj = 0; bj < 2; ++bj) { f32x4 v0 = acc[ai][bj][m][0], v1 = acc[ai][bj][m][1];
                    if (rope) { f32x4 p0, p1;
#pragma unroll
                        for (int i = 0; i < 4; ++i) { p0[i] = __shfl_xor(v0[i], 16); p1[i] = __shfl_xor(v1[i], 16); }
                        if (fq < 2) { v0 = v0 * c0 + (p0 * s0) * sgn; v1 = v1 * c1 + (p1 * s1) * sgn; } }
                    v0 = v0 * s; v1 = v1 * s;
                    u32x4 w; w.x = cvt_pk_bf16(v0[0], v0[1]); w.y = cvt_pk_bf16(v0[2], v0[3]); w.z = cvt_pk_bf16(v1[0], v1[1]); w.w = cvt_pk_bf16(v1[2], v1[3]);
                    *(u32x4*)(rowp + bj * HALF) = w; }
                asm volatile("" ::: "memory"); }
    }
};

struct EpiResid {
    static constexpr bool PERM = false, AFTER_DRAIN = false;
    const float* base; float* out;
    __device__ __forceinline__ void operator()(const f32x4 (&acc)[2][2][4][2], const Unit& u, int wr, int wc, int fr, int fq) const {
        const int row0 = u.pm * BM + wr * 64 + fr;
        const int col0 = u.pn * BM + wc * 32 + 4 * fq;
#pragma unroll
        for (int ai = 0; ai < 2; ++ai)
#pragma unroll
            for (int m = 0; m < 4; ++m) { const size_t off = (size_t)(row0 + ai * HALF + m * 16) * 1024 + col0;
#pragma unroll
                for (int bj = 0; bj < 2; ++bj)
#pragma unroll
                    for (int n = 0; n < 2; ++n) { const f32x4 b = *(const f32x4*)(base + off + bj * HALF + n * 16); *(f32x4*)(out + off + bj * HALF + n * 16) = b + acc[ai][bj][m][n]; }
                asm volatile("" ::: "memory"); }
    }
};
template <class Epi, class Sched, bool ALIGN_EPI = false, bool SP2 = false>
__device__ __forceinline__ void gemm_phase(PG8_LAS unsigned char* lds, const Gemm g, const Sched& S, const Epi& E) {
    int tid_ = threadIdx.x; asm volatile("" : "+v"(tid_));
    const int tid = tid_, wid = __builtin_amdgcn_readfirstlane(tid >> 6), lane = tid & 63, wr = wid >> 2, wc = wid & 3, fr = lane & 15, fq = lane >> 4;
    const int K = g.K, nt = K / BK;
    unsigned voffA[2], voffB[2];
#pragma unroll
    for (int i = 0; i < 2; ++i) { int R, C; stage_rc(tid * 16 + i * 8192, R, C); const int Rb = Epi::PERM ? ((R & ~31) + perm32(R & 31)) : R;
        voffA[i] = (unsigned)(R * K + C) * 2u; voffB[i] = (unsigned)(Rb * K + C) * 2u; }
    const size_t kstep = (size_t)(BK * 2);
    const size_t hstep = (size_t)HALF * K * 2;
    const size_t tstep = 2 * hstep;
    const unsigned ldsw = (unsigned)wid * 1024u;
    const int aoff = lds_byte(wr * 64 + fr, fq * 8), boff = lds_byte(wc * 32 + fr, fq * 8);
#define PG8_SA(b, h) (((b) * 2 + (h)) * HTB)
#define PG8_SB(b, h) ((4 + (b) * 2 + (h)) * HTB)
#define PG8_STAGE(bufoff, gbase, voff) do { _Pragma("unroll") for (int _i = 0; _i < 2; ++_i) \
        __builtin_amdgcn_global_load_lds((const unsigned*)((const char*)(gbase) + (voff)[_i]), (PG8_LAS unsigned*)(lds + (bufoff) + ldsw + _i * 8192), 16, 0, 0); } while (0)
#define PG8_LDA(dst, b, h) do { _Pragma("unroll") for (int m = 0; m < 4; ++m) _Pragma("unroll") for (int k = 0; k < 2; ++k) dst[m][k] = *(const PG8_LAS bf16x8*)(lds + PG8_SA(b, h) + aoff + m * 2048 + k * 1024); } while (0)
#define PG8_LDB(dst, b, h) do { _Pragma("unroll") for (int n = 0; n < 2; ++n) _Pragma("unroll") for (int k = 0; k < 2; ++k) dst[n][k] = *(const PG8_LAS bf16x8*)(lds + PG8_SB(b, h) + boff + n * 2048 + k * 1024); } while (0)
#define PG8_MMA(ai, bj, At, Bt) do { __builtin_amdgcn_s_setprio(1); _Pragma("unroll") for (int m = 0; m < 4; ++m) _Pragma("unroll") for (int n = 0; n < 2; ++n) _Pragma("unroll") for (int k = 0; k < 2; ++k) \
        acc[ai][bj][m][n] = __builtin_amdgcn_mfma_f32_16x16x32_bf16(Bt[n][k], At[m][k], acc[ai][bj][m][n], 0, 0, 0); __builtin_amdgcn_s_setprio(0); } while (0)
#define PG8_WAIT_V(n) asm volatile("s_waitcnt vmcnt(" #n ")" ::: "memory")
#define PG8_WAIT_L(n) asm volatile("s_waitcnt lgkmcnt(" #n ")" ::: "memory")
#define PG8_BAR __builtin_amdgcn_s_barrier()
#define PG8_SCHED __builtin_amdgcn_sched_barrier(0)
    Unit cur, nxt; int ui = 0;
    if (!S.next(0, cur)) return;
    f32x4 acc[2][2][4][2];
#pragma unroll
    for (int a = 0; a < 2; ++a)
#pragma unroll
        for (int b = 0; b < 2; ++b)
#pragma unroll
            for (int m = 0; m < 4; ++m)
#pragma unroll
                for (int n = 0; n < 2; ++n) acc[a][b][m][n] = (f32x4){0.f, 0.f, 0.f, 0.f};
    bf16x8 At[4][2], B0[2][2], B1[2][2];
    const char* cA = (const char*)g.A + (size_t)cur.pm * tstep; const char* cB = (const char*)g.Bt + (size_t)cur.pn * tstep;
    S.a_ready(cur);
    if constexpr (SP2) {
        PG8_STAGE(PG8_SB(0, 0), cB, voffB); PG8_STAGE(PG8_SB(0, 1), cB + hstep, voffB); PG8_STAGE(PG8_SA(0, 0), cA, voffA); PG8_STAGE(PG8_SA(0, 1), cA + hstep, voffA);
        if (wr == 1) PG8_BAR;
        PG8_WAIT_V(2); PG8_BAR;
        PG8_STAGE(PG8_SB(1, 0), cB + kstep, voffB); PG8_STAGE(PG8_SA(1, 0), cA + kstep, voffA); PG8_STAGE(PG8_SB(1, 1), cB + hstep + kstep, voffB);
        PG8_WAIT_V(6); PG8_BAR;
    } else {
        PG8_STAGE(PG8_SB(0, 0), cB, voffB); PG8_STAGE(PG8_SA(0, 0), cA, voffA); PG8_STAGE(PG8_SB(0, 1), cB + hstep, voffB); PG8_STAGE(PG8_SA(0, 1), cA + hstep, voffA);
        if (wr == 1) PG8_BAR;
        PG8_WAIT_V(4); PG8_BAR;
        PG8_STAGE(PG8_SB(1, 0), cB + kstep, voffB); PG8_STAGE(PG8_SA(1, 0), cA + kstep, voffA); PG8_STAGE(PG8_SB(1, 1), cB + hstep + kstep, voffB);
        PG8_WAIT_V(6); PG8_BAR;
    }
    for (;;) {
        const bool has_next = S.next(ui + 1, nxt);
        const char* nA = has_next ? (const char*)g.A + (size_t)nxt.pm * tstep : cA; const char* nB = has_next ? (const char*)g.Bt + (size_t)nxt.pn * tstep : cB;
        for (int t = 0; t < nt; t += 2) {
            const bool last = (t == nt - 2);
            const char* a1 = cA + (size_t)(t + 1) * kstep;
            const char* a2 = last ? nA : cA + (size_t)(t + 2) * kstep; const char* b2 = last ? nB : cB + (size_t)(t + 2) * kstep;
            const char* a3 = a2 + kstep; const char* b3 = b2 + kstep;
            if (last && has_next) S.a_ready(nxt);
            if constexpr (SP2) {
            PG8_LDB(B0, 0, 0); PG8_LDB(B1, 0, 1); PG8_SCHED; PG8_LDA(At, 0, 0); PG8_STAGE(PG8_SA(1, 1), a1 + hstep, voffA);
            PG8_WAIT_V(8); PG8_WAIT_L(0); PG8_BAR; PG8_MMA(0, 0, At, B0); PG8_MMA(0, 1, At, B1); PG8_BAR; PG8_SCHED;
            PG8_LDA(At, 0, 1); PG8_STAGE(PG8_SB(0, 0), b2, voffB); PG8_STAGE(PG8_SB(0, 1), b2 + hstep, voffB); PG8_STAGE(PG8_SA(0, 0), a2, voffA);
            PG8_WAIT_V(8); PG8_WAIT_L(0); PG8_BAR; PG8_MMA(1, 0, At, B0); PG8_MMA(1, 1, At, B1); PG8_BAR; PG8_SCHED;
            PG8_LDB(B0, 1, 0); PG8_LDB(B1, 1, 1); PG8_SCHED; PG8_LDA(At, 1, 0); PG8_STAGE(PG8_SA(0, 1), a2 + hstep, voffA);
            PG8_WAIT_V(8); PG8_WAIT_L(0); PG8_BAR; PG8_MMA(0, 0, At, B0); PG8_MMA(0, 1, At, B1); PG8_BAR; PG8_SCHED;
            PG8_LDA(At, 1, 1); PG8_STAGE(PG8_SB(1, 0), b3, voffB); PG8_STAGE(PG8_SB(1, 1), b3 + hstep, voffB); PG8_STAGE(PG8_SA(1, 0), a3, voffA);
            PG8_WAIT_V(8); PG8_WAIT_L(0); PG8_BAR; PG8_MMA(1, 0, At, B0); PG8_MMA(1, 1, At, B1); PG8_BAR; PG8_SCHED;
            } else {
            PG8_LDB(B0, 0, 0); PG8_SCHED; PG8_LDA(At, 0, 0); PG8_STAGE(PG8_SA(1, 1), a1 + hstep, voffA);
            PG8_WAIT_L(8); PG8_BAR; PG8_WAIT_L(0); PG8_MMA(0, 0, At, B0); PG8_BAR; PG8_SCHED;
            PG8_LDB(B1, 0, 1); PG8_STAGE(PG8_SB(0, 0), b2, voffB);
            PG8_BAR; PG8_WAIT_L(0); PG8_MMA(0, 1, At, B1); PG8_BAR;
            PG8_LDA(At, 0, 1); PG8_STAGE(PG8_SA(0, 0), a2, voffA);
            PG8_BAR; PG8_WAIT_L(0); PG8_MMA(1, 0, At, B0); PG8_BAR; PG8_SCHED;
            PG8_STAGE(PG8_SB(0, 1), b2 + hstep, voffB);
            PG8_WAIT_V(6); PG8_BAR; PG8_MMA(1, 1, At, B1); PG8_BAR;
            PG8_LDB(B0, 1, 0); PG8_SCHED; PG8_LDA(At, 1, 0); PG8_STAGE(PG8_SA(0, 1), a2 + hstep, voffA);
            PG8_WAIT_L(8); PG8_BAR; PG8_WAIT_L(0); PG8_MMA(0, 0, At, B0); PG8_BAR; PG8_SCHED;
            PG8_LDB(B1, 1, 1); PG8_STAGE(PG8_SB(1, 0), b3, voffB);
            PG8_BAR; PG8_WAIT_L(0); PG8_MMA(0, 1, At, B1); PG8_BAR;
            PG8_LDA(At, 1, 1); PG8_STAGE(PG8_SA(1, 0), a3, voffA);
            PG8_BAR; PG8_WAIT_L(0); PG8_MMA(1, 0, At, B0); PG8_BAR; PG8_SCHED;
            PG8_STAGE(PG8_SB(1, 1), b3 + hstep, voffB);
            PG8_WAIT_V(6); PG8_BAR; PG8_MMA(1, 1, At, B1); PG8_BAR;
            }
        }
        if constexpr (ALIGN_EPI) { if (wr == 0) PG8_BAR; }
        if constexpr (!Epi::AFTER_DRAIN) { E(acc, cur, wr, wc, fr, fq); S.done(cur); }
        if (!has_next) break;
#pragma unroll
        for (int a = 0; a < 2; ++a)
#pragma unroll
            for (int b = 0; b < 2; ++b)
#pragma unroll
                for (int m = 0; m < 4; ++m)
#pragma unroll
                    for (int n = 0; n < 2; ++n) acc[a][b][m][n] = (f32x4){0.f, 0.f, 0.f, 0.f};
        cur = nxt; cA = nA; cB = nB; ++ui;
        if constexpr (ALIGN_EPI) { if (wr == 1) PG8_BAR; }
    }
    PG8_WAIT_V(0);
    if constexpr (!ALIGN_EPI) { if (wr == 0) PG8_BAR; }
    PG8_BAR;
    if constexpr (Epi::AFTER_DRAIN) { E.fused(acc, cur, wr, wc, fr, fq, lds, wid, lane); S.done(cur); }
#undef PG8_SA
#undef PG8_SB
#undef PG8_STAGE
#undef PG8_LDA
#undef PG8_LDB
#undef PG8_MMA
#undef PG8_WAIT_V
#undef PG8_WAIT_L
#undef PG8_BAR
#undef PG8_SCHED
}
}

#include <hip/hip_bf16.h>
#include <cmath>
namespace attn_body {
using bf16=__hip_bfloat16;
using bf16x8=__attribute__((ext_vector_type(8)))short;
using s16x4=__attribute__((ext_vector_type(4)))short;
using f32x16=__attribute__((ext_vector_type(16)))float;
using u32x4=__attribute__((ext_vector_type(4)))unsigned;
constexpr int BATCH=2,NHEAD=16,SEQ=16384,D=64,DM=NHEAD*D;
constexpr int NW=8,QBLK=32,QB=QBLK*NW,KVBLK=64,NQB=SEQ/QB;
constexpr int ATTN_PITCH=DM, ATTN_UNIT_ROWS=QB;
__device__ __forceinline__ int crow(int r,int hi){return (r&3)+8*(r>>2)+4*hi;}
#define SBAR() __builtin_amdgcn_sched_barrier(0)
__device__ __forceinline__ void cmask(f32x16&p0,f32x16&p1,int jb,int qrel,int hi){
  const float NEG=-INFINITY; int kb=64*jb+4*hi;
  #pragma unroll
  for(int r=0;r<16;++r){int kv=kb+(r&3)+8*(r>>2); if(kv>qrel)p0[r]=NEG; if(kv+32>qrel)p1[r]=NEG;}
}

constexpr int NSLOT=3, SLOTB=8192;
constexpr int LDS_K=0, LDS_V=NSLOT*SLOTB, LDS_WS=2*NSLOT*SLOTB, LDS_OST=LDS_WS+NW*64*4, LDS_BYTES=LDS_OST+NW*4096;
constexpr float C2=0.125f*1.4426950408889634f;
__device__ __forceinline__ void glds16(const void*gsrc,unsigned lds_dst){unsigned keep;
  asm volatile("s_mov_b32 %0, m0\n\ts_mov_b32 m0, %2\n\ts_nop 0\n\tglobal_load_lds_dwordx4 %1, off\n\ts_mov_b32 m0, %0":"=&s"(keep):"v"(gsrc),"s"(lds_dst):"memory");}
__device__ __forceinline__ float max3f(float a,float b,float c){float r;asm("v_max3_f32 %0, %1, %2, %3":"=v"(r):"v"(a),"v"(b),"v"(c));return r;}
__device__ __forceinline__ float max2f(float a,float b){float r;asm("v_max_f32_e32 %0, %1, %2":"=v"(r):"v"(a),"v"(b));return r;}
__device__ __forceinline__ float fadd_s(float a,float b){float r;asm("v_add_f32_e32 %0, %1, %2":"=v"(r):"v"(a),"v"(b));return r;}
__device__ __forceinline__ float fsub_s(float a,float b){float r;asm("v_sub_f32_e32 %0, %1, %2":"=v"(r):"v"(a),"v"(b));return r;}
typedef float f32x2_t __attribute__((ext_vector_type(2))); typedef __bf16 bf16x2_t __attribute__((ext_vector_type(2)));
__device__ __forceinline__ unsigned cvtpk_s(float lo,float hi){f32x2_t v={lo,hi};bf16x2_t b=__builtin_convertvector(v,bf16x2_t);return __builtin_bit_cast(unsigned,b);}
#define WAIT_BAR(N) asm volatile("s_waitcnt vmcnt(" #N ") lgkmcnt(0)\n\ts_barrier":::"memory")

__device__ __forceinline__ void qkt(f32x16&p0,f32x16&p1,const char*Kslot,const bf16x8*qr,const f32x16&negm,int r32,int hi){
  const char*kb=Kslot+hi*1024+r32*16;
  #pragma unroll
  for(int d0=0;d0<4;++d0){
    const bf16x8 b0=*reinterpret_cast<const bf16x8*>(kb+d0*2048);
    const bf16x8 b1=*reinterpret_cast<const bf16x8*>(kb+d0*2048+512);
    if(d0==0){p0=__builtin_amdgcn_mfma_f32_32x32x16_bf16(b0,qr[0],negm,0,0,0);p1=__builtin_amdgcn_mfma_f32_32x32x16_bf16(b1,qr[0],negm,0,0,0);}
    else{p0=__builtin_amdgcn_mfma_f32_32x32x16_bf16(b0,qr[d0],p0,0,0,0);p1=__builtin_amdgcn_mfma_f32_32x32x16_bf16(b1,qr[d0],p1,0,0,0);}}
}
typedef __attribute__((address_space(3))) const char* lds_cptr;
typedef short v4i16_t __attribute__((ext_vector_type(4)));
__device__ __forceinline__ void kload8(bf16x8*kf,lds_cptr kp){
  kf[0]=*(const __attribute__((address_space(3))) bf16x8*)(kp);      kf[1]=*(const __attribute__((address_space(3))) bf16x8*)(kp+512);
  kf[2]=*(const __attribute__((address_space(3))) bf16x8*)(kp+2048); kf[3]=*(const __attribute__((address_space(3))) bf16x8*)(kp+2560);
  kf[4]=*(const __attribute__((address_space(3))) bf16x8*)(kp+4096); kf[5]=*(const __attribute__((address_space(3))) bf16x8*)(kp+4608);
  kf[6]=*(const __attribute__((address_space(3))) bf16x8*)(kp+6144); kf[7]=*(const __attribute__((address_space(3))) bf16x8*)(kp+6656);
}
__device__ __forceinline__ void kload2(bf16x8*kf,lds_cptr kp,int j){ kf[2*j]=*(const __attribute__((address_space(3))) bf16x8*)(kp+j*2048); kf[2*j+1]=*(const __attribute__((address_space(3))) bf16x8*)(kp+j*2048+512); }
__device__ __forceinline__ s16x4 vtr(lds_cptr p){ return __builtin_bit_cast(s16x4,__builtin_amdgcn_ds_read_tr16_b64_v4i16((__attribute__((address_space(3))) v4i16_t*)p)); }
__device__ __forceinline__ float rowmax(const f32x16&p0,const f32x16&p1){
  float a=max3f(p0[0],p0[1],p1[0]),b=max3f(p0[2],p0[3],p1[1]);a=max3f(a,p1[2],p1[3]);
  #pragma unroll
  for(int r=4;r<16;r+=4){a=max3f(a,p0[r],p0[r+1]);b=max3f(b,p0[r+2],p0[r+3]);a=max3f(a,p1[r],p1[r+1]);b=max3f(b,p1[r+2],p1[r+3]);}
  const float m=max2f(a,b);
  auto rr=__builtin_amdgcn_permlane32_swap(__float_as_uint(m),__float_as_uint(m),false,false);
  return max2f(__uint_as_float(rr[0]),__uint_as_float(rr[1]));
}
__device__ __forceinline__ void pv(f32x16*o,int vb,bf16x8 pa0,bf16x8 pa1,bf16x8 pa2,bf16x8 pa3){
  #pragma unroll
  for(int d0=0;d0<2;++d0){s16x4 lo[4],hi[4];
    #pragma unroll
    for(int ks=0;ks<4;++ks){
      asm volatile("ds_read_b64_tr_b16 %0,%1 offset:%c2":"=&v"(lo[ks]):"v"(vb),"i"(d0*4096+ks*1024):"memory");
      asm volatile("ds_read_b64_tr_b16 %0,%1 offset:%c2":"=&v"(hi[ks]):"v"(vb),"i"(d0*4096+ks*1024+512):"memory");}
    asm volatile("s_waitcnt lgkmcnt(0)":::"memory");SBAR();
    #define PK(k) (bf16x8){lo[k][0],lo[k][1],lo[k][2],lo[k][3],hi[k][0],hi[k][1],hi[k][2],hi[k][3]}
    o[d0]=__builtin_amdgcn_mfma_f32_32x32x16_bf16(pa0,PK(0),o[d0],0,0,0);
    o[d0]=__builtin_amdgcn_mfma_f32_32x32x16_bf16(pa1,PK(1),o[d0],0,0,0);
    o[d0]=__builtin_amdgcn_mfma_f32_32x32x16_bf16(pa2,PK(2),o[d0],0,0,0);
    o[d0]=__builtin_amdgcn_mfma_f32_32x32x16_bf16(pa3,PK(3),o[d0],0,0,0);
    #undef PK
  }
}

#ifndef ATTN_STORE16
#define ATTN_STORE16(p,v) (*(u32x4*)(p)=(v))
#endif
template<int THRL> __device__ __forceinline__ void attn_unit(int b,int cq,int cv,int qb,const bf16*Q,const bf16*__restrict__ K,const bf16*__restrict__ V,bf16*O,char*shm){
  int tid_=threadIdx.x; asm volatile("":"+v"(tid_)); const int tid=tid_,lane=tid&63,r32=lane&31,hi=lane>>5; const int wid=__builtin_amdgcn_readfirstlane(tid>>6);
  const long rowbase=(long)b*SEQ; const int q0=qb*QB;
  const bf16*Qw=Q+(rowbase+q0+wid*QBLK)*DM+cq;
  const bf16*Kh=K+rowbase*DM+cq,*Vh=V+rowbase*DM+cv;
  const unsigned lds0=(unsigned)(uintptr_t)shm;
  float*wsf=(float*)(shm+LDS_WS)+wid*64;
  const bf16*ksrc=Kh+(long)lane*DM+wid*8;
  const bf16*vsrc=Vh+(long)(16*(wid&3)+(lane>>2))*DM+(wid>>2)*32+(lane&3)*8;
  const unsigned kdst=lds0+LDS_K+wid*1024, vdst=lds0+LDS_V+wid*1024;
  #define DMA_K(t,slot) glds16(ksrc+(long)(t)*KVBLK*DM,(unsigned)__builtin_amdgcn_readfirstlane(kdst+(slot)))
  #define DMA_V(t,slot) glds16(vsrc+(long)(t)*KVBLK*DM,(unsigned)__builtin_amdgcn_readfirstlane(vdst+(slot)))
  const int vb0=(int)(lds0+LDS_V)+((lane>>4)&1)*32+(lane&3)*8+(4*hi+((lane&15)>>2))*64;
  const char*Kbase=shm+LDS_K; bf16x8 kf[8];
  const lds_cptr shm3=(lds_cptr)shm; const lds_cptr kp0=shm3+LDS_K+hi*1024+r32*16; const lds_cptr vp0=shm3+LDS_V+((lane>>4)&1)*32+(lane&3)*8+(4*hi+((lane&15)>>2))*64;
  const int NT=(q0+QB)/KVBLK;
  DMA_K(0,0);DMA_V(0,0);DMA_K(1,SLOTB);
  bf16x8 qr[4];
  #pragma unroll
  for(int d0=0;d0<4;++d0)qr[d0]=*reinterpret_cast<const bf16x8*>(&Qw[(long)r32*DM+d0*16+hi*8]);
  float mhat=0.f,l_reg=0.f;f32x16 o[2];o[0]=f32x16{};o[1]=f32x16{};f32x16 negm=f32x16{};asm volatile("":"+v"(negm));
  const int qrel=wid*QBLK+r32;
  #define CMASK(P0,P1,t) do{int jb_=(t)-(NT-4); if(jb_>=0)cmask(P0,P1,jb_,qrel,hi);}while(0)
  bool resc=false;
  #define START(P0,P1) do{ const float rm=rowmax(P0,P1); resc=false; \
    { const float dl=rm; mhat=fadd_s(mhat,dl); \
      _Pragma("unroll") for(int r=0;r<16;++r){P0[r]=fsub_s(P0[r],dl);P1[r]=fsub_s(P1[r],dl);} \
      _Pragma("unroll") for(int r=0;r<16;++r)negm[r]=-mhat; asm volatile("":"+v"(negm)); } \
    _Pragma("unroll") for(int r=0;r<16;++r)P0[r]=__builtin_amdgcn_exp2f(P0[r]); }while(0)
  #define RESC() do{ if(resc){ asm volatile("s_waitcnt lgkmcnt(0)":::"memory"); \
      _Pragma("unroll") for(int d_=0;d_<2;++d_) _Pragma("unroll") for(int r=0;r<16;++r)o[d_][r]*=wsf[crow(r,hi)]; } }while(0)
  f32x16 pA0,pA1,pB0,pB1;
  int sl_prev=0,sl_cur=0,sl_next=SLOTB;
  #define ROT() do{sl_prev=sl_cur;sl_cur=sl_next;sl_next=(sl_next==(NSLOT-1)*SLOTB)?0:sl_next+SLOTB;}while(0)
  DMA_K(2,2*SLOTB);
  WAIT_BAR(3);
  qkt(pA0,pA1,Kbase,qr,negm,r32,hi);asm volatile("s_nop 15\n\ts_nop 7":"+v"(pA0),"+v"(pA1));CMASK(pA0,pA1,0);
  START(pA0,pA1);
  _Pragma("unroll") for(int r=0;r<16;++r)pA1[r]=__builtin_amdgcn_exp2f(pA1[r]);
  WAIT_BAR(0);
  DMA_K(3,0);DMA_V(1,SLOTB);
  ROT();
  kload8(kf,kp0+sl_cur);
  WAIT_BAR(2);
  s16x4 vlo[8],vhi[8]; u32x4 pw0,pw1,pw2,pw3;
  #define PKW(P,B) cvtpk_s(P[B],P[B+1])
  #define PAF(k) __builtin_bit_cast(bf16x8,pw##k)
  #define VFR(i) (bf16x8){vlo[i][0],vlo[i][1],vlo[i][2],vlo[i][3],vhi[i][0],vhi[i][1],vhi[i][2],vhi[i][3]}
  #define PIN(x) asm volatile("":"+v"(x))
  #define MX3(a,b,c) __builtin_fmaxf(__builtin_fmaxf((a),(b)),(c))
  #define GAPA(MF,A0,A1,A2,A3,W0,W1,PW) do{ MF; sacc+=A0; sacc+=A1; sacc+=A2; sacc+=A3; PIN(sacc); W0; W1; PIN(PW); SBAR(); }while(0)
  #define EX(v) __builtin_amdgcn_exp2f(v)
  #define GAPB(MF,X,B) do{ MF; X[B]=EX(X[B]); X[B+1]=EX(X[B+1]); X[B+2]=EX(X[B+2]); X[B+3]=EX(X[B+3]); PIN(X); SBAR(); }while(0)
  #define VRD(i) do{ vlo[i]=vtr(vp_+(((i)>>2)*4096+((i)&3)*1024)); vhi[i]=vtr(vp_+(((i)>>2)*4096+((i)&3)*1024+512)); }while(0)
  #define KRD(G,j) do{ if(G){ kload2(kf,kp0+sl_next,j); SBAR(); } }while(0)
  #define STEP(C0,C1,P0,P1,t,GK,GV,GL) do{ SBAR(); \
    const lds_cptr vp_=vp0+sl_prev; \
    VRD(0); SBAR(); float sacc=(P0[0]+P0[1]); \
    GAPA(C0=__builtin_amdgcn_mfma_f32_32x32x16_bf16(kf[0],qr[0],negm,0,0,0), P0[2],P0[3],P0[4],P0[5],     pw0[0]=PKW(P0,0), pw0[1]=PKW(P0,2), pw0); \
    VRD(4); SBAR(); GAPA(C1=__builtin_amdgcn_mfma_f32_32x32x16_bf16(kf[1],qr[0],negm,0,0,0), P0[6],P0[7],P0[8],P0[9],     pw0[2]=PKW(P0,4), pw0[3]=PKW(P0,6), pw0); \
    VRD(1); SBAR(); GAPA(C0=__builtin_amdgcn_mfma_f32_32x32x16_bf16(kf[2],qr[1],C0,0,0,0),   P0[10],P0[11],P0[12],P0[13], pw1[0]=PKW(P0,8), pw1[1]=PKW(P0,10), pw1); \
    VRD(5); SBAR(); GAPA(C1=__builtin_amdgcn_mfma_f32_32x32x16_bf16(kf[3],qr[1],C1,0,0,0),   P0[14],P0[15],P1[0],P1[1],   pw1[2]=PKW(P0,12),pw1[3]=PKW(P0,14), pw1); \
    VRD(2); SBAR(); GAPA(C0=__builtin_amdgcn_mfma_f32_32x32x16_bf16(kf[4],qr[2],C0,0,0,0),   P1[2],P1[3],P1[4],P1[5],     pw2[0]=PKW(P1,0), pw2[1]=PKW(P1,2), pw2); \
    VRD(6); SBAR(); GAPA(C1=__builtin_amdgcn_mfma_f32_32x32x16_bf16(kf[5],qr[2],C1,0,0,0),   P1[6],P1[7],P1[8],P1[9],     pw2[2]=PKW(P1,4), pw2[3]=PKW(P1,6), pw2); \
    VRD(3); SBAR(); GAPA(C0=__builtin_amdgcn_mfma_f32_32x32x16_bf16(kf[6],qr[3],C0,0,0,0),   P1[10],P1[11],P1[12],P1[13], pw3[0]=PKW(P1,8), pw3[1]=PKW(P1,10), pw3); \
    VRD(7); SBAR(); GAPA(C1=__builtin_amdgcn_mfma_f32_32x32x16_bf16(kf[7],qr[3],C1,0,0,0),   P1[14],P1[15],0.f,0.f,       pw3[2]=PKW(P1,12),pw3[3]=PKW(P1,14), pw3); \
    l_reg+=sacc; \
    if(GK){DMA_K((t)+3,sl_cur);} if(GV){DMA_V((t)+1,sl_next);} \
    CMASK(C0,C1,t); \
    { float a=MX3(C0[0],C0[1],C1[0]),b=MX3(C0[2],C0[3],C1[1]); a=MX3(a,C1[2],C1[3]); \
      _Pragma("unroll") for(int r=4;r<16;r+=4){a=MX3(a,C0[r],C0[r+1]);b=MX3(b,C0[r+2],C0[r+3]);a=MX3(a,C1[r],C1[r+1]);b=MX3(b,C1[r+2],C1[r+3]);} \
      float rm=__builtin_fmaxf(a,b); { auto rr=__builtin_amdgcn_permlane32_swap(__float_as_uint(rm),__float_as_uint(rm),false,false); rm=__builtin_fmaxf(__uint_as_float(rr[0]),__uint_as_float(rr[1])); } \
      resc=false; \
      if(__builtin_expect(__any(rm>(float)THRL),0)){ const float dl=__builtin_fmaxf(rm,0.f); mhat+=dl; \
        _Pragma("unroll") for(int r=0;r<16;++r){C0[r]-=dl;C1[r]-=dl;} \
        _Pragma("unroll") for(int r=0;r<16;++r)negm[r]=-mhat; asm volatile("":"+v"(negm)); \
        const float f=__builtin_amdgcn_exp2f(-dl); l_reg*=f; if(hi==0)wsf[r32]=f; resc=true; } } \
    SBAR(); \
    GAPB(o[0]=__builtin_amdgcn_mfma_f32_32x32x16_bf16(PAF(0),VFR(0),o[0],0,0,0), C0,0); \
    GAPB(o[1]=__builtin_amdgcn_mfma_f32_32x32x16_bf16(PAF(0),VFR(4),o[1],0,0,0), C0,4); \
    KRD(GL,0); GAPB(o[0]=__builtin_amdgcn_mfma_f32_32x32x16_bf16(PAF(1),VFR(1),o[0],0,0,0), C0,8); \
    KRD(GL,1); GAPB(o[1]=__builtin_amdgcn_mfma_f32_32x32x16_bf16(PAF(1),VFR(5),o[1],0,0,0), C0,12); \
    KRD(GL,2); GAPB(o[0]=__builtin_amdgcn_mfma_f32_32x32x16_bf16(PAF(2),VFR(2),o[0],0,0,0), C1,0); \
    KRD(GL,3); GAPB(o[1]=__builtin_amdgcn_mfma_f32_32x32x16_bf16(PAF(2),VFR(6),o[1],0,0,0), C1,4); \
    GAPB(o[0]=__builtin_amdgcn_mfma_f32_32x32x16_bf16(PAF(3),VFR(3),o[0],0,0,0), C1,8); \
    GAPB(o[1]=__builtin_amdgcn_mfma_f32_32x32x16_bf16(PAF(3),VFR(7),o[1],0,0,0), C1,12); \
    }while(0)
  int t=1;
  #undef CMASK
  #define CMASK(P0,P1,t) do{}while(0)
  for(;t+5<NT;t+=2){
    STEP(pB0,pB1,pA0,pA1,t,true,true,true);     WAIT_BAR(2); RESC(); ROT();
    STEP(pA0,pA1,pB0,pB1,t+1,true,true,true);   WAIT_BAR(2); RESC(); ROT();
  }
  #undef CMASK
  #define CMASK(P0,P1,t) do{int jb_=(t)-(NT-4); if(jb_>=0)cmask(P0,P1,jb_,qrel,hi);}while(0)
  #define ENDW(tt) do{ if((tt)+3<NT){WAIT_BAR(2);} else if((tt)+2<NT){WAIT_BAR(1);} else {WAIT_BAR(0);} }while(0)
  for(;t+1<NT;t+=2){
    STEP(pB0,pB1,pA0,pA1,t,(t+3<NT),(t+1<NT),(t+1<NT));       ENDW(t);   RESC(); ROT();
    STEP(pA0,pA1,pB0,pB1,t+1,(t+4<NT),(t+2<NT),(t+2<NT));     ENDW(t+1); RESC(); ROT();
  }
  STEP(pB0,pB1,pA0,pA1,NT-1,false,false,false); RESC();
  { float sacc=pB0[0]+pB0[1]; _Pragma("unroll") for(int r=2;r<16;++r)sacc+=pB0[r]; _Pragma("unroll") for(int r=0;r<16;++r)sacc+=pB1[r]; l_reg+=sacc;
    pw0=(u32x4){PKW(pB0,0),PKW(pB0,2),PKW(pB0,4),PKW(pB0,6)};pw1=(u32x4){PKW(pB0,8),PKW(pB0,10),PKW(pB0,12),PKW(pB0,14)};pw2=(u32x4){PKW(pB1,0),PKW(pB1,2),PKW(pB1,4),PKW(pB1,6)};pw3=(u32x4){PKW(pB1,8),PKW(pB1,10),PKW(pB1,12),PKW(pB1,14)};
    SBAR(); pv(o,vb0+sl_cur,PAF(0),PAF(1),PAF(2),PAF(3)); }
  #undef PKW
  #undef PAF
  #undef VFR
  #undef PIN
  #undef MX3
  #undef GAPA
  #undef GAPB
  #undef EX
  #undef VRD
  #undef KRD
  #undef STEP
  #undef ENDW
  {auto rr=__builtin_amdgcn_permlane32_swap(__float_as_uint(l_reg),__float_as_uint(l_reg),false,false);l_reg=__uint_as_float(rr[0])+__uint_as_float(rr[1]);}
  if(hi==0)wsf[32+r32]=l_reg;asm volatile("s_waitcnt lgkmcnt(0)":::"memory");
  float rli[16];
  #pragma unroll
  for(int r=0;r<16;++r)rli[r]=__builtin_amdgcn_rcpf(wsf[32+crow(r,hi)]);
  bf16*Ow=O+(rowbase+q0+wid*QBLK)*DM+cv;
  { bf16*stg=(bf16*)(shm+LDS_OST)+wid*2048;
    #pragma unroll
    for(int r=0;r<16;++r){const int orow=crow(r,hi);
      #pragma unroll
      for(int d0=0;d0<2;++d0)stg[orow*64+d0*32+r32]=__float2bfloat16(o[d0][r]*rli[r]);}
    asm volatile("s_waitcnt lgkmcnt(0)":::"memory");
    #pragma unroll
    for(int i=0;i<4;++i){const int row=i*8+(lane>>3),ch=lane&7; const u32x4 v=*(const u32x4*)(stg+row*64+ch*8); ATTN_STORE16(Ow+(long)row*DM+ch*8,v);} }
  asm volatile("s_waitcnt lgkmcnt(0)\n\ts_barrier":::"memory");
  #undef DMA_K
  #undef DMA_V
  #undef CMASK
  #undef START
  #undef RESC
  #undef ROT
}
constexpr int ATTN_LDS_BYTES=LDS_BYTES;
struct AttnTensors { const bf16* Q; const bf16* K; const bf16* V; bf16* O0; bf16* O1; };
template<int THRL> __device__ __forceinline__ void attn_phase(char*lds,const AttnTensors&T,int vcu,int G){
  for(int v=vcu;v<256;v+=G){
    const int e=v>>2,s=v&3; const int b=e>>5,rem=e&31,h=rem>>2,m=(rem>>1)&1,vh=rem&1;
    const int cq=(2*h+m)*64,cv=(2*h+vh)*64; bf16*O=m?T.O1:T.O0;
    for(int i=0;i<16;++i){ const int j=i>>1; const int qb=(i&1)?(8*j+7-s):(8*j+s); attn_unit<THRL>(b,cq,cv,qb,T.Q,T.K,T.V,O,lds); }
  }
}
#undef SBAR
#undef WAIT_BAR
}

#define GAS __attribute__((address_space(1)))
#define LAS __attribute__((address_space(3)))
typedef unsigned short bf16;
typedef unsigned v4u __attribute__((ext_vector_type(4)));
typedef float f32x4 __attribute__((ext_vector_type(4)));
typedef short bf16x8 __attribute__((ext_vector_type(8)));
typedef GAS unsigned gu32;
typedef GAS unsigned long long gu64;
#define RLX_AGENT __ATOMIC_RELAXED, __HIP_MEMORY_SCOPE_AGENT
#define LDS_WAIT() asm volatile("s_waitcnt lgkmcnt(0)" ::: "memory")
#define VM_WAIT() asm volatile("s_waitcnt vmcnt(0)" ::: "memory")
__device__ __forceinline__ unsigned long long rt() { return __builtin_amdgcn_s_memrealtime(); }

constexpr int NWAVES = 8;
#ifndef REP_SCAN
#define REP_SCAN 1
#endif
#ifndef REP_ATTN
#define REP_ATTN 1
#endif
#ifndef REP_G1
#define REP_G1 1
#endif
constexpr int BATCH = 2, SEQ = 16384, D = 1024, M = BATCH * SEQ;
constexpr size_t MiB = 1u << 20;
constexpr size_t WS_ROPE_C = 1 * MiB, WS_ROPE_S = 2 * MiB, WS_S = 3 * MiB, WS_BIAS = 5 * MiB, WS_W = 6 * MiB, WS_U = 32 * MiB, UNIT = 64 * MiB, WS_H = WS_U + 7 * UNIT, WS_END = WS_H + 16 * MiB;
constexpr size_t W_FOLD = 0, W_UP = 17 * MiB, W_OUT = 19 * MiB;
constexpr size_t W_PROJ = 0, W_BOUT = 8 * MiB;
constexpr int LDS_BYTES = 147456;
constexpr float C2F = 0.125f * 1.4426950408889634f;

typedef _Float16 h16x4 __attribute__((ext_vector_type(4)));
typedef unsigned u32x2 __attribute__((ext_vector_type(2)));
typedef float f32x2 __attribute__((ext_vector_type(2)));
__device__ __forceinline__ unsigned f2bf(float f) { unsigned u = __builtin_bit_cast(unsigned, f); return (u + 0x7fffu + ((u >> 16) & 1u)) >> 16; }
__device__ __forceinline__ unsigned pk2(float lo, float hi) { return f2bf(lo) | (f2bf(hi) << 16); }
__device__ __forceinline__ float bflo(unsigned w) { return __uint_as_float(w << 16); }
__device__ __forceinline__ float bfhi(unsigned w) { return __uint_as_float(w & 0xffff0000u); }
__device__ __forceinline__ float wave_sum(float v) {
#pragma unroll
    for (int o = 1; o < 64; o <<= 1) v += __shfl_xor(v, o);
    return v;
}
template <int CTRL> __device__ __forceinline__ float dpp_mov(float x) { return __builtin_bit_cast(float, __builtin_amdgcn_update_dpp(0, __builtin_bit_cast(int, x), CTRL, 0xf, 0xf, false)); }
__device__ __forceinline__ float allreduce16(float x) { x += dpp_mov<0x128>(x); x += dpp_mov<0x124>(x); x += dpp_mov<0x122>(x); x += dpp_mov<0x121>(x); return x; }

__device__ __forceinline__ void conv_tile(const float* src, int ldsrc, int k0s, int n0s, int kvalid, const float* sc, int smode, bf16* dst, int pitch, int n0d, int k0d, LAS float* scr, int lane) {
#pragma unroll 8
    for (int i = 0; i < 32; ++i) { const int kk = 2 * i + (lane >> 5), n = lane & 31; float v = 0.f;
        if (kk < kvalid) { v = src[(size_t)(k0s + kk) * ldsrc + n0s + n]; if (smode) { const float s = sc[k0s + kk]; v *= (smode == 1) ? s : (1.0f - s); } }
        scr[kk * 33 + n] = v; }
    LDS_WAIT(); asm volatile("" ::: "memory");
    const int c = lane & 7;
#pragma unroll
    for (int j = 0; j < 4; ++j) { const int n = (lane >> 3) + 8 * j; const LAS float* s = scr + (8 * c) * 33 + n;
        v4u o; o.x = pk2(s[0 * 33], s[1 * 33]); o.y = pk2(s[2 * 33], s[3 * 33]); o.z = pk2(s[4 * 33], s[5 * 33]); o.w = pk2(s[6 * 33], s[7 * 33]);
        *(v4u*)(dst + (size_t)(n0d + n) * pitch + k0d + 8 * c) = o; }
    LDS_WAIT(); asm volatile("" ::: "memory");
}

struct In {
    const float* x; const int* pos; const float *a_norm, *a_mu, *a_w_in, *a_w0, *a_w1, *a_w2, *a_a0, *a_a1, *a_a2, *a_v0, *a_v1, *a_v2, *a_k_k, *a_k_a, *a_r_k, *a_ln_w, *a_ln_b, *a_w_out;
    const float *kv_norm, *w_kv, *b_norm, *b_w_in, *b_lq1, *b_lk1, *b_lq2, *b_lk2, *b_subln, *b_w_out, *final_norm;
};

__device__ __forceinline__ void conv_rwkv(const In& I, int l, unsigned char* wreg, float* bias3, LAS float* scr, int gw, int NGW, int lane) {
    if (gw < 48) { const int i = gw * 64 + lane; const int t = i >> 10, c = i & 1023; bias3[i] = (t == 0) ? I.a_w0[l * 1024 + c] : (t == 1) ? I.a_a0[l * 1024 + c] : I.a_v0[c]; }
    bf16* Wf = (bf16*)(wreg + W_FOLD); bf16* Wu = (bf16*)(wreg + W_UP); bf16* Wo = (bf16*)(wreg + W_OUT);
    const int NUPB = (l == 0 ? 2048 : 3072) / 32;
    const int I_F = 136 * 32, I_U = NUPB * 4, I_O = 32 * 16;
    for (int it = gw; it < I_F + I_U + I_O; it += NGW) {
        int r = it;
        if (r < I_F) { const int nb = r >> 5, kb = r & 31; const int n0d = nb * 32, k0d = kb * 64, half = kb >> 4, k0s = (kb & 15) * 64;
            const float* mu = I.a_mu + (size_t)l * 6 * 1024;
            if (n0d < 4096) { const int p = n0d >> 10; conv_tile(I.a_w_in + (size_t)(l * 4 + p) * 1024 * 1024, 1024, k0s, n0d & 1023, 64, mu + p * 1024, half ? 1 : 2, Wf, 2048, n0d, k0d, scr, lane); }
            else { const int c0 = n0d - 4096;
                if (c0 < 64) conv_tile(I.a_w1 + (size_t)l * 1024 * 64, 64, k0s, c0, 64, mu + 4 * 1024, half ? 1 : 2, Wf, 2048, n0d, k0d, scr, lane);
                else if (c0 < 128) conv_tile(I.a_a1 + (size_t)l * 1024 * 64, 64, k0s, c0 - 64, 64, mu + 5 * 1024, half ? 1 : 2, Wf, 2048, n0d, k0d, scr, lane);
                else if (c0 < 160 && l == 1) conv_tile(I.a_v1, 32, k0s, 0, 64, mu + 2 * 1024, half ? 1 : 2, Wf, 2048, n0d, k0d, scr, lane);
                else conv_tile(I.a_w1, 64, 0, 0, 0, mu, 0, Wf, 2048, n0d, k0d, scr, lane); }
            continue; }
        r -= I_F;
        if (r < I_U) { const int nb = r >> 2, kb = r & 3; const int n0d = nb * 32, k0d = kb * 64, t = n0d >> 10;
            if (kb == t) { if (t == 0) conv_tile(I.a_w2 + (size_t)l * 64 * 1024, 1024, 0, n0d, 64, I.a_mu, 0, Wu, 256, n0d, k0d, scr, lane);
                else if (t == 1) conv_tile(I.a_a2 + (size_t)l * 64 * 1024, 1024, 0, n0d - 1024, 64, I.a_mu, 0, Wu, 256, n0d, k0d, scr, lane);
                else conv_tile(I.a_v2, 1024, 0, n0d - 2048, 32, I.a_mu, 0, Wu, 256, n0d, k0d, scr, lane); }
            else conv_tile(I.a_w2, 1024, 0, 0, 0, I.a_mu, 0, Wu, 256, n0d, k0d, scr, lane);
            continue; }
        r -= I_U;
        { const int nb = r >> 4, kb = r & 15; conv_tile(I.a_w_out + (size_t)l * 1024 * 1024, 1024, kb * 64, nb * 32, 64, I.a_mu, 0, Wo, 1024, nb * 32, kb * 64, scr, lane); }
    }
}
__device__ __forceinline__ void conv_attn(const In& I, int j, unsigned char* wreg, LAS float* scr, int gw, int NGW, int lane) {
    bf16* Wp = (bf16*)(wreg + W_PROJ); bf16* Wo = (bf16*)(wreg + W_BOUT);
    const int NPB = (j == 0 ? 4096 : 2048) / 32;
    const int I_P = NPB * 16, I_O = 32 * 16;
    for (int it = gw; it < I_P + I_O; it += NGW) {
        int r = it;
        if (r < I_P) { const int nb = r >> 4, kb = r & 15; const int n0d = nb * 32, k0 = kb * 64;
            if (j == 0) { if (n0d < 2048) conv_tile(I.w_kv, 2048, k0, n0d, 64, I.kv_norm, 1, Wp, 1024, n0d, k0, scr, lane);
                else conv_tile(I.b_w_in, 2048, k0, n0d - 2048, 64, I.b_norm, 1, Wp, 1024, n0d, k0, scr, lane); }
            else conv_tile(I.b_w_in + (size_t)1024 * 2048, 2048, k0, n0d, 64, I.b_norm + 1024, 1, Wp, 1024, n0d, k0, scr, lane);
            continue; }
        r -= I_P;
        { const int nb = r >> 4, kb = r & 15; conv_tile(I.b_w_out + (size_t)j * 1024 * 1024, 1024, kb * 64, nb * 32, 64, I.kv_norm, 0, Wo, 1024, nb * 32, kb * 64, scr, lane); }
    }
}

__device__ __forceinline__ void rope_tables(const int* pos, float* rc, float* rs, int gtid, int nthr) {
    for (int idx = gtid; idx < M * 8; idx += nthr) { const int m = idx >> 3, i = idx & 7;
        const float inv = (i == 0) ? 1.0f : (i == 1) ? 0.1939227432012558f : (i == 2) ? 0.03760603070259094f : (i == 3) ? 0.007292664609849453f : (i == 4) ? 0.0014142135623842478f : (i == 5) ? 0.00027424818836152554f : (i == 6) ? 5.3182957344688475e-05f : 1.0313385246263351e-05f;
        const float ang = (float)pos[m] * inv;
        const double x = (double)ang; const double k = __builtin_rint(x * 0.15915494309189535); const double r = x - k * 6.283185307179586476925;
        const double r2 = r * r; double sn = 0.0, cs = 0.0;
#pragma unroll
        for (int t = 12; t >= 1; --t) { sn = (1.0 - sn) * r2 / (double)((2 * t) * (2 * t + 1)); cs = (1.0 - cs) * r2 / (double)((2 * t - 1) * (2 * t)); }
        rs[idx] = (float)(r * (1.0 - sn)); rc[idx] = (float)(1.0 - cs); }
}

__device__ __forceinline__ void pre_rwkv(const float* x, const float* g, bf16* XN2, int gw, int NGW, int lane) {
    f32x4 gv[4];
#pragma unroll
    for (int j = 0; j < 4; ++j) gv[j] = *((const f32x4*)g + lane + 64 * j);
    for (int c = gw; c < M / 16; c += NGW) { const int m0 = c * 16;
        f32x4 prev[4];
#pragma unroll
        for (int j = 0; j < 4; ++j) prev[j] = (f32x4){0.f, 0.f, 0.f, 0.f};
        if ((m0 % SEQ) != 0) { const f32x4* xr = (const f32x4*)(x + (size_t)(m0 - 1) * D) + lane; f32x4 v[4]; float s = 0.f;
#pragma unroll
            for (int j = 0; j < 4; ++j) { v[j] = xr[64 * j]; s += (v[j].x * v[j].x + v[j].y * v[j].y) + (v[j].z * v[j].z + v[j].w * v[j].w); }
            const float rstd = 1.0f / sqrtf(wave_sum(s) * (1.0f / D) + 1e-6f);
#pragma unroll
            for (int j = 0; j < 4; ++j) prev[j] = v[j] * rstd * gv[j]; }
        for (int r = 0; r < 16; ++r) { const int m = m0 + r; const f32x4* xr = (const f32x4*)(x + (size_t)m * D) + lane; f32x4 v[4]; float s = 0.f;
#pragma unroll
            for (int j = 0; j < 4; ++j) { v[j] = xr[64 * j]; s += (v[j].x * v[j].x + v[j].y * v[j].y) + (v[j].z * v[j].z + v[j].w * v[j].w); }
            const float rstd = 1.0f / sqrtf(wave_sum(s) * (1.0f / D) + 1e-6f);
            unsigned long long* o8 = (unsigned long long*)(XN2 + (size_t)m * 2048) + lane;
#pragma unroll
            for (int j = 0; j < 4; ++j) { const f32x4 xn = v[j] * rstd * gv[j];
                o8[64 * j] = (unsigned long long)pk2(xn.x, xn.y) | ((unsigned long long)pk2(xn.z, xn.w) << 32);
                o8[256 + 64 * j] = (unsigned long long)pk2(prev[j].x, prev[j].y) | ((unsigned long long)pk2(prev[j].z, prev[j].w) << 32);
                prev[j] = xn; } }
    }
}
__device__ __forceinline__ void pre_attn(const float* x, bf16* XH, int gw, int NGW, int lane) {
    for (int m = gw; m < M; m += NGW) { const f32x4* xr = (const f32x4*)(x + (size_t)m * D) + lane; f32x4 v[4]; float s = 0.f;
#pragma unroll
        for (int j = 0; j < 4; ++j) { v[j] = xr[64 * j]; s += (v[j].x * v[j].x + v[j].y * v[j].y) + (v[j].z * v[j].z + v[j].w * v[j].w); }
        const float rstd = 1.0f / sqrtf(wave_sum(s) * (1.0f / D) + 1e-6f);
        unsigned long long* o8 = (unsigned long long*)(XH + (size_t)m * D) + lane;
#pragma unroll
        for (int j = 0; j < 4; ++j) o8[64 * j] = (unsigned long long)pk2(v[j].x * rstd, v[j].y * rstd) | ((unsigned long long)pk2(v[j].z * rstd, v[j].w * rstd) << 32); }
}
__device__ __forceinline__ void final_norm_rows(const float* x, const float* g, float* out, int gw, int NGW, int lane) {
    f32x4 gv[4];
#pragma unroll
    for (int j = 0; j < 4; ++j) gv[j] = *((const f32x4*)g + lane + 64 * j);
    for (int m = gw; m < M; m += NGW) { const f32x4* xr = (const f32x4*)(x + (size_t)m * D) + lane; f32x4 v[4]; float s = 0.f;
#pragma unroll
        for (int j = 0; j < 4; ++j) { v[j] = xr[64 * j]; s += (v[j].x * v[j].x + v[j].y * v[j].y) + (v[j].z * v[j].z + v[j].w * v[j].w); }
        const float rstd = 1.0f / sqrtf(wave_sum(s) * (1.0f / D) + 1e-6f);
        f32x4* o = (f32x4*)(out + (size_t)m * D) + lane;
#pragma unroll
        for (int j = 0; j < 4; ++j) o[64 * j] = v[j] * rstd * gv[j]; }
}

__device__ __forceinline__ void ld16bf(const bf16* p, float (&f)[16]) { const v4u a = *(const v4u*)p, b = *(const v4u*)(p + 8);
    f[0] = bflo(a.x); f[1] = bfhi(a.x); f[2] = bflo(a.y); f[3] = bfhi(a.y); f[4] = bflo(a.z); f[5] = bfhi(a.z); f[6] = bflo(a.w); f[7] = bfhi(a.w);
    f[8] = bflo(b.x); f[9] = bfhi(b.x); f[10] = bflo(b.y); f[11] = bfhi(b.y); f[12] = bflo(b.z); f[13] = bfhi(b.z); f[14] = bflo(b.w); f[15] = bfhi(b.w); }
__device__ __forceinline__ void st16bf(bf16* p, const float (&f)[16]) { v4u a, b;
    a.x = pk2(f[0], f[1]); a.y = pk2(f[2], f[3]); a.z = pk2(f[4], f[5]); a.w = pk2(f[6], f[7]); b.x = pk2(f[8], f[9]); b.y = pk2(f[10], f[11]); b.z = pk2(f[12], f[13]); b.w = pk2(f[14], f[15]);
    *(v4u*)p = a; *(v4u*)(p + 8) = b; }

__device__ __forceinline__ void post_rwkv(const bf16* Y, const float* S, const bf16* V, const bf16* G, const float* ln_w, const float* ln_b, bf16* O, int gw, int NGW, int lane) {
    float lw[16], lb[16];
#pragma unroll
    for (int i = 0; i < 16; ++i) { lw[i] = ln_w[lane * 16 + i]; lb[i] = ln_b[lane * 16 + i]; }
    for (int m = gw; m < M; m += NGW) { const size_t off = (size_t)m * D + lane * 16;
        float y[16], v[16], g[16], o[16]; ld16bf(Y + off, y); ld16bf(V + off, v); ld16bf(G + off, g);
        const float sb = S[(size_t)m * 16 + (lane >> 2)];
        float sum = 0.f;
#pragma unroll
        for (int i = 0; i < 16; ++i) sum += y[i];
        sum += __shfl_xor(sum, 1); sum += __shfl_xor(sum, 2);
        const float mean = sum * (1.0f / 64.0f); float q = 0.f;
#pragma unroll
        for (int i = 0; i < 16; ++i) { const float d = y[i] - mean; q += d * d; }
        q += __shfl_xor(q, 1); q += __shfl_xor(q, 2);
        const float rstd = 1.0f / sqrtf(q * (1.0f / 64.0f) + 64e-5f);
#pragma unroll
        for (int i = 0; i < 16; ++i) { const float yn = (y[i] - mean) * rstd * lw[i] + lb[i]; o[i] = (yn + sb * v[i]) * (g[i] / (1.0f + __expf(-g[i]))); }
        st16bf(O + off, o); }
}
__device__ __forceinline__ void post_attn(const bf16* O0, const bf16* O1, const bf16* GT, const float* subln, float lam, float lam_init, bf16* O, int gw, int NGW, int lane) {
    float sw[16];
#pragma unroll
    for (int i = 0; i < 16; ++i) sw[i] = subln[(lane & 7) * 16 + i] * (1.0f - lam_init);
    for (int m = gw; m < M; m += NGW) { const size_t off = (size_t)m * D + lane * 16;
        float a[16], b[16], g[16], o[16]; ld16bf(O0 + off, a); ld16bf(O1 + off, b); ld16bf(GT + off, g);
        float q = 0.f;
#pragma unroll
        for (int i = 0; i < 16; ++i) { o[i] = a[i] - lam * b[i]; q += o[i] * o[i]; }
        q += __shfl_xor(q, 1); q += __shfl_xor(q, 2); q += __shfl_xor(q, 4);
        const float rstd = 1.0f / sqrtf(q * (1.0f / 128.0f) + 1e-5f);
#pragma unroll
        for (int i = 0; i < 16; ++i) o[i] = o[i] * rstd * sw[i] * (g[i] / (1.0f + __expf(-g[i])));
        st16bf(O + off, o); }
}

constexpr int SC_T = 16, SC_NB = SEQ / SC_T;
struct ScRaw { u32x2 r, k, w, a; v4u v; };
__device__ __forceinline__ void scan_phase(LAS unsigned char* lds, const bf16* R, const bf16* K, const bf16* V, const _Float16* W, const _Float16* A, const float* k_k, const float* k_a, const float* r_k,
                                           bf16* Y, float* S, int vcu, int G, int tid, int wave, int lane) {
    LAS float* OPS = (LAS float*)lds;
    LAS float* VB = (LAS float*)(lds + 40960);
    LAS float* YP = (LAS float*)(lds + 41984);
    for (int u = vcu; u < 256; u += G) {
        const int bh = u >> 3, rg = u & 7, b = bh >> 4, h = bh & 15;
        const size_t rowbase = (size_t)b * SEQ; const int cb = h * 64;
        const int p = tid - 128, ptt = (p >> 4) & 15, c4 = (p & 15) * 4;
        f32x4 kkw = {0.f, 0.f, 0.f, 0.f}, kaw = kkw, rkw = kkw;
        ScRaw rawA, rawB; rawA.r = (u32x2){0u, 0u}; rawA.k = rawA.r; rawA.w = rawA.r; rawA.a = rawA.r; rawA.v = (v4u){0u, 0u, 0u, 0u}; rawB = rawA;
        const bool prod = (wave >= 2 && wave < 6), vld = (wave == 6 && lane < 16), ywr = (wave == 7), cons = (wave < 2);
        if (prod) { kkw = *(const f32x4*)(k_k + cb + c4); kaw = *(const f32x4*)(k_a + cb + c4); rkw = *(const f32x4*)(r_k + cb + c4); }
        const int jq = lane & 15, rl = wave * 4 + (lane >> 4);
        f32x2 S01 = {0.f, 0.f}, S23 = {0.f, 0.f};
#define SC_LOAD(raw, nblk) do { if (prod) { const size_t o_ = (rowbase + (size_t)(nblk) * SC_T + ptt) * D + cb + c4; raw.r = *(const u32x2*)(R + o_); raw.k = *(const u32x2*)(K + o_); raw.w = *(const u32x2*)(W + o_); raw.a = *(const u32x2*)(A + o_); } \
        if (vld) { raw.v = *(const v4u*)(V + (rowbase + (size_t)(nblk) * SC_T + lane) * D + cb + rg * 8); } } while (0)
#define SC_DERIVE(raw, nblk, buf) do { if (prod) { \
            const float r0 = bflo(raw.r.x), r1 = bfhi(raw.r.x), r2 = bflo(raw.r.y), r3 = bfhi(raw.r.y); \
            const float k0 = bflo(raw.k.x), k1 = bfhi(raw.k.x), k2 = bflo(raw.k.y), k3 = bfhi(raw.k.y); \
            const h16x4 wh = __builtin_bit_cast(h16x4, raw.w), ah = __builtin_bit_cast(h16x4, raw.a); \
            const float a0 = (float)ah[0], a1 = (float)ah[1], a2 = (float)ah[2], a3 = (float)ah[3]; \
            const float x0 = k0 * kkw.x, x1 = k1 * kkw.y, x2 = k2 * kkw.z, x3 = k3 * kkw.w; \
            const float ss = allreduce16((x0 * x0 + x1 * x1) + (x2 * x2 + x3 * x3)); \
            const float inv = 1.0f / fmaxf(sqrtf(ss), 1e-12f); \
            const f32x4 kn = {x0 * inv, x1 * inv, x2 * inv, x3 * inv}; \
            const f32x4 km = {k0 * (1.0f + (a0 - 1.0f) * kaw.x), k1 * (1.0f + (a1 - 1.0f) * kaw.y), k2 * (1.0f + (a2 - 1.0f) * kaw.z), k3 * (1.0f + (a3 - 1.0f) * kaw.w)}; \
            const float sp = allreduce16((r0 * km.x * rkw.x + r1 * km.y * rkw.y) + (r2 * km.z * rkw.z + r3 * km.w * rkw.w)); \
            LAS float* op_ = OPS + (buf) * 5120 + ptt * 320 + c4; \
            *(LAS f32x4*)(op_) = -kn; \
            *(LAS f32x4*)(op_ + 64) = (f32x4){kn.x * a0, kn.y * a1, kn.z * a2, kn.w * a3}; \
            *(LAS f32x4*)(op_ + 128) = (f32x4){__expf(-__expf((float)wh[0])), __expf(-__expf((float)wh[1])), __expf(-__expf((float)wh[2])), __expf(-__expf((float)wh[3]))}; \
            *(LAS f32x4*)(op_ + 192) = km; \
            *(LAS f32x4*)(op_ + 256) = (f32x4){r0, r1, r2, r3}; \
            if (rg == 0 && c4 == 0) S[(rowbase + (size_t)(nblk) * SC_T + ptt) * 16 + h] = sp; } \
        if (vld) { LAS float* vb_ = VB + (buf) * 128 + lane * 8; \
            *(LAS f32x4*)(vb_) = (f32x4){bflo(raw.v.x), bfhi(raw.v.x), bflo(raw.v.y), bfhi(raw.v.y)}; *(LAS f32x4*)(vb_ + 4) = (f32x4){bflo(raw.v.z), bfhi(raw.v.z), bflo(raw.v.w), bfhi(raw.v.w)}; } } while (0)
#define SC_YOUT(nblk, buf) do { const int tt_ = lane >> 2, rp_ = lane & 3; const LAS f32x4* yp_ = (const LAS f32x4*)(YP + (buf) * 2048 + (tt_ * 8 + 2 * rp_) * 16); \
            const f32x4 q0 = yp_[0], q1 = yp_[1], q2 = yp_[2], q3 = yp_[3], q4 = yp_[4], q5 = yp_[5], q6 = yp_[6], q7 = yp_[7]; \
            const f32x4 e0 = (q0 + q1) + (q2 + q3), e1 = (q4 + q5) + (q6 + q7); \
            const float y0_ = (e0.x + e0.y) + (e0.z + e0.w), y1_ = (e1.x + e1.y) + (e1.z + e1.w); \
            *(unsigned*)(Y + (rowbase + (size_t)(nblk) * SC_T + tt_) * D + cb + rg * 8 + 2 * rp_) = pk2(y0_, y1_); } while (0)
#define SC_LDOPS(N, B, W, K, R, VV, t) do { const LAS float* o_ = ops + (t) * 320; N = *(const LAS f32x4*)(o_); B = *(const LAS f32x4*)(o_ + 64); W = *(const LAS f32x4*)(o_ + 128); K = *(const LAS f32x4*)(o_ + 192); R = *(const LAS f32x4*)(o_ + 256); VV = vb[(t) * 8]; } while (0)
#define SC_CONSUME(buf) do { const LAS float* ops = OPS + (buf) * 5120 + 4 * jq; const LAS float* vb = VB + (buf) * 128 + rl; LAS float* yp = YP + (buf) * 2048 + rl * 16 + jq; \
            f32x4 nk, bb, dw, km, rr, nk2, bb2, dw2, km2, rr2; float vi, vi2; SC_LDOPS(nk, bb, dw, km, rr, vi, 0); SC_LDOPS(nk2, bb2, dw2, km2, rr2, vi2, 1); \
            _Pragma("unroll") for (int tt = 0; tt < SC_T; ++tt) { \
                f32x4 nk3 = nk2, bb3 = bb2, dw3 = dw2, km3 = km2, rr3 = rr2; float vi3 = vi2; \
                if (tt + 2 < SC_T) SC_LDOPS(nk3, bb3, dw3, km3, rr3, vi3, tt + 2); \
                asm volatile("" ::: "memory"); \
                const f32x2 t_ = S01 * nk.lo + S23 * nk.hi; \
                const f32x2 P01 = S01 * dw.lo + km.lo * vi, P23 = S23 * dw.hi + km.hi * vi; \
                const float sa = allreduce16(t_.x + t_.y); \
                S01 = P01 + bb.lo * sa; S23 = P23 + bb.hi * sa; \
                const f32x2 y_ = S01 * rr.lo + S23 * rr.hi; \
                yp[tt * 128] = y_.x + y_.y; \
                nk = nk2; bb = bb2; dw = dw2; km = km2; rr = rr2; vi = vi2; nk2 = nk3; bb2 = bb3; dw2 = dw3; km2 = km3; rr2 = rr3; vi2 = vi3; } } while (0)
        SC_LOAD(rawA, 0); SC_DERIVE(rawA, 0, 0); SC_LOAD(rawB, 1); SC_LOAD(rawA, 2);
        __syncthreads();
        for (int n = 0; n < SC_NB; n += 2) {
            if (cons) { SC_CONSUME(0); }
            else { SC_DERIVE(rawB, n + 1, 1); if (n + 3 < SC_NB) SC_LOAD(rawB, n + 3);
                if (ywr && n >= 1) SC_YOUT(n - 1, 1); }
            __syncthreads();
            if (cons) { SC_CONSUME(1); }
            else { if (n + 2 < SC_NB) { SC_DERIVE(rawA, n + 2, 0); if (n + 4 < SC_NB) SC_LOAD(rawA, n + 4); }
                if (ywr) SC_YOUT(n, 0); }
            __syncthreads();
        }
        if (ywr) SC_YOUT(SC_NB - 1, 1);
        __syncthreads();
#undef SC_LOAD
#undef SC_DERIVE
#undef SC_YOUT
#undef SC_CONSUME
#undef SC_LDOPS
    }
}

struct Args { const void* in[31]; float* out; unsigned char* ws; };
__global__ void __launch_bounds__(NWAVES * 64, 2) mk_fwd(Args args) {
    extern __shared__ __attribute__((aligned(16))) unsigned char lds[];
    cg::grid_group grid = cg::this_grid();
    LAS unsigned char* L = (LAS unsigned char*)lds;
    const int G = gridDim.x; const int bx = blockIdx.x; const int vcu = (G % 8 == 0) ? (bx % 8) * (G / 8) + bx / 8 : bx;
    const int NGW = G * NWAVES;
#define PH_IDS() int tid_ = threadIdx.x; asm volatile("" : "+v"(tid_)); const int tid = tid_, lane = tid & 63, wave = __builtin_amdgcn_readfirstlane(tid >> 6); const int gw = vcu * NWAVES + wave; LAS float* scr = (LAS float*)(L + wave * 16384); (void)scr; (void)gw; (void)lane
    typedef const void* cvp_t; typedef const __attribute__((address_space(4))) cvp_t* kargp_t;
#define KP_(k) (((kargp_t)kp_)[k])
#define PH_PTRS() const __attribute__((address_space(4))) char* kp_ = (const __attribute__((address_space(4))) char*)__builtin_amdgcn_kernarg_segment_ptr(); asm volatile("" : "+s"(kp_)); \
    In I; I.x = (const float*)KP_(0); I.pos = (const int*)KP_(1); I.a_norm = (const float*)KP_(2); I.a_mu = (const float*)KP_(3); I.a_w_in = (const float*)KP_(4); I.a_w0 = (const float*)KP_(5); I.a_w1 = (const float*)KP_(6); I.a_w2 = (const float*)KP_(7); I.a_a0 = (const float*)KP_(8); I.a_a1 = (const float*)KP_(9); I.a_a2 = (const float*)KP_(10); I.a_v0 = (const float*)KP_(11); I.a_v1 = (const float*)KP_(12); I.a_v2 = (const float*)KP_(13); I.a_k_k = (const float*)KP_(14); I.a_k_a = (const float*)KP_(15); I.a_r_k = (const float*)KP_(16); I.a_ln_w = (const float*)KP_(17); I.a_ln_b = (const float*)KP_(18); I.a_w_out = (const float*)KP_(19); I.kv_norm = (const float*)KP_(20); I.w_kv = (const float*)KP_(21); I.b_norm = (const float*)KP_(22); I.b_w_in = (const float*)KP_(23); I.b_lq1 = (const float*)KP_(24); I.b_lk1 = (const float*)KP_(25); I.b_lq2 = (const float*)KP_(26); I.b_lk2 = (const float*)KP_(27); I.b_subln = (const float*)KP_(28); I.b_w_out = (const float*)KP_(29); I.final_norm = (const float*)KP_(30); \
    float* XS = (float*)KP_(31); unsigned char* ws = (unsigned char*)KP_(32); \
    float* rc = (float*)(ws + WS_ROPE_C); float* rs = (float*)(ws + WS_ROPE_S); float* SB = (float*)(ws + WS_S); unsigned char* wreg = ws + WS_W; \
    bf16* U0 = (bf16*)(ws + WS_U); bf16* U1 = (bf16*)(ws + WS_U + UNIT); bf16* U2 = (bf16*)(ws + WS_U + 2 * UNIT); bf16* U3 = (bf16*)(ws + WS_U + 3 * UNIT); \
    bf16* U4 = (bf16*)(ws + WS_U + 4 * UNIT); bf16* U5 = (bf16*)(ws + WS_U + 5 * UNIT); bf16* U6 = (bf16*)(ws + WS_U + 6 * UNIT); bf16* HB = (bf16*)(ws + WS_H); \
    (void)I; (void)XS; (void)rc; (void)rs; (void)SB; (void)wreg; (void)U0; (void)U1; (void)U2; (void)U3; (void)U4; (void)U5; (void)U6; (void)HB

    { PH_IDS(); PH_PTRS(); rope_tables(I.pos, rc, rs, vcu * 512 + tid, G * 512);
    conv_rwkv(I, 0, wreg, (float*)(ws + WS_BIAS), scr, gw, NGW, lane);
    pre_rwkv(I.x, I.a_norm, U0, gw, NGW, lane); }
    grid.sync();

#pragma nounroll
    for (int l = 0; l < 2; ++l) {
#pragma nounroll
        for (int rp = 0; rp < REP_G1; ++rp) {
            if (rp) grid.sync();
            PH_PTRS(); bf16* Vl = (l == 0) ? U4 : U6;
            pg8::Gemm g{U0, (const bf16*)(wreg + W_FOLD), M, 4352, 2048}; pg8::StaticOrder S; S.init(M, 4352, G, bx);
            pg8::EpiFold E{U2, U3, Vl, U5, HB};
            pg8::gemm_phase<pg8::EpiFold, pg8::StaticOrder, true, true>(L, g, S, E);
        }
        grid.sync();
        {
            PH_PTRS(); bf16* Vl = (l == 0) ? U4 : U6;
            const int NUP = (l == 0) ? 2048 : 3072;
            pg8::Gemm g{HB, (const bf16*)(wreg + W_UP), M, NUP, 256}; pg8::StaticOrder S; S.init(M, NUP, G, bx);
            pg8::EpiLoraUp E{(const float*)(ws + WS_BIAS), (_Float16*)U0, (_Float16*)U1, Vl, U4};
            pg8::gemm_phase<pg8::EpiLoraUp, pg8::StaticOrder, true, false>(L, g, S, E);
        }
        grid.sync();
#pragma nounroll
        for (int rp = 0; rp < REP_SCAN; ++rp) { if (rp) grid.sync(); PH_IDS(); PH_PTRS(); bf16* Vl = (l == 0) ? U4 : U6; bf16* Yl = (l == 0) ? U6 : U4; scan_phase(L, U2, U3, Vl, (const _Float16*)U0, (const _Float16*)U1, I.a_k_k + l * 1024, I.a_k_a + l * 1024, I.a_r_k + l * 1024, Yl, SB, vcu, G, tid, wave, lane); }
        grid.sync();
        { PH_IDS(); PH_PTRS(); bf16* Vl = (l == 0) ? U4 : U6; bf16* Yl = (l == 0) ? U6 : U4; post_rwkv(Yl, SB, Vl, U5, I.a_ln_w + l * 1024, I.a_ln_b + l * 1024, U2, gw, NGW, lane); }
        grid.sync();
        {
            PH_PTRS(); const float* xin = (l == 0) ? I.x : XS;
            pg8::Gemm g{U2, (const bf16*)(wreg + W_OUT), M, 1024, 1024}; pg8::StaticOrder S; S.init(M, 1024, G, bx);
            pg8::EpiResid E{xin, XS};
            pg8::gemm_phase<pg8::EpiResid, pg8::StaticOrder, true, true>(L, g, S, E);
        }
        grid.sync();
        { PH_IDS(); PH_PTRS(); if (l == 0) { conv_rwkv(I, 1, wreg, (float*)(ws + WS_BIAS), scr, gw, NGW, lane); pre_rwkv(XS, I.a_norm + 1024, U0, gw, NGW, lane); }
        else { conv_attn(I, 0, wreg, scr, gw, NGW, lane); pre_attn(XS, U0, gw, NGW, lane); } }
        grid.sync();
    }

#pragma nounroll
    for (int j = 0; j < 2; ++j) {
        {
            PH_PTRS();
            const int NP = (j == 0) ? 4096 : 2048;
            pg8::Gemm g{U0, (const bf16*)(wreg + W_PROJ), M, NP, 1024}; pg8::StaticOrder S; S.init(M, NP, G, bx);
            pg8::EpiProj E;
            if (j == 0) { E.d0 = U1; E.d1 = U2; E.d2 = U3; E.d3 = U4; E.ropemask = 0x5; E.scalemask = 0x4; }
            else { E.d0 = U3; E.d1 = U4; E.d2 = U3; E.d3 = U4; E.ropemask = 0x1; E.scalemask = 0x1; }
            E.sc = C2F; E.rc = rc; E.rs = rs;
            pg8::gemm_phase<pg8::EpiProj, pg8::StaticOrder, true, true>(L, g, S, E);
        }
        grid.sync();
#pragma nounroll
        for (int rp = 0; rp < REP_ATTN; ++rp) {
            if (rp) grid.sync();
            PH_PTRS();
            const attn_body::AttnTensors AT{(const attn_body::bf16*)U3, (const attn_body::bf16*)U1, (const attn_body::bf16*)U2, (attn_body::bf16*)U5, (attn_body::bf16*)U6};
            attn_body::attn_phase<8>((char*)lds, AT, vcu, G);
        }
        grid.sync();
        {
            PH_IDS(); PH_PTRS();
            const float e1 = __expf(wave_sum(I.b_lq1[j * 64 + lane] * I.b_lk1[j * 64 + lane])), e2 = __expf(wave_sum(I.b_lq2[j * 64 + lane] * I.b_lk2[j * 64 + lane]));
            const float lam_init = (j == 0) ? 0.4707130183435842f : 0.5560582041556406f;
            post_attn(U5, U6, U4, I.b_subln + j * 128, e1 - e2 + lam_init, lam_init, U0, gw, NGW, lane);
        }
        grid.sync();
        {
            PH_PTRS();
            pg8::Gemm g{U0, (const bf16*)(wreg + W_BOUT), M, 1024, 1024}; pg8::StaticOrder S; S.init(M, 1024, G, bx);
            pg8::EpiResid E{XS, XS};
            pg8::gemm_phase<pg8::EpiResid, pg8::StaticOrder, true, true>(L, g, S, E);
        }
        grid.sync();
        if (j == 0) { { PH_IDS(); PH_PTRS(); conv_attn(I, 1, wreg, scr, gw, NGW, lane); pre_attn(XS, U0, gw, NGW, lane); } grid.sync(); }
    }
    { PH_IDS(); PH_PTRS(); final_norm_rows(XS, I.final_norm, XS, gw, NGW, lane); }
}

extern "C" void kernel_launch(void* const* d_in, const int* in_sizes, int n_in, void* d_out, int out_size, void* d_ws, size_t ws_size, hipStream_t stream) {
    static int grid = 0;
    if (grid == 0) {
        if (n_in != 31 || in_sizes[0] != M * D || out_size != M * D || ws_size < WS_END) { fprintf(stderr, "kernel_launch: unexpected shapes (n_in %d, in0 %d, out %d, ws %zu < %zu)\n", n_in, n_in > 0 ? in_sizes[0] : -1, out_size, ws_size, (size_t)WS_END); grid = -1; return; }
        int dev = 0, cus = 0, per_cu = 0;
        hipGetDevice(&dev); hipDeviceGetAttribute(&cus, hipDeviceAttributeMultiprocessorCount, dev);
        if (hipFuncSetAttribute((const void*)mk_fwd, hipFuncAttributeMaxDynamicSharedMemorySize, LDS_BYTES) != hipSuccess) { fprintf(stderr, "kernel_launch: hipFuncSetAttribute failed\n"); grid = -1; return; }
        if (hipOccupancyMaxActiveBlocksPerMultiprocessor(&per_cu, (const void*)mk_fwd, NWAVES * 64, LDS_BYTES) != hipSuccess || per_cu < 1) { fprintf(stderr, "kernel_launch: occupancy query says %d\n", per_cu); per_cu = 1; }
        (void)hipGetLastError();
        grid = cus;
    }
    if (grid < 0) return;
    Args a{};
    for (int i = 0; i < 31; ++i) a.in[i] = d_in[i];
    a.out = (float*)d_out; a.ws = (unsigned char*)d_ws;
    void* kargs[] = {&a};
    hipError_t e = hipLaunchCooperativeKernel((const void*)mk_fwd, dim3(grid), dim3(NWAVES * 64), kargs, LDS_BYTES, stream);
    if (e != hipSuccess) fprintf(stderr, "kernel_launch: cooperative launch failed: %s (grid %d)\n", hipGetErrorString(e), grid);
}
```

```cpp
#include <hip/hip_runtime.h>
#include <hip/hip_cooperative_groups.h>
#include <cstdio>
#include <cstdint>
namespace cg = cooperative_groups;
namespace pg8 {
#define PG8_LAS __attribute__((address_space(3)))
typedef unsigned short bf16_t;
typedef short bf16x8 __attribute__((ext_vector_type(8)));
typedef float f32x4 __attribute__((ext_vector_type(4)));
typedef unsigned u32x4 __attribute__((ext_vector_type(4)));
constexpr int BM = 256, BK = 64, HALF = 128, HTB = HALF * BK * 2  , STAGE_BYTES = 8 * HTB, NXCD = 8, WGM = 8;

__host__ __device__ __forceinline__ int lds_byte(int r, int c) { const int st = (r >> 4) * 2 + (c >> 5), rr = r & 15, cc = c & 31, ob = rr * 64 + cc * 2; return st * 1024 + (ob ^ (((ob >> 9) & 1) << 5)); }
__host__ __device__ __forceinline__ void stage_rc(int b, int& R, int& C) { const int st = b / 1024, sb = b % 1024, swz = sb ^ (((sb >> 9) & 1) << 5); R = (st >> 1) * 16 + swz / 64; C = (st & 1) * 32 + (swz % 64) / 2; }
__host__ __device__ __forceinline__ int perm32(int rho) { const int n = rho >> 4, i = rho & 15; return 8 * (i >> 2) + 4 * n + (i & 3); }

struct Unit { int pm, pn; };
struct Gemm { const bf16_t* A; const bf16_t* Bt; int M, N, K; };

struct StaticOrder {
    int nM, nN, nwg, G, c;
    __host__ __device__ void init(int M, int N, int G_, int c_) { nM = M / BM; nN = N / BM; nwg = nM * nN; G = G_; c = c_; }
    __host__ __device__ bool next(int i, Unit& u) const {
        const long L = (long)i * G + c; if (L >= nwg) return false;
        int wgid = (int)L; { const int q = nwg / NXCD, r = nwg % NXCD, xcd = wgid % NXCD, off = wgid / NXCD; wgid = (xcd < r ? xcd * (q + 1) : r * (q + 1) + (xcd - r) * q) + off; }
        const int nig = WGM * nN, gid = wgid / nig, fm = gid * WGM, gsz = (nM - fm) < WGM ? (nM - fm) : WGM;
        u.pm = fm + ((wgid % nig) % gsz); u.pn = (wgid % nig) / gsz; return true;
    }
    __device__ __forceinline__ void a_ready(const Unit&) const {}
    __device__ __forceinline__ void done(const Unit&) const {}
};

__device__ __forceinline__ unsigned cvt_pk_bf16(float lo, float hi) { unsigned r; asm volatile("v_cvt_pk_bf16_f32 %0, %1, %2" : "=v"(r) : "v"(lo), "v"(hi)); return r; }
typedef float f32x2 __attribute__((ext_vector_type(2)));
typedef _Float16 h16x4 __attribute__((ext_vector_type(4)));
typedef unsigned u32x2 __attribute__((ext_vector_type(2)));
__device__ __forceinline__ float sigmoidf_(float z) { return 1.0f / (1.0f + __expf(-z)); }
__device__ __forceinline__ float tanhf_(float x) { const float t = __expf(-2.0f * fabsf(x)); const float r = (1.0f - t) / (1.0f + t); return x < 0.f ? -r : r; }
__device__ __forceinline__ float bf_lo(unsigned w) { return __uint_as_float(w << 16); }
__device__ __forceinline__ float bf_hi(unsigned w) { return __uint_as_float(w & 0xffff0000u); }

struct EpiFold {
    static constexpr bool PERM = true, AFTER_DRAIN = false;
    bf16_t *R, *Kb, *V, *G, *H;
    __device__ __forceinline__ void operator()(const f32x4 (&acc)[2][2][4][2], const Unit& u, int wr, int wc, int fr, int fq) const {
        const int row0 = u.pm * BM + wr * 64 + fr;
        const int t = u.pn >> 2;
        bf16_t* base; int ldc, colt;
        if (u.pn < 16) { base = (t == 0) ? R : (t == 1) ? Kb : (t == 2) ? V : G; ldc = 1024; colt = (u.pn & 3) * 256; }
        else { base = H; ldc = 256; colt = 0; }
        const int col0 = colt + wc * 32 + 8 * fq;
        const bool th = (u.pn == 16) && (wc < 2);
#pragma unroll
        for (int ai = 0; ai < 2; ++ai)
#pragma unroll
            for (int m = 0; m < 4; ++m) { bf16_t* rowp = base + (size_t)(row0 + ai * HALF + m * 16) * ldc + col0;
#pragma unroll
                for (int bj = 0; bj < 2; ++bj) { f32x4 v0 = acc[ai][bj][m][0], v1 = acc[ai][bj][m][1];
                    if (th && bj == 0) {
#pragma unroll
                        for (int i = 0; i < 4; ++i) { v0[i] = tanhf_(v0[i]); v1[i] = tanhf_(v1[i]); } }
                    u32x4 w; w.x = cvt_pk_bf16(v0[0], v0[1]); w.y = cvt_pk_bf16(v0[2], v0[3]); w.z = cvt_pk_bf16(v1[0], v1[1]); w.w = cvt_pk_bf16(v1[2], v1[3]);
                    *(u32x4*)(rowp + bj * HALF) = w; }
                asm volatile("" ::: "memory"); }
    }
};

struct EpiLoraUp {
    static constexpr bool PERM = false, AFTER_DRAIN = false;
    const float* bias3; _Float16 *Wb, *Ab; bf16_t* Vb; const bf16_t* Vf;
    __device__ __forceinline__ void operator()(const f32x4 (&acc)[2][2][4][2], const Unit& u, int wr, int wc, int fr_unused, int fq_unused) const {
        int t_ = threadIdx.x; asm volatile("" : "+v"(t_)); const int fr = t_ & 15, fq = (t_ >> 4) & 3;
        const int row0 = u.pm * BM + wr * 64 + fr;
        const int t = u.pn >> 2;
        const int cc0 = (u.pn & 3) * 256 + wc * 32 + 4 * fq;
        const float* bias = bias3 + t * 1024;
#pragma unroll
        for (int bj = 0; bj < 2; ++bj)
#pragma unroll
            for (int n = 0; n < 2; ++n) { const int c = cc0 + bj * HALF + n * 16; const f32x4 bv = *(const f32x4*)(bias + c);
#pragma unroll
                for (int ai = 0; ai < 2; ++ai)
#pragma unroll
                    for (int m = 0; m < 4; ++m) { const size_t off = (size_t)(row0 + ai * HALF + m * 16) * 1024 + c; const f32x4 z = acc[ai][bj][m][n] + bv;
                        if (t == 0) { h16x4 o;
#pragma unroll
                            for (int i = 0; i < 4; ++i) { const float zz = -z[i]; const float sp = fmaxf(zz, 0.f) + __logf(1.0f + __expf(-fabsf(zz))); o[i] = (_Float16)(-sp - 0.5f); }
                            *(h16x4*)(Wb + off) = o; }
                        else if (t == 1) { h16x4 o;
#pragma unroll
                            for (int i = 0; i < 4; ++i) o[i] = (_Float16)sigmoidf_(z[i]);
                            *(h16x4*)(Ab + off) = o; }
                        else { const u32x2 vv = *(const u32x2*)(Vb + off), vf = *(const u32x2*)(Vf + off);
                            const float v_0 = bf_lo(vv.x), v_1 = bf_hi(vv.x), v_2 = bf_lo(vv.y), v_3 = bf_hi(vv.y);
                            const float f_0 = bf_lo(vf.x), f_1 = bf_hi(vf.x), f_2 = bf_lo(vf.y), f_3 = bf_hi(vf.y);
                            u32x2 o; o.x = cvt_pk_bf16(v_0 + (f_0 - v_0) * sigmoidf_(z[0]), v_1 + (f_1 - v_1) * sigmoidf_(z[1]));
                            o.y = cvt_pk_bf16(v_2 + (f_2 - v_2) * sigmoidf_(z[2]), v_3 + (f_3 - v_3) * sigmoidf_(z[3]));
                            *(u32x2*)(Vb + off) = o; }
                        asm volatile("" ::: "memory"); } }
    }
};

struct EpiProj {
    static constexpr bool PERM = true, AFTER_DRAIN = false;
    bf16_t *d0, *d1, *d2, *d3; int ropemask, scalemask; float sc; const float* rc; const float* rs;
    __device__ __forceinline__ void operator()(const f32x4 (&acc)[2][2][4][2], const Unit& u, int wr, int wc, int fr, int fq) const {
        const int row0 = u.pm * BM + wr * 64 + fr;
        const int t = u.pn >> 2;
        bf16_t* base = (t == 0) ? d0 : (t == 1) ? d1 : (t == 2) ? d2 : d3;
        const int col0 = (u.pn & 3) * 256 + wc * 32 + 8 * fq;
        const bool rope = (((ropemask >> t) & 1) != 0) && ((wc & 1) == 0);
        const float s = ((scalemask >> t) & 1) ? sc : 1.0f;
        const float sgn = (fq == 0) ? -1.0f : 1.0f;
#pragma unroll
        for (int ai = 0; ai < 2; ++ai)
#pragma unroll
            for (int m = 0; m < 4; ++m) { const int row = row0 + ai * HALF + m * 16; bf16_t* rowp = base + (size_t)row * 1024 + col0;
                f32x4 c0 = {1.f, 1.f, 1.f, 1.f}, c1 = c0, s0 = {0.f, 0.f, 0.f, 0.f}, s1 = s0;
                if (rope) { c0 = *(const f32x4*)(rc + (size_t)row * 8); c1 = *(const f32x4*)(rc + (size_t)row * 8 + 4); s0 = *(const f32x4*)(rs + (size_t)row * 8); s1 = *(const f32x4*)(rs + (size_t)row * 8 + 4); }
#pragma unroll
                for (int bj = 0; bj < 2; ++bj) { f32x4 v0 = acc[ai][bj][m][0], v1 = acc[ai][bj][m][1];
                    if (rope) { f32x4 p0, p1;
#pragma unroll
                        for (int i = 0; i < 4; ++i) { p0[i] = __shfl_xor(v0[i], 16); p1[i] = __shfl_xor(v1[i], 16); }
                        if (fq < 2) { v0 = v0 * c0 + (p0 * s0) * sgn; v1 = v1 * c1 + (p1 * s1) * sgn; } }
                    v0 = v0 * s; v1 = v1 * s;
                    u32x4 w; w.x = cvt_pk_bf16(v0[0], v0[1]); w.y = cvt_pk_bf16(v0[2], v0[3]); w.z = cvt_pk_bf16(v1[0], v1[1]); w.w = cvt_pk_bf16(v1[2], v1[3]);
                    *(u32x4*)(rowp + bj * HALF) = w; }
                asm volatile("" ::: "memory"); }
    }
};

struct EpiResid {
    static constexpr bool PERM = false, AFTER_DRAIN = false;
    const float* base; float* out;
    __device__ __forceinline__ void operator()(const f32x4 (&acc)[2][2][4][2], const Unit& u, int wr, int wc, int fr, int fq) const {
        const int row0 = u.pm * BM + wr * 64 + fr;
        const int col0 = u.pn * BM + wc * 32 + 4 * fq;
#pragma unroll
        for (int ai = 0; ai < 2; ++ai)
#pragma unroll
            for (int m = 0; m < 4; ++m) { const size_t off = (size_t)(row0 + ai * HALF + m * 16) * 1024 + col0;
#pragma unroll
                for (int bj = 0; bj < 2; ++bj)
#pragma unroll
                    for (int n = 0; n < 2; ++n) { const f32x4 b = *(const f32x4*)(base + off + bj * HALF + n * 16); *(f32x4*)(out + off + bj * HALF + n * 16) = b + acc[ai][bj][m][n]; }
                asm volatile("" ::: "memory"); }
    }
};
template <class Epi, class Sched, bool ALIGN_EPI = false, bool SP2 = false>
__device__ __forceinline__ void gemm_phase(PG8_LAS unsigned char* lds, const Gemm g, const Sched& S, const Epi& E) {
    int tid_ = threadIdx.x; asm volatile("" : "+v"(tid_));
    const int tid = tid_, wid = __builtin_amdgcn_readfirstlane(tid >> 6), lane = tid & 63, wr = wid >> 2, wc = wid & 3, fr = lane & 15, fq = lane >> 4;
    const int K = g.K, nt = K / BK;
    unsigned voffA[2], voffB[2];
#pragma unroll
    for (int i = 0; i < 2; ++i) { int R, C; stage_rc(tid * 16 + i * 8192, R, C); const int Rb = Epi::PERM ? ((R & ~31) + perm32(R & 31)) : R;
        voffA[i] = (unsigned)(R * K + C) * 2u; voffB[i] = (unsigned)(Rb * K + C) * 2u; }
    const size_t kstep = (size_t)(BK * 2);
    const size_t hstep = (size_t)HALF * K * 2;
    const size_t tstep = 2 * hstep;
    const unsigned ldsw = (unsigned)wid * 1024u;
    const int aoff = lds_byte(wr * 64 + fr, fq * 8), boff = lds_byte(wc * 32 + fr, fq * 8);
#define PG8_SA(b, h) (((b) * 2 + (h)) * HTB)
#define PG8_SB(b, h) ((4 + (b) * 2 + (h)) * HTB)
#define PG8_STAGE(bufoff, gbase, voff) do { _Pragma("unroll") for (int _i = 0; _i < 2; ++_i) \
        __builtin_amdgcn_global_load_lds((const unsigned*)((const char*)(gbase) + (voff)[_i]), (PG8_LAS unsigned*)(lds + (bufoff) + ldsw + _i * 8192), 16, 0, 0); } while (0)
#define PG8_LDA(dst, b, h) do { _Pragma("unroll") for (int m = 0; m < 4; ++m) _Pragma("unroll") for (int k = 0; k < 2; ++k) dst[m][k] = *(const PG8_LAS bf16x8*)(lds + PG8_SA(b, h) + aoff + m * 2048 + k * 1024); } while (0)
#define PG8_LDB(dst, b, h) do { _Pragma("unroll") for (int n = 0; n < 2; ++n) _Pragma("unroll") for (int k = 0; k < 2; ++k) dst[n][k] = *(const PG8_LAS bf16x8*)(lds + PG8_SB(b, h) + boff + n * 2048 + k * 1024); } while (0)
#define PG8_MMA(ai, bj, At, Bt) do { __builtin_amdgcn_s_setprio(1); _Pragma("unroll") for (int m = 0; m < 4; ++m) _Pragma("unroll") for (int n = 0; n < 2; ++n) _Pragma("unroll") for (int k = 0; k < 2; ++k) \
        acc[ai][bj][m][n] = __builtin_amdgcn_mfma_f32_16x16x32_bf16(Bt[n][k], At[m][k], acc[ai][bj][m][n], 0, 0, 0); __builtin_amdgcn_s_setprio(0); } while (0)
#define PG8_WAIT_V(n) asm volatile("s_waitcnt vmcnt(" #n ")" ::: "memory")
#define PG8_WAIT_L(n) asm volatile("s_waitcnt lgkmcnt(" #n ")" ::: "memory")
#define PG8_BAR __builtin_amdgcn_s_barrier()
#define PG8_SCHED __builtin_amdgcn_sched_barrier(0)
    Unit cur, nxt; int ui = 0;
    if (!S.next(0, cur)) return;
    f32x4 acc[2][2][4][2];
#pragma unroll
    for (int a = 0; a < 2; ++a)
#pragma unroll
        for (int b = 0; b < 2; ++b)
#pragma unroll
            for (int m = 0; m < 4; ++m)
#pragma unroll
                for (int n = 0; n < 2; ++n) acc[a][b][m][n] = (f32x4){0.f, 0.f, 0.f, 0.f};
    bf16x8 At[4][2], B0[2][2], B1[2][2];
    const char* cA = (const char*)g.A + (size_t)cur.pm * tstep; const char* cB = (const char*)g.Bt + (size_t)cur.pn * tstep;
    S.a_ready(cur);
    if constexpr (SP2) {
        PG8_STAGE(PG8_SB(0, 0), cB, voffB); PG8_STAGE(PG8_SB(0, 1), cB + hstep, voffB); PG8_STAGE(PG8_SA(0, 0), cA, voffA); PG8_STAGE(PG8_SA(0, 1), cA + hstep, voffA);
        if (wr == 1) PG8_BAR;
        PG8_WAIT_V(2); PG8_BAR;
        PG8_STAGE(PG8_SB(1, 0), cB + kstep, voffB); PG8_STAGE(PG8_SA(1, 0), cA + kstep, voffA); PG8_STAGE(PG8_SB(1, 1), cB + hstep + kstep, voffB);
        PG8_WAIT_V(6); PG8_BAR;
    } else {
        PG8_STAGE(PG8_SB(0, 0), cB, voffB); PG8_STAGE(PG8_SA(0, 0), cA, voffA); PG8_STAGE(PG8_SB(0, 1), cB + hstep, voffB); PG8_STAGE(PG8_SA(0, 1), cA + hstep, voffA);
        if (wr == 1) PG8_BAR;
        PG8_WAIT_V(4); PG8_BAR;
        PG8_STAGE(PG8_SB(1, 0), cB + kstep, voffB); PG8_STAGE(PG8_SA(1, 0), cA + kstep, voffA); PG8_STAGE(PG8_SB(1, 1), cB + hstep + kstep, voffB);
        PG8_WAIT_V(6); PG8_BAR;
    }
    for (;;) {
        const bool has_next = S.next(ui + 1, nxt);
        const char* nA = has_next ? (const char*)g.A + (size_t)nxt.pm * tstep : cA; const char* nB = has_next ? (const char*)g.Bt + (size_t)nxt.pn * tstep : cB;
        for (int t = 0; t < nt; t += 2) {
            const bool last = (t == nt - 2);
            const char* a1 = cA + (size_t)(t + 1) * kstep;
            const char* a2 = last ? nA : cA + (size_t)(t + 2) * kstep; const char* b2 = last ? nB : cB + (size_t)(t + 2) * kstep;
            const char* a3 = a2 + kstep; const char* b3 = b2 + kstep;
            if (last && has_next) S.a_ready(nxt);
            if constexpr (SP2) {
            PG8_LDB(B0, 0, 0); PG8_LDB(B1, 0, 1); PG8_SCHED; PG8_LDA(At, 0, 0); PG8_STAGE(PG8_SA(1, 1), a1 + hstep, voffA);
            PG8_WAIT_V(8); PG8_WAIT_L(0); PG8_BAR; PG8_MMA(0, 0, At, B0); PG8_MMA(0, 1, At, B1); PG8_BAR; PG8_SCHED;
            PG8_LDA(At, 0, 1); PG8_STAGE(PG8_SB(0, 0), b2, voffB); PG8_STAGE(PG8_SB(0, 1), b2 + hstep, voffB); PG8_STAGE(PG8_SA(0, 0), a2, voffA);
            PG8_WAIT_V(8); PG8_WAIT_L(0); PG8_BAR; PG8_MMA(1, 0, At, B0); PG8_MMA(1, 1, At, B1); PG8_BAR; PG8_SCHED;
            PG8_LDB(B0, 1, 0); PG8_LDB(B1, 1, 1); PG8_SCHED; PG8_LDA(At, 1, 0); PG8_STAGE(PG8_SA(0, 1), a2 + hstep, voffA);
            PG8_WAIT_V(8); PG8_WAIT_L(0); PG8_BAR; PG8_MMA(0, 0, At, B0); PG8_MMA(0, 1, At, B1); PG8_BAR; PG8_SCHED;
            PG8_LDA(At, 1, 1); PG8_STAGE(PG8_SB(1, 0), b3, voffB); PG8_STAGE(PG8_SB(1, 1), b3 + hstep, voffB); PG8_STAGE(PG8_SA(1, 0), a3, voffA);
            PG8_WAIT_V(8); PG8_WAIT_L(0); PG8_BAR; PG8_MMA(1, 0, At, B0); PG8_MMA(1, 1, At, B1); PG8_BAR; PG8_SCHED;
            } else {
            PG8_LDB(B0, 0, 0); PG8_SCHED; PG8_LDA(At, 0, 0); PG8_STAGE(PG8_SA(1, 1), a1 + hstep, voffA);
            PG8_WAIT_L(8); PG8_BAR; PG8_WAIT_L(0); PG8_MMA(0, 0, At, B0); PG8_BAR; PG8_SCHED;
            PG8_LDB(B1, 0, 1); PG8_STAGE(PG8_SB(0, 0), b2, voffB);
            PG8_BAR; PG8_WAIT_L(0); PG8_MMA(0, 1, At, B1); PG8_BAR;
            PG8_LDA(At, 0, 1); PG8_STAGE(PG8_SA(0, 0), a2, voffA);
            PG8_BAR; PG8_WAIT_L(0); PG8_MMA(1, 0, At, B0); PG8_BAR; PG8_SCHED;
            PG8_STAGE(PG8_SB(0, 1), b2 + hstep, voffB);
            PG8_WAIT_V(6); PG8_BAR; PG8_MMA(1, 1, At, B1); PG8_BAR;
            PG8_LDB(B0, 1, 0); PG8_SCHED; PG8_LDA(At, 1, 0); PG8_STAGE(PG8_SA(0, 1), a2 + hstep, voffA);
            PG8_WAIT_L(8); PG8_BAR; PG8_WAIT_L(0); PG8_MMA(0, 0, At, B0); PG8_BAR; PG8_SCHED;
            PG8_LDB(B1, 1, 1); PG8_STAGE(PG8_SB(1, 0), b3, voffB);
            PG8_BAR; PG8_WAIT_L(0); PG8_MMA(0, 1, At, B1); PG8_BAR;
            PG8_LDA(At, 1, 1); PG8_STAGE(PG8_SA(1, 0), a3, voffA);
            PG8_BAR; PG8_WAIT_L(0); PG8_MMA(1, 0, At, B0); PG8_BAR; PG8_SCHED;
            PG8_STAGE(PG8_SB(1, 1), b3 + hstep, voffB);
            PG8_WAIT_V(6); PG8_BAR; PG8_MMA(1, 1, At, B1); PG8_BAR;
            }
        }
        if constexpr (ALIGN_EPI) { if (wr == 0) PG8_BAR; }
        if constexpr (!Epi::AFTER_DRAIN) { E(acc, cur, wr, wc, fr, fq); S.done(cur); }
        if (!has_next) break;
#pragma unroll
        for (int a = 0; a < 2; ++a)
#pragma unroll
            for (int b = 0; b < 2; ++b)
#pragma unroll
                for (int m = 0; m < 4; ++m)
#pragma unroll
                    for (int n = 0; n < 2; ++n) acc[a][b][m][n] = (f32x4){0.f, 0.f, 0.f, 0.f};
        cur = nxt; cA = nA; cB = nB; ++ui;
        if constexpr (ALIGN_EPI) { if (wr == 1) PG8_BAR; }
    }
    PG8_WAIT_V(0);
    if constexpr (!ALIGN_EPI) { if (wr == 0) PG8_BAR; }
    PG8_BAR;
    if constexpr (Epi::AFTER_DRAIN) { E.fused(acc, cur, wr, wc, fr, fq, lds, wid, lane); S.done(cur); }
#undef PG8_SA
#undef PG8_SB
#undef PG8_STAGE
#undef PG8_LDA
#undef PG8_LDB
#undef PG8_MMA
#undef PG8_WAIT_V
#undef PG8_WAIT_L
#undef PG8_BAR
#undef PG8_SCHED
}
}

#include <hip/hip_bf16.h>
#include <cmath>
namespace attn_body {
using bf16=__hip_bfloat16;
using bf16x8=__attribute__((ext_vector_type(8)))short;
using s16x4=__attribute__((ext_vector_type(4)))short;
using f32x16=__attribute__((ext_vector_type(16)))float;
using u32x4=__attribute__((ext_vector_type(4)))unsigned;
constexpr int BATCH=2,NHEAD=16,SEQ=16384,D=64,DM=NHEAD*D;
constexpr int NW=8,QBLK=32,QB=QBLK*NW,KVBLK=64,NQB=SEQ/QB;
constexpr int ATTN_PITCH=DM, ATTN_UNIT_ROWS=QB;
__device__ __forceinline__ int crow(int r,int hi){return (r&3)+8*(r>>2)+4*hi;}
#define SBAR() __builtin_amdgcn_sched_barrier(0)
__device__ __forceinline__ void cmask(f32x16&p0,f32x16&p1,int jb,int qrel,int hi){
  const float NEG=-INFINITY; int kb=64*jb+4*hi;
  #pragma unroll
  for(int r=0;r<16;++r){int kv=kb+(r&3)+8*(r>>2); if(kv>qrel)p0[r]=NEG; if(kv+32>qrel)p1[r]=NEG;}
}

constexpr int NSLOT=3, SLOTB=8192;
constexpr int LDS_K=0, LDS_V=NSLOT*SLOTB, LDS_WS=2*NSLOT*SLOTB, LDS_OST=LDS_WS+NW*64*4, LDS_BYTES=LDS_OST+NW*4096;
constexpr float C2=0.125f*1.4426950408889634f;
__device__ __forceinline__ void glds16(const void*gsrc,unsigned lds_dst){unsigned keep;
  asm volatile("s_mov_b32 %0, m0\n\ts_mov_b32 m0, %2\n\ts_nop 0\n\tglobal_load_lds_dwordx4 %1, off\n\ts_mov_b32 m0, %0":"=&s"(keep):"v"(gsrc),"s"(lds_dst):"memory");}
__device__ __forceinline__ float max3f(float a,float b,float c){float r;asm("v_max3_f32 %0, %1, %2, %3":"=v"(r):"v"(a),"v"(b),"v"(c));return r;}
__device__ __forceinline__ float max2f(float a,float b){float r;asm("v_max_f32_e32 %0, %1, %2":"=v"(r):"v"(a),"v"(b));return r;}
__device__ __forceinline__ float fadd_s(float a,float b){float r;asm("v_add_f32_e32 %0, %1, %2":"=v"(r):"v"(a),"v"(b));return r;}
__device__ __forceinline__ float fsub_s(float a,float b){float r;asm("v_sub_f32_e32 %0, %1, %2":"=v"(r):"v"(a),"v"(b));return r;}
typedef float f32x2_t __attribute__((ext_vector_type(2))); typedef __bf16 bf16x2_t __attribute__((ext_vector_type(2)));
__device__ __forceinline__ unsigned cvtpk_s(float lo,float hi){f32x2_t v={lo,hi};bf16x2_t b=__builtin_convertvector(v,bf16x2_t);return __builtin_bit_cast(unsigned,b);}
#define WAIT_BAR(N) asm volatile("s_waitcnt vmcnt(" #N ") lgkmcnt(0)\n\ts_barrier":::"memory")

__device__ __forceinline__ void qkt(f32x16&p0,f32x16&p1,const char*Kslot,const bf16x8*qr,const f32x16&negm,int r32,int hi){
  const char*kb=Kslot+hi*1024+r32*16;
  #pragma unroll
  for(int d0=0;d0<4;++d0){
    const bf16x8 b0=*reinterpret_cast<const bf16x8*>(kb+d0*2048);
    const bf16x8 b1=*reinterpret_cast<const bf16x8*>(kb+d0*2048+512);
    if(d0==0){p0=__builtin_amdgcn_mfma_f32_32x32x16_bf16(b0,qr[0],negm,0,0,0);p1=__builtin_amdgcn_mfma_f32_32x32x16_bf16(b1,qr[0],negm,0,0,0);}
    else{p0=__builtin_amdgcn_mfma_f32_32x32x16_bf16(b0,qr[d0],p0,0,0,0);p1=__builtin_amdgcn_mfma_f32_32x32x16_bf16(b1,qr[d0],p1,0,0,0);}}
}
typedef __attribute__((address_space(3))) const char* lds_cptr;
typedef short v4i16_t __attribute__((ext_vector_type(4)));
__device__ __forceinline__ void kload8(bf16x8*kf,lds_cptr kp){
  kf[0]=*(const __attribute__((address_space(3))) bf16x8*)(kp);      kf[1]=*(const __attribute__((address_space(3))) bf16x8*)(kp+512);
  kf[2]=*(const __attribute__((address_space(3))) bf16x8*)(kp+2048); kf[3]=*(const __attribute__((address_space(3))) bf16x8*)(kp+2560);
  kf[4]=*(const __attribute__((address_space(3))) bf16x8*)(kp+4096); kf[5]=*(const __attribute__((address_space(3))) bf16x8*)(kp+4608);
  kf[6]=*(const __attribute__((address_space(3))) bf16x8*)(kp+6144); kf[7]=*(const __attribute__((address_space(3))) bf16x8*)(kp+6656);
}
__device__ __forceinline__ void kload2(bf16x8*kf,lds_cptr kp,int j){ kf[2*j]=*(const __attribute__((address_space(3))) bf16x8*)(kp+j*2048); kf[2*j+1]=*(const __attribute__((address_space(3))) bf16x8*)(kp+j*2048+512); }
__device__ __forceinline__ s16x4 vtr(lds_cptr p){ return __builtin_bit_cast(s16x4,__builtin_amdgcn_ds_read_tr16_b64_v4i16((__attribute__((address_space(3))) v4i16_t*)p)); }
__device__ __forceinline__ float rowmax(const f32x16&p0,const f32x16&p1){
  float a=max3f(p0[0],p0[1],p1[0]),b=max3f(p0[2],p0[3],p1[1]);a=max3f(a,p1[2],p1[3]);
  #pragma unroll
  for(int r=4;r<16;r+=4){a=max3f(a,p0[r],p0[r+1]);b=max3f(b,p0[r+2],p0[r+3]);a=max3f(a,p1[r],p1[r+1]);b=max3f(b,p1[r+2],p1[r+3]);}
  const float m=max2f(a,b);
  auto rr=__builtin_amdgcn_permlane32_swap(__float_as_uint(m),__float_as_uint(m),false,false);
  return max2f(__uint_as_float(rr[0]),__uint_as_float(rr[1]));
}
__device__ __forceinline__ void pv(f32x16*o,int vb,bf16x8 pa0,bf16x8 pa1,bf16x8 pa2,bf16x8 pa3){
  #pragma unroll
  for(int d0=0;d0<2;++d0){s16x4 lo[4],hi[4];
    #pragma unroll
    for(int ks=0;ks<4;++ks){
      asm volatile("ds_read_b64_tr_b16 %0,%1 offset:%c2":"=&v"(lo[ks]):"v"(vb),"i"(d0*4096+ks*1024):"memory");
      asm volatile("ds_read_b64_tr_b16 %0,%1 offset:%c2":"=&v"(hi[ks]):"v"(vb),"i"(d0*4096+ks*1024+512):"memory");}
    asm volatile("s_waitcnt lgkmcnt(0)":::"memory");SBAR();
    #define PK(k) (bf16x8){lo[k][0],lo[k][1],lo[k][2],lo[k][3],hi[k][0],hi[k][1],hi[k][2],hi[k][3]}
    o[d0]=__builtin_amdgcn_mfma_f32_32x32x16_bf16(pa0,PK(0),o[d0],0,0,0);
    o[d0]=__builtin_amdgcn_mfma_f32_32x32x16_bf16(pa1,PK(1),o[d0],0,0,0);
    o[d0]=__builtin_amdgcn_mfma_f32_32x32x16_bf16(pa2,PK(2),o[d0],0,0,0);
    o[d0]=__builtin_amdgcn_mfma_f32_32x32x16_bf16(pa3,PK(3),o[d0],0,0,0);
    #undef PK
  }
}

#ifndef ATTN_STORE16
#define ATTN_STORE16(p,v) (*(u32x4*)(p)=(v))
#endif
template<int THRL> __device__ __forceinline__ void attn_unit(int b,int cq,int cv,int qb,const bf16*Q,const bf16*__restrict__ K,const bf16*__restrict__ V,bf16*O,char*shm){
  int tid_=threadIdx.x; asm volatile("":"+v"(tid_)); const int tid=tid_,lane=tid&63,r32=lane&31,hi=lane>>5; const int wid=__builtin_amdgcn_readfirstlane(tid>>6);
  const long rowbase=(long)b*SEQ; const int q0=qb*QB;
  const bf16*Qw=Q+(rowbase+q0+wid*QBLK)*DM+cq;
  const bf16*Kh=K+rowbase*DM+cq,*Vh=V+rowbase*DM+cv;
  const unsigned lds0=(unsigned)(uintptr_t)shm;
  float*wsf=(float*)(shm+LDS_WS)+wid*64;
  const bf16*ksrc=Kh+(long)lane*DM+wid*8;
  const bf16*vsrc=Vh+(long)(16*(wid&3)+(lane>>2))*DM+(wid>>2)*32+(lane&3)*8;
  const unsigned kdst=lds0+LDS_K+wid*1024, vdst=lds0+LDS_V+wid*1024;
  #define DMA_K(t,slot) glds16(ksrc+(long)(t)*KVBLK*DM,(unsigned)__builtin_amdgcn_readfirstlane(kdst+(slot)))
  #define DMA_V(t,slot) glds16(vsrc+(long)(t)*KVBLK*DM,(unsigned)__builtin_amdgcn_readfirstlane(vdst+(slot)))
  const int vb0=(int)(lds0+LDS_V)+((lane>>4)&1)*32+(lane&3)*8+(4*hi+((lane&15)>>2))*64;
  const char*Kbase=shm+LDS_K; bf16x8 kf[8];
  const lds_cptr shm3=(lds_cptr)shm; const lds_cptr kp0=shm3+LDS_K+hi*1024+r32*16; const lds_cptr vp0=shm3+LDS_V+((lane>>4)&1)*32+(lane&3)*8+(4*hi+((lane&15)>>2))*64;
  const int NT=(q0+QB)/KVBLK;
  DMA_K(0,0);DMA_V(0,0);DMA_K(1,SLOTB);
  bf16x8 qr[4];
  #pragma unroll
  for(int d0=0;d0<4;++d0)qr[d0]=*reinterpret_cast<const bf16x8*>(&Qw[(long)r32*DM+d0*16+hi*8]);
  float mhat=0.f,l_reg=0.f;f32x16 o[2];o[0]=f32x16{};o[1]=f32x16{};f32x16 negm=f32x16{};asm volatile("":"+v"(negm));
  const int qrel=wid*QBLK+r32;
  #define CMASK(P0,P1,t) do{int jb_=(t)-(NT-4); if(jb_>=0)cmask(P0,P1,jb_,qrel,hi);}while(0)
  bool resc=false;
  #define START(P0,P1) do{ const float rm=rowmax(P0,P1); resc=false; \
    { const float dl=rm; mhat=fadd_s(mhat,dl); \
      _Pragma("unroll") for(int r=0;r<16;++r){P0[r]=fsub_s(P0[r],dl);P1[r]=fsub_s(P1[r],dl);} \
      _Pragma("unroll") for(int r=0;r<16;++r)negm[r]=-mhat; asm volatile("":"+v"(negm)); } \
    _Pragma("unroll") for(int r=0;r<16;++r)P0[r]=__builtin_amdgcn_exp2f(P0[r]); }while(0)
  #define RESC() do{ if(resc){ asm volatile("s_waitcnt lgkmcnt(0)":::"memory"); \
      _Pragma("unroll") for(int d_=0;d_<2;++d_) _Pragma("unroll") for(int r=0;r<16;++r)o[d_][r]*=wsf[crow(r,hi)]; } }while(0)
  f32x16 pA0,pA1,pB0,pB1;
  int sl_prev=0,sl_cur=0,sl_next=SLOTB;
  #define ROT() do{sl_prev=sl_cur;sl_cur=sl_next;sl_next=(sl_next==(NSLOT-1)*SLOTB)?0:sl_next+SLOTB;}while(0)
  DMA_K(2,2*SLOTB);
  WAIT_BAR(3);
  qkt(pA0,pA1,Kbase,qr,negm,r32,hi);asm volatile("s_nop 15\n\ts_nop 7":"+v"(pA0),"+v"(pA1));CMASK(pA0,pA1,0);
  START(pA0,pA1);
  _Pragma("unroll") for(int r=0;r<16;++r)pA1[r]=__builtin_amdgcn_exp2f(pA1[r]);
  WAIT_BAR(0);
  DMA_K(3,0);DMA_V(1,SLOTB);
  ROT();
  kload8(kf,kp0+sl_cur);
  WAIT_BAR(2);
  s16x4 vlo[8],vhi[8]; u32x4 pw0,pw1,pw2,pw3;
  #define PKW(P,B) cvtpk_s(P[B],P[B+1])
  #define PAF(k) __builtin_bit_cast(bf16x8,pw##k)
  #define VFR(i) (bf16x8){vlo[i][0],vlo[i][1],vlo[i][2],vlo[i][3],vhi[i][0],vhi[i][1],vhi[i][2],vhi[i][3]}
  #define PIN(x) asm volatile("":"+v"(x))
  #define MX3(a,b,c) __builtin_fmaxf(__builtin_fmaxf((a),(b)),(c))
  #define GAPA(MF,A0,A1,A2,A3,W0,W1,PW) do{ MF; sacc+=A0; sacc+=A1; sacc+=A2; sacc+=A3; PIN(sacc); W0; W1; PIN(PW); SBAR(); }while(0)
  #define EX(v) __builtin_amdgcn_exp2f(v)
  #define GAPB(MF,X,B) do{ MF; X[B]=EX(X[B]); X[B+1]=EX(X[B+1]); X[B+2]=EX(X[B+2]); X[B+3]=EX(X[B+3]); PIN(X); SBAR(); }while(0)
  #define VRD(i) do{ vlo[i]=vtr(vp_+(((i)>>2)*4096+((i)&3)*1024)); vhi[i]=vtr(vp_+(((i)>>2)*4096+((i)&3)*1024+512)); }while(0)
  #define KRD(G,j) do{ if(G){ kload2(kf,kp0+sl_next,j); SBAR(); } }while(0)
  #define STEP(C0,C1,P0,P1,t,GK,GV,GL) do{ SBAR(); \
    const lds_cptr vp_=vp0+sl_prev; \
    VRD(0); SBAR(); float sacc=(P0[0]+P0[1]); \
    GAPA(C0=__builtin_amdgcn_mfma_f32_32x32x16_bf16(kf[0],qr[0],negm,0,0,0), P0[2],P0[3],P0[4],P0[5],     pw0[0]=PKW(P0,0), pw0[1]=PKW(P0,2), pw0); \
    VRD(4); SBAR(); GAPA(C1=__builtin_amdgcn_mfma_f32_32x32x16_bf16(kf[1],qr[0],negm,0,0,0), P0[6],P0[7],P0[8],P0[9],     pw0[2]=PKW(P0,4), pw0[3]=PKW(P0,6), pw0); \
    VRD(1); SBAR(); GAPA(C0=__builtin_amdgcn_mfma_f32_32x32x16_bf16(kf[2],qr[1],C0,0,0,0),   P0[10],P0[11],P0[12],P0[13], pw1[0]=PKW(P0,8), pw1[1]=PKW(P0,10), pw1); \
    VRD(5); SBAR(); GAPA(C1=__builtin_amdgcn_mfma_f32_32x32x16_bf16(kf[3],qr[1],C1,0,0,0),   P0[14],P0[15],P1[0],P1[1],   pw1[2]=PKW(P0,12),pw1[3]=PKW(P0,14), pw1); \
    VRD(2); SBAR(); GAPA(C0=__builtin_amdgcn_mfma_f32_32x32x16_bf16(kf[4],qr[2],C0,0,0,0),   P1[2],P1[3],P1[4],P1[5],     pw2[0]=PKW(P1,0), pw2[1]=PKW(P1,2), pw2); \
    VRD(6); SBAR(); GAPA(C1=__builtin_amdgcn_mfma_f32_32x32x16_bf16(kf[5],qr[2],C1,0,0,0),   P1[6],P1[7],P1[8],P1[9],     pw2[2]=PKW(P1,4), pw2[3]=PKW(P1,6), pw2); \
    VRD(3); SBAR(); GAPA(C0=__builtin_amdgcn_mfma_f32_32x32x16_bf16(kf[6],qr[3],C0,0,0,0),   P1[10],P1[11],P1[12],P1[13], pw3[0]=PKW(P1,8), pw3[1]=PKW(P1,10), pw3); \
    VRD(7); SBAR(); GAPA(C1=__builtin_amdgcn_mfma_f32_32x32x16_bf16(kf[7],qr[3],C1,0,0,0),   P1[14],P1[15],0.f,0.f,       pw3[2]=PKW(P1,12),pw3[3]=PKW(P1,14), pw3); \
    l_reg+=sacc; \
    if(GK){DMA_K((t)+3,sl_cur);} if(GV){DMA_V((t)+1,sl_next);} \
    CMASK(C0,C1,t); \
    { float a=MX3(C0[0],C0[1],C1[0]),b=MX3(C0[2],C0[3],C1[1]); a=MX3(a,C1[2],C1[3]); \
      _Pragma("unroll") for(int r=4;r<16;r+=4){a=MX3(a,C0[r],C0[r+1]);b=MX3(b,C0[r+2],C0[r+3]);a=MX3(a,C1[r],C1[r+1]);b=MX3(b,C1[r+2],C1[r+3]);} \
      float rm=__builtin_fmaxf(a,b); { auto rr=__builtin_amdgcn_permlane32_swap(__float_as_uint(rm),__float_as_uint(rm),false,false); rm=__builtin_fmaxf(__uint_as_float(rr[0]),__uint_as_float(rr[1])); } \
      resc=false; \
      if(__builtin_expect(__any(rm>(float)THRL),0)){ const float dl=__builtin_fmaxf(rm,0.f); mhat+=dl; \
        _Pragma("unroll") for(int r=0;r<16;++r){C0[r]-=dl;C1[r]-=dl;} \
        _Pragma("unroll") for(int r=0;r<16;++r)negm[r]=-mhat; asm volatile("":"+v"(negm)); \
        const float f=__builtin_amdgcn_exp2f(-dl); l_reg*=f; if(hi==0)wsf[r32]=f; resc=true; } } \
    SBAR(); \
    GAPB(o[0]=__builtin_amdgcn_mfma_f32_32x32x16_bf16(PAF(0),VFR(0),o[0],0,0,0), C0,0); \
    GAPB(o[1]=__builtin_amdgcn_mfma_f32_32x32x16_bf16(PAF(0),VFR(4),o[1],0,0,0), C0,4); \
    KRD(GL,0); GAPB(o[0]=__builtin_amdgcn_mfma_f32_32x32x16_bf16(PAF(1),VFR(1),o[0],0,0,0), C0,8); \
    KRD(GL,1); GAPB(o[1]=__builtin_amdgcn_mfma_f32_32x32x16_bf16(PAF(1),VFR(5),o[1],0,0,0), C0,12); \
    KRD(GL,2); GAPB(o[0]=__builtin_amdgcn_mfma_f32_32x32x16_bf16(PAF(2),VFR(2),o[0],0,0,0), C1,0); \
    KRD(GL,3); GAPB(o[1]=__builtin_amdgcn_mfma_f32_32x32x16_bf16(PAF(2),VFR(6),o[1],0,0,0), C1,4); \
    GAPB(o[0]=__builtin_amdgcn_mfma_f32_32x32x16_bf16(PAF(3),VFR(3),o[0],0,0,0), C1,8); \
    GAPB(o[1]=__builtin_amdgcn_mfma_f32_32x32x16_bf16(PAF(3),VFR(7),o[1],0,0,0), C1,12); \
    }while(0)
  int t=1;
  #undef CMASK
  #define CMASK(P0,P1,t) do{}while(0)
  for(;t+5<NT;t+=2){
    STEP(pB0,pB1,pA0,pA1,t,true,true,true);     WAIT_BAR(2); RESC(); ROT();
    STEP(pA0,pA1,pB0,pB1,t+1,true,true,true);   WAIT_BAR(2); RESC(); ROT();
  }
  #undef CMASK
  #define CMASK(P0,P1,t) do{int jb_=(t)-(NT-4); if(jb_>=0)cmask(P0,P1,jb_,qrel,hi);}while(0)
  #define ENDW(tt) do{ if((tt)+3<NT){WAIT_BAR(2);} else if((tt)+2<NT){WAIT_BAR(1);} else {WAIT_BAR(0);} }while(0)
  for(;t+1<NT;t+=2){
    STEP(pB0,pB1,pA0,pA1,t,(t+3<NT),(t+1<NT),(t+1<NT));       ENDW(t);   RESC(); ROT();
    STEP(pA0,pA1,pB0,pB1,t+1,(t+4<NT),(t+2<NT),(t+2<NT));     ENDW(t+1); RESC(); ROT();
  }
  STEP(pB0,pB1,pA0,pA1,NT-1,false,false,false); RESC();
  { float sacc=pB0[0]+pB0[1]; _Pragma("unroll") for(int r=2;r<16;++r)sacc+=pB0[r]; _Pragma("unroll") for(int r=0;r<16;++r)sacc+=pB1[r]; l_reg+=sacc;
    pw0=(u32x4){PKW(pB0,0),PKW(pB0,2),PKW(pB0,4),PKW(pB0,6)};pw1=(u32x4){PKW(pB0,8),PKW(pB0,10),PKW(pB0,12),PKW(pB0,14)};pw2=(u32x4){PKW(pB1,0),PKW(pB1,2),PKW(pB1,4),PKW(pB1,6)};pw3=(u32x4){PKW(pB1,8),PKW(pB1,10),PKW(pB1,12),PKW(pB1,14)};
    SBAR(); pv(o,vb0+sl_cur,PAF(0),PAF(1),PAF(2),PAF(3)); }
  #undef PKW
  #undef PAF
  #undef VFR
  #undef PIN
  #undef MX3
  #undef GAPA
  #undef GAPB
  #undef EX
  #undef VRD
  #undef KRD
  #undef STEP
  #undef ENDW
  {auto rr=__builtin_amdgcn_permlane32_swap(__float_as_uint(l_reg),__float_as_uint(l_reg),false,false);l_reg=__uint_as_float(rr[0])+__uint_as_float(rr[1]);}
  if(hi==0)wsf[32+r32]=l_reg;asm volatile("s_waitcnt lgkmcnt(0)":::"memory");
  float rli[16];
  #pragma unroll
  for(int r=0;r<16;++r)rli[r]=__builtin_amdgcn_rcpf(wsf[32+crow(r,hi)]);
  bf16*Ow=O+(rowbase+q0+wid*QBLK)*DM+cv;
  { bf16*stg=(bf16*)(shm+LDS_OST)+wid*2048;
    #pragma unroll
    for(int r=0;r<16;++r){const int orow=crow(r,hi);
      #pragma unroll
      for(int d0=0;d0<2;++d0)stg[orow*64+d0*32+r32]=__float2bfloat16(o[d0][r]*rli[r]);}
    asm volatile("s_waitcnt lgkmcnt(0)":::"memory");
    #pragma unroll
    for(int i=0;i<4;++i){const int row=i*8+(lane>>3),ch=lane&7; const u32x4 v=*(const u32x4*)(stg+row*64+ch*8); ATTN_STORE16(Ow+(long)row*DM+ch*8,v);} }
  asm volatile("s_waitcnt lgkmcnt(0)\n\ts_barrier":::"memory");
  #undef DMA_K
  #undef DMA_V
  #undef CMASK
  #undef START
  #undef RESC
  #undef ROT
}
constexpr int ATTN_LDS_BYTES=LDS_BYTES;
struct AttnTensors { const bf16* Q; const bf16* K; const bf16* V; bf16* O0; bf16* O1; };
template<int THRL> __device__ __forceinline__ void attn_phase(char*lds,const AttnTensors&T,int vcu,int G){
  for(int v=vcu;v<256;v+=G){
    const int e=v>>2,s=v&3; const int b=e>>5,rem=e&31,h=rem>>2,m=(rem>>1)&1,vh=rem&1;
    const int cq=(2*h+m)*64,cv=(2*h+vh)*64; bf16*O=m?T.O1:T.O0;
    for(int i=0;i<16;++i){ const int j=i>>1; const int qb=(i&1)?(8*j+7-s):(8*j+s); attn_unit<THRL>(b,cq,cv,qb,T.Q,T.K,T.V,O,lds); }
  }
}
#undef SBAR
#undef WAIT_BAR
}

namespace attn128 {
constexpr int D = 128, PITCH = 1024, SEQ = 16384;
constexpr float THR = 8.f; constexpr bool WSKIP = false;
constexpr float SCALE = 0.125f;
constexpr int NW = 8, QBLK = 32, KVBLK = 64, QB = NW * QBLK;
constexpr int SHM_V = KVBLK * D * 2, SHM_K = KVBLK * D * 2;
constexpr int LDS_BYTES = 2 * SHM_V + 2 * SHM_K + NW * 64 * 4;
using bf16 = unsigned short;
typedef short bf16x8 __attribute__((ext_vector_type(8)));
typedef short s16x4 __attribute__((ext_vector_type(4)));
typedef float f32x16 __attribute__((ext_vector_type(16)));
typedef float f32x4 __attribute__((ext_vector_type(4)));
typedef unsigned u32x4 __attribute__((ext_vector_type(4)));
template <class A, class Bt> struct same_t { static constexpr bool v = false; };
template <class A> struct same_t<A, A> { static constexpr bool v = true; };

#define KSWZ(row, colB) ((row) * 256 + ((colB) ^ (((row) & 7) << 4)))
#define SBAR() __builtin_amdgcn_sched_barrier(0)
__device__ __forceinline__ int v_st(int k, int c) { const int kk = (k & ~0xC) | ((k & 4) << 1) | ((k & 8) >> 1); return ((kk >> 3) * 4 + (c >> 5)) * 512 + ((kk & 7) * 32 + (c & 31)) * 2; }
__device__ __forceinline__ int v_rd_base(int lane) { return ((lane & 3) << 3) | (((lane >> 2) & 3) << 6) | (((lane >> 4) & 1) << 5) | (((lane >> 5) & 1) << 8); }
constexpr int v_rd_off(int d0, int ks, int half) { return d0 * 512 + ks * 4096 + half * 2048; }
__device__ __forceinline__ int crow(int r, int hi) { return (r & 3) + 8 * (r >> 2) + 4 * hi; }
__device__ __forceinline__ unsigned cvtpk(float lo, float hi) {
    unsigned r; asm volatile("v_cvt_pk_bf16_f32 %0, %1, %2" : "=v"(r) : "v"(lo), "v"(hi)); return r;
}
__device__ __forceinline__ bf16x8 pack8(f32x4 a, f32x4 b) {
    u32x4 w = {cvtpk(a[0], a[1]), cvtpk(a[2], a[3]), cvtpk(b[0], b[1]), cvtpk(b[2], b[3])};
    return *reinterpret_cast<bf16x8*>(&w);
}
template <class T> __device__ __forceinline__ bf16x8 load8(const T* p) {
    if constexpr (same_t<T, float>::v) { return pack8(*(const f32x4*)p, *(const f32x4*)(p + 4)); }
    else { return *reinterpret_cast<const bf16x8*>(p); }
}
__device__ __forceinline__ void mask_tile(f32x16& p0, f32x16& p1, int dq, unsigned W) {
    const float NEG = -__builtin_inff();
#pragma unroll
    for (int r = 0; r < 16; ++r) {
        const int c = (r & 3) + 8 * (r >> 2);
        if ((unsigned)(dq - c) >= W) p0[r] = NEG;
        if ((unsigned)(dq - c - 32) >= W) p1[r] = NEG;
    }
}
__device__ __forceinline__ void partialSM(f32x16& p0, f32x16& p1, float& m_reg, float& mn, float& alpha) {
    float pmax = p0[0]; for (int r = 1; r < 16; ++r) pmax = fmaxf(pmax, p0[r]); for (int r = 0; r < 16; ++r) pmax = fmaxf(pmax, p1[r]);
    { auto rr = __builtin_amdgcn_permlane32_swap(__float_as_uint(pmax), __float_as_uint(pmax), false, false);
      pmax = fmaxf(__uint_as_float(rr[0]), __uint_as_float(rr[1])); }
    constexpr float C2 = 1.4426950408889634f * SCALE;
    if (__builtin_expect(__all((pmax - m_reg) * SCALE <= THR), 1)) { mn = m_reg; alpha = 1.f; }
    else { mn = fmaxf(m_reg, pmax); alpha = __builtin_amdgcn_exp2f((m_reg - mn) * C2); m_reg = mn; }
    const float mnL = -mn * C2;
    for (int r = 0; r < 16; ++r) p0[r] = fmaf(p0[r], C2, mnL); for (int r = 0; r < 16; ++r) p1[r] = fmaf(p1[r], C2, mnL);
    for (int r = 0; r < 16; ++r) p0[r] = __builtin_amdgcn_exp2f(p0[r]);
}
__device__ __forceinline__ void finishSM(f32x16& p0, f32x16& p1, float alpha, float& l_reg, bf16x8& pa0, bf16x8& pa1, bf16x8& pa2, bf16x8& pa3) {
    for (int r = 0; r < 16; ++r) p1[r] = __builtin_amdgcn_exp2f(p1[r]);
    float ps = 0; for (int r = 0; r < 16; ++r) ps += p0[r]; for (int r = 0; r < 16; ++r) ps += p1[r];
    { auto rr = __builtin_amdgcn_permlane32_swap(__float_as_uint(ps), __float_as_uint(ps), false, false);
      ps = __uint_as_float(rr[0]) + __uint_as_float(rr[1]); }
    l_reg = l_reg * alpha + ps;
#define PK4(P, B_, OUT) do { unsigned a0 = cvtpk(P[B_+0], P[B_+1]), a1 = cvtpk(P[B_+2], P[B_+3]);                          \
        unsigned b0 = cvtpk(P[B_+4], P[B_+5]), b1 = cvtpk(P[B_+6], P[B_+7]);                                             \
        auto r0 = __builtin_amdgcn_permlane32_swap(a0, b0, false, false); auto r1 = __builtin_amdgcn_permlane32_swap(a1, b1, false, false); \
        u32x4 w = {r0[0], r1[0], r0[1], r1[1]}; OUT = *reinterpret_cast<bf16x8*>(&w); } while (0)
    PK4(p0, 0, pa0); PK4(p0, 8, pa1); PK4(p1, 0, pa2); PK4(p1, 8, pa3);
#undef PK4
}
template <int KB, bool SK>
__device__ __forceinline__ void qkt(f32x16& p0, f32x16& p1, const char* K_lds, int r32, int hi, const bf16x8* qr, bool act, int kmo) {
    if (SK && !act) { const float NEG = -__builtin_inff();
#pragma unroll
        for (int r = 0; r < 16; ++r) { p0[r] = NEG; p1[r] = NEG; } return; }
    p0 = f32x16{}; p1 = f32x16{};
    const char* kb[4];
#pragma unroll
    for (int dd = 0; dd < 4; ++dd) kb[dd] = K_lds + KB * SHM_K + KSWZ(r32, (dd * 16 + hi * 8) * 2);
#pragma unroll
    for (int d0 = 0; d0 < 4; ++d0) { const char* a = kb[d0] + kmo;
        bf16x8 b0 = *reinterpret_cast<const bf16x8*>(a);
        bf16x8 b1 = *reinterpret_cast<const bf16x8*>(a + 32 * 256);
        p0 = __builtin_amdgcn_mfma_f32_32x32x16_bf16(b0, qr[d0], p0, 0, 0, 0);
        p1 = __builtin_amdgcn_mfma_f32_32x32x16_bf16(b1, qr[d0], p1, 0, 0, 0); }
}
template <int VB, bool SK>
__device__ __forceinline__ void pv_tile(f32x16* o, int vb0, bf16x8 pa0, bf16x8 pa1, bf16x8 pa2, bf16x8 pa3, bool act) {
    if (SK && !act) return;
#define TRRD(dst, off) asm volatile("ds_read_b64_tr_b16 %0, %1 offset:%2" : "=&v"(dst) : "v"(vb0), "i"(off) : "memory")
#define PV_D0(d0) do { s16x4 l0, l1, l2, l3, h0, h1, h2, h3; constexpr int b_ = VB * SHM_V + v_rd_off(d0, 0, 0);     \
        TRRD(l0, b_); TRRD(h0, b_ + 2048); TRRD(l1, b_ + 4096); TRRD(h1, b_ + 6144); TRRD(l2, b_ + 8192); TRRD(h2, b_ + 10240); TRRD(l3, b_ + 12288); TRRD(h3, b_ + 14336); \
        asm volatile("s_waitcnt lgkmcnt(0)" ::: "memory"); SBAR();                 \
        o[d0] = __builtin_amdgcn_mfma_f32_32x32x16_bf16(pa0, (bf16x8){l0[0], l0[1], l0[2], l0[3], h0[0], h0[1], h0[2], h0[3]}, o[d0], 0, 0, 0);   \
        o[d0] = __builtin_amdgcn_mfma_f32_32x32x16_bf16(pa1, (bf16x8){l1[0], l1[1], l1[2], l1[3], h1[0], h1[1], h1[2], h1[3]}, o[d0], 0, 0, 0);   \
        o[d0] = __builtin_amdgcn_mfma_f32_32x32x16_bf16(pa2, (bf16x8){l2[0], l2[1], l2[2], l2[3], h2[0], h2[1], h2[2], h2[3]}, o[d0], 0, 0, 0);   \
        o[d0] = __builtin_amdgcn_mfma_f32_32x32x16_bf16(pa3, (bf16x8){l3[0], l3[1], l3[2], l3[3], h3[0], h3[1], h3[2], h3[3]}, o[d0], 0, 0, 0); } while (0)
    PV_D0(0); PV_D0(1); PV_D0(2); PV_D0(3);
#undef PV_D0
#undef TRRD
}

template <class TIn, class TOut> struct BlockRef { const TIn* Q; const TIn* K; const TIn* V; TOut* O; int P0; int kmo; };
template <class TIn> struct Seam {
    bf16x8 qr[4];
    bf16x8 st_v0, st_v1, st_k0, st_k1; f32x4 sf0, sf1, sf2, sf3;
    f32x4 tq[1];
};
__device__ __forceinline__ int swa_jlo(int P0, int W) { const int lowk = P0 - W + 1; return lowk > 0 ? lowk / KVBLK : 0; }
#define ROW(p, k0, rr) ((p) + (size_t)((k0) + (rr)) * PITCH + sc)
#define VMW() asm volatile("s_waitcnt vmcnt(0)" ::: "memory")
#define VMWN(n) asm volatile("s_waitcnt vmcnt(%0)" :: "i"(n) : "memory")
#define SLOAD_H(Kp, Vp, k0) do { S.st_v0 = load8<TIn>(ROW(Vp, k0, sr)); S.st_v1 = load8<TIn>(ROW(Vp, k0, 32 + sr));              \
                         S.st_k0 = load8<TIn>(ROW(Kp, k0, sr)); S.st_k1 = load8<TIn>(ROW(Kp, k0, 32 + sr)); } while (0)
#define SWRITE_HK(bf) do { *(bf16x8*)(K_lds + (bf) * SHM_K + kws) = S.st_k0; *(bf16x8*)(K_lds + (bf) * SHM_K + kws + 32 * 256) = S.st_k1; } while (0)
#define SWRITE_HV(bf) do { *(bf16x8*)(V_lds + (bf) * SHM_V + vst0) = S.st_v0; *(bf16x8*)(V_lds + (bf) * SHM_V + vst1) = S.st_v1; } while (0)
#define SWRITE_H(bf) do { SWRITE_HV(bf); SWRITE_HK(bf); } while (0)
#define SLOAD_F(p, k0) do { S.sf0 = *(const f32x4*)ROW(p, k0, sr); S.sf1 = *(const f32x4*)(ROW(p, k0, sr) + 4);                \
                            S.sf2 = *(const f32x4*)ROW(p, k0, 32 + sr); S.sf3 = *(const f32x4*)(ROW(p, k0, 32 + sr) + 4); } while (0)
#define SWRITE_KF(bf) do { *(bf16x8*)(K_lds + (bf) * SHM_K + kws) = pack8(S.sf0, S.sf1); *(bf16x8*)(K_lds + (bf) * SHM_K + kws + 32 * 256) = pack8(S.sf2, S.sf3); } while (0)
#define SWRITE_VF(bf) do { *(bf16x8*)(V_lds + (bf) * SHM_V + vst0) = pack8(S.sf0, S.sf1); *(bf16x8*)(V_lds + (bf) * SHM_V + vst1) = pack8(S.sf2, S.sf3); } while (0)
template <class TIn, class TOut>
__device__ __forceinline__ void causal_swa_prime(const BlockRef<TIn, TOut>& cur, int W, char* lds, Seam<TIn>& S) {
    constexpr bool F32 = same_t<TIn, float>::v;
    int tid_ = threadIdx.x; asm volatile("" : "+v"(tid_)); const int tid = tid_, wid = __builtin_amdgcn_readfirstlane(tid >> 6), lane = tid & 63, r32 = lane & 31, hi = lane >> 5;
    const int sr = tid >> 4, sc = (tid & 15) * 8, kws = KSWZ(sr, sc * 2); char* K_lds = lds + 2 * SHM_V;
    const int kb0 = swa_jlo(cur.P0, W) * KVBLK;
    for (int d0 = 0; d0 < 4; ++d0) S.qr[d0] = load8<TIn>(cur.Q + (size_t)(wid * QBLK + r32) * PITCH + d0 * 16 + hi * 8);
    if constexpr (F32) { SLOAD_F((const float*)cur.K, kb0); VMW(); SWRITE_KF(0); SBAR(); SLOAD_F((const float*)cur.V, kb0); }
    else { SLOAD_H(cur.K, cur.V, kb0); VMW(); SWRITE_HK(0); }
    __syncthreads();
}
template <class TIn, class TOut>
__device__ __forceinline__ void causal_swa_block(const BlockRef<TIn, TOut>& cur, const BlockRef<TIn, TOut>& nxt, int skv, int W, char* lds, Seam<TIn>& S) {
    constexpr bool F32 = same_t<TIn, float>::v;
    int tid_ = threadIdx.x; asm volatile("" : "+v"(tid_)); const int tid = tid_, wid = __builtin_amdgcn_readfirstlane(tid >> 6), lane = tid & 63, r32 = lane & 31, hi = lane >> 5;
    const int j_lo = swa_jlo(cur.P0, W);
    int j_hi = (cur.P0 + QB - 1) / KVBLK + 1; if (j_hi > skv / KVBLK) j_hi = skv / KVBLK;
    const int NT = j_hi - j_lo;
    const int kbn = swa_jlo(nxt.P0, W) * KVBLK;
    const int qlo = cur.P0 + wid * QBLK, qm = qlo + r32 - 4 * hi;
    char* V_lds = lds; char* K_lds = lds + 2 * SHM_V;
    float* ws = (float*)(lds + 2 * SHM_V + 2 * SHM_K) + wid * 64; float* li_l = ws, * al_l = ws + 32;
    float m_reg = -1e30f, l_reg = 0; f32x16 o[4] = {};
    const int sr = tid >> 4, sc = (tid & 15) * 8, vst0 = v_st(sr, sc), vst1 = v_st(32 + sr, sc), kws = KSWZ(sr, sc * 2);
    const int vb0 = (int)(uintptr_t)V_lds + v_rd_base(lane);
    const TIn* Kh = cur.K; const TIn* Vh = cur.V;
#define RESC(a) do { if (__any((a) < 1.f)) { if (hi == 0) al_l[r32] = (a); asm volatile("s_waitcnt lgkmcnt(0)" ::: "memory");              \
                     for (int d_ = 0; d_ < 4; ++d_) for (int r = 0; r < 16; ++r) o[d_][r] *= al_l[crow(r, hi)]; } } while (0)
#define KBASE(t) ((j_lo + (t)) * KVBLK)
#define ACT(t) (KBASE(t) <= qlo + QBLK - 1 && KBASE(t) + KVBLK - 1 >= qlo - W + 1)
#define MASKT(P0_, P1_, t) do { const int kb_ = KBASE(t); if ((!SK || ACT(t)) && (kb_ + KVBLK - 1 > qlo || kb_ <= qlo + QBLK - 1 - W)) mask_tile(P0_, P1_, qm - kb_, (unsigned)W); } while (0)
    constexpr int NQL = F32 ? 16 : 4;
    constexpr bool SK = WSKIP && !F32;
#define SEAM_K0() do { VMWN(NQL); if constexpr (F32) { SWRITE_KF(0); SBAR(); SLOAD_F((const float*)nxt.V, kbn); } else { SWRITE_HK(0); } SBAR(); } while (0)
    f32x16 pA0, pA1, pB0, pB1; float mnA, mnB, alA, alB; bf16x8 pa0, pa1, pa2, pa3;
    if constexpr (F32) { VMW(); SWRITE_VF(0); SBAR(); } else { SWRITE_HV(0); SBAR(); }
    if (NT > 1) { if constexpr (F32) SLOAD_F((const float*)Kh, KBASE(1)); else SLOAD_H(Kh, Vh, KBASE(1)); }
    SBAR(); qkt<0, SK>(pA0, pA1, K_lds, r32, hi, S.qr, ACT(0), cur.kmo);
    if constexpr (F32) { if (NT > 1) { VMW(); SWRITE_KF(1); SBAR(); SLOAD_F((const float*)Vh, KBASE(1)); } }
    MASKT(pA0, pA1, 0); partialSM(pA0, pA1, m_reg, mnA, alA);
    if (NT > 1) { VMW(); if constexpr (F32) { SWRITE_VF(1); SBAR(); if (NT > 2) SLOAD_F((const float*)Kh, KBASE(2)); } else SWRITE_H(1); }
    __syncthreads();
#define HALF_STEP(PX0, PX1, mnX, alX, PY0, PY1, alY, t, KB, VB, SB) do {                                                      \
        SBAR(); qkt<KB, SK>(PX0, PX1, K_lds, r32, hi, S.qr, ACT(t), cur.kmo);                                             \
        finishSM(PY0, PY1, alY, l_reg, pa0, pa1, pa2, pa3); SBAR();                                                           \
        if ((t) + 1 < NT) { if constexpr (F32) { VMW(); SWRITE_KF(SB); SBAR(); SLOAD_F((const float*)Vh, KBASE((t) + 1)); }  \
                            else { SLOAD_H(Kh, Vh, KBASE((t) + 1)); } SBAR(); }                                               \
        pv_tile<VB, SK>(o, vb0, pa0, pa1, pa2, pa3, ACT((t) - 1)); MASKT(PX0, PX1, (t)); partialSM(PX0, PX1, m_reg, mnX, alX);                                        \
        __syncthreads();                                                                                                      \
        if ((t) + 1 < NT) { VMW(); if constexpr (F32) { SWRITE_VF(SB); SBAR(); if ((t) + 2 < NT) SLOAD_F((const float*)Kh, KBASE((t) + 2)); } \
                            else { SWRITE_H(SB); } }                                                                          \
        RESC(alX); __syncthreads(); } while (0)
    for (int t = 1; t + 1 < NT; t += 2) {
        HALF_STEP(pB0, pB1, mnB, alB, pA0, pA1, alA, t, 1, 0, 0);
        HALF_STEP(pA0, pA1, mnA, alA, pB0, pB1, alB, t + 1, 0, 1, 1);
    }
    const bool even = (NT & 1) == 0;
    if (even) { SBAR(); qkt<1, SK>(pB0, pB1, K_lds, r32, hi, S.qr, ACT(NT - 1), cur.kmo); SBAR(); }
#define QROW(e) (nxt.Q + (size_t)(wid * QBLK + r32) * D + ((e) >> 1) * 16 + hi * 8 + ((e) & 1) * 4)
    if constexpr (F32) { SLOAD_F((const float*)nxt.K, kbn); SBAR();
#pragma unroll
        for (int e = 0; e < 8; ++e) S.tq[e] = *(const f32x4*)QROW(e); }
    else { SLOAD_H(nxt.K, nxt.V, kbn); SBAR();
#pragma unroll
        for (int d0 = 0; d0 < 4; ++d0) S.qr[d0] = load8<TIn>(nxt.Q + (size_t)(wid * QBLK + r32) * PITCH + d0 * 16 + hi * 8); }
    SBAR();
    finishSM(pA0, pA1, alA, l_reg, pa0, pa1, pa2, pa3); SBAR();
    if constexpr (F32) {
#pragma unroll
        for (int e = 8; e < 16; ++e) S.tq[e] = *(const f32x4*)QROW(e); SBAR(); }
#undef QROW
    pv_tile<0, SK>(o, vb0, pa0, pa1, pa2, pa3, ACT(even ? NT - 2 : NT - 1));
    if (even) { MASKT(pB0, pB1, NT - 1); partialSM(pB0, pB1, m_reg, mnB, alB); __syncthreads(); RESC(alB);
        finishSM(pB0, pB1, alB, l_reg, pa0, pa1, pa2, pa3); SBAR(); pv_tile<1, SK>(o, vb0, pa0, pa1, pa2, pa3, ACT(NT - 1)); }
    SBAR(); SEAM_K0();
    if (hi == 0) li_l[r32] = l_reg; asm volatile("s_waitcnt lgkmcnt(0)" ::: "memory");
    float rli[16];
#pragma unroll
    for (int r = 0; r < 16; ++r) rli[r] = __builtin_amdgcn_rcpf(li_l[crow(r, hi)]);
    TOut* Ow = cur.O + (size_t)(wid * QBLK) * PITCH;
#pragma unroll
    for (int r = 0; r < 16; ++r) { const int orow = crow(r, hi);
#pragma unroll
        for (int d0 = 0; d0 < 4; ++d0) { const float v = o[d0][r] * rli[r];
            if constexpr (same_t<TOut, float>::v) { Ow[(size_t)orow * PITCH + d0 * 32 + r32] = v; }
            else { const float vn = __shfl_xor(v, 1);
                   if ((r32 & 1) == 0) *(unsigned*)(Ow + (size_t)orow * PITCH + d0 * 32 + r32) = cvtpk(v, vn); } } }
    if constexpr (F32) {
#pragma unroll
        for (int d0 = 0; d0 < 8; ++d0) S.qr[d0] = pack8(S.tq[2 * d0], S.tq[2 * d0 + 1]); }
    __syncthreads();
#undef RESC
#undef KBASE
#undef ACT
#undef MASKT
#undef SEAM_K0
#undef HALF_STEP
}
#undef ROW
#undef VMW
#undef VMWN
#undef SLOAD_H
#undef SWRITE_HK
#undef SWRITE_HV
#undef SWRITE_H
#undef SLOAD_F
#undef SWRITE_KF
#undef SWRITE_VF


struct AttnTensors { const bf16* Q; const bf16* K; const bf16* V; bf16* O0; bf16* O1; };
__device__ __forceinline__ BlockRef<bf16, bf16> blk_ref(const AttnTensors& T, int vcu, int G, int li) {
    const int v = vcu + (li >> 3) * G, i = li & 7, e = v >> 3, s = v & 7, b = e >> 4, h = (e >> 1) & 7, m = e & 1, j = i >> 1;
    const int qb = (i & 1) ? (16 * j + 15 - s) : (16 * j + s);
    BlockRef<bf16, bf16> r;
    r.Q = T.Q + ((size_t)b * SEQ + (size_t)qb * QB) * PITCH + h * 128 + m * 64;
    r.K = T.K + (size_t)b * SEQ * PITCH + h * 128; r.V = T.V + (size_t)b * SEQ * PITCH + h * 128;
    r.O = (m ? T.O1 : T.O0) + ((size_t)b * SEQ + (size_t)qb * QB) * PITCH + h * 128;
    r.P0 = qb * QB; r.kmo = m * 128;
    return r;
}
__device__ __forceinline__ void attn_phase(char* lds, const AttnTensors& T, int vcu, int G) {
    int nv = 0; for (int v = vcu; v < 256; v += G) ++nv;
    const int nblk = nv * 8; if (nblk == 0) return;
    Seam<bf16> S;
    BlockRef<bf16, bf16> cur = blk_ref(T, vcu, G, 0);
    causal_swa_prime<bf16, bf16>(cur, SEQ, lds, S);
    for (int li = 0; li < nblk; ++li) {
        const BlockRef<bf16, bf16> nxt = (li + 1 < nblk) ? blk_ref(T, vcu, G, li + 1) : cur;
        causal_swa_block<bf16, bf16>(cur, nxt, SEQ, SEQ, lds, S);
        cur = nxt;
    }
}
}

#define GAS __attribute__((address_space(1)))
#define LAS __attribute__((address_space(3)))
typedef unsigned short bf16;
typedef unsigned v4u __attribute__((ext_vector_type(4)));
typedef float f32x4 __attribute__((ext_vector_type(4)));
typedef short bf16x8 __attribute__((ext_vector_type(8)));
typedef GAS unsigned gu32;
typedef GAS unsigned long long gu64;
#define RLX_AGENT __ATOMIC_RELAXED, __HIP_MEMORY_SCOPE_AGENT
#define LDS_WAIT() asm volatile("s_waitcnt lgkmcnt(0)" ::: "memory")
#define VM_WAIT() asm volatile("s_waitcnt vmcnt(0)" ::: "memory")
__device__ __forceinline__ unsigned long long rt() { return __builtin_amdgcn_s_memrealtime(); }

constexpr int NWAVES = 8;
#ifndef REP_SCAN
#define REP_SCAN 1
#endif
#ifndef REP_ATTN
#define REP_ATTN 1
#endif
#ifndef REP_G1
#define REP_G1 1
#endif
constexpr int BATCH = 2, SEQ = 16384, D = 1024, M = BATCH * SEQ;
constexpr size_t MiB = 1u << 20;
constexpr size_t WS_ROPE_C = 1 * MiB, WS_ROPE_S = 2 * MiB, WS_S = 3 * MiB, WS_BIAS = 5 * MiB, WS_W = 6 * MiB, WS_U = 32 * MiB, UNIT = 64 * MiB, WS_H = WS_U + 7 * UNIT, WS_END = WS_H + 16 * MiB;
constexpr size_t W_FOLD = 0, W_UP = 17 * MiB, W_OUT = 19 * MiB;
constexpr size_t W_PROJ = 0, W_BOUT = 8 * MiB;
constexpr int LDS_BYTES = 147456;
constexpr float C2F = 0.125f * 1.4426950408889634f;
#ifdef ATTN_D64
#define QSCALE_MASK0 0x4
#define QSCALE_MASK1 0x1
#else
#define QSCALE_MASK0 0x0
#define QSCALE_MASK1 0x0
#endif

typedef _Float16 h16x4 __attribute__((ext_vector_type(4)));
typedef unsigned u32x2 __attribute__((ext_vector_type(2)));
typedef float f32x2 __attribute__((ext_vector_type(2)));
__device__ __forceinline__ unsigned f2bf(float f) { unsigned u = __builtin_bit_cast(unsigned, f); return (u + 0x7fffu + ((u >> 16) & 1u)) >> 16; }
__device__ __forceinline__ unsigned pk2(float lo, float hi) { return f2bf(lo) | (f2bf(hi) << 16); }
__device__ __forceinline__ float bflo(unsigned w) { return __uint_as_float(w << 16); }
__device__ __forceinline__ float bfhi(unsigned w) { return __uint_as_float(w & 0xffff0000u); }
__device__ __forceinline__ float wave_sum(float v) {
#pragma unroll
    for (int o = 1; o < 64; o <<= 1) v += __shfl_xor(v, o);
    return v;
}
template <int CTRL> __device__ __forceinline__ float dpp_mov(float x) { return __builtin_bit_cast(float, __builtin_amdgcn_update_dpp(0, __builtin_bit_cast(int, x), CTRL, 0xf, 0xf, false)); }
__device__ __forceinline__ float allreduce16(float x) { x += dpp_mov<0x128>(x); x += dpp_mov<0x124>(x); x += dpp_mov<0x122>(x); x += dpp_mov<0x121>(x); return x; }

__device__ __forceinline__ void conv_tile(const float* src, int ldsrc, int k0s, int n0s, int kvalid, const float* sc, int smode, bf16* dst, int pitch, int n0d, int k0d, LAS float* scr, int lane) {
#pragma unroll 8
    for (int i = 0; i < 32; ++i) { const int kk = 2 * i + (lane >> 5), n = lane & 31; float v = 0.f;
        if (kk < kvalid) { v = src[(size_t)(k0s + kk) * ldsrc + n0s + n]; if (smode) { const float s = sc[k0s + kk]; v *= (smode == 1) ? s : (1.0f - s); } }
        scr[kk * 33 + n] = v; }
    LDS_WAIT(); asm volatile("" ::: "memory");
    const int c = lane & 7;
#pragma unroll
    for (int j = 0; j < 4; ++j) { const int n = (lane >> 3) + 8 * j; const LAS float* s = scr + (8 * c) * 33 + n;
        v4u o; o.x = pk2(s[0 * 33], s[1 * 33]); o.y = pk2(s[2 * 33], s[3 * 33]); o.z = pk2(s[4 * 33], s[5 * 33]); o.w = pk2(s[6 * 33], s[7 * 33]);
        *(v4u*)(dst + (size_t)(n0d + n) * pitch + k0d + 8 * c) = o; }
    LDS_WAIT(); asm volatile("" ::: "memory");
}

struct In {
    const float* x; const int* pos; const float *a_norm, *a_mu, *a_w_in, *a_w0, *a_w1, *a_w2, *a_a0, *a_a1, *a_a2, *a_v0, *a_v1, *a_v2, *a_k_k, *a_k_a, *a_r_k, *a_ln_w, *a_ln_b, *a_w_out;
    const float *kv_norm, *w_kv, *b_norm, *b_w_in, *b_lq1, *b_lk1, *b_lq2, *b_lk2, *b_subln, *b_w_out, *final_norm;
};

__device__ __forceinline__ void conv_rwkv(const In& I, int l, unsigned char* wreg, float* bias3, LAS float* scr, int gw, int NGW, int lane) {
    if (gw < 48) { const int i = gw * 64 + lane; const int t = i >> 10, c = i & 1023; bias3[i] = (t == 0) ? I.a_w0[l * 1024 + c] : (t == 1) ? I.a_a0[l * 1024 + c] : I.a_v0[c]; }
    bf16* Wf = (bf16*)(wreg + W_FOLD); bf16* Wu = (bf16*)(wreg + W_UP); bf16* Wo = (bf16*)(wreg + W_OUT);
    const int NUPB = (l == 0 ? 2048 : 3072) / 32;
    const int I_F = 136 * 32, I_U = NUPB * 4, I_O = 32 * 16;
    for (int it = gw; it < I_F + I_U + I_O; it += NGW) {
        int r = it;
        if (r < I_F) { const int nb = r >> 5, kb = r & 31; const int n0d = nb * 32, k0d = kb * 64, half = kb >> 4, k0s = (kb & 15) * 64;
            const float* mu = I.a_mu + (size_t)l * 6 * 1024;
            if (n0d < 4096) { const int p = n0d >> 10; conv_tile(I.a_w_in + (size_t)(l * 4 + p) * 1024 * 1024, 1024, k0s, n0d & 1023, 64, mu + p * 1024, half ? 1 : 2, Wf, 2048, n0d, k0d, scr, lane); }
            else { const int c0 = n0d - 4096;
                if (c0 < 64) conv_tile(I.a_w1 + (size_t)l * 1024 * 64, 64, k0s, c0, 64, mu + 4 * 1024, half ? 1 : 2, Wf, 2048, n0d, k0d, scr, lane);
                else if (c0 < 128) conv_tile(I.a_a1 + (size_t)l * 1024 * 64, 64, k0s, c0 - 64, 64, mu + 5 * 1024, half ? 1 : 2, Wf, 2048, n0d, k0d, scr, lane);
                else if (c0 < 160 && l == 1) conv_tile(I.a_v1, 32, k0s, 0, 64, mu + 2 * 1024, half ? 1 : 2, Wf, 2048, n0d, k0d, scr, lane);
                else conv_tile(I.a_w1, 64, 0, 0, 0, mu, 0, Wf, 2048, n0d, k0d, scr, lane); }
            continue; }
        r -= I_F;
        if (r < I_U) { const int nb = r >> 2, kb = r & 3; const int n0d = nb * 32, k0d = kb * 64, t = n0d >> 10;
            if (kb == t) { if (t == 0) conv_tile(I.a_w2 + (size_t)l * 64 * 1024, 1024, 0, n0d, 64, I.a_mu, 0, Wu, 256, n0d, k0d, scr, lane);
                else if (t == 1) conv_tile(I.a_a2 + (size_t)l * 64 * 1024, 1024, 0, n0d - 1024, 64, I.a_mu, 0, Wu, 256, n0d, k0d, scr, lane);
                else conv_tile(I.a_v2, 1024, 0, n0d - 2048, 32, I.a_mu, 0, Wu, 256, n0d, k0d, scr, lane); }
            else conv_tile(I.a_w2, 1024, 0, 0, 0, I.a_mu, 0, Wu, 256, n0d, k0d, scr, lane);
            continue; }
        r -= I_U;
        { const int nb = r >> 4, kb = r & 15; conv_tile(I.a_w_out + (size_t)l * 1024 * 1024, 1024, kb * 64, nb * 32, 64, I.a_mu, 0, Wo, 1024, nb * 32, kb * 64, scr, lane); }
    }
}
__device__ __forceinline__ void conv_attn(const In& I, int j, unsigned char* wreg, LAS float* scr, int gw, int NGW, int lane) {
    bf16* Wp = (bf16*)(wreg + W_PROJ); bf16* Wo = (bf16*)(wreg + W_BOUT);
    const int NPB = (j == 0 ? 4096 : 2048) / 32;
    const int I_P = NPB * 16, I_O = 32 * 16;
    for (int it = gw; it < I_P + I_O; it += NGW) {
        int r = it;
        if (r < I_P) { const int nb = r >> 4, kb = r & 15; const int n0d = nb * 32, k0 = kb * 64;
            if (j == 0) { if (n0d < 2048) conv_tile(I.w_kv, 2048, k0, n0d, 64, I.kv_norm, 1, Wp, 1024, n0d, k0, scr, lane);
                else conv_tile(I.b_w_in, 2048, k0, n0d - 2048, 64, I.b_norm, 1, Wp, 1024, n0d, k0, scr, lane); }
            else conv_tile(I.b_w_in + (size_t)1024 * 2048, 2048, k0, n0d, 64, I.b_norm + 1024, 1, Wp, 1024, n0d, k0, scr, lane);
            continue; }
        r -= I_P;
        { const int nb = r >> 4, kb = r & 15; conv_tile(I.b_w_out + (size_t)j * 1024 * 1024, 1024, kb * 64, nb * 32, 64, I.kv_norm, 0, Wo, 1024, nb * 32, kb * 64, scr, lane); }
    }
}

__device__ __forceinline__ void rope_tables(const int* pos, float* rc, float* rs, int gtid, int nthr) {
    for (int idx = gtid; idx < M * 8; idx += nthr) { const int m = idx >> 3, i = idx & 7;
        const float inv = (i == 0) ? 1.0f : (i == 1) ? 0.1939227432012558f : (i == 2) ? 0.03760603070259094f : (i == 3) ? 0.007292664609849453f : (i == 4) ? 0.0014142135623842478f : (i == 5) ? 0.00027424818836152554f : (i == 6) ? 5.3182957344688475e-05f : 1.0313385246263351e-05f;
        const float ang = (float)pos[m] * inv;
        const double x = (double)ang; const double k = __builtin_rint(x * 0.15915494309189535); const double r = x - k * 6.283185307179586476925;
        const double r2 = r * r; double sn = 0.0, cs = 0.0;
#pragma unroll
        for (int t = 12; t >= 1; --t) { sn = (1.0 - sn) * r2 / (double)((2 * t) * (2 * t + 1)); cs = (1.0 - cs) * r2 / (double)((2 * t - 1) * (2 * t)); }
        rs[idx] = (float)(r * (1.0 - sn)); rc[idx] = (float)(1.0 - cs); }
}

__device__ __forceinline__ void pre_rwkv(const float* x, const float* g, bf16* XN2, int gw, int NGW, int lane) {
    f32x4 gv[4];
#pragma unroll
    for (int j = 0; j < 4; ++j) gv[j] = *((const f32x4*)g + lane + 64 * j);
    for (int c = gw; c < M / 16; c += NGW) { const int m0 = c * 16;
        f32x4 prev[4];
#pragma unroll
        for (int j = 0; j < 4; ++j) prev[j] = (f32x4){0.f, 0.f, 0.f, 0.f};
        if ((m0 % SEQ) != 0) { const f32x4* xr = (const f32x4*)(x + (size_t)(m0 - 1) * D) + lane; f32x4 v[4]; float s = 0.f;
#pragma unroll
            for (int j = 0; j < 4; ++j) { v[j] = xr[64 * j]; s += (v[j].x * v[j].x + v[j].y * v[j].y) + (v[j].z * v[j].z + v[j].w * v[j].w); }
            const float rstd = 1.0f / sqrtf(wave_sum(s) * (1.0f / D) + 1e-6f);
#pragma unroll
            for (int j = 0; j < 4; ++j) prev[j] = v[j] * rstd * gv[j]; }
        for (int r = 0; r < 16; ++r) { const int m = m0 + r; const f32x4* xr = (const f32x4*)(x + (size_t)m * D) + lane; f32x4 v[4]; float s = 0.f;
#pragma unroll
            for (int j = 0; j < 4; ++j) { v[j] = xr[64 * j]; s += (v[j].x * v[j].x + v[j].y * v[j].y) + (v[j].z * v[j].z + v[j].w * v[j].w); }
            const float rstd = 1.0f / sqrtf(wave_sum(s) * (1.0f / D) + 1e-6f);
            unsigned long long* o8 = (unsigned long long*)(XN2 + (size_t)m * 2048) + lane;
#pragma unroll
            for (int j = 0; j < 4; ++j) { const f32x4 xn = v[j] * rstd * gv[j];
                o8[64 * j] = (unsigned long long)pk2(xn.x, xn.y) | ((unsigned long long)pk2(xn.z, xn.w) << 32);
                o8[256 + 64 * j] = (unsigned long long)pk2(prev[j].x, prev[j].y) | ((unsigned long long)pk2(prev[j].z, prev[j].w) << 32);
                prev[j] = xn; } }
    }
}
__device__ __forceinline__ void pre_attn(const float* x, bf16* XH, int gw, int NGW, int lane) {
    for (int m = gw; m < M; m += NGW) { const f32x4* xr = (const f32x4*)(x + (size_t)m * D) + lane; f32x4 v[4]; float s = 0.f;
#pragma unroll
        for (int j = 0; j < 4; ++j) { v[j] = xr[64 * j]; s += (v[j].x * v[j].x + v[j].y * v[j].y) + (v[j].z * v[j].z + v[j].w * v[j].w); }
        const float rstd = 1.0f / sqrtf(wave_sum(s) * (1.0f / D) + 1e-6f);
        unsigned long long* o8 = (unsigned long long*)(XH + (size_t)m * D) + lane;
#pragma unroll
        for (int j = 0; j < 4; ++j) o8[64 * j] = (unsigned long long)pk2(v[j].x * rstd, v[j].y * rstd) | ((unsigned long long)pk2(v[j].z * rstd, v[j].w * rstd) << 32); }
}
__device__ __forceinline__ void final_norm_rows(const float* x, const float* g, float* out, int gw, int NGW, int lane) {
    f32x4 gv[4];
#pragma unroll
    for (int j = 0; j < 4; ++j) gv[j] = *((const f32x4*)g + lane + 64 * j);
    for (int m = gw; m < M; m += NGW) { const f32x4* xr = (const f32x4*)(x + (size_t)m * D) + lane; f32x4 v[4]; float s = 0.f;
#pragma unroll
        for (int j = 0; j < 4; ++j) { v[j] = xr[64 * j]; s += (v[j].x * v[j].x + v[j].y * v[j].y) + (v[j].z * v[j].z + v[j].w * v[j].w); }
        const float rstd = 1.0f / sqrtf(wave_sum(s) * (1.0f / D) + 1e-6f);
        f32x4* o = (f32x4*)(out + (size_t)m * D) + lane;
#pragma unroll
        for (int j = 0; j < 4; ++j) o[64 * j] = v[j] * rstd * gv[j]; }
}

__device__ __forceinline__ void ld16bf(const bf16* p, float (&f)[16]) { const v4u a = *(const v4u*)p, b = *(const v4u*)(p + 8);
    f[0] = bflo(a.x); f[1] = bfhi(a.x); f[2] = bflo(a.y); f[3] = bfhi(a.y); f[4] = bflo(a.z); f[5] = bfhi(a.z); f[6] = bflo(a.w); f[7] = bfhi(a.w);
    f[8] = bflo(b.x); f[9] = bfhi(b.x); f[10] = bflo(b.y); f[11] = bfhi(b.y); f[12] = bflo(b.z); f[13] = bfhi(b.z); f[14] = bflo(b.w); f[15] = bfhi(b.w); }
__device__ __forceinline__ void st16bf(bf16* p, const float (&f)[16]) { v4u a, b;
    a.x = pk2(f[0], f[1]); a.y = pk2(f[2], f[3]); a.z = pk2(f[4], f[5]); a.w = pk2(f[6], f[7]); b.x = pk2(f[8], f[9]); b.y = pk2(f[10], f[11]); b.z = pk2(f[12], f[13]); b.w = pk2(f[14], f[15]);
    *(v4u*)p = a; *(v4u*)(p + 8) = b; }

__device__ __forceinline__ void post_rwkv(const bf16* Y, const float* S, const bf16* V, const bf16* G, const float* ln_w, const float* ln_b, bf16* O, int gw, int NGW, int lane) {
    float lw[16], lb[16];
#pragma unroll
    for (int i = 0; i < 16; ++i) { lw[i] = ln_w[lane * 16 + i]; lb[i] = ln_b[lane * 16 + i]; }
    for (int m = gw; m < M; m += NGW) { const size_t off = (size_t)m * D + lane * 16;
        float y[16], v[16], g[16], o[16]; ld16bf(Y + off, y); ld16bf(V + off, v); ld16bf(G + off, g);
        const float sb = S[(size_t)m * 16 + (lane >> 2)];
        float sum = 0.f;
#pragma unroll
        for (int i = 0; i < 16; ++i) sum += y[i];
        sum += __shfl_xor(sum, 1); sum += __shfl_xor(sum, 2);
        const float mean = sum * (1.0f / 64.0f); float q = 0.f;
#pragma unroll
        for (int i = 0; i < 16; ++i) { const float d = y[i] - mean; q += d * d; }
        q += __shfl_xor(q, 1); q += __shfl_xor(q, 2);
        const float rstd = 1.0f / sqrtf(q * (1.0f / 64.0f) + 64e-5f);
#pragma unroll
        for (int i = 0; i < 16; ++i) { const float yn = (y[i] - mean) * rstd * lw[i] + lb[i]; o[i] = (yn + sb * v[i]) * (g[i] / (1.0f + __expf(-g[i]))); }
        st16bf(O + off, o); }
}
__device__ __forceinline__ void post_attn(const bf16* O0, const bf16* O1, const bf16* GT, const float* subln, float lam, float lam_init, bf16* O, int gw, int NGW, int lane) {
    float sw[16];
#pragma unroll
    for (int i = 0; i < 16; ++i) sw[i] = subln[(lane & 7) * 16 + i] * (1.0f - lam_init);
    for (int m = gw; m < M; m += NGW) { const size_t off = (size_t)m * D + lane * 16;
        float a[16], b[16], g[16], o[16]; ld16bf(O0 + off, a); ld16bf(O1 + off, b); ld16bf(GT + off, g);
        float q = 0.f;
#pragma unroll
        for (int i = 0; i < 16; ++i) { o[i] = a[i] - lam * b[i]; q += o[i] * o[i]; }
        q += __shfl_xor(q, 1); q += __shfl_xor(q, 2); q += __shfl_xor(q, 4);
        const float rstd = 1.0f / sqrtf(q * (1.0f / 128.0f) + 1e-5f);
#pragma unroll
        for (int i = 0; i < 16; ++i) o[i] = o[i] * rstd * sw[i] * (g[i] / (1.0f + __expf(-g[i])));
        st16bf(O + off, o); }
}

constexpr int SC_T = 32, SC_NB = SEQ / SC_T, SC_OPS = SC_T * 320, SC_VB = SC_T * 8, SC_YP = SC_T * 128;
struct ScRaw { u32x2 r, k, w, a; };
__device__ __forceinline__ void scan_phase(LAS unsigned char* lds, const bf16* R, const bf16* K, const bf16* V, const _Float16* W, const _Float16* A, const float* k_k, const float* k_a, const float* r_k,
                                           bf16* Y, float* S, int vcu, int G, int tid, int wave, int lane) {
    LAS float* OPS = (LAS float*)lds;
    LAS float* VB = (LAS float*)(lds + 2 * SC_OPS * 4);
    LAS float* YP = (LAS float*)(lds + 2 * SC_OPS * 4 + 2 * SC_VB * 4);
    for (int u = vcu; u < 256; u += G) {
        const int bh = u >> 3, rg = u & 7, b = bh >> 4, h = bh & 15;
        const size_t rowbase = (size_t)b * SEQ; const int cb = h * 64;
        const int pw = (wave == 2) ? 0 : (wave == 3) ? 1 : (wave == 6) ? 2 : 3;
        const int p = pw * 64 + lane, ptt = p >> 4, c4 = (p & 15) * 4;
        f32x4 kkw = {0.f, 0.f, 0.f, 0.f}, kaw = kkw, rkw = kkw;
        ScRaw rawA0, rawA1, rawB0, rawB1; rawA0.r = (u32x2){0u, 0u}; rawA0.k = rawA0.r; rawA0.w = rawA0.r; rawA0.a = rawA0.r; rawA1 = rawA0; rawB0 = rawA0; rawB1 = rawA0;
        v4u rawvA = {0u, 0u, 0u, 0u}, rawvB = rawvA;
        const bool prod = (wave == 2 || wave == 3 || wave == 6 || wave == 7), vld = (wave == 2 && lane < 32), ywr = (wave == 7), cons = (wave < 2);
        if (prod) { kkw = *(const f32x4*)(k_k + cb + c4); kaw = *(const f32x4*)(k_a + cb + c4); rkw = *(const f32x4*)(r_k + cb + c4); }
        const int jq = lane & 15, rl = wave * 4 + (lane >> 4);
        f32x2 S01 = {0.f, 0.f}, S23 = {0.f, 0.f};
#define SC_LOAD1(raw, nblk, tt_) do { const size_t o_ = (rowbase + (size_t)(nblk) * SC_T + (tt_)) * D + cb + c4; raw.r = *(const u32x2*)(R + o_); raw.k = *(const u32x2*)(K + o_); raw.w = *(const u32x2*)(W + o_); raw.a = *(const u32x2*)(A + o_); } while (0)
#define SC_LOAD(raw0, raw1, rawv, nblk) do { if (prod) { SC_LOAD1(raw0, nblk, ptt); SC_LOAD1(raw1, nblk, ptt + 16); } \
        if (vld) { rawv = *(const v4u*)(V + (rowbase + (size_t)(nblk) * SC_T + lane) * D + cb + rg * 8); } } while (0)
#define SC_DERIVE1(raw, nblk, buf, tt_) do { \
            const float r0 = bflo(raw.r.x), r1 = bfhi(raw.r.x), r2 = bflo(raw.r.y), r3 = bfhi(raw.r.y); \
            const float k0 = bflo(raw.k.x), k1 = bfhi(raw.k.x), k2 = bflo(raw.k.y), k3 = bfhi(raw.k.y); \
            const h16x4 wh = __builtin_bit_cast(h16x4, raw.w), ah = __builtin_bit_cast(h16x4, raw.a); \
            const float a0 = (float)ah[0], a1 = (float)ah[1], a2 = (float)ah[2], a3 = (float)ah[3]; \
            const float x0 = k0 * kkw.x, x1 = k1 * kkw.y, x2 = k2 * kkw.z, x3 = k3 * kkw.w; \
            const float ss = allreduce16((x0 * x0 + x1 * x1) + (x2 * x2 + x3 * x3)); \
            const float inv = 1.0f / fmaxf(sqrtf(ss), 1e-12f); \
            const f32x4 kn = {x0 * inv, x1 * inv, x2 * inv, x3 * inv}; \
            const f32x4 km = {k0 * (1.0f + (a0 - 1.0f) * kaw.x), k1 * (1.0f + (a1 - 1.0f) * kaw.y), k2 * (1.0f + (a2 - 1.0f) * kaw.z), k3 * (1.0f + (a3 - 1.0f) * kaw.w)}; \
            const float sp = allreduce16((r0 * km.x * rkw.x + r1 * km.y * rkw.y) + (r2 * km.z * rkw.z + r3 * km.w * rkw.w)); \
            LAS float* op_ = OPS + (buf) * SC_OPS + (tt_) * 320 + c4; \
            *(LAS f32x4*)(op_) = -kn; \
            *(LAS f32x4*)(op_ + 64) = (f32x4){kn.x * a0, kn.y * a1, kn.z * a2, kn.w * a3}; \
            *(LAS f32x4*)(op_ + 128) = (f32x4){__expf(-__expf((float)wh[0])), __expf(-__expf((float)wh[1])), __expf(-__expf((float)wh[2])), __expf(-__expf((float)wh[3]))}; \
            *(LAS f32x4*)(op_ + 192) = km; \
            *(LAS f32x4*)(op_ + 256) = (f32x4){r0, r1, r2, r3}; \
            if (rg == 0 && c4 == 0) S[(rowbase + (size_t)(nblk) * SC_T + (tt_)) * 16 + h] = sp; } while (0)
#define SC_DERIVE(raw0, raw1, rawv, nblk, buf) do { if (prod) { SC_DERIVE1(raw0, nblk, buf, ptt); SC_DERIVE1(raw1, nblk, buf, ptt + 16); } \
        if (vld) { LAS float* vb_ = VB + (buf) * SC_VB + lane * 8; \
            *(LAS f32x4*)(vb_) = (f32x4){bflo(rawv.x), bfhi(rawv.x), bflo(rawv.y), bfhi(rawv.y)}; *(LAS f32x4*)(vb_ + 4) = (f32x4){bflo(rawv.z), bfhi(rawv.z), bflo(rawv.w), bfhi(rawv.w)}; } } while (0)
#define SC_YOUT1(nblk, buf, tt_) do { const int rp_ = lane & 3; const LAS f32x4* yp_ = (const LAS f32x4*)(YP + (buf) * SC_YP + ((tt_) * 8 + 2 * rp_) * 16); \
            const f32x4 q0 = yp_[0], q1 = yp_[1], q2 = yp_[2], q3 = yp_[3], q4 = yp_[4], q5 = yp_[5], q6 = yp_[6], q7 = yp_[7]; \
            const f32x4 e0 = (q0 + q1) + (q2 + q3), e1 = (q4 + q5) + (q6 + q7); \
            const float y0_ = (e0.x + e0.y) + (e0.z + e0.w), y1_ = (e1.x + e1.y) + (e1.z + e1.w); \
            *(unsigned*)(Y + (rowbase + (size_t)(nblk) * SC_T + (tt_)) * D + cb + rg * 8 + 2 * rp_) = pk2(y0_, y1_); } while (0)
#define SC_YOUT(nblk, buf) do { SC_YOUT1(nblk, buf, lane >> 2); SC_YOUT1(nblk, buf, (lane >> 2) + 16); } while (0)
#define SC_LDOPS(N, B, W_, K_, R_, VV, t) do { const LAS float* o_ = ops + (t) * 320; N = *(const LAS f32x4*)(o_); B = *(const LAS f32x4*)(o_ + 64); W_ = *(const LAS f32x4*)(o_ + 128); K_ = *(const LAS f32x4*)(o_ + 192); R_ = *(const LAS f32x4*)(o_ + 256); VV = vb[(t) * 8]; } while (0)
#define SC_CONSUME(buf) do { const LAS float* ops = OPS + (buf) * SC_OPS + 4 * jq; const LAS float* vb = VB + (buf) * SC_VB + rl; LAS float* yp = YP + (buf) * SC_YP + rl * 16 + jq; \
            f32x4 nk, bb, dw, km, rr, nk2, bb2, dw2, km2, rr2; float vi, vi2; SC_LDOPS(nk, bb, dw, km, rr, vi, 0); SC_LDOPS(nk2, bb2, dw2, km2, rr2, vi2, 1); \
            _Pragma("unroll") for (int tt = 0; tt < SC_T; ++tt) { \
                f32x4 nk3 = nk2, bb3 = bb2, dw3 = dw2, km3 = km2, rr3 = rr2; float vi3 = vi2; \
                if (tt + 2 < SC_T) SC_LDOPS(nk3, bb3, dw3, km3, rr3, vi3, tt + 2); \
                asm volatile("" ::: "memory"); \
                const f32x2 t_ = S01 * nk.lo + S23 * nk.hi; \
                const f32x2 P01 = S01 * dw.lo + km.lo * vi, P23 = S23 * dw.hi + km.hi * vi; \
                const float sa = allreduce16(t_.x + t_.y); \
                S01 = P01 + bb.lo * sa; S23 = P23 + bb.hi * sa; \
                const f32x2 y_ = S01 * rr.lo + S23 * rr.hi; \
                yp[tt * 128] = y_.x + y_.y; \
                nk = nk2; bb = bb2; dw = dw2; km = km2; rr = rr2; vi = vi2; nk2 = nk3; bb2 = bb3; dw2 = dw3; km2 = km3; rr2 = rr3; vi2 = vi3; } } while (0)
        SC_LOAD(rawA0, rawA1, rawvA, 0); SC_DERIVE(rawA0, rawA1, rawvA, 0, 0); SC_LOAD(rawB0, rawB1, rawvB, 1); SC_LOAD(rawA0, rawA1, rawvA, 2);
        __syncthreads();
        for (int n = 0; n < SC_NB; n += 2) {
            if (cons) { SC_CONSUME(0); }
            else { SC_DERIVE(rawB0, rawB1, rawvB, n + 1, 1); if (n + 3 < SC_NB) SC_LOAD(rawB0, rawB1, rawvB, n + 3);
                if (ywr && n >= 1) SC_YOUT(n - 1, 1); }
            __syncthreads();
            if (cons) { SC_CONSUME(1); }
            else { if (n + 2 < SC_NB) { SC_DERIVE(rawA0, rawA1, rawvA, n + 2, 0); if (n + 4 < SC_NB) SC_LOAD(rawA0, rawA1, rawvA, n + 4); }
                if (ywr) SC_YOUT(n, 0); }
            __syncthreads();
        }
        if (ywr) SC_YOUT(SC_NB - 1, 1);
        __syncthreads();
#undef SC_LOAD1
#undef SC_LOAD
#undef SC_DERIVE1
#undef SC_DERIVE
#undef SC_YOUT1
#undef SC_YOUT
#undef SC_CONSUME
#undef SC_LDOPS
    }
}

struct Args { const void* in[31]; float* out; unsigned char* ws; };
__global__ void __launch_bounds__(NWAVES * 64, 2) mk_fwd(Args args) {
    extern __shared__ __attribute__((aligned(16))) unsigned char lds[];
    cg::grid_group grid = cg::this_grid();
    LAS unsigned char* L = (LAS unsigned char*)lds;
    const int G = gridDim.x; const int bx = blockIdx.x; const int vcu = (G % 8 == 0) ? (bx % 8) * (G / 8) + bx / 8 : bx;
    const int NGW = G * NWAVES;
#define PH_IDS() int tid_ = threadIdx.x; asm volatile("" : "+v"(tid_)); const int tid = tid_, lane = tid & 63, wave = __builtin_amdgcn_readfirstlane(tid >> 6); const int gw = vcu * NWAVES + wave; LAS float* scr = (LAS float*)(L + wave * 16384); (void)scr; (void)gw; (void)lane
    typedef const void* cvp_t; typedef const __attribute__((address_space(4))) cvp_t* kargp_t;
#define KP_(k) (((kargp_t)kp_)[k])
#define PH_PTRS() const __attribute__((address_space(4))) char* kp_ = (const __attribute__((address_space(4))) char*)__builtin_amdgcn_kernarg_segment_ptr(); asm volatile("" : "+s"(kp_)); \
    In I; I.x = (const float*)KP_(0); I.pos = (const int*)KP_(1); I.a_norm = (const float*)KP_(2); I.a_mu = (const float*)KP_(3); I.a_w_in = (const float*)KP_(4); I.a_w0 = (const float*)KP_(5); I.a_w1 = (const float*)KP_(6); I.a_w2 = (const float*)KP_(7); I.a_a0 = (const float*)KP_(8); I.a_a1 = (const float*)KP_(9); I.a_a2 = (const float*)KP_(10); I.a_v0 = (const float*)KP_(11); I.a_v1 = (const float*)KP_(12); I.a_v2 = (const float*)KP_(13); I.a_k_k = (const float*)KP_(14); I.a_k_a = (const float*)KP_(15); I.a_r_k = (const float*)KP_(16); I.a_ln_w = (const float*)KP_(17); I.a_ln_b = (const float*)KP_(18); I.a_w_out = (const float*)KP_(19); I.kv_norm = (const float*)KP_(20); I.w_kv = (const float*)KP_(21); I.b_norm = (const float*)KP_(22); I.b_w_in = (const float*)KP_(23); I.b_lq1 = (const float*)KP_(24); I.b_lk1 = (const float*)KP_(25); I.b_lq2 = (const float*)KP_(26); I.b_lk2 = (const float*)KP_(27); I.b_subln = (const float*)KP_(28); I.b_w_out = (const float*)KP_(29); I.final_norm = (const float*)KP_(30); \
    float* XS = (float*)KP_(31); unsigned char* ws = (unsigned char*)KP_(32); \
    float* rc = (float*)(ws + WS_ROPE_C); float* rs = (float*)(ws + WS_ROPE_S); float* SB = (float*)(ws + WS_S); unsigned char* wreg = ws + WS_W; \
    bf16* U0 = (bf16*)(ws + WS_U); bf16* U1 = (bf16*)(ws + WS_U + UNIT); bf16* U2 = (bf16*)(ws + WS_U + 2 * UNIT); bf16* U3 = (bf16*)(ws + WS_U + 3 * UNIT); \
    bf16* U4 = (bf16*)(ws + WS_U + 4 * UNIT); bf16* U5 = (bf16*)(ws + WS_U + 5 * UNIT); bf16* U6 = (bf16*)(ws + WS_U + 6 * UNIT); bf16* HB = (bf16*)(ws + WS_H); \
    (void)I; (void)XS; (void)rc; (void)rs; (void)SB; (void)wreg; (void)U0; (void)U1; (void)U2; (void)U3; (void)U4; (void)U5; (void)U6; (void)HB

    { PH_IDS(); PH_PTRS(); rope_tables(I.pos, rc, rs, vcu * 512 + tid, G * 512);
    conv_rwkv(I, 0, wreg, (float*)(ws + WS_BIAS), scr, gw, NGW, lane);
    pre_rwkv(I.x, I.a_norm, U0, gw, NGW, lane); }
    grid.sync();

#pragma nounroll
    for (int l = 0; l < 2; ++l) {
#pragma nounroll
        for (int rp = 0; rp < REP_G1; ++rp) {
            if (rp) grid.sync();
            PH_PTRS(); bf16* Vl = (l == 0) ? U4 : U6;
            pg8::Gemm g{U0, (const bf16*)(wreg + W_FOLD), M, 4352, 2048}; pg8::StaticOrder S; S.init(M, 4352, G, bx);
            pg8::EpiFold E{U2, U3, Vl, U5, HB};
            pg8::gemm_phase<pg8::EpiFold, pg8::StaticOrder, true, true>(L, g, S, E);
        }
        grid.sync();
        {
            PH_PTRS(); bf16* Vl = (l == 0) ? U4 : U6;
            const int NUP = (l == 0) ? 2048 : 3072;
            pg8::Gemm g{HB, (const bf16*)(wreg + W_UP), M, NUP, 256}; pg8::StaticOrder S; S.init(M, NUP, G, bx);
            pg8::EpiLoraUp E{(const float*)(ws + WS_BIAS), (_Float16*)U0, (_Float16*)U1, Vl, U4};
            pg8::gemm_phase<pg8::EpiLoraUp, pg8::StaticOrder, true, false>(L, g, S, E);
        }
        grid.sync();
#pragma nounroll
        for (int rp = 0; rp < REP_SCAN; ++rp) { if (rp) grid.sync(); PH_IDS(); PH_PTRS(); bf16* Vl = (l == 0) ? U4 : U6; bf16* Yl = (l == 0) ? U6 : U4; scan_phase(L, U2, U3, Vl, (const _Float16*)U0, (const _Float16*)U1, I.a_k_k + l * 1024, I.a_k_a + l * 1024, I.a_r_k + l * 1024, Yl, SB, vcu, G, tid, wave, lane); }
        grid.sync();
        { PH_IDS(); PH_PTRS(); bf16* Vl = (l == 0) ? U4 : U6; bf16* Yl = (l == 0) ? U6 : U4; post_rwkv(Yl, SB, Vl, U5, I.a_ln_w + l * 1024, I.a_ln_b + l * 1024, U2, gw, NGW, lane); }
        grid.sync();
        {
            PH_PTRS(); const float* xin = (l == 0) ? I.x : XS;
            pg8::Gemm g{U2, (const bf16*)(wreg + W_OUT), M, 1024, 1024}; pg8::StaticOrder S; S.init(M, 1024, G, bx);
            pg8::EpiResid E{xin, XS};
            pg8::gemm_phase<pg8::EpiResid, pg8::StaticOrder, true, true>(L, g, S, E);
        }
        grid.sync();
        { PH_IDS(); PH_PTRS(); if (l == 0) { conv_rwkv(I, 1, wreg, (float*)(ws + WS_BIAS), scr, gw, NGW, lane); pre_rwkv(XS, I.a_norm + 1024, U0, gw, NGW, lane); }
        else { conv_attn(I, 0, wreg, scr, gw, NGW, lane); pre_attn(XS, U0, gw, NGW, lane); } }
        grid.sync();
    }

#pragma nounroll
    for (int j = 0; j < 2; ++j) {
        {
            PH_PTRS();
            const int NP = (j == 0) ? 4096 : 2048;
            pg8::Gemm g{U0, (const bf16*)(wreg + W_PROJ), M, NP, 1024}; pg8::StaticOrder S; S.init(M, NP, G, bx);
            pg8::EpiProj E;
            if (j == 0) { E.d0 = U1; E.d1 = U2; E.d2 = U3; E.d3 = U4; E.ropemask = 0x5; E.scalemask = QSCALE_MASK0; }
            else { E.d0 = U3; E.d1 = U4; E.d2 = U3; E.d3 = U4; E.ropemask = 0x1; E.scalemask = QSCALE_MASK1; }
            E.sc = C2F; E.rc = rc; E.rs = rs;
            pg8::gemm_phase<pg8::EpiProj, pg8::StaticOrder, true, true>(L, g, S, E);
        }
        grid.sync();
#pragma nounroll
        for (int rp = 0; rp < REP_ATTN; ++rp) {
            if (rp) grid.sync();
            PH_PTRS();
#ifdef ATTN_D64
            const attn_body::AttnTensors AT{(const attn_body::bf16*)U3, (const attn_body::bf16*)U1, (const attn_body::bf16*)U2, (attn_body::bf16*)U5, (attn_body::bf16*)U6};
            attn_body::attn_phase<8>((char*)lds, AT, vcu, G);
#else
            const attn128::AttnTensors AT{U3, U1, U2, U5, U6};
            attn128::attn_phase((char*)lds, AT, vcu, G);
#endif
        }
        grid.sync();
        {
            PH_IDS(); PH_PTRS();
            const float e1 = __expf(wave_sum(I.b_lq1[j * 64 + lane] * I.b_lk1[j * 64 + lane])), e2 = __expf(wave_sum(I.b_lq2[j * 64 + lane] * I.b_lk2[j * 64 + lane]));
            const float lam_init = (j == 0) ? 0.4707130183435842f : 0.5560582041556406f;
            post_attn(U5, U6, U4, I.b_subln + j * 128, e1 - e2 + lam_init, lam_init, U0, gw, NGW, lane);
        }
        grid.sync();
        {
            PH_PTRS();
            pg8::Gemm g{U0, (const bf16*)(wreg + W_BOUT), M, 1024, 1024}; pg8::StaticOrder S; S.init(M, 1024, G, bx);
            pg8::EpiResid E{XS, XS};
            pg8::gemm_phase<pg8::EpiResid, pg8::StaticOrder, true, true>(L, g, S, E);
        }
        grid.sync();
        if (j == 0) { { PH_IDS(); PH_PTRS(); conv_attn(I, 1, wreg, scr, gw, NGW, lane); pre_attn(XS, U0, gw, NGW, lane); } grid.sync(); }
    }
    { PH_IDS(); PH_PTRS(); final_norm_rows(XS, I.final_norm, XS, gw, NGW, lane); }
}

extern "C" void kernel_launch(void* const* d_in, const int* in_sizes, int n_in, void* d_out, int out_size, void* d_ws, size_t ws_size, hipStream_t stream) {
    static int grid = 0;
    if (grid == 0) {
        if (n_in != 31 || in_sizes[0] != M * D || out_size != M * D || ws_size < WS_END) { fprintf(stderr, "kernel_launch: unexpected shapes (n_in %d, in0 %d, out %d, ws %zu < %zu)\n", n_in, n_in > 0 ? in_sizes[0] : -1, out_size, ws_size, (size_t)WS_END); grid = -1; return; }
        int dev = 0, cus = 0, per_cu = 0;
        hipGetDevice(&dev); hipDeviceGetAttribute(&cus, hipDeviceAttributeMultiprocessorCount, dev);
        if (hipFuncSetAttribute((const void*)mk_fwd, hipFuncAttributeMaxDynamicSharedMemorySize, LDS_BYTES) != hipSuccess) { fprintf(stderr, "kernel_launch: hipFuncSetAttribute failed\n"); grid = -1; return; }
        if (hipOccupancyMaxActiveBlocksPerMultiprocessor(&per_cu, (const void*)mk_fwd, NWAVES * 64, LDS_BYTES) != hipSuccess || per_cu < 1) { fprintf(stderr, "kernel_launch: occupancy query says %d\n", per_cu); per_cu = 1; }
        (void)hipGetLastError();
        grid = cus;
    }
    if (grid < 0) return;
    Args a{};
    for (int i = 0; i < 31; ++i) a.in[i] = d_in[i];
    a.out = (float*)d_out; a.ws = (unsigned char*)d_ws;
    void* kargs[] = {&a};
    hipError_t e = hipLaunchCooperativeKernel((const void*)mk_fwd, dim3(grid), dim3(NWAVES * 64), kargs, LDS_BYTES, stream);
    if (e != hipSuccess) fprintf(stderr, "kernel_launch: cooperative launch failed: %s (grid %d)\n", hipGetErrorString(e), grid);
}
```

```cpp
#include <hip/hip_runtime.h>
#include <hip/hip_cooperative_groups.h>
#include <cstdio>
#include <cstdint>
namespace cg = cooperative_groups;
namespace pg8 {
#define PG8_LAS __attribute__((address_space(3)))
typedef unsigned short bf16_t;
typedef short bf16x8 __attribute__((ext_vector_type(8)));
typedef float f32x4 __attribute__((ext_vector_type(4)));
typedef unsigned u32x4 __attribute__((ext_vector_type(4)));
constexpr int BM = 256, BK = 64, HALF = 128, HTB = HALF * BK * 2  , STAGE_BYTES = 8 * HTB, NXCD = 8, WGM = 8;

__host__ __device__ __forceinline__ int lds_byte(int r, int c) { const int st = (r >> 4) * 2 + (c >> 5), rr = r & 15, cc = c & 31, ob = rr * 64 + cc * 2; return st * 1024 + (ob ^ (((ob >> 9) & 1) << 5)); }
__host__ __device__ __forceinline__ void stage_rc(int b, int& R, int& C) { const int st = b / 1024, sb = b % 1024, swz = sb ^ (((sb >> 9) & 1) << 5); R = (st >> 1) * 16 + swz / 64; C = (st & 1) * 32 + (swz % 64) / 2; }
__host__ __device__ __forceinline__ int perm32(int rho) { const int n = rho >> 4, i = rho & 15; return 8 * (i >> 2) + 4 * n + (i & 3); }

struct Unit { int pm, pn; };
struct Gemm { const bf16_t* A; const bf16_t* Bt; int M, N, K; };

struct StaticOrder {
    int nM, nN, nwg, G, c;
    __host__ __device__ void init(int M, int N, int G_, int c_) { nM = M / BM; nN = N / BM; nwg = nM * nN; G = G_; c = c_; }
    __host__ __device__ bool next(int i, Unit& u) const {
        const long L = (long)i * G + c; if (L >= nwg) return false;
        int wgid = (int)L; { const int q = nwg / NXCD, r = nwg % NXCD, xcd = wgid % NXCD, off = wgid / NXCD; wgid = (xcd < r ? xcd * (q + 1) : r * (q + 1) + (xcd - r) * q) + off; }
        const int nig = WGM * nN, gid = wgid / nig, fm = gid * WGM, gsz = (nM - fm) < WGM ? (nM - fm) : WGM;
        u.pm = fm + ((wgid % nig) % gsz); u.pn = (wgid % nig) / gsz; return true;
    }
    __device__ __forceinline__ void a_ready(const Unit&) const {}
    __device__ __forceinline__ void done(const Unit&) const {}
};

__device__ __forceinline__ unsigned cvt_pk_bf16(float lo, float hi) { unsigned r; asm volatile("v_cvt_pk_bf16_f32 %0, %1, %2" : "=v"(r) : "v"(lo), "v"(hi)); return r; }
typedef float f32x2 __attribute__((ext_vector_type(2)));
typedef _Float16 h16x4 __attribute__((ext_vector_type(4)));
typedef unsigned u32x2 __attribute__((ext_vector_type(2)));
__device__ __forceinline__ float sigmoidf_(float z) { return 1.0f / (1.0f + __expf(-z)); }
__device__ __forceinline__ float tanhf_(float x) { const float t = __expf(-2.0f * fabsf(x)); const float r = (1.0f - t) / (1.0f + t); return x < 0.f ? -r : r; }
__device__ __forceinline__ float bf_lo(unsigned w) { return __uint_as_float(w << 16); }
__device__ __forceinline__ float bf_hi(unsigned w) { return __uint_as_float(w & 0xffff0000u); }

struct EpiFold {
    static constexpr bool PERM = true, AFTER_DRAIN = false;
    bf16_t *R, *Kb, *V, *G, *H;
    __device__ __forceinline__ void operator()(const f32x4 (&acc)[2][2][4][2], const Unit& u, int wr, int wc, int fr, int fq) const {
        const int row0 = u.pm * BM + wr * 64 + fr;
        const int t = u.pn >> 2;
        bf16_t* base; int ldc, colt;
        if (u.pn < 16) { base = (t == 0) ? R : (t == 1) ? Kb : (t == 2) ? V : G; ldc = 1024; colt = (u.pn & 3) * 256; }
        else { base = H; ldc = 256; colt = 0; }
        const int col0 = colt + wc * 32 + 8 * fq;
        const bool th = (u.pn == 16) && (wc < 2);
#pragma unroll
        for (int ai = 0; ai < 2; ++ai)
#pragma unroll
            for (int m = 0; m < 4; ++m) { bf16_t* rowp = base + (size_t)(row0 + ai * HALF + m * 16) * ldc + col0;
#pragma unroll
                for (int bj = 0; bj < 2; ++bj) { f32x4 v0 = acc[ai][bj][m][0], v1 = acc[ai][bj][m][1];
                    if (th && bj == 0) {
#pragma unroll
                        for (int i = 0; i < 4; ++i) { v0[i] = tanhf_(v0[i]); v1[i] = tanhf_(v1[i]); } }
                    u32x4 w; w.x = cvt_pk_bf16(v0[0], v0[1]); w.y = cvt_pk_bf16(v0[2], v0[3]); w.z = cvt_pk_bf16(v1[0], v1[1]); w.w = cvt_pk_bf16(v1[2], v1[3]);
                    *(u32x4*)(rowp + bj * HALF) = w; }
                asm volatile("" ::: "memory"); }
    }
};

struct EpiLoraUp {
    static constexpr bool PERM = false, AFTER_DRAIN = false;
    const float* bias3; _Float16 *Wb, *Ab; bf16_t* Vb; const bf16_t* Vf;
    __device__ __forceinline__ void operator()(const f32x4 (&acc)[2][2][4][2], const Unit& u, int wr, int wc, int fr_unused, int fq_unused) const {
        int t_ = threadIdx.x; asm volatile("" : "+v"(t_)); const int fr = t_ & 15, fq = (t_ >> 4) & 3;
        const int row0 = u.pm * BM + wr * 64 + fr;
        const int t = u.pn >> 2;
        const int cc0 = (u.pn & 3) * 256 + wc * 32 + 4 * fq;
        const float* bias = bias3 + t * 1024;
#pragma unroll
        for (int bj = 0; bj < 2; ++bj)
#pragma unroll
            for (int n = 0; n < 2; ++n) { const int c = cc0 + bj * HALF + n * 16; const f32x4 bv = *(const f32x4*)(bias + c);
#pragma unroll
                for (int ai = 0; ai < 2; ++ai)
#pragma unroll
                    for (int m = 0; m < 4; ++m) { const size_t off = (size_t)(row0 + ai * HALF + m * 16) * 1024 + c; const f32x4 z = acc[ai][bj][m][n] + bv;
                        if (t == 0) { h16x4 o;
#pragma unroll
                            for (int i = 0; i < 4; ++i) { const float zz = -z[i]; const float sp = fmaxf(zz, 0.f) + __logf(1.0f + __expf(-fabsf(zz))); o[i] = (_Float16)(-sp - 0.5f); }
                            *(h16x4*)(Wb + off) = o; }
                        else if (t == 1) { h16x4 o;
#pragma unroll
                            for (int i = 0; i < 4; ++i) o[i] = (_Float16)sigmoidf_(z[i]);
                            *(h16x4*)(Ab + off) = o; }
                        else { const u32x2 vv = *(const u32x2*)(Vb + off), vf = *(const u32x2*)(Vf + off);
                            const float v_0 = bf_lo(vv.x), v_1 = bf_hi(vv.x), v_2 = bf_lo(vv.y), v_3 = bf_hi(vv.y);
                            const float f_0 = bf_lo(vf.x), f_1 = bf_hi(vf.x), f_2 = bf_lo(vf.y), f_3 = bf_hi(vf.y);
                            u32x2 o; o.x = cvt_pk_bf16(v_0 + (f_0 - v_0) * sigmoidf_(z[0]), v_1 + (f_1 - v_1) * sigmoidf_(z[1]));
                            o.y = cvt_pk_bf16(v_2 + (f_2 - v_2) * sigmoidf_(z[2]), v_3 + (f_3 - v_3) * sigmoidf_(z[3]));
                            *(u32x2*)(Vb + off) = o; }
                        asm volatile("" ::: "memory"); } }
    }
};

struct EpiProj {
    static constexpr bool PERM = true, AFTER_DRAIN = false;
    bf16_t *d0, *d1, *d2, *d3; int ropemask, scalemask; float sc; const float* rc; const float* rs;
    __device__ __forceinline__ void operator()(const f32x4 (&acc)[2][2][4][2], const Unit& u, int wr, int wc, int fr, int fq) const {
        const int row0 = u.pm * BM + wr * 64 + fr;
        const int t = u.pn >> 2;
        bf16_t* base = (t == 0) ? d0 : (t == 1) ? d1 : (t == 2) ? d2 : d3;
        const int col0 = (u.pn & 3) * 256 + wc * 32 + 8 * fq;
        const bool rope = (((ropemask >> t) & 1) != 0) && ((wc & 1) == 0);
        const float s = ((scalemask >> t) & 1) ? sc : 1.0f;
        const float sgn = (fq == 0) ? -1.0f : 1.0f;
#pragma unroll
        for (int ai = 0; ai < 2; ++ai)
#pragma unroll
            for (int m = 0; m < 4; ++m) { const int row = row0 + ai * HALF + m * 16; bf16_t* rowp = base + (size_t)row * 1024 + col0;
                f32x4 c0 = {1.f, 1.f, 1.f, 1.f}, c1 = c0, s0 = {0.f, 0.f, 0.f, 0.f}, s1 = s0;
                if (rope) { c0 = *(const f32x4*)(rc + (size_t)row * 8); c1 = *(const f32x4*)(rc + (size_t)row * 8 + 4); s0 = *(const f32x4*)(rs + (size_t)row * 8); s1 = *(const f32x4*)(rs + (size_t)row * 8 + 4); }
#pragma unroll
                for (int bj = 0; bj < 2; ++bj) { f32x4 v0 = acc[ai][bj][m][0], v1 = acc[ai][bj][m][1];
                    if (rope) { f32x4 p0, p1;
#pragma unroll
                        for (int i = 0; i < 4; ++i) { p0[i] = __shfl_xor(v0[i], 16); p1[i] = __shfl_xor(v1[i], 16); }
                        if (fq < 2) { v0 = v0 * c0 + (p0 * s0) * sgn; v1 = v1 * c1 + (p1 * s1) * sgn; } }
                    v0 = v0 * s; v1 = v1 * s;
                    u32x4 w; w.x = cvt_pk_bf16(v0[0], v0[1]); w.y = cvt_pk_bf16(v0[2], v0[3]); w.z = cvt_pk_bf16(v1[0], v1[1]); w.w = cvt_pk_bf16(v1[2], v1[3]);
                    *(u32x4*)(rowp + bj * HALF) = w; }
                asm volatile("" ::: "memory"); }
    }
};

struct EpiResid {
    static constexpr bool PERM = false, AFTER_DRAIN = false;
    const float* base; float* out;
    __device__ __forceinline__ void operator()(const f32x4 (&acc)[2][2][4][2], const Unit& u, int wr, int wc, int fr, int fq) const {
        const int row0 = u.pm * BM + wr * 64 + fr;
        const int col0 = u.pn * BM + wc * 32 + 4 * fq;
#pragma unroll
        for (int ai = 0; ai < 2; ++ai)
#pragma unroll
            for (int m = 0; m < 4; ++m) { const size_t off = (size_t)(row0 + ai * HALF + m * 16) * 1024 + col0;
#pragma unroll
                for (int bj = 0; bj < 2; ++bj)
#pragma unroll
                    for (int n = 0; n < 2; ++n) { const f32x4 b = *(const f32x4*)(base + off + bj * HALF + n * 16); *(f32x4*)(out + off + bj * HALF + n * 16) = b + acc[ai][bj][m][n]; }
                asm volatile("" ::: "memory"); }
    }
};
template <class Epi, class Sched, bool ALIGN_EPI = false, bool SP2 = false>
__device__ __forceinline__ void gemm_phase(PG8_LAS unsigned char* lds, const Gemm g, const Sched& S, const Epi& E) {
    int tid_ = threadIdx.x; asm volatile("" : "+v"(tid_));
    const int tid = tid_, wid = __builtin_amdgcn_readfirstlane(tid >> 6), lane = tid & 63, wr = wid >> 2, wc = wid & 3, fr = lane & 15, fq = lane >> 4;
    const int K = g.K, nt = K / BK;
    unsigned voffA[2], voffB[2];
#pragma unroll
    for (int i = 0; i < 2; ++i) { int R, C; stage_rc(tid * 16 + i * 8192, R, C); const int Rb = Epi::PERM ? ((R & ~31) + perm32(R & 31)) : R;
        voffA[i] = (unsigned)(R * K + C) * 2u; voffB[i] = (unsigned)(Rb * K + C) * 2u; }
    const size_t kstep = (size_t)(BK * 2);
    const size_t hstep = (size_t)HALF * K * 2;
    const size_t tstep = 2 * hstep;
    const unsigned ldsw = (unsigned)wid * 1024u;
    const int aoff = lds_byte(wr * 64 + fr, fq * 8), boff = lds_byte(wc * 32 + fr, fq * 8);
#define PG8_SA(b, h) (((b) * 2 + (h)) * HTB)
#define PG8_SB(b, h) ((4 + (b) * 2 + (h)) * HTB)
#define PG8_STAGE(bufoff, gbase, voff) do { _Pragma("unroll") for (int _i = 0; _i < 2; ++_i) \
        __builtin_amdgcn_global_load_lds((const unsigned*)((const char*)(gbase) + (voff)[_i]), (PG8_LAS unsigned*)(lds + (bufoff) + ldsw + _i * 8192), 16, 0, 0); } while (0)
#define PG8_LDA(dst, b, h) do { _Pragma("unroll") for (int m = 0; m < 4; ++m) _Pragma("unroll") for (int k = 0; k < 2; ++k) dst[m][k] = *(const PG8_LAS bf16x8*)(lds + PG8_SA(b, h) + aoff + m * 2048 + k * 1024); } while (0)
#define PG8_LDB(dst, b, h) do { _Pragma("unroll") for (int n = 0; n < 2; ++n) _Pragma("unroll") for (int k = 0; k < 2; ++k) dst[n][k] = *(const PG8_LAS bf16x8*)(lds + PG8_SB(b, h) + boff + n * 2048 + k * 1024); } while (0)
#define PG8_MMA(ai, bj, At, Bt) do { __builtin_amdgcn_s_setprio(1); _Pragma("unroll") for (int m = 0; m < 4; ++m) _Pragma("unroll") for (int n = 0; n < 2; ++n) _Pragma("unroll") for (int k = 0; k < 2; ++k) \
        acc[ai][bj][m][n] = __builtin_amdgcn_mfma_f32_16x16x32_bf16(Bt[n][k], At[m][k], acc[ai][bj][m][n], 0, 0, 0); __builtin_amdgcn_s_setprio(0); } while (0)
#define PG8_WAIT_V(n) asm volatile("s_waitcnt vmcnt(" #n ")" ::: "memory")
#define PG8_WAIT_L(n) asm volatile("s_waitcnt lgkmcnt(" #n ")" ::: "memory")
#define PG8_BAR __builtin_amdgcn_s_barrier()
#define PG8_SCHED __builtin_amdgcn_sched_barrier(0)
    Unit cur, nxt; int ui = 0;
    if (!S.next(0, cur)) return;
    f32x4 acc[2][2][4][2];
#pragma unroll
    for (int a = 0; a < 2; ++a)
#pragma unroll
        for (int b = 0; b < 2; ++b)
#pragma unroll
            for (int m = 0; m < 4; ++m)
#pragma unroll
                for (int n = 0; n < 2; ++n) acc[a][b][m][n] = (f32x4){0.f, 0.f, 0.f, 0.f};
    bf16x8 At[4][2], B0[2][2], B1[2][2];
    const char* cA = (const char*)g.A + (size_t)cur.pm * tstep; const char* cB = (const char*)g.Bt + (size_t)cur.pn * tstep;
    S.a_ready(cur);
    if constexpr (SP2) {
        PG8_STAGE(PG8_SB(0, 0), cB, voffB); PG8_STAGE(PG8_SB(0, 1), cB + hstep, voffB); PG8_STAGE(PG8_SA(0, 0), cA, voffA); PG8_STAGE(PG8_SA(0, 1), cA + hstep, voffA);
        if (wr == 1) PG8_BAR;
        PG8_WAIT_V(2); PG8_BAR;
        PG8_STAGE(PG8_SB(1, 0), cB + kstep, voffB); PG8_STAGE(PG8_SA(1, 0), cA + kstep, voffA); PG8_STAGE(PG8_SB(1, 1), cB + hstep + kstep, voffB);
        PG8_WAIT_V(6); PG8_BAR;
    } else {
        PG8_STAGE(PG8_SB(0, 0), cB, voffB); PG8_STAGE(PG8_SA(0, 0), cA, voffA); PG8_STAGE(PG8_SB(0, 1), cB + hstep, voffB); PG8_STAGE(PG8_SA(0, 1), cA + hstep, voffA);
        if (wr == 1) PG8_BAR;
        PG8_WAIT_V(4); PG8_BAR;
        PG8_STAGE(PG8_SB(1, 0), cB + kstep, voffB); PG8_STAGE(PG8_SA(1, 0), cA + kstep, voffA); PG8_STAGE(PG8_SB(1, 1), cB + hstep + kstep, voffB);
        PG8_WAIT_V(6); PG8_BAR;
    }
    for (;;) {
        const bool has_next = S.next(ui + 1, nxt);
        const char* nA = has_next ? (const char*)g.A + (size_t)nxt.pm * tstep : cA; const char* nB = has_next ? (const char*)g.Bt + (size_t)nxt.pn * tstep : cB;
        for (int t = 0; t < nt; t += 2) {
            const bool last = (t == nt - 2);
            const char* a1 = cA + (size_t)(t + 1) * kstep;
            const char* a2 = last ? nA : cA + (size_t)(t + 2) * kstep; const char* b2 = last ? nB : cB + (size_t)(t + 2) * kstep;
            const char* a3 = a2 + kstep; const char* b3 = b2 + kstep;
            if (last && has_next) S.a_ready(nxt);
            if constexpr (SP2) {
            PG8_LDB(B0, 0, 0); PG8_LDB(B1, 0, 1); PG8_SCHED; PG8_LDA(At, 0, 0); PG8_STAGE(PG8_SA(1, 1), a1 + hstep, voffA);
            PG8_WAIT_V(8); PG8_WAIT_L(0); PG8_BAR; PG8_MMA(0, 0, At, B0); PG8_MMA(0, 1, At, B1); PG8_BAR; PG8_SCHED;
            PG8_LDA(At, 0, 1); PG8_STAGE(PG8_SB(0, 0), b2, voffB); PG8_STAGE(PG8_SB(0, 1), b2 + hstep, voffB); PG8_STAGE(PG8_SA(0, 0), a2, voffA);
            PG8_WAIT_V(8); PG8_WAIT_L(0); PG8_BAR; PG8_MMA(1, 0, At, B0); PG8_MMA(1, 1, At, B1); PG8_BAR; PG8_SCHED;
            PG8_LDB(B0, 1, 0); PG8_LDB(B1, 1, 1); PG8_SCHED; PG8_LDA(At, 1, 0); PG8_STAGE(PG8_SA(0, 1), a2 + hstep, voffA);
            PG8_WAIT_V(8); PG8_WAIT_L(0); PG8_BAR; PG8_MMA(0, 0, At, B0); PG8_MMA(0, 1, At, B1); PG8_BAR; PG8_SCHED;
            PG8_LDA(At, 1, 1); PG8_STAGE(PG8_SB(1, 0), b3, voffB); PG8_STAGE(PG8_SB(1, 1), b3 + hstep, voffB); PG8_STAGE(PG8_SA(1, 0), a3, voffA);
            PG8_WAIT_V(8); PG8_WAIT_L(0); PG8_BAR; PG8_MMA(1, 0, At, B0); PG8_MMA(1, 1, At, B1); PG8_BAR; PG8_SCHED;
            } else {
            PG8_LDB(B0, 0, 0); PG8_SCHED; PG8_LDA(At, 0, 0); PG8_STAGE(PG8_SA(1, 1), a1 + hstep, voffA);
            PG8_WAIT_L(8); PG8_BAR; PG8_WAIT_L(0); PG8_MMA(0, 0, At, B0); PG8_BAR; PG8_SCHED;
            PG8_LDB(B1, 0, 1); PG8_STAGE(PG8_SB(0, 0), b2, voffB);
            PG8_BAR; PG8_WAIT_L(0); PG8_MMA(0, 1, At, B1); PG8_BAR;
            PG8_LDA(At, 0, 1); PG8_STAGE(PG8_SA(0, 0), a2, voffA);
            PG8_BAR; PG8_WAIT_L(0); PG8_MMA(1, 0, At, B0); PG8_BAR; PG8_SCHED;
            PG8_STAGE(PG8_SB(0, 1), b2 + hstep, voffB);
            PG8_WAIT_V(6); PG8_BAR; PG8_MMA(1, 1, At, B1); PG8_BAR;
            PG8_LDB(B0, 1, 0); PG8_SCHED; PG8_LDA(At, 1, 0); PG8_STAGE(PG8_SA(0, 1), a2 + hstep, voffA);
            PG8_WAIT_L(8); PG8_BAR; PG8_WAIT_L(0); PG8_MMA(0, 0, At, B0); PG8_BAR; PG8_SCHED;
            PG8_LDB(B1, 1, 1); PG8_STAGE(PG8_SB(1, 0), b3, voffB);
            PG8_BAR; PG8_WAIT_L(0); PG8_MMA(0, 1, At, B1); PG8_BAR;
            PG8_LDA(At, 1, 1); PG8_STAGE(PG8_SA(1, 0), a3, voffA);
            PG8_BAR; PG8_WAIT_L(0); PG8_MMA(1, 0, At, B0); PG8_BAR; PG8_SCHED;
            PG8_STAGE(PG8_SB(1, 1), b3 + hstep, voffB);
            PG8_WAIT_V(6); PG8_BAR; PG8_MMA(1, 1, At, B1); PG8_BAR;
            }
        }
        if constexpr (ALIGN_EPI) { if (wr == 0) PG8_BAR; }
        if constexpr (!Epi::AFTER_DRAIN) { E(acc, cur, wr, wc, fr, fq); S.done(cur); }
        if (!has_next) break;
#pragma unroll
        for (int a = 0; a < 2; ++a)
#pragma unroll
            for (int b = 0; b < 2; ++b)
#pragma unroll
                for (int m = 0; m < 4; ++m)
#pragma unroll
                    for (int n = 0; n < 2; ++n) acc[a][b][m][n] = (f32x4){0.f, 0.f, 0.f, 0.f};
        cur = nxt; cA = nA; cB = nB; ++ui;
        if constexpr (ALIGN_EPI) { if (wr == 1) PG8_BAR; }
    }
    PG8_WAIT_V(0);
    if constexpr (!ALIGN_EPI) { if (wr == 0) PG8_BAR; }
    PG8_BAR;
    if constexpr (Epi::AFTER_DRAIN) { E.fused(acc, cur, wr, wc, fr, fq, lds, wid, lane); S.done(cur); }
#undef PG8_SA
#undef PG8_SB
#undef PG8_STAGE
#undef PG8_LDA
#undef PG8_LDB
#undef PG8_MMA
#undef PG8_WAIT_V
#undef PG8_WAIT_L
#undef PG8_BAR
#undef PG8_SCHED
}
}

#include <hip/hip_bf16.h>
#include <cmath>
namespace attn_body {
using bf16=__hip_bfloat16;
using bf16x8=__attribute__((ext_vector_type(8)))short;
using s16x4=__attribute__((ext_vector_type(4)))short;
using f32x16=__attribute__((ext_vector_type(16)))float;
using u32x4=__attribute__((ext_vector_type(4)))unsigned;
constexpr int BATCH=2,NHEAD=16,SEQ=16384,D=64,DM=NHEAD*D;
constexpr int NW=8,QBLK=32,QB=QBLK*NW,KVBLK=64,NQB=SEQ/QB;
constexpr int ATTN_PITCH=DM, ATTN_UNIT_ROWS=QB;
__device__ __forceinline__ int crow(int r,int hi){return (r&3)+8*(r>>2)+4*hi;}
#define SBAR() __builtin_amdgcn_sched_barrier(0)
__device__ __forceinline__ void cmask(f32x16&p0,f32x16&p1,int jb,int qrel,int hi){
  const float NEG=-INFINITY; int kb=64*jb+4*hi;
  #pragma unroll
  for(int r=0;r<16;++r){int kv=kb+(r&3)+8*(r>>2); if(kv>qrel)p0[r]=NEG; if(kv+32>qrel)p1[r]=NEG;}
}

constexpr int NSLOT=3, SLOTB=8192;
constexpr int LDS_K=0, LDS_V=NSLOT*SLOTB, LDS_WS=2*NSLOT*SLOTB, LDS_OST=LDS_WS+NW*64*4, LDS_BYTES=LDS_OST+NW*4096;
constexpr float C2=0.125f*1.4426950408889634f;
__device__ __forceinline__ void glds16(const void*gsrc,unsigned lds_dst){unsigned keep;
  asm volatile("s_mov_b32 %0, m0\n\ts_mov_b32 m0, %2\n\ts_nop 0\n\tglobal_load_lds_dwordx4 %1, off\n\ts_mov_b32 m0, %0":"=&s"(keep):"v"(gsrc),"s"(lds_dst):"memory");}
__device__ __forceinline__ float max3f(float a,float b,float c){float r;asm("v_max3_f32 %0, %1, %2, %3":"=v"(r):"v"(a),"v"(b),"v"(c));return r;}
__device__ __forceinline__ float max2f(float a,float b){float r;asm("v_max_f32_e32 %0, %1, %2":"=v"(r):"v"(a),"v"(b));return r;}
__device__ __forceinline__ float fadd_s(float a,float b){float r;asm("v_add_f32_e32 %0, %1, %2":"=v"(r):"v"(a),"v"(b));return r;}
__device__ __forceinline__ float fsub_s(float a,float b){float r;asm("v_sub_f32_e32 %0, %1, %2":"=v"(r):"v"(a),"v"(b));return r;}
typedef float f32x2_t __attribute__((ext_vector_type(2))); typedef __bf16 bf16x2_t __attribute__((ext_vector_type(2)));
__device__ __forceinline__ unsigned cvtpk_s(float lo,float hi){f32x2_t v={lo,hi};bf16x2_t b=__builtin_convertvector(v,bf16x2_t);return __builtin_bit_cast(unsigned,b);}
#define WAIT_BAR(N) asm volatile("s_waitcnt vmcnt(" #N ") lgkmcnt(0)\n\ts_barrier":::"memory")

__device__ __forceinline__ void qkt(f32x16&p0,f32x16&p1,const char*Kslot,const bf16x8*qr,const f32x16&negm,int r32,int hi){
  const char*kb=Kslot+hi*1024+r32*16;
  #pragma unroll
  for(int d0=0;d0<4;++d0){
    const bf16x8 b0=*reinterpret_cast<const bf16x8*>(kb+d0*2048);
    const bf16x8 b1=*reinterpret_cast<const bf16x8*>(kb+d0*2048+512);
    if(d0==0){p0=__builtin_amdgcn_mfma_f32_32x32x16_bf16(b0,qr[0],negm,0,0,0);p1=__builtin_amdgcn_mfma_f32_32x32x16_bf16(b1,qr[0],negm,0,0,0);}
    else{p0=__builtin_amdgcn_mfma_f32_32x32x16_bf16(b0,qr[d0],p0,0,0,0);p1=__builtin_amdgcn_mfma_f32_32x32x16_bf16(b1,qr[d0],p1,0,0,0);}}
}
typedef __attribute__((address_space(3))) const char* lds_cptr;
typedef short v4i16_t __attribute__((ext_vector_type(4)));
__device__ __forceinline__ void kload8(bf16x8*kf,lds_cptr kp){
  kf[0]=*(const __attribute__((address_space(3))) bf16x8*)(kp);      kf[1]=*(const __attribute__((address_space(3))) bf16x8*)(kp+512);
  kf[2]=*(const __attribute__((address_space(3))) bf16x8*)(kp+2048); kf[3]=*(const __attribute__((address_space(3))) bf16x8*)(kp+2560);
  kf[4]=*(const __attribute__((address_space(3))) bf16x8*)(kp+4096); kf[5]=*(const __attribute__((address_space(3))) bf16x8*)(kp+4608);
  kf[6]=*(const __attribute__((address_space(3))) bf16x8*)(kp+6144); kf[7]=*(const __attribute__((address_space(3))) bf16x8*)(kp+6656);
}
__device__ __forceinline__ void kload2(bf16x8*kf,lds_cptr kp,int j){ kf[2*j]=*(const __attribute__((address_space(3))) bf16x8*)(kp+j*2048); kf[2*j+1]=*(const __attribute__((address_space(3))) bf16x8*)(kp+j*2048+512); }
__device__ __forceinline__ s16x4 vtr(lds_cptr p){ return __builtin_bit_cast(s16x4,__builtin_amdgcn_ds_read_tr16_b64_v4i16((__attribute__((address_space(3))) v4i16_t*)p)); }
__device__ __forceinline__ float rowmax(const f32x16&p0,const f32x16&p1){
  float a=max3f(p0[0],p0[1],p1[0]),b=max3f(p0[2],p0[3],p1[1]);a=max3f(a,p1[2],p1[3]);
  #pragma unroll
  for(int r=4;r<16;r+=4){a=max3f(a,p0[r],p0[r+1]);b=max3f(b,p0[r+2],p0[r+3]);a=max3f(a,p1[r],p1[r+1]);b=max3f(b,p1[r+2],p1[r+3]);}
  const float m=max2f(a,b);
  auto rr=__builtin_amdgcn_permlane32_swap(__float_as_uint(m),__float_as_uint(m),false,false);
  return max2f(__uint_as_float(rr[0]),__uint_as_float(rr[1]));
}
__device__ __forceinline__ void pv(f32x16*o,int vb,bf16x8 pa0,bf16x8 pa1,bf16x8 pa2,bf16x8 pa3){
  #pragma unroll
  for(int d0=0;d0<2;++d0){s16x4 lo[4],hi[4];
    #pragma unroll
    for(int ks=0;ks<4;++ks){
      asm volatile("ds_read_b64_tr_b16 %0,%1 offset:%c2":"=&v"(lo[ks]):"v"(vb),"i"(d0*4096+ks*1024):"memory");
      asm volatile("ds_read_b64_tr_b16 %0,%1 offset:%c2":"=&v"(hi[ks]):"v"(vb),"i"(d0*4096+ks*1024+512):"memory");}
    asm volatile("s_waitcnt lgkmcnt(0)":::"memory");SBAR();
    #define PK(k) (bf16x8){lo[k][0],lo[k][1],lo[k][2],lo[k][3],hi[k][0],hi[k][1],hi[k][2],hi[k][3]}
    o[d0]=__builtin_amdgcn_mfma_f32_32x32x16_bf16(pa0,PK(0),o[d0],0,0,0);
    o[d0]=__builtin_amdgcn_mfma_f32_32x32x16_bf16(pa1,PK(1),o[d0],0,0,0);
    o[d0]=__builtin_amdgcn_mfma_f32_32x32x16_bf16(pa2,PK(2),o[d0],0,0,0);
    o[d0]=__builtin_amdgcn_mfma_f32_32x32x16_bf16(pa3,PK(3),o[d0],0,0,0);
    #undef PK
  }
}

#ifndef ATTN_STORE16
#define ATTN_STORE16(p,v) (*(u32x4*)(p)=(v))
#endif
template<int THRL> __device__ __forceinline__ void attn_unit(int b,int cq,int cv,int qb,const bf16*Q,const bf16*__restrict__ K,const bf16*__restrict__ V,bf16*O,char*shm){
  int tid_=threadIdx.x; asm volatile("":"+v"(tid_)); const int tid=tid_,lane=tid&63,r32=lane&31,hi=lane>>5; const int wid=__builtin_amdgcn_readfirstlane(tid>>6);
  const long rowbase=(long)b*SEQ; const int q0=qb*QB;
  const bf16*Qw=Q+(rowbase+q0+wid*QBLK)*DM+cq;
  const bf16*Kh=K+rowbase*DM+cq,*Vh=V+rowbase*DM+cv;
  const unsigned lds0=(unsigned)(uintptr_t)shm;
  float*wsf=(float*)(shm+LDS_WS)+wid*64;
  const bf16*ksrc=Kh+(long)lane*DM+wid*8;
  const bf16*vsrc=Vh+(long)(16*(wid&3)+(lane>>2))*DM+(wid>>2)*32+(lane&3)*8;
  const unsigned kdst=lds0+LDS_K+wid*1024, vdst=lds0+LDS_V+wid*1024;
  #define DMA_K(t,slot) glds16(ksrc+(long)(t)*KVBLK*DM,(unsigned)__builtin_amdgcn_readfirstlane(kdst+(slot)))
  #define DMA_V(t,slot) glds16(vsrc+(long)(t)*KVBLK*DM,(unsigned)__builtin_amdgcn_readfirstlane(vdst+(slot)))
  const int vb0=(int)(lds0+LDS_V)+((lane>>4)&1)*32+(lane&3)*8+(4*hi+((lane&15)>>2))*64;
  const char*Kbase=shm+LDS_K; bf16x8 kf[8];
  const lds_cptr shm3=(lds_cptr)shm; const lds_cptr kp0=shm3+LDS_K+hi*1024+r32*16; const lds_cptr vp0=shm3+LDS_V+((lane>>4)&1)*32+(lane&3)*8+(4*hi+((lane&15)>>2))*64;
  const int NT=(q0+QB)/KVBLK;
  DMA_K(0,0);DMA_V(0,0);DMA_K(1,SLOTB);
  bf16x8 qr[4];
  #pragma unroll
  for(int d0=0;d0<4;++d0)qr[d0]=*reinterpret_cast<const bf16x8*>(&Qw[(long)r32*DM+d0*16+hi*8]);
  float mhat=0.f,l_reg=0.f;f32x16 o[2];o[0]=f32x16{};o[1]=f32x16{};f32x16 negm=f32x16{};asm volatile("":"+v"(negm));
  const int qrel=wid*QBLK+r32;
  #define CMASK(P0,P1,t) do{int jb_=(t)-(NT-4); if(jb_>=0)cmask(P0,P1,jb_,qrel,hi);}while(0)
  bool resc=false;
  #define START(P0,P1) do{ const float rm=rowmax(P0,P1); resc=false; \
    { const float dl=rm; mhat=fadd_s(mhat,dl); \
      _Pragma("unroll") for(int r=0;r<16;++r){P0[r]=fsub_s(P0[r],dl);P1[r]=fsub_s(P1[r],dl);} \
      _Pragma("unroll") for(int r=0;r<16;++r)negm[r]=-mhat; asm volatile("":"+v"(negm)); } \
    _Pragma("unroll") for(int r=0;r<16;++r)P0[r]=__builtin_amdgcn_exp2f(P0[r]); }while(0)
  #define RESC() do{ if(resc){ asm volatile("s_waitcnt lgkmcnt(0)":::"memory"); \
      _Pragma("unroll") for(int d_=0;d_<2;++d_) _Pragma("unroll") for(int r=0;r<16;++r)o[d_][r]*=wsf[crow(r,hi)]; } }while(0)
  f32x16 pA0,pA1,pB0,pB1;
  int sl_prev=0,sl_cur=0,sl_next=SLOTB;
  #define ROT() do{sl_prev=sl_cur;sl_cur=sl_next;sl_next=(sl_next==(NSLOT-1)*SLOTB)?0:sl_next+SLOTB;}while(0)
  DMA_K(2,2*SLOTB);
  WAIT_BAR(3);
  qkt(pA0,pA1,Kbase,qr,negm,r32,hi);asm volatile("s_nop 15\n\ts_nop 7":"+v"(pA0),"+v"(pA1));CMASK(pA0,pA1,0);
  START(pA0,pA1);
  _Pragma("unroll") for(int r=0;r<16;++r)pA1[r]=__builtin_amdgcn_exp2f(pA1[r]);
  WAIT_BAR(0);
  DMA_K(3,0);DMA_V(1,SLOTB);
  ROT();
  kload8(kf,kp0+sl_cur);
  WAIT_BAR(2);
  s16x4 vlo[8],vhi[8]; u32x4 pw0,pw1,pw2,pw3;
  #define PKW(P,B) cvtpk_s(P[B],P[B+1])
  #define PAF(k) __builtin_bit_cast(bf16x8,pw##k)
  #define VFR(i) (bf16x8){vlo[i][0],vlo[i][1],vlo[i][2],vlo[i][3],vhi[i][0],vhi[i][1],vhi[i][2],vhi[i][3]}
  #define PIN(x) asm volatile("":"+v"(x))
  #define MX3(a,b,c) __builtin_fmaxf(__builtin_fmaxf((a),(b)),(c))
  #define GAPA(MF,A0,A1,A2,A3,W0,W1,PW) do{ MF; sacc+=A0; sacc+=A1; sacc+=A2; sacc+=A3; PIN(sacc); W0; W1; PIN(PW); SBAR(); }while(0)
  #define EX(v) __builtin_amdgcn_exp2f(v)
  #define GAPB(MF,X,B) do{ MF; X[B]=EX(X[B]); X[B+1]=EX(X[B+1]); X[B+2]=EX(X[B+2]); X[B+3]=EX(X[B+3]); PIN(X); SBAR(); }while(0)
  #define VRD(i) do{ vlo[i]=vtr(vp_+(((i)>>2)*4096+((i)&3)*1024)); vhi[i]=vtr(vp_+(((i)>>2)*4096+((i)&3)*1024+512)); }while(0)
  #define KRD(G,j) do{ if(G){ kload2(kf,kp0+sl_next,j); SBAR(); } }while(0)
  #define STEP(C0,C1,P0,P1,t,GK,GV,GL) do{ SBAR(); \
    const lds_cptr vp_=vp0+sl_prev; \
    VRD(0); SBAR(); float sacc=(P0[0]+P0[1]); \
    GAPA(C0=__builtin_amdgcn_mfma_f32_32x32x16_bf16(kf[0],qr[0],negm,0,0,0), P0[2],P0[3],P0[4],P0[5],     pw0[0]=PKW(P0,0), pw0[1]=PKW(P0,2), pw0); \
    VRD(4); SBAR(); GAPA(C1=__builtin_amdgcn_mfma_f32_32x32x16_bf16(kf[1],qr[0],negm,0,0,0), P0[6],P0[7],P0[8],P0[9],     pw0[2]=PKW(P0,4), pw0[3]=PKW(P0,6), pw0); \
    VRD(1); SBAR(); GAPA(C0=__builtin_amdgcn_mfma_f32_32x32x16_bf16(kf[2],qr[1],C0,0,0,0),   P0[10],P0[11],P0[12],P0[13], pw1[0]=PKW(P0,8), pw1[1]=PKW(P0,10), pw1); \
    VRD(5); SBAR(); GAPA(C1=__builtin_amdgcn_mfma_f32_32x32x16_bf16(kf[3],qr[1],C1,0,0,0),   P0[14],P0[15],P1[0],P1[1],   pw1[2]=PKW(P0,12),pw1[3]=PKW(P0,14), pw1); \
    VRD(2); SBAR(); GAPA(C0=__builtin_amdgcn_mfma_f32_32x32x16_bf16(kf[4],qr[2],C0,0,0,0),   P1[2],P1[3],P1[4],P1[5],     pw2[0]=PKW(P1,0), pw2[1]=PKW(P1,2), pw2); \
    VRD(6); SBAR(); GAPA(C1=__builtin_amdgcn_mfma_f32_32x32x16_bf16(kf[5],qr[2],C1,0,0,0),   P1[6],P1[7],P1[8],P1[9],     pw2[2]=PKW(P1,4), pw2[3]=PKW(P1,6), pw2); \
    VRD(3); SBAR(); GAPA(C0=__builtin_amdgcn_mfma_f32_32x32x16_bf16(kf[6],qr[3],C0,0,0,0),   P1[10],P1[11],P1[12],P1[13], pw3[0]=PKW(P1,8), pw3[1]=PKW(P1,10), pw3); \
    VRD(7); SBAR(); GAPA(C1=__builtin_amdgcn_mfma_f32_32x32x16_bf16(kf[7],qr[3],C1,0,0,0),   P1[14],P1[15],0.f,0.f,       pw3[2]=PKW(P1,12),pw3[3]=PKW(P1,14), pw3); \
    l_reg+=sacc; \
    if(GK){DMA_K((t)+3,sl_cur);} if(GV){DMA_V((t)+1,sl_next);} \
    CMASK(C0,C1,t); \
    { float a=MX3(C0[0],C0[1],C1[0]),b=MX3(C0[2],C0[3],C1[1]); a=MX3(a,C1[2],C1[3]); \
      _Pragma("unroll") for(int r=4;r<16;r+=4){a=MX3(a,C0[r],C0[r+1]);b=MX3(b,C0[r+2],C0[r+3]);a=MX3(a,C1[r],C1[r+1]);b=MX3(b,C1[r+2],C1[r+3]);} \
      float rm=__builtin_fmaxf(a,b); { auto rr=__builtin_amdgcn_permlane32_swap(__float_as_uint(rm),__float_as_uint(rm),false,false); rm=__builtin_fmaxf(__uint_as_float(rr[0]),__uint_as_float(rr[1])); } \
      resc=false; \
      if(__builtin_expect(__any(rm>(float)THRL),0)){ const float dl=__builtin_fmaxf(rm,0.f); mhat+=dl; \
        _Pragma("unroll") for(int r=0;r<16;++r){C0[r]-=dl;C1[r]-=dl;} \
        _Pragma("unroll") for(int r=0;r<16;++r)negm[r]=-mhat; asm volatile("":"+v"(negm)); \
        const float f=__builtin_amdgcn_exp2f(-dl); l_reg*=f; if(hi==0)wsf[r32]=f; resc=true; } } \
    SBAR(); \
    GAPB(o[0]=__builtin_amdgcn_mfma_f32_32x32x16_bf16(PAF(0),VFR(0),o[0],0,0,0), C0,0); \
    GAPB(o[1]=__builtin_amdgcn_mfma_f32_32x32x16_bf16(PAF(0),VFR(4),o[1],0,0,0), C0,4); \
    KRD(GL,0); GAPB(o[0]=__builtin_amdgcn_mfma_f32_32x32x16_bf16(PAF(1),VFR(1),o[0],0,0,0), C0,8); \
    KRD(GL,1); GAPB(o[1]=__builtin_amdgcn_mfma_f32_32x32x16_bf16(PAF(1),VFR(5),o[1],0,0,0), C0,12); \
    KRD(GL,2); GAPB(o[0]=__builtin_amdgcn_mfma_f32_32x32x16_bf16(PAF(2),VFR(2),o[0],0,0,0), C1,0); \
    KRD(GL,3); GAPB(o[1]=__builtin_amdgcn_mfma_f32_32x32x16_bf16(PAF(2),VFR(6),o[1],0,0,0), C1,4); \
    GAPB(o[0]=__builtin_amdgcn_mfma_f32_32x32x16_bf16(PAF(3),VFR(3),o[0],0,0,0), C1,8); \
    GAPB(o[1]=__builtin_amdgcn_mfma_f32_32x32x16_bf16(PAF(3),VFR(7),o[1],0,0,0), C1,12); \
    }while(0)
  int t=1;
  #undef CMASK
  #define CMASK(P0,P1,t) do{}while(0)
  for(;t+5<NT;t+=2){
    STEP(pB0,pB1,pA0,pA1,t,true,true,true);     WAIT_BAR(2); RESC(); ROT();
    STEP(pA0,pA1,pB0,pB1,t+1,true,true,true);   WAIT_BAR(2); RESC(); ROT();
  }
  #undef CMASK
  #define CMASK(P0,P1,t) do{int jb_=(t)-(NT-4); if(jb_>=0)cmask(P0,P1,jb_,qrel,hi);}while(0)
  #define ENDW(tt) do{ if((tt)+3<NT){WAIT_BAR(2);} else if((tt)+2<NT){WAIT_BAR(1);} else {WAIT_BAR(0);} }while(0)
  for(;t+1<NT;t+=2){
    STEP(pB0,pB1,pA0,pA1,t,(t+3<NT),(t+1<NT),(t+1<NT));       ENDW(t);   RESC(); ROT();
    STEP(pA0,pA1,pB0,pB1,t+1,(t+4<NT),(t+2<NT),(t+2<NT));     ENDW(t+1); RESC(); ROT();
  }
  STEP(pB0,pB1,pA0,pA1,NT-1,false,false,false); RESC();
  { float sacc=pB0[0]+pB0[1]; _Pragma("unroll") for(int r=2;r<16;++r)sacc+=pB0[r]; _Pragma("unroll") for(int r=0;r<16;++r)sacc+=pB1[r]; l_reg+=sacc;
    pw0=(u32x4){PKW(pB0,0),PKW(pB0,2),PKW(pB0,4),PKW(pB0,6)};pw1=(u32x4){PKW(pB0,8),PKW(pB0,10),PKW(pB0,12),PKW(pB0,14)};pw2=(u32x4){PKW(pB1,0),PKW(pB1,2),PKW(pB1,4),PKW(pB1,6)};pw3=(u32x4){PKW(pB1,8),PKW(pB1,10),PKW(pB1,12),PKW(pB1,14)};
    SBAR(); pv(o,vb0+sl_cur,PAF(0),PAF(1),PAF(2),PAF(3)); }
  #undef PKW
  #undef PAF
  #undef VFR
  #undef PIN
  #undef MX3
  #undef GAPA
  #undef GAPB
  #undef EX
  #undef VRD
  #undef KRD
  #undef STEP
  #undef ENDW
  {auto rr=__builtin_amdgcn_permlane32_swap(__float_as_uint(l_reg),__float_as_uint(l_reg),false,false);l_reg=__uint_as_float(rr[0])+__uint_as_float(rr[1]);}
  if(hi==0)wsf[32+r32]=l_reg;asm volatile("s_waitcnt lgkmcnt(0)":::"memory");
  float rli[16];
  #pragma unroll
  for(int r=0;r<16;++r)rli[r]=__builtin_amdgcn_rcpf(wsf[32+crow(r,hi)]);
  bf16*Ow=O+(rowbase+q0+wid*QBLK)*DM+cv;
  { bf16*stg=(bf16*)(shm+LDS_OST)+wid*2048;
    #pragma unroll
    for(int r=0;r<16;++r){const int orow=crow(r,hi);
      #pragma unroll
      for(int d0=0;d0<2;++d0)stg[orow*64+d0*32+r32]=__float2bfloat16(o[d0][r]*rli[r]);}
    asm volatile("s_waitcnt lgkmcnt(0)":::"memory");
    #pragma unroll
    for(int i=0;i<4;++i){const int row=i*8+(lane>>3),ch=lane&7; const u32x4 v=*(const u32x4*)(stg+row*64+ch*8); ATTN_STORE16(Ow+(long)row*DM+ch*8,v);} }
  asm volatile("s_waitcnt lgkmcnt(0)\n\ts_barrier":::"memory");
  #undef DMA_K
  #undef DMA_V
  #undef CMASK
  #undef START
  #undef RESC
  #undef ROT
}
constexpr int ATTN_LDS_BYTES=LDS_BYTES;
struct AttnTensors { const bf16* Q; const bf16* K; const bf16* V; bf16* O0; bf16* O1; };
template<int THRL> __device__ __forceinline__ void attn_phase(char*lds,const AttnTensors&T,int vcu,int G){
  for(int v=vcu;v<256;v+=G){
    const int e=v>>2,s=v&3; const int b=e>>5,rem=e&31,h=rem>>2,m=(rem>>1)&1,vh=rem&1;
    const int cq=(2*h+m)*64,cv=(2*h+vh)*64; bf16*O=m?T.O1:T.O0;
    for(int i=0;i<16;++i){ const int j=i>>1; const int qb=(i&1)?(8*j+7-s):(8*j+s); attn_unit<THRL>(b,cq,cv,qb,T.Q,T.K,T.V,O,lds); }
  }
}
#undef SBAR
#undef WAIT_BAR
}

namespace attn128 {
constexpr int D = 128, PITCH = 1024, SEQ = 16384;
constexpr float THR = 8.f; constexpr bool WSKIP = false;
constexpr float SCALE = 0.125f;
constexpr int NW = 8, QBLK = 32, KVBLK = 64, QB = NW * QBLK;
constexpr int SHM_V = KVBLK * D * 2, SHM_K = KVBLK * D * 2;
constexpr int LDS_BYTES = 2 * SHM_V + 2 * SHM_K + NW * 64 * 4;
using bf16 = unsigned short;
typedef short bf16x8 __attribute__((ext_vector_type(8)));
typedef short s16x4 __attribute__((ext_vector_type(4)));
typedef float f32x16 __attribute__((ext_vector_type(16)));
typedef float f32x4 __attribute__((ext_vector_type(4)));
typedef unsigned u32x4 __attribute__((ext_vector_type(4)));
template <class A, class Bt> struct same_t { static constexpr bool v = false; };
template <class A> struct same_t<A, A> { static constexpr bool v = true; };

#define KSWZ(row, colB) ((row) * 256 + ((colB) ^ (((row) & 7) << 4)))
#define SBAR() __builtin_amdgcn_sched_barrier(0)
__device__ __forceinline__ int v_st(int k, int c) { const int kk = (k & ~0xC) | ((k & 4) << 1) | ((k & 8) >> 1); return ((kk >> 3) * 4 + (c >> 5)) * 512 + ((kk & 7) * 32 + (c & 31)) * 2; }
__device__ __forceinline__ int v_rd_base(int lane) { return ((lane & 3) << 3) | (((lane >> 2) & 3) << 6) | (((lane >> 4) & 1) << 5) | (((lane >> 5) & 1) << 8); }
constexpr int v_rd_off(int d0, int ks, int half) { return d0 * 512 + ks * 4096 + half * 2048; }
__device__ __forceinline__ int crow(int r, int hi) { return (r & 3) + 8 * (r >> 2) + 4 * hi; }
__device__ __forceinline__ unsigned cvtpk(float lo, float hi) {
    unsigned r; asm volatile("v_cvt_pk_bf16_f32 %0, %1, %2" : "=v"(r) : "v"(lo), "v"(hi)); return r;
}
__device__ __forceinline__ bf16x8 pack8(f32x4 a, f32x4 b) {
    u32x4 w = {cvtpk(a[0], a[1]), cvtpk(a[2], a[3]), cvtpk(b[0], b[1]), cvtpk(b[2], b[3])};
    return *reinterpret_cast<bf16x8*>(&w);
}
template <class T> __device__ __forceinline__ bf16x8 load8(const T* p) {
    if constexpr (same_t<T, float>::v) { return pack8(*(const f32x4*)p, *(const f32x4*)(p + 4)); }
    else { return *reinterpret_cast<const bf16x8*>(p); }
}
__device__ __forceinline__ void mask_tile(f32x16& p0, f32x16& p1, int dq, unsigned W) {
    const float NEG = -__builtin_inff();
#pragma unroll
    for (int r = 0; r < 16; ++r) {
        const int c = (r & 3) + 8 * (r >> 2);
        if ((unsigned)(dq - c) >= W) p0[r] = NEG;
        if ((unsigned)(dq - c - 32) >= W) p1[r] = NEG;
    }
}
__device__ __forceinline__ void partialSM(f32x16& p0, f32x16& p1, float& m_reg, float& mn, float& alpha) {
    float pmax = p0[0]; for (int r = 1; r < 16; ++r) pmax = fmaxf(pmax, p0[r]); for (int r = 0; r < 16; ++r) pmax = fmaxf(pmax, p1[r]);
    { auto rr = __builtin_amdgcn_permlane32_swap(__float_as_uint(pmax), __float_as_uint(pmax), false, false);
      pmax = fmaxf(__uint_as_float(rr[0]), __uint_as_float(rr[1])); }
    constexpr float C2 = 1.4426950408889634f * SCALE;
    if (__builtin_expect(__all((pmax - m_reg) * SCALE <= THR), 1)) { mn = m_reg; alpha = 1.f; }
    else { mn = fmaxf(m_reg, pmax); alpha = __builtin_amdgcn_exp2f((m_reg - mn) * C2); m_reg = mn; }
    const float mnL = -mn * C2;
    for (int r = 0; r < 16; ++r) p0[r] = fmaf(p0[r], C2, mnL); for (int r = 0; r < 16; ++r) p1[r] = fmaf(p1[r], C2, mnL);
    for (int r = 0; r < 16; ++r) p0[r] = __builtin_amdgcn_exp2f(p0[r]);
}
__device__ __forceinline__ void finishSM(f32x16& p0, f32x16& p1, float alpha, float& l_reg, bf16x8& pa0, bf16x8& pa1, bf16x8& pa2, bf16x8& pa3) {
    for (int r = 0; r < 16; ++r) p1[r] = __builtin_amdgcn_exp2f(p1[r]);
    float ps = 0; for (int r = 0; r < 16; ++r) ps += p0[r]; for (int r = 0; r < 16; ++r) ps += p1[r];
    { auto rr = __builtin_amdgcn_permlane32_swap(__float_as_uint(ps), __float_as_uint(ps), false, false);
      ps = __uint_as_float(rr[0]) + __uint_as_float(rr[1]); }
    l_reg = l_reg * alpha + ps;
#define PK4(P, B_, OUT) do { unsigned a0 = cvtpk(P[B_+0], P[B_+1]), a1 = cvtpk(P[B_+2], P[B_+3]);                          \
        unsigned b0 = cvtpk(P[B_+4], P[B_+5]), b1 = cvtpk(P[B_+6], P[B_+7]);                                             \
        auto r0 = __builtin_amdgcn_permlane32_swap(a0, b0, false, false); auto r1 = __builtin_amdgcn_permlane32_swap(a1, b1, false, false); \
        u32x4 w = {r0[0], r1[0], r0[1], r1[1]}; OUT = *reinterpret_cast<bf16x8*>(&w); } while (0)
    PK4(p0, 0, pa0); PK4(p0, 8, pa1); PK4(p1, 0, pa2); PK4(p1, 8, pa3);
#undef PK4
}
template <int KB, bool SK>
__device__ __forceinline__ void qkt(f32x16& p0, f32x16& p1, const char* K_lds, int r32, int hi, const bf16x8* qr, bool act, int kmo) {
    if (SK && !act) { const float NEG = -__builtin_inff();
#pragma unroll
        for (int r = 0; r < 16; ++r) { p0[r] = NEG; p1[r] = NEG; } return; }
    p0 = f32x16{}; p1 = f32x16{};
    const char* kb[4];
#pragma unroll
    for (int dd = 0; dd < 4; ++dd) kb[dd] = K_lds + KB * SHM_K + KSWZ(r32, (dd * 16 + hi * 8) * 2);
#pragma unroll
    for (int d0 = 0; d0 < 4; ++d0) { const char* a = kb[d0] + kmo;
        bf16x8 b0 = *reinterpret_cast<const bf16x8*>(a);
        bf16x8 b1 = *reinterpret_cast<const bf16x8*>(a + 32 * 256);
        p0 = __builtin_amdgcn_mfma_f32_32x32x16_bf16(b0, qr[d0], p0, 0, 0, 0);
        p1 = __builtin_amdgcn_mfma_f32_32x32x16_bf16(b1, qr[d0], p1, 0, 0, 0); }
}
template <int VB, bool SK>
__device__ __forceinline__ void pv_tile(f32x16* o, int vb0, bf16x8 pa0, bf16x8 pa1, bf16x8 pa2, bf16x8 pa3, bool act) {
    if (SK && !act) return;
#define TRRD(dst, off) asm volatile("ds_read_b64_tr_b16 %0, %1 offset:%2" : "=&v"(dst) : "v"(vb0), "i"(off) : "memory")
#define PV_D0(d0) do { s16x4 l0, l1, l2, l3, h0, h1, h2, h3; constexpr int b_ = VB * SHM_V + v_rd_off(d0, 0, 0);     \
        TRRD(l0, b_); TRRD(h0, b_ + 2048); TRRD(l1, b_ + 4096); TRRD(h1, b_ + 6144); TRRD(l2, b_ + 8192); TRRD(h2, b_ + 10240); TRRD(l3, b_ + 12288); TRRD(h3, b_ + 14336); \
        asm volatile("s_waitcnt lgkmcnt(0)" ::: "memory"); SBAR();                 \
        o[d0] = __builtin_amdgcn_mfma_f32_32x32x16_bf16(pa0, (bf16x8){l0[0], l0[1], l0[2], l0[3], h0[0], h0[1], h0[2], h0[3]}, o[d0], 0, 0, 0);   \
        o[d0] = __builtin_amdgcn_mfma_f32_32x32x16_bf16(pa1, (bf16x8){l1[0], l1[1], l1[2], l1[3], h1[0], h1[1], h1[2], h1[3]}, o[d0], 0, 0, 0);   \
        o[d0] = __builtin_amdgcn_mfma_f32_32x32x16_bf16(pa2, (bf16x8){l2[0], l2[1], l2[2], l2[3], h2[0], h2[1], h2[2], h2[3]}, o[d0], 0, 0, 0);   \
        o[d0] = __builtin_amdgcn_mfma_f32_32x32x16_bf16(pa3, (bf16x8){l3[0], l3[1], l3[2], l3[3], h3[0], h3[1], h3[2], h3[3]}, o[d0], 0, 0, 0); } while (0)
    PV_D0(0); PV_D0(1); PV_D0(2); PV_D0(3);
#undef PV_D0
#undef TRRD
}

template <class TIn, class TOut> struct BlockRef { const TIn* Q; const TIn* K; const TIn* V; TOut* O; int P0; int kmo; };
template <class TIn> struct Seam {
    bf16x8 qr[4];
    bf16x8 st_v0, st_v1, st_k0, st_k1; f32x4 sf0, sf1, sf2, sf3;
    f32x4 tq[1];
};
__device__ __forceinline__ int swa_jlo(int P0, int W) { const int lowk = P0 - W + 1; return lowk > 0 ? lowk / KVBLK : 0; }
#define ROW(p, k0, rr) ((p) + (size_t)((k0) + (rr)) * PITCH + sc)
#define VMW() asm volatile("s_waitcnt vmcnt(0)" ::: "memory")
#define VMWN(n) asm volatile("s_waitcnt vmcnt(%0)" :: "i"(n) : "memory")
#define SLOAD_H(Kp, Vp, k0) do { S.st_v0 = load8<TIn>(ROW(Vp, k0, sr)); S.st_v1 = load8<TIn>(ROW(Vp, k0, 32 + sr));              \
                         S.st_k0 = load8<TIn>(ROW(Kp, k0, sr)); S.st_k1 = load8<TIn>(ROW(Kp, k0, 32 + sr)); } while (0)
#define SWRITE_HK(bf) do { *(bf16x8*)(K_lds + (bf) * SHM_K + kws) = S.st_k0; *(bf16x8*)(K_lds + (bf) * SHM_K + kws + 32 * 256) = S.st_k1; } while (0)
#define SWRITE_HV(bf) do { *(bf16x8*)(V_lds + (bf) * SHM_V + vst0) = S.st_v0; *(bf16x8*)(V_lds + (bf) * SHM_V + vst1) = S.st_v1; } while (0)
#define SWRITE_H(bf) do { SWRITE_HV(bf); SWRITE_HK(bf); } while (0)
#define SLOAD_F(p, k0) do { S.sf0 = *(const f32x4*)ROW(p, k0, sr); S.sf1 = *(const f32x4*)(ROW(p, k0, sr) + 4);                \
                            S.sf2 = *(const f32x4*)ROW(p, k0, 32 + sr); S.sf3 = *(const f32x4*)(ROW(p, k0, 32 + sr) + 4); } while (0)
#define SWRITE_KF(bf) do { *(bf16x8*)(K_lds + (bf) * SHM_K + kws) = pack8(S.sf0, S.sf1); *(bf16x8*)(K_lds + (bf) * SHM_K + kws + 32 * 256) = pack8(S.sf2, S.sf3); } while (0)
#define SWRITE_VF(bf) do { *(bf16x8*)(V_lds + (bf) * SHM_V + vst0) = pack8(S.sf0, S.sf1); *(bf16x8*)(V_lds + (bf) * SHM_V + vst1) = pack8(S.sf2, S.sf3); } while (0)
template <class TIn, class TOut>
__device__ __forceinline__ void causal_swa_prime(const BlockRef<TIn, TOut>& cur, int W, char* lds, Seam<TIn>& S) {
    constexpr bool F32 = same_t<TIn, float>::v;
    int tid_ = threadIdx.x; asm volatile("" : "+v"(tid_)); const int tid = tid_, wid = __builtin_amdgcn_readfirstlane(tid >> 6), lane = tid & 63, r32 = lane & 31, hi = lane >> 5;
    const int sr = tid >> 4, sc = (tid & 15) * 8, kws = KSWZ(sr, sc * 2); char* K_lds = lds + 2 * SHM_V;
    const int kb0 = swa_jlo(cur.P0, W) * KVBLK;
    for (int d0 = 0; d0 < 4; ++d0) S.qr[d0] = load8<TIn>(cur.Q + (size_t)(wid * QBLK + r32) * PITCH + d0 * 16 + hi * 8);
    if constexpr (F32) { SLOAD_F((const float*)cur.K, kb0); VMW(); SWRITE_KF(0); SBAR(); SLOAD_F((const float*)cur.V, kb0); }
    else { SLOAD_H(cur.K, cur.V, kb0); VMW(); SWRITE_HK(0); }
    __syncthreads();
}
template <class TIn, class TOut>
__device__ __forceinline__ void causal_swa_block(const BlockRef<TIn, TOut>& cur, const BlockRef<TIn, TOut>& nxt, int skv, int W, char* lds, Seam<TIn>& S) {
    constexpr bool F32 = same_t<TIn, float>::v;
    int tid_ = threadIdx.x; asm volatile("" : "+v"(tid_)); const int tid = tid_, wid = __builtin_amdgcn_readfirstlane(tid >> 6), lane = tid & 63, r32 = lane & 31, hi = lane >> 5;
    const int j_lo = swa_jlo(cur.P0, W);
    int j_hi = (cur.P0 + QB - 1) / KVBLK + 1; if (j_hi > skv / KVBLK) j_hi = skv / KVBLK;
    const int NT = j_hi - j_lo;
    const int kbn = swa_jlo(nxt.P0, W) * KVBLK;
    const int qlo = cur.P0 + wid * QBLK, qm = qlo + r32 - 4 * hi;
    char* V_lds = lds; char* K_lds = lds + 2 * SHM_V;
    float* ws = (float*)(lds + 2 * SHM_V + 2 * SHM_K) + wid * 64; float* li_l = ws, * al_l = ws + 32;
    float m_reg = -1e30f, l_reg = 0; f32x16 o[4] = {};
    const int sr = tid >> 4, sc = (tid & 15) * 8, vst0 = v_st(sr, sc), vst1 = v_st(32 + sr, sc), kws = KSWZ(sr, sc * 2);
    const int vb0 = (int)(uintptr_t)V_lds + v_rd_base(lane);
    const TIn* Kh = cur.K; const TIn* Vh = cur.V;
#define RESC(a) do { if (__any((a) < 1.f)) { if (hi == 0) al_l[r32] = (a); asm volatile("s_waitcnt lgkmcnt(0)" ::: "memory");              \
                     for (int d_ = 0; d_ < 4; ++d_) for (int r = 0; r < 16; ++r) o[d_][r] *= al_l[crow(r, hi)]; } } while (0)
#define KBASE(t) ((j_lo + (t)) * KVBLK)
#define ACT(t) (KBASE(t) <= qlo + QBLK - 1 && KBASE(t) + KVBLK - 1 >= qlo - W + 1)
#define MASKT(P0_, P1_, t) do { const int kb_ = KBASE(t); if ((!SK || ACT(t)) && (kb_ + KVBLK - 1 > qlo || kb_ <= qlo + QBLK - 1 - W)) mask_tile(P0_, P1_, qm - kb_, (unsigned)W); } while (0)
    constexpr int NQL = F32 ? 16 : 4;
    constexpr bool SK = WSKIP && !F32;
#define SEAM_K0() do { VMWN(NQL); if constexpr (F32) { SWRITE_KF(0); SBAR(); SLOAD_F((const float*)nxt.V, kbn); } else { SWRITE_HK(0); } SBAR(); } while (0)
    f32x16 pA0, pA1, pB0, pB1; float mnA, mnB, alA, alB; bf16x8 pa0, pa1, pa2, pa3;
    if constexpr (F32) { VMW(); SWRITE_VF(0); SBAR(); } else { SWRITE_HV(0); SBAR(); }
    if (NT > 1) { if constexpr (F32) SLOAD_F((const float*)Kh, KBASE(1)); else SLOAD_H(Kh, Vh, KBASE(1)); }
    SBAR(); qkt<0, SK>(pA0, pA1, K_lds, r32, hi, S.qr, ACT(0), cur.kmo);
    if constexpr (F32) { if (NT > 1) { VMW(); SWRITE_KF(1); SBAR(); SLOAD_F((const float*)Vh, KBASE(1)); } }
    MASKT(pA0, pA1, 0); partialSM(pA0, pA1, m_reg, mnA, alA);
    if (NT > 1) { VMW(); if constexpr (F32) { SWRITE_VF(1); SBAR(); if (NT > 2) SLOAD_F((const float*)Kh, KBASE(2)); } else SWRITE_H(1); }
    __syncthreads();
#define HALF_STEP(PX0, PX1, mnX, alX, PY0, PY1, alY, t, KB, VB, SB) do {                                                      \
        SBAR(); qkt<KB, SK>(PX0, PX1, K_lds, r32, hi, S.qr, ACT(t), cur.kmo);                                             \
        finishSM(PY0, PY1, alY, l_reg, pa0, pa1, pa2, pa3); SBAR();                                                           \
        if ((t) + 1 < NT) { if constexpr (F32) { VMW(); SWRITE_KF(SB); SBAR(); SLOAD_F((const float*)Vh, KBASE((t) + 1)); }  \
                            else { SLOAD_H(Kh, Vh, KBASE((t) + 1)); } SBAR(); }                                               \
        pv_tile<VB, SK>(o, vb0, pa0, pa1, pa2, pa3, ACT((t) - 1)); MASKT(PX0, PX1, (t)); partialSM(PX0, PX1, m_reg, mnX, alX);                                        \
        __syncthreads();                                                                                                      \
        if ((t) + 1 < NT) { VMW(); if constexpr (F32) { SWRITE_VF(SB); SBAR(); if ((t) + 2 < NT) SLOAD_F((const float*)Kh, KBASE((t) + 2)); } \
                            else { SWRITE_H(SB); } }                                                                          \
        RESC(alX); __syncthreads(); } while (0)
    for (int t = 1; t + 1 < NT; t += 2) {
        HALF_STEP(pB0, pB1, mnB, alB, pA0, pA1, alA, t, 1, 0, 0);
        HALF_STEP(pA0, pA1, mnA, alA, pB0, pB1, alB, t + 1, 0, 1, 1);
    }
    const bool even = (NT & 1) == 0;
    if (even) { SBAR(); qkt<1, SK>(pB0, pB1, K_lds, r32, hi, S.qr, ACT(NT - 1), cur.kmo); SBAR(); }
#define QROW(e) (nxt.Q + (size_t)(wid * QBLK + r32) * D + ((e) >> 1) * 16 + hi * 8 + ((e) & 1) * 4)
    if constexpr (F32) { SLOAD_F((const float*)nxt.K, kbn); SBAR();
#pragma unroll
        for (int e = 0; e < 8; ++e) S.tq[e] = *(const f32x4*)QROW(e); }
    else { SLOAD_H(nxt.K, nxt.V, kbn); SBAR();
#pragma unroll
        for (int d0 = 0; d0 < 4; ++d0) S.qr[d0] = load8<TIn>(nxt.Q + (size_t)(wid * QBLK + r32) * PITCH + d0 * 16 + hi * 8); }
    SBAR();
    finishSM(pA0, pA1, alA, l_reg, pa0, pa1, pa2, pa3); SBAR();
    if constexpr (F32) {
#pragma unroll
        for (int e = 8; e < 16; ++e) S.tq[e] = *(const f32x4*)QROW(e); SBAR(); }
#undef QROW
    pv_tile<0, SK>(o, vb0, pa0, pa1, pa2, pa3, ACT(even ? NT - 2 : NT - 1));
    if (even) { MASKT(pB0, pB1, NT - 1); partialSM(pB0, pB1, m_reg, mnB, alB); __syncthreads(); RESC(alB);
        finishSM(pB0, pB1, alB, l_reg, pa0, pa1, pa2, pa3); SBAR(); pv_tile<1, SK>(o, vb0, pa0, pa1, pa2, pa3, ACT(NT - 1)); }
    SBAR(); SEAM_K0();
    if (hi == 0) li_l[r32] = l_reg; asm volatile("s_waitcnt lgkmcnt(0)" ::: "memory");
    float rli[16];
#pragma unroll
    for (int r = 0; r < 16; ++r) rli[r] = __builtin_amdgcn_rcpf(li_l[crow(r, hi)]);
    TOut* Ow = cur.O + (size_t)(wid * QBLK) * PITCH;
#pragma unroll
    for (int r = 0; r < 16; ++r) { const int orow = crow(r, hi);
#pragma unroll
        for (int d0 = 0; d0 < 4; ++d0) { const float v = o[d0][r] * rli[r];
            if constexpr (same_t<TOut, float>::v) { Ow[(size_t)orow * PITCH + d0 * 32 + r32] = v; }
            else { const float vn = __shfl_xor(v, 1);
                   if ((r32 & 1) == 0) *(unsigned*)(Ow + (size_t)orow * PITCH + d0 * 32 + r32) = cvtpk(v, vn); } } }
    if constexpr (F32) {
#pragma unroll
        for (int d0 = 0; d0 < 8; ++d0) S.qr[d0] = pack8(S.tq[2 * d0], S.tq[2 * d0 + 1]); }
    __syncthreads();
#undef RESC
#undef KBASE
#undef ACT
#undef MASKT
#undef SEAM_K0
#undef HALF_STEP
}
#undef ROW
#undef VMW
#undef VMWN
#undef SLOAD_H
#undef SWRITE_HK
#undef SWRITE_HV
#undef SWRITE_H
#undef SLOAD_F
#undef SWRITE_KF
#undef SWRITE_VF


struct AttnTensors { const bf16* Q; const bf16* K; const bf16* V; bf16* O0; bf16* O1; };
__device__ __forceinline__ BlockRef<bf16, bf16> blk_ref(const AttnTensors& T, int vcu, int G, int li) {
    const int v = vcu + (li >> 3) * G, i = li & 7, e = v >> 3, s = v & 7, b = e >> 4, h = (e >> 1) & 7, m = e & 1, j = i >> 1;
    const int qb = (i & 1) ? (16 * j + 15 - s) : (16 * j + s);
    BlockRef<bf16, bf16> r;
    r.Q = T.Q + ((size_t)b * SEQ + (size_t)qb * QB) * PITCH + h * 128 + m * 64;
    r.K = T.K + (size_t)b * SEQ * PITCH + h * 128; r.V = T.V + (size_t)b * SEQ * PITCH + h * 128;
    r.O = (m ? T.O1 : T.O0) + ((size_t)b * SEQ + (size_t)qb * QB) * PITCH + h * 128;
    r.P0 = qb * QB; r.kmo = m * 128;
    return r;
}
__device__ __forceinline__ void attn_phase(char* lds, const AttnTensors& T, int vcu, int G) {
    int nv = 0; for (int v = vcu; v < 256; v += G) ++nv;
    const int nblk = nv * 8; if (nblk == 0) return;
    Seam<bf16> S;
    BlockRef<bf16, bf16> cur = blk_ref(T, vcu, G, 0);
    causal_swa_prime<bf16, bf16>(cur, SEQ, lds, S);
    for (int li = 0; li < nblk; ++li) {
        const BlockRef<bf16, bf16> nxt = (li + 1 < nblk) ? blk_ref(T, vcu, G, li + 1) : cur;
        causal_swa_block<bf16, bf16>(cur, nxt, SEQ, SEQ, lds, S);
        cur = nxt;
    }
}
}

#define GAS __attribute__((address_space(1)))
#define LAS __attribute__((address_space(3)))
typedef unsigned short bf16;
typedef unsigned v4u __attribute__((ext_vector_type(4)));
typedef float f32x4 __attribute__((ext_vector_type(4)));
typedef short bf16x8 __attribute__((ext_vector_type(8)));
typedef GAS unsigned gu32;
typedef GAS unsigned long long gu64;
#define RLX_AGENT __ATOMIC_RELAXED, __HIP_MEMORY_SCOPE_AGENT
#define LDS_WAIT() asm volatile("s_waitcnt lgkmcnt(0)" ::: "memory")
#define VM_WAIT() asm volatile("s_waitcnt vmcnt(0)" ::: "memory")
__device__ __forceinline__ unsigned long long rt() { return __builtin_amdgcn_s_memrealtime(); }

#define XB_TMO      128
#define XB_XCNT(j)  (256  + 64 * (j))
#define XB_XSUB(j)  (1280 + 64 * (j))
#define XB_XGEN(j)  (2304 + 64 * (j))
#define XB_TOP      3328
#define XB_TOPGEN   3392
#define XCD_BAR_WORDS 3456
#define XB_SPIN_CAP (1u << 18)

__device__ __forceinline__ unsigned xb_ld(unsigned* p)              { return __hip_atomic_load(p, __ATOMIC_RELAXED, __HIP_MEMORY_SCOPE_AGENT); }
__device__ __forceinline__ unsigned xb_add(unsigned* p, unsigned v) { return __hip_atomic_fetch_add(p, v, __ATOMIC_RELAXED, __HIP_MEMORY_SCOPE_AGENT); }
__device__ __forceinline__ unsigned xb_xcc_id() { return (unsigned)__builtin_amdgcn_s_getreg((3 << 11) | 20) & 0xFu; }
#define XB_SPIN(cond, bar) do { unsigned _sp = 0; while (cond) { __builtin_amdgcn_s_sleep(1); \
    if ((++_sp & 255u) == 0u) { if (xb_ld(&(bar)[XB_TMO])) break; if (_sp > XB_SPIN_CAP) { atomicAdd(&(bar)[XB_TMO], 1u); break; } } } } while (0)

struct XcdBarrier {
    unsigned* bar; unsigned x;
    volatile LAS unsigned* st;
};

__device__ __forceinline__ XcdBarrier xcd_barrier_post(unsigned* bar, volatile LAS unsigned* st) {
    XcdBarrier b; b.bar = bar; b.x = xb_xcc_id(); b.st = st;
    if (threadIdx.x == 0) (void)xb_add(&bar[XB_XCNT(b.x)], 1u);
    return b;
}
__device__ __forceinline__ void xcd_barrier_complete(unsigned* bar, unsigned x, unsigned& nloc, unsigned& nx) {
    const unsigned G = gridDim.x * gridDim.y * gridDim.z;
    unsigned sum, cnt, mine, sp = 0u;
    for (;;) {
        sum = 0u; cnt = 0u; mine = 0u;
#pragma unroll
        for (unsigned j = 0; j < 16; ++j) { const unsigned c = xb_ld(&bar[XB_XCNT(j)]); sum += c; cnt += (c > 0u) ? 1u : 0u; mine = (j == x) ? c : mine; }
        if (sum == G) break;
        __builtin_amdgcn_s_sleep(1);
        if ((++sp & 255u) == 0u) { if (xb_ld(&bar[XB_TMO])) break; if (sp > XB_SPIN_CAP) { atomicAdd(&bar[XB_TMO], 1u); break; } }
    }
    nloc = mine > 0u ? mine : 1u; nx = cnt > 0u ? cnt : 1u;
}

__device__ __forceinline__ void xcd_barrier(const XcdBarrier& b) {
    asm volatile("s_waitcnt vmcnt(0)" ::: "memory");
    __syncthreads();
    if (threadIdx.x == 0) {
        unsigned* bar = b.bar;
        __builtin_amdgcn_s_waitcnt(0);
        unsigned nloc = b.st[0], nx = b.st[1];
        if (nloc == 0u) { xcd_barrier_complete(bar, b.x, nloc, nx); b.st[0] = nloc; b.st[1] = nx; }
        const unsigned old = xb_add(&bar[XB_XSUB(b.x)], 1u);
        const unsigned gen = old / nloc;
        if (old + 1u == (gen + 1u) * nloc) {
            __builtin_amdgcn_fence(__ATOMIC_RELEASE, "agent");
            asm volatile("s_waitcnt vmcnt(0)" ::: "memory");
            const unsigned og = xb_add(&bar[XB_TOP], 1u);
            const unsigned tg = og / nx;
            if (og + 1u == (tg + 1u) * nx) xb_add(&bar[XB_TOPGEN], 1u);
            else XB_SPIN(xb_ld(&bar[XB_TOPGEN]) == tg, bar);
            __builtin_amdgcn_fence(__ATOMIC_ACQUIRE, "agent");
            xb_add(&bar[XB_XGEN(b.x)], 1u);
            asm volatile("s_waitcnt vmcnt(0)" ::: "memory");
        } else {
            XB_SPIN(xb_ld(&bar[XB_XGEN(b.x)]) == gen, bar);
            __builtin_amdgcn_fence(__ATOMIC_ACQUIRE, "agent");
            asm volatile("s_waitcnt vmcnt(0)" ::: "memory");
        }
    }
    __syncthreads();
}
constexpr int NWAVES = 8;
#ifndef REP_SCAN
#define REP_SCAN 1
#endif
#ifndef REP_ATTN
#define REP_ATTN 1
#endif
#ifndef REP_PASS
#define REP_PASS 1
#endif
#ifndef REP_OG
#define REP_OG 1
#endif
#ifndef REP_SYNC
#define REP_SYNC 0
#endif
#ifndef REP_G1
#define REP_G1 1
#endif
constexpr int BATCH = 2, SEQ = 16384, D = 1024, M = BATCH * SEQ;
constexpr size_t MiB = 1u << 20;
constexpr size_t WS_ROPE_C = 1 * MiB, WS_ROPE_S = 2 * MiB, WS_S = 3 * MiB, WS_BIAS = 5 * MiB, WS_W = 6 * MiB, WS_U = 32 * MiB, UNIT = 64 * MiB, WS_H = WS_U + 7 * UNIT, WS_END = WS_H + 16 * MiB;
constexpr size_t W_FOLD = 0, W_UP = 17 * MiB, W_OUT = 19 * MiB;
constexpr size_t W_PROJ = 0, W_BOUT = 8 * MiB;
constexpr int LDS_BYTES = 147456;
constexpr float C2F = 0.125f * 1.4426950408889634f;
#ifdef ATTN_D64
#define QSCALE_MASK0 0x4
#define QSCALE_MASK1 0x1
#else
#define QSCALE_MASK0 0x0
#define QSCALE_MASK1 0x0
#endif

typedef _Float16 h16x4 __attribute__((ext_vector_type(4)));
typedef unsigned u32x2 __attribute__((ext_vector_type(2)));
typedef float f32x2 __attribute__((ext_vector_type(2)));
__device__ __forceinline__ unsigned f2bf(float f) { unsigned u = __builtin_bit_cast(unsigned, f); return (u + 0x7fffu + ((u >> 16) & 1u)) >> 16; }
__device__ __forceinline__ unsigned pk2(float lo, float hi) { return f2bf(lo) | (f2bf(hi) << 16); }
__device__ __forceinline__ float bflo(unsigned w) { return __uint_as_float(w << 16); }
__device__ __forceinline__ float bfhi(unsigned w) { return __uint_as_float(w & 0xffff0000u); }
__device__ __forceinline__ float wave_sum(float v) {
#pragma unroll
    for (int o = 1; o < 64; o <<= 1) v += __shfl_xor(v, o);
    return v;
}
template <int CTRL> __device__ __forceinline__ float dpp_mov(float x) { return __builtin_bit_cast(float, __builtin_amdgcn_update_dpp(0, __builtin_bit_cast(int, x), CTRL, 0xf, 0xf, false)); }
__device__ __forceinline__ float allreduce16(float x) { x += dpp_mov<0x128>(x); x += dpp_mov<0x124>(x); x += dpp_mov<0x122>(x); x += dpp_mov<0x121>(x); return x; }

__device__ __forceinline__ void conv_tile(const float* src, int ldsrc, int k0s, int n0s, int kvalid, const float* sc, int smode, bf16* dst, int pitch, int n0d, int k0d, LAS float* scr, int lane) {
#pragma unroll 8
    for (int i = 0; i < 32; ++i) { const int kk = 2 * i + (lane >> 5), n = lane & 31; float v = 0.f;
        if (kk < kvalid) { v = src[(size_t)(k0s + kk) * ldsrc + n0s + n]; if (smode) { const float s = sc[k0s + kk]; v *= (smode == 1) ? s : (1.0f - s); } }
        scr[kk * 33 + n] = v; }
    LDS_WAIT(); asm volatile("" ::: "memory");
    const int c = lane & 7;
#pragma unroll
    for (int j = 0; j < 4; ++j) { const int n = (lane >> 3) + 8 * j; const LAS float* s = scr + (8 * c) * 33 + n;
        v4u o; o.x = pk2(s[0 * 33], s[1 * 33]); o.y = pk2(s[2 * 33], s[3 * 33]); o.z = pk2(s[4 * 33], s[5 * 33]); o.w = pk2(s[6 * 33], s[7 * 33]);
        *(v4u*)(dst + (size_t)(n0d + n) * pitch + k0d + 8 * c) = o; }
    LDS_WAIT(); asm volatile("" ::: "memory");
}

struct In {
    const float* x; const int* pos; const float *a_norm, *a_mu, *a_w_in, *a_w0, *a_w1, *a_w2, *a_a0, *a_a1, *a_a2, *a_v0, *a_v1, *a_v2, *a_k_k, *a_k_a, *a_r_k, *a_ln_w, *a_ln_b, *a_w_out;
    const float *kv_norm, *w_kv, *b_norm, *b_w_in, *b_lq1, *b_lk1, *b_lq2, *b_lk2, *b_subln, *b_w_out, *final_norm;
};

__device__ __forceinline__ void conv_rwkv(const In& I, int l, unsigned char* wreg, float* bias3, LAS float* scr, int gw, int NGW, int lane) {
    if (gw < 48) { const int i = gw * 64 + lane; const int t = i >> 10, c = i & 1023; bias3[i] = (t == 0) ? I.a_w0[l * 1024 + c] : (t == 1) ? I.a_a0[l * 1024 + c] : I.a_v0[c]; }
    bf16* Wf = (bf16*)(wreg + W_FOLD); bf16* Wu = (bf16*)(wreg + W_UP); bf16* Wo = (bf16*)(wreg + W_OUT);
    const int NUPB = (l == 0 ? 2048 : 3072) / 32;
    const int I_F = 136 * 32, I_U = NUPB * 4, I_O = 32 * 16;
    for (int it = gw; it < I_F + I_U + I_O; it += NGW) {
        int r = it;
        if (r < I_F) { const int nb = r >> 5, kb = r & 31; const int n0d = nb * 32, k0d = kb * 64, half = kb >> 4, k0s = (kb & 15) * 64;
            const float* mu = I.a_mu + (size_t)l * 6 * 1024;
            if (n0d < 4096) { const int p = n0d >> 10; conv_tile(I.a_w_in + (size_t)(l * 4 + p) * 1024 * 1024, 1024, k0s, n0d & 1023, 64, mu + p * 1024, half ? 1 : 2, Wf, 2048, n0d, k0d, scr, lane); }
            else { const int c0 = n0d - 4096;
                if (c0 < 64) conv_tile(I.a_w1 + (size_t)l * 1024 * 64, 64, k0s, c0, 64, mu + 4 * 1024, half ? 1 : 2, Wf, 2048, n0d, k0d, scr, lane);
                else if (c0 < 128) conv_tile(I.a_a1 + (size_t)l * 1024 * 64, 64, k0s, c0 - 64, 64, mu + 5 * 1024, half ? 1 : 2, Wf, 2048, n0d, k0d, scr, lane);
                else if (c0 < 160 && l == 1) conv_tile(I.a_v1, 32, k0s, 0, 64, mu + 2 * 1024, half ? 1 : 2, Wf, 2048, n0d, k0d, scr, lane);
                else conv_tile(I.a_w1, 64, 0, 0, 0, mu, 0, Wf, 2048, n0d, k0d, scr, lane); }
            continue; }
        r -= I_F;
        if (r < I_U) { const int nb = r >> 2, kb = r & 3; const int n0d = nb * 32, k0d = kb * 64, t = n0d >> 10;
            if (kb == t) { if (t == 0) conv_tile(I.a_w2 + (size_t)l * 64 * 1024, 1024, 0, n0d, 64, I.a_mu, 0, Wu, 256, n0d, k0d, scr, lane);
                else if (t == 1) conv_tile(I.a_a2 + (size_t)l * 64 * 1024, 1024, 0, n0d - 1024, 64, I.a_mu, 0, Wu, 256, n0d, k0d, scr, lane);
                else conv_tile(I.a_v2, 1024, 0, n0d - 2048, 32, I.a_mu, 0, Wu, 256, n0d, k0d, scr, lane); }
            else conv_tile(I.a_w2, 1024, 0, 0, 0, I.a_mu, 0, Wu, 256, n0d, k0d, scr, lane);
            continue; }
        r -= I_U;
        { const int nb = r >> 4, kb = r & 15; conv_tile(I.a_w_out + (size_t)l * 1024 * 1024, 1024, kb * 64, nb * 32, 64, I.a_mu, 0, Wo, 1024, nb * 32, kb * 64, scr, lane); }
    }
}
__device__ __forceinline__ void conv_attn(const In& I, int j, unsigned char* wreg, LAS float* scr, int gw, int NGW, int lane) {
    bf16* Wp = (bf16*)(wreg + W_PROJ); bf16* Wo = (bf16*)(wreg + W_BOUT);
    const int NPB = (j == 0 ? 4096 : 2048) / 32;
    const int I_P = NPB * 16, I_O = 32 * 16;
    for (int it = gw; it < I_P + I_O; it += NGW) {
        int r = it;
        if (r < I_P) { const int nb = r >> 4, kb = r & 15; const int n0d = nb * 32, k0 = kb * 64;
            if (j == 0) { if (n0d < 2048) conv_tile(I.w_kv, 2048, k0, n0d, 64, I.kv_norm, 1, Wp, 1024, n0d, k0, scr, lane);
                else conv_tile(I.b_w_in, 2048, k0, n0d - 2048, 64, I.b_norm, 1, Wp, 1024, n0d, k0, scr, lane); }
            else conv_tile(I.b_w_in + (size_t)1024 * 2048, 2048, k0, n0d, 64, I.b_norm + 1024, 1, Wp, 1024, n0d, k0, scr, lane);
            continue; }
        r -= I_P;
        { const int nb = r >> 4, kb = r & 15; conv_tile(I.b_w_out + (size_t)j * 1024 * 1024, 1024, kb * 64, nb * 32, 64, I.kv_norm, 0, Wo, 1024, nb * 32, kb * 64, scr, lane); }
    }
}

__device__ __forceinline__ void rope_tables(const int* pos, float* rc, float* rs, int gtid, int nthr) {
    for (int idx = gtid; idx < M * 8; idx += nthr) { const int m = idx >> 3, i = idx & 7;
        const float inv = (i == 0) ? 1.0f : (i == 1) ? 0.1939227432012558f : (i == 2) ? 0.03760603070259094f : (i == 3) ? 0.007292664609849453f : (i == 4) ? 0.0014142135623842478f : (i == 5) ? 0.00027424818836152554f : (i == 6) ? 5.3182957344688475e-05f : 1.0313385246263351e-05f;
        const float ang = (float)pos[m] * inv;
        const double x = (double)ang; const double k = __builtin_rint(x * 0.15915494309189535); const double r = x - k * 6.283185307179586476925;
        const double r2 = r * r; double sn = 0.0, cs = 0.0;
#pragma unroll
        for (int t = 12; t >= 1; --t) { sn = (1.0 - sn) * r2 / (double)((2 * t) * (2 * t + 1)); cs = (1.0 - cs) * r2 / (double)((2 * t - 1) * (2 * t)); }
        rs[idx] = (float)(r * (1.0 - sn)); rc[idx] = (float)(1.0 - cs); }
}

__device__ __forceinline__ void pre_rwkv(const float* x, const float* g, bf16* XN2, int gw, int NGW, int lane) {
    f32x4 gv[4];
#pragma unroll
    for (int j = 0; j < 4; ++j) gv[j] = *((const f32x4*)g + lane + 64 * j);
    for (int c = gw; c < M / 16; c += NGW) { const int m0 = c * 16;
        f32x4 prev[4];
#pragma unroll
        for (int j = 0; j < 4; ++j) prev[j] = (f32x4){0.f, 0.f, 0.f, 0.f};
        if ((m0 % SEQ) != 0) { const f32x4* xr = (const f32x4*)(x + (size_t)(m0 - 1) * D) + lane; f32x4 v[4]; float s = 0.f;
#pragma unroll
            for (int j = 0; j < 4; ++j) { v[j] = xr[64 * j]; s += (v[j].x * v[j].x + v[j].y * v[j].y) + (v[j].z * v[j].z + v[j].w * v[j].w); }
            const float rstd = 1.0f / sqrtf(wave_sum(s) * (1.0f / D) + 1e-6f);
#pragma unroll
            for (int j = 0; j < 4; ++j) prev[j] = v[j] * rstd * gv[j]; }
        for (int r = 0; r < 16; ++r) { const int m = m0 + r; const f32x4* xr = (const f32x4*)(x + (size_t)m * D) + lane; f32x4 v[4]; float s = 0.f;
#pragma unroll
            for (int j = 0; j < 4; ++j) { v[j] = xr[64 * j]; s += (v[j].x * v[j].x + v[j].y * v[j].y) + (v[j].z * v[j].z + v[j].w * v[j].w); }
            const float rstd = 1.0f / sqrtf(wave_sum(s) * (1.0f / D) + 1e-6f);
            unsigned long long* o8 = (unsigned long long*)(XN2 + (size_t)m * 2048) + lane;
#pragma unroll
            for (int j = 0; j < 4; ++j) { const f32x4 xn = v[j] * rstd * gv[j];
                o8[64 * j] = (unsigned long long)pk2(xn.x, xn.y) | ((unsigned long long)pk2(xn.z, xn.w) << 32);
                o8[256 + 64 * j] = (unsigned long long)pk2(prev[j].x, prev[j].y) | ((unsigned long long)pk2(prev[j].z, prev[j].w) << 32);
                prev[j] = xn; } }
    }
}
__device__ __forceinline__ void pre_attn(const float* x, bf16* XH, int gw, int NGW, int lane) {
    for (int m = gw; m < M; m += NGW) { const f32x4* xr = (const f32x4*)(x + (size_t)m * D) + lane; f32x4 v[4]; float s = 0.f;
#pragma unroll
        for (int j = 0; j < 4; ++j) { v[j] = xr[64 * j]; s += (v[j].x * v[j].x + v[j].y * v[j].y) + (v[j].z * v[j].z + v[j].w * v[j].w); }
        const float rstd = 1.0f / sqrtf(wave_sum(s) * (1.0f / D) + 1e-6f);
        unsigned long long* o8 = (unsigned long long*)(XH + (size_t)m * D) + lane;
#pragma unroll
        for (int j = 0; j < 4; ++j) o8[64 * j] = (unsigned long long)pk2(v[j].x * rstd, v[j].y * rstd) | ((unsigned long long)pk2(v[j].z * rstd, v[j].w * rstd) << 32); }
}
__device__ __forceinline__ void final_norm_rows(const float* x, const float* g, float* out, int gw, int NGW, int lane) {
    f32x4 gv[4];
#pragma unroll
    for (int j = 0; j < 4; ++j) gv[j] = *((const f32x4*)g + lane + 64 * j);
    for (int m = gw; m < M; m += NGW) { const f32x4* xr = (const f32x4*)(x + (size_t)m * D) + lane; f32x4 v[4]; float s = 0.f;
#pragma unroll
        for (int j = 0; j < 4; ++j) { v[j] = xr[64 * j]; s += (v[j].x * v[j].x + v[j].y * v[j].y) + (v[j].z * v[j].z + v[j].w * v[j].w); }
        const float rstd = 1.0f / sqrtf(wave_sum(s) * (1.0f / D) + 1e-6f);
        f32x4* o = (f32x4*)(out + (size_t)m * D) + lane;
#pragma unroll
        for (int j = 0; j < 4; ++j) o[64 * j] = v[j] * rstd * gv[j]; }
}

__device__ __forceinline__ void ld16bf(const bf16* p, float (&f)[16]) { const v4u a = *(const v4u*)p, b = *(const v4u*)(p + 8);
    f[0] = bflo(a.x); f[1] = bfhi(a.x); f[2] = bflo(a.y); f[3] = bfhi(a.y); f[4] = bflo(a.z); f[5] = bfhi(a.z); f[6] = bflo(a.w); f[7] = bfhi(a.w);
    f[8] = bflo(b.x); f[9] = bfhi(b.x); f[10] = bflo(b.y); f[11] = bfhi(b.y); f[12] = bflo(b.z); f[13] = bfhi(b.z); f[14] = bflo(b.w); f[15] = bfhi(b.w); }
__device__ __forceinline__ void st16bf(bf16* p, const float (&f)[16]) { v4u a, b;
    a.x = pk2(f[0], f[1]); a.y = pk2(f[2], f[3]); a.z = pk2(f[4], f[5]); a.w = pk2(f[6], f[7]); b.x = pk2(f[8], f[9]); b.y = pk2(f[10], f[11]); b.z = pk2(f[12], f[13]); b.w = pk2(f[14], f[15]);
    *(v4u*)p = a; *(v4u*)(p + 8) = b; }

__device__ __forceinline__ void post_rwkv(const bf16* Y, const float* S, const bf16* V, const bf16* G, const float* ln_w, const float* ln_b, bf16* O, int gw, int NGW, int lane) {
    float lw[16], lb[16];
#pragma unroll
    for (int i = 0; i < 16; ++i) { lw[i] = ln_w[lane * 16 + i]; lb[i] = ln_b[lane * 16 + i]; }
    for (int m = gw; m < M; m += NGW) { const size_t off = (size_t)m * D + lane * 16;
        float y[16], v[16], g[16], o[16]; ld16bf(Y + off, y); ld16bf(V + off, v); ld16bf(G + off, g);
        const float sb = S[(size_t)m * 16 + (lane >> 2)];
        float sum = 0.f;
#pragma unroll
        for (int i = 0; i < 16; ++i) sum += y[i];
        sum += __shfl_xor(sum, 1); sum += __shfl_xor(sum, 2);
        const float mean = sum * (1.0f / 64.0f); float q = 0.f;
#pragma unroll
        for (int i = 0; i < 16; ++i) { const float d = y[i] - mean; q += d * d; }
        q += __shfl_xor(q, 1); q += __shfl_xor(q, 2);
        const float rstd = 1.0f / sqrtf(q * (1.0f / 64.0f) + 64e-5f);
#pragma unroll
        for (int i = 0; i < 16; ++i) { const float yn = (y[i] - mean) * rstd * lw[i] + lb[i]; o[i] = (yn + sb * v[i]) * (g[i] / (1.0f + __expf(-g[i]))); }
        st16bf(O + off, o); }
}
__device__ __forceinline__ void post_attn(const bf16* O0, const bf16* O1, const bf16* GT, const float* subln, float lam, float lam_init, bf16* O, int gw, int NGW, int lane) {
    float sw[16];
#pragma unroll
    for (int i = 0; i < 16; ++i) sw[i] = subln[(lane & 7) * 16 + i] * (1.0f - lam_init);
    for (int m = gw; m < M; m += NGW) { const size_t off = (size_t)m * D + lane * 16;
        float a[16], b[16], g[16], o[16]; ld16bf(O0 + off, a); ld16bf(O1 + off, b); ld16bf(GT + off, g);
        float q = 0.f;
#pragma unroll
        for (int i = 0; i < 16; ++i) { o[i] = a[i] - lam * b[i]; q += o[i] * o[i]; }
        q += __shfl_xor(q, 1); q += __shfl_xor(q, 2); q += __shfl_xor(q, 4);
        const float rstd = 1.0f / sqrtf(q * (1.0f / 128.0f) + 1e-5f);
#pragma unroll
        for (int i = 0; i < 16; ++i) o[i] = o[i] * rstd * sw[i] * (g[i] / (1.0f + __expf(-g[i])));
        st16bf(O + off, o); }
}

constexpr int SC_T = 32, SC_NB = SEQ / SC_T, SC_OPS = SC_T * 320, SC_VB = SC_T * 8, SC_YP = SC_T * 128;
struct ScRaw { u32x2 r, k, w, a; };
__device__ __forceinline__ void scan_phase(LAS unsigned char* lds, const bf16* R, const bf16* K, const bf16* V, const _Float16* W, const _Float16* A, const float* k_k, const float* k_a, const float* r_k,
                                           bf16* Y, float* S, int vcu, int G, int tid, int wave, int lane) {
    LAS float* OPS = (LAS float*)lds;
    LAS float* VB = (LAS float*)(lds + 2 * SC_OPS * 4);
    LAS float* YP = (LAS float*)(lds + 2 * SC_OPS * 4 + 2 * SC_VB * 4);
    for (int u = vcu; u < 256; u += G) {
        const int bh = u >> 3, rg = u & 7, b = bh >> 4, h = bh & 15;
        const size_t rowbase = (size_t)b * SEQ; const int cb = h * 64;
        const int pw = (wave == 2) ? 0 : (wave == 3) ? 1 : (wave == 6) ? 2 : 3;
        const int p = pw * 64 + lane, ptt = p >> 4, c4 = (p & 15) * 4;
        f32x4 kkw = {0.f, 0.f, 0.f, 0.f}, kaw = kkw, rkw = kkw;
        ScRaw rawA0, rawA1, rawB0, rawB1; rawA0.r = (u32x2){0u, 0u}; rawA0.k = rawA0.r; rawA0.w = rawA0.r; rawA0.a = rawA0.r; rawA1 = rawA0; rawB0 = rawA0; rawB1 = rawA0;
        v4u rawvA = {0u, 0u, 0u, 0u}, rawvB = rawvA;
        const bool prod = (wave == 2 || wave == 3 || wave == 6 || wave == 7), vld = (wave == 2 && lane < 32), ywr = (wave == 7), cons = (wave < 2);
        if (prod) { kkw = *(const f32x4*)(k_k + cb + c4); kaw = *(const f32x4*)(k_a + cb + c4); rkw = *(const f32x4*)(r_k + cb + c4); }
        const int jq = lane & 15, rl = wave * 4 + (lane >> 4);
        f32x2 S01 = {0.f, 0.f}, S23 = {0.f, 0.f};
#define SC_LOAD1(raw, nblk, tt_) do { const size_t o_ = (rowbase + (size_t)(nblk) * SC_T + (tt_)) * D + cb + c4; raw.r = *(const u32x2*)(R + o_); raw.k = *(const u32x2*)(K + o_); raw.w = *(const u32x2*)(W + o_); raw.a = *(const u32x2*)(A + o_); } while (0)
#define SC_LOAD(raw0, raw1, rawv, nblk) do { if (prod) { SC_LOAD1(raw0, nblk, ptt); SC_LOAD1(raw1, nblk, ptt + 16); } \
        if (vld) { rawv = *(const v4u*)(V + (rowbase + (size_t)(nblk) * SC_T + lane) * D + cb + rg * 8); } } while (0)
#define SC_DERIVE1(raw, nblk, buf, tt_) do { \
            const float r0 = bflo(raw.r.x), r1 = bfhi(raw.r.x), r2 = bflo(raw.r.y), r3 = bfhi(raw.r.y); \
            const float k0 = bflo(raw.k.x), k1 = bfhi(raw.k.x), k2 = bflo(raw.k.y), k3 = bfhi(raw.k.y); \
            const h16x4 wh = __builtin_bit_cast(h16x4, raw.w), ah = __builtin_bit_cast(h16x4, raw.a); \
            const float a0 = (float)ah[0], a1 = (float)ah[1], a2 = (float)ah[2], a3 = (float)ah[3]; \
            const float x0 = k0 * kkw.x, x1 = k1 * kkw.y, x2 = k2 * kkw.z, x3 = k3 * kkw.w; \
            const float ss = allreduce16((x0 * x0 + x1 * x1) + (x2 * x2 + x3 * x3)); \
            const float inv = 1.0f / fmaxf(sqrtf(ss), 1e-12f); \
            const f32x4 kn = {x0 * inv, x1 * inv, x2 * inv, x3 * inv}; \
            const f32x4 km = {k0 * (1.0f + (a0 - 1.0f) * kaw.x), k1 * (1.0f + (a1 - 1.0f) * kaw.y), k2 * (1.0f + (a2 - 1.0f) * kaw.z), k3 * (1.0f + (a3 - 1.0f) * kaw.w)}; \
            const float sp = allreduce16((r0 * km.x * rkw.x + r1 * km.y * rkw.y) + (r2 * km.z * rkw.z + r3 * km.w * rkw.w)); \
            LAS float* op_ = OPS + (buf) * SC_OPS + (tt_) * 320 + c4; \
            *(LAS f32x4*)(op_) = -kn; \
            *(LAS f32x4*)(op_ + 64) = (f32x4){kn.x * a0, kn.y * a1, kn.z * a2, kn.w * a3}; \
            *(LAS f32x4*)(op_ + 128) = (f32x4){__expf(-__expf((float)wh[0])), __expf(-__expf((float)wh[1])), __expf(-__expf((float)wh[2])), __expf(-__expf((float)wh[3]))}; \
            *(LAS f32x4*)(op_ + 192) = km; \
            *(LAS f32x4*)(op_ + 256) = (f32x4){r0, r1, r2, r3}; \
            if (rg == 0 && c4 == 0) S[(rowbase + (size_t)(nblk) * SC_T + (tt_)) * 16 + h] = sp; } while (0)
#define SC_DERIVE(raw0, raw1, rawv, nblk, buf) do { if (prod) { SC_DERIVE1(raw0, nblk, buf, ptt); SC_DERIVE1(raw1, nblk, buf, ptt + 16); } \
        if (vld) { LAS float* vb_ = VB + (buf) * SC_VB + lane * 8; \
            *(LAS f32x4*)(vb_) = (f32x4){bflo(rawv.x), bfhi(rawv.x), bflo(rawv.y), bfhi(rawv.y)}; *(LAS f32x4*)(vb_ + 4) = (f32x4){bflo(rawv.z), bfhi(rawv.z), bflo(rawv.w), bfhi(rawv.w)}; } } while (0)
#define SC_YOUT1(nblk, buf, tt_) do { const int rp_ = lane & 3; const LAS f32x4* yp_ = (const LAS f32x4*)(YP + (buf) * SC_YP + ((tt_) * 8 + 2 * rp_) * 16); \
            const f32x4 q0 = yp_[0], q1 = yp_[1], q2 = yp_[2], q3 = yp_[3], q4 = yp_[4], q5 = yp_[5], q6 = yp_[6], q7 = yp_[7]; \
            const f32x4 e0 = (q0 + q1) + (q2 + q3), e1 = (q4 + q5) + (q6 + q7); \
            const float y0_ = (e0.x + e0.y) + (e0.z + e0.w), y1_ = (e1.x + e1.y) + (e1.z + e1.w); \
            *(unsigned*)(Y + (rowbase + (size_t)(nblk) * SC_T + (tt_)) * D + cb + rg * 8 + 2 * rp_) = pk2(y0_, y1_); } while (0)
#define SC_YOUT(nblk, buf) do { SC_YOUT1(nblk, buf, lane >> 2); SC_YOUT1(nblk, buf, (lane >> 2) + 16); } while (0)
#define SC_LDOPS(N, B, W_, K_, R_, VV, t) do { const LAS float* o_ = ops + (t) * 320; N = *(const LAS f32x4*)(o_); B = *(const LAS f32x4*)(o_ + 64); W_ = *(const LAS f32x4*)(o_ + 128); K_ = *(const LAS f32x4*)(o_ + 192); R_ = *(const LAS f32x4*)(o_ + 256); VV = vb[(t) * 8]; } while (0)
#define SC_CONSUME(buf) do { const LAS float* ops = OPS + (buf) * SC_OPS + 4 * jq; const LAS float* vb = VB + (buf) * SC_VB + rl; LAS float* yp = YP + (buf) * SC_YP + rl * 16 + jq; \
            f32x4 nk, bb, dw, km, rr, nk2, bb2, dw2, km2, rr2; float vi, vi2; SC_LDOPS(nk, bb, dw, km, rr, vi, 0); SC_LDOPS(nk2, bb2, dw2, km2, rr2, vi2, 1); \
            _Pragma("unroll") for (int tt = 0; tt < SC_T; ++tt) { \
                f32x4 nk3 = nk2, bb3 = bb2, dw3 = dw2, km3 = km2, rr3 = rr2; float vi3 = vi2; \
                if (tt + 2 < SC_T) SC_LDOPS(nk3, bb3, dw3, km3, rr3, vi3, tt + 2); \
                asm volatile("" ::: "memory"); \
                const f32x2 t_ = S01 * nk.lo + S23 * nk.hi; \
                const f32x2 P01 = S01 * dw.lo + km.lo * vi, P23 = S23 * dw.hi + km.hi * vi; \
                const float sa = allreduce16(t_.x + t_.y); \
                S01 = P01 + bb.lo * sa; S23 = P23 + bb.hi * sa; \
                const f32x2 y_ = S01 * rr.lo + S23 * rr.hi; \
                yp[tt * 128] = y_.x + y_.y; \
                nk = nk2; bb = bb2; dw = dw2; km = km2; rr = rr2; vi = vi2; nk2 = nk3; bb2 = bb3; dw2 = dw3; km2 = km3; rr2 = rr3; vi2 = vi3; } } while (0)
        SC_LOAD(rawA0, rawA1, rawvA, 0); SC_DERIVE(rawA0, rawA1, rawvA, 0, 0); SC_LOAD(rawB0, rawB1, rawvB, 1); SC_LOAD(rawA0, rawA1, rawvA, 2);
        __syncthreads();
        for (int n = 0; n < SC_NB; n += 2) {
            if (cons) { SC_CONSUME(0); }
            else { SC_DERIVE(rawB0, rawB1, rawvB, n + 1, 1); if (n + 3 < SC_NB) SC_LOAD(rawB0, rawB1, rawvB, n + 3);
                if (ywr && n >= 1) SC_YOUT(n - 1, 1); }
            __syncthreads();
            if (cons) { SC_CONSUME(1); }
            else { if (n + 2 < SC_NB) { SC_DERIVE(rawA0, rawA1, rawvA, n + 2, 0); if (n + 4 < SC_NB) SC_LOAD(rawA0, rawA1, rawvA, n + 4); }
                if (ywr) SC_YOUT(n, 0); }
            __syncthreads();
        }
        if (ywr) SC_YOUT(SC_NB - 1, 1);
        __syncthreads();
#undef SC_LOAD1
#undef SC_LOAD
#undef SC_DERIVE1
#undef SC_DERIVE
#undef SC_YOUT1
#undef SC_YOUT
#undef SC_CONSUME
#undef SC_LDOPS
    }
}

struct Args { const void* in[31]; float* out; unsigned char* ws; };
__global__ void __launch_bounds__(NWAVES * 64, 2) mk_fwd(Args args) {
    extern __shared__ __attribute__((aligned(16))) unsigned char lds[];
    cg::grid_group grid = cg::this_grid();
    LAS unsigned char* L = (LAS unsigned char*)lds;
    const int G = gridDim.x; const int bx = blockIdx.x; const int vcu = (G % 8 == 0) ? (bx % 8) * (G / 8) + bx / 8 : bx;
    const int NGW = G * NWAVES;
    { volatile LAS unsigned* st0 = (volatile LAS unsigned*)(L + 131072 + 1024); if (threadIdx.x < 2) st0[threadIdx.x] = 0u; __syncthreads(); }
    const XcdBarrier xbar = xcd_barrier_post((unsigned*)args.ws, (volatile LAS unsigned*)(L + 131072 + 1024));
#define PH_IDS() int tid_ = threadIdx.x; asm volatile("" : "+v"(tid_)); const int tid = tid_, lane = tid & 63, wave = __builtin_amdgcn_readfirstlane(tid >> 6); const int gw = vcu * NWAVES + wave; LAS float* scr = (LAS float*)(L + wave * 16384); (void)scr; (void)gw; (void)lane
    typedef const void* cvp_t; typedef const __attribute__((address_space(4))) cvp_t* kargp_t;
#define KP_(k) (((kargp_t)kp_)[k])
#define PH_PTRS() const __attribute__((address_space(4))) char* kp_ = (const __attribute__((address_space(4))) char*)__builtin_amdgcn_kernarg_segment_ptr(); asm volatile("" : "+s"(kp_)); \
    In I; I.x = (const float*)KP_(0); I.pos = (const int*)KP_(1); I.a_norm = (const float*)KP_(2); I.a_mu = (const float*)KP_(3); I.a_w_in = (const float*)KP_(4); I.a_w0 = (const float*)KP_(5); I.a_w1 = (const float*)KP_(6); I.a_w2 = (const float*)KP_(7); I.a_a0 = (const float*)KP_(8); I.a_a1 = (const float*)KP_(9); I.a_a2 = (const float*)KP_(10); I.a_v0 = (const float*)KP_(11); I.a_v1 = (const float*)KP_(12); I.a_v2 = (const float*)KP_(13); I.a_k_k = (const float*)KP_(14); I.a_k_a = (const float*)KP_(15); I.a_r_k = (const float*)KP_(16); I.a_ln_w = (const float*)KP_(17); I.a_ln_b = (const float*)KP_(18); I.a_w_out = (const float*)KP_(19); I.kv_norm = (const float*)KP_(20); I.w_kv = (const float*)KP_(21); I.b_norm = (const float*)KP_(22); I.b_w_in = (const float*)KP_(23); I.b_lq1 = (const float*)KP_(24); I.b_lk1 = (const float*)KP_(25); I.b_lq2 = (const float*)KP_(26); I.b_lk2 = (const float*)KP_(27); I.b_subln = (const float*)KP_(28); I.b_w_out = (const float*)KP_(29); I.final_norm = (const float*)KP_(30); \
    float* XS = (float*)KP_(31); unsigned char* ws = (unsigned char*)KP_(32); \
    float* rc = (float*)(ws + WS_ROPE_C); float* rs = (float*)(ws + WS_ROPE_S); float* SB = (float*)(ws + WS_S); unsigned char* wreg = ws + WS_W; \
    bf16* U0 = (bf16*)(ws + WS_U); bf16* U1 = (bf16*)(ws + WS_U + UNIT); bf16* U2 = (bf16*)(ws + WS_U + 2 * UNIT); bf16* U3 = (bf16*)(ws + WS_U + 3 * UNIT); \
    bf16* U4 = (bf16*)(ws + WS_U + 4 * UNIT); bf16* U5 = (bf16*)(ws + WS_U + 5 * UNIT); bf16* U6 = (bf16*)(ws + WS_U + 6 * UNIT); bf16* HB = (bf16*)(ws + WS_H); \
    (void)I; (void)XS; (void)rc; (void)rs; (void)SB; (void)wreg; (void)U0; (void)U1; (void)U2; (void)U3; (void)U4; (void)U5; (void)U6; (void)HB

    for (int rp = 0; rp < REP_PASS; ++rp) { PH_IDS(); PH_PTRS(); rope_tables(I.pos, rc, rs, vcu * 512 + tid, G * 512);
    conv_rwkv(I, 0, wreg, (float*)(ws + WS_BIAS), scr, gw, NGW, lane);
    pre_rwkv(I.x, I.a_norm, U0, gw, NGW, lane); }
    grid.sync();

    for (int rp = 0; rp < REP_SYNC; ++rp) xcd_barrier(xbar);
#pragma nounroll
    for (int l = 0; l < 2; ++l) {
#pragma nounroll
        for (int rp = 0; rp < REP_G1; ++rp) {
            if (rp) xcd_barrier(xbar);
            PH_PTRS(); bf16* Vl = (l == 0) ? U4 : U6;
            pg8::Gemm g{U0, (const bf16*)(wreg + W_FOLD), M, 4352, 2048}; pg8::StaticOrder S; S.init(M, 4352, G, bx);
            pg8::EpiFold E{U2, U3, Vl, U5, HB};
            pg8::gemm_phase<pg8::EpiFold, pg8::StaticOrder, true, true>(L, g, S, E);
        }
        xcd_barrier(xbar);
        {
            PH_PTRS(); bf16* Vl = (l == 0) ? U4 : U6;
            const int NUP = (l == 0) ? 2048 : 3072;
            pg8::Gemm g{HB, (const bf16*)(wreg + W_UP), M, NUP, 256}; pg8::StaticOrder S; S.init(M, NUP, G, bx);
            pg8::EpiLoraUp E{(const float*)(ws + WS_BIAS), (_Float16*)U0, (_Float16*)U1, Vl, U4};
            pg8::gemm_phase<pg8::EpiLoraUp, pg8::StaticOrder, true, false>(L, g, S, E);
        }
        xcd_barrier(xbar);
#pragma nounroll
        for (int rp = 0; rp < REP_SCAN; ++rp) { if (rp) xcd_barrier(xbar); PH_IDS(); PH_PTRS(); bf16* Vl = (l == 0) ? U4 : U6; bf16* Yl = (l == 0) ? U6 : U4; scan_phase(L, U2, U3, Vl, (const _Float16*)U0, (const _Float16*)U1, I.a_k_k + l * 1024, I.a_k_a + l * 1024, I.a_r_k + l * 1024, Yl, SB, vcu, G, tid, wave, lane); }
        xcd_barrier(xbar);
        for (int rp = 0; rp < REP_PASS; ++rp) { PH_IDS(); PH_PTRS(); bf16* Vl = (l == 0) ? U4 : U6; bf16* Yl = (l == 0) ? U6 : U4; post_rwkv(Yl, SB, Vl, U5, I.a_ln_w + l * 1024, I.a_ln_b + l * 1024, U2, gw, NGW, lane); }
        xcd_barrier(xbar);
        {
            PH_PTRS(); const float* xin = (l == 0) ? I.x : XS;
            pg8::Gemm g{U2, (const bf16*)(wreg + W_OUT), M, 1024, 1024}; pg8::StaticOrder S; S.init(M, 1024, G, bx);
            pg8::EpiResid E{xin, XS};
            pg8::gemm_phase<pg8::EpiResid, pg8::StaticOrder, true, true>(L, g, S, E);
        }
        xcd_barrier(xbar);
        for (int rp = 0; rp < REP_PASS; ++rp) { PH_IDS(); PH_PTRS(); if (l == 0) { conv_rwkv(I, 1, wreg, (float*)(ws + WS_BIAS), scr, gw, NGW, lane); pre_rwkv(XS, I.a_norm + 1024, U0, gw, NGW, lane); }
        else { conv_attn(I, 0, wreg, scr, gw, NGW, lane); pre_attn(XS, U0, gw, NGW, lane); } }
        xcd_barrier(xbar);
    }

#pragma nounroll
    for (int j = 0; j < 2; ++j) {
        {
            PH_PTRS();
            const int NP = (j == 0) ? 4096 : 2048;
            pg8::Gemm g{U0, (const bf16*)(wreg + W_PROJ), M, NP, 1024}; pg8::StaticOrder S; S.init(M, NP, G, bx);
            pg8::EpiProj E;
            if (j == 0) { E.d0 = U1; E.d1 = U2; E.d2 = U3; E.d3 = U4; E.ropemask = 0x5; E.scalemask = QSCALE_MASK0; }
            else { E.d0 = U3; E.d1 = U4; E.d2 = U3; E.d3 = U4; E.ropemask = 0x1; E.scalemask = QSCALE_MASK1; }
            E.sc = C2F; E.rc = rc; E.rs = rs;
            pg8::gemm_phase<pg8::EpiProj, pg8::StaticOrder, true, true>(L, g, S, E);
        }
        xcd_barrier(xbar);
#pragma nounroll
        for (int rp = 0; rp < REP_ATTN; ++rp) {
            if (rp) xcd_barrier(xbar);
            PH_PTRS();
#ifdef ATTN_D64
            const attn_body::AttnTensors AT{(const attn_body::bf16*)U3, (const attn_body::bf16*)U1, (const attn_body::bf16*)U2, (attn_body::bf16*)U5, (attn_body::bf16*)U6};
            attn_body::attn_phase<8>((char*)lds, AT, vcu, G);
#else
            const attn128::AttnTensors AT{U3, U1, U2, U5, U6};
            attn128::attn_phase((char*)lds, AT, vcu, G);
#endif
        }
        xcd_barrier(xbar);
        for (int rp = 0; rp < REP_PASS; ++rp) {
            PH_IDS(); PH_PTRS();
            const float e1 = __expf(wave_sum(I.b_lq1[j * 64 + lane] * I.b_lk1[j * 64 + lane])), e2 = __expf(wave_sum(I.b_lq2[j * 64 + lane] * I.b_lk2[j * 64 + lane]));
            const float lam_init = (j == 0) ? 0.4707130183435842f : 0.5560582041556406f;
            post_attn(U5, U6, U4, I.b_subln + j * 128, e1 - e2 + lam_init, lam_init, U0, gw, NGW, lane);
        }
        xcd_barrier(xbar);
        {
            PH_PTRS();
            pg8::Gemm g{U0, (const bf16*)(wreg + W_BOUT), M, 1024, 1024}; pg8::StaticOrder S; S.init(M, 1024, G, bx);
            pg8::EpiResid E{XS, XS};
            pg8::gemm_phase<pg8::EpiResid, pg8::StaticOrder, true, true>(L, g, S, E);
        }
        xcd_barrier(xbar);
        if (j == 0) { for (int rp = 0; rp < REP_PASS; ++rp) { PH_IDS(); PH_PTRS(); conv_attn(I, 1, wreg, scr, gw, NGW, lane); pre_attn(XS, U0, gw, NGW, lane); } xcd_barrier(xbar); }
    }
    { PH_IDS(); PH_PTRS(); final_norm_rows(XS, I.final_norm, XS, gw, NGW, lane); }
}

extern "C" void kernel_launch(void* const* d_in, const int* in_sizes, int n_in, void* d_out, int out_size, void* d_ws, size_t ws_size, hipStream_t stream) {
    static int grid = 0;
    if (grid == 0) {
        if (n_in != 31 || in_sizes[0] != M * D || out_size != M * D || ws_size < WS_END) { fprintf(stderr, "kernel_launch: unexpected shapes (n_in %d, in0 %d, out %d, ws %zu < %zu)\n", n_in, n_in > 0 ? in_sizes[0] : -1, out_size, ws_size, (size_t)WS_END); grid = -1; return; }
        int dev = 0, cus = 0, per_cu = 0;
        hipGetDevice(&dev); hipDeviceGetAttribute(&cus, hipDeviceAttributeMultiprocessorCount, dev);
        if (hipFuncSetAttribute((const void*)mk_fwd, hipFuncAttributeMaxDynamicSharedMemorySize, LDS_BYTES) != hipSuccess) { fprintf(stderr, "kernel_launch: hipFuncSetAttribute failed\n"); grid = -1; return; }
        if (hipOccupancyMaxActiveBlocksPerMultiprocessor(&per_cu, (const void*)mk_fwd, NWAVES * 64, LDS_BYTES) != hipSuccess || per_cu < 1) { fprintf(stderr, "kernel_launch: occupancy query says %d\n", per_cu); per_cu = 1; }
        (void)hipGetLastError();
        grid = cus;
    }
    if (grid < 0) return;
    if (hipMemsetAsync(d_ws, 0, 16384, stream) != hipSuccess) { fprintf(stderr, "kernel_launch: memset of the barrier words failed\n"); return; }
    Args a{};
    for (int i = 0; i < 31; ++i) a.in[i] = d_in[i];
    a.out = (float*)d_out; a.ws = (unsigned char*)d_ws;
    void* kargs[] = {&a};
    hipError_t e = hipLaunchCooperativeKernel((const void*)mk_fwd, dim3(grid), dim3(NWAVES * 64), kargs, LDS_BYTES, stream);
    if (e != hipSuccess) fprintf(stderr, "kernel_launch: cooperative launch failed: %s (grid %d)\n", hipGetErrorString(e), grid);
}
```

```cpp
#include <hip/hip_runtime.h>
#include <hip/hip_cooperative_groups.h>
#include <cstdio>
#include <cstdint>
namespace cg = cooperative_groups;
namespace pg8 {
#define PG8_LAS __attribute__((address_space(3)))
typedef unsigned short bf16_t;
typedef short bf16x8 __attribute__((ext_vector_type(8)));
typedef float f32x4 __attribute__((ext_vector_type(4)));
typedef unsigned u32x4 __attribute__((ext_vector_type(4)));
constexpr int BM = 256, BK = 64, HALF = 128, HTB = HALF * BK * 2  , STAGE_BYTES = 8 * HTB, NXCD = 8, WGM = 8;

__host__ __device__ __forceinline__ int lds_byte(int r, int c) { const int st = (r >> 4) * 2 + (c >> 5), rr = r & 15, cc = c & 31, ob = rr * 64 + cc * 2; return st * 1024 + (ob ^ (((ob >> 9) & 1) << 5)); }
__host__ __device__ __forceinline__ void stage_rc(int b, int& R, int& C) { const int st = b / 1024, sb = b % 1024, swz = sb ^ (((sb >> 9) & 1) << 5); R = (st >> 1) * 16 + swz / 64; C = (st & 1) * 32 + (swz % 64) / 2; }
__host__ __device__ __forceinline__ int perm32(int rho) { const int n = rho >> 4, i = rho & 15; return 8 * (i >> 2) + 4 * n + (i & 3); }

struct Unit { int pm, pn; };
struct Gemm { const bf16_t* A; const bf16_t* Bt; int M, N, K; };

struct StaticOrder {
    int nM, nN, nwg, G, c;
    __host__ __device__ void init(int M, int N, int G_, int c_) { nM = M / BM; nN = N / BM; nwg = nM * nN; G = G_; c = c_; }
    __host__ __device__ bool next(int i, Unit& u) const {
        const long L = (long)i * G + c; if (L >= nwg) return false;
        int wgid = (int)L; { const int q = nwg / NXCD, r = nwg % NXCD, xcd = wgid % NXCD, off = wgid / NXCD; wgid = (xcd < r ? xcd * (q + 1) : r * (q + 1) + (xcd - r) * q) + off; }
        const int nig = WGM * nN, gid = wgid / nig, fm = gid * WGM, gsz = (nM - fm) < WGM ? (nM - fm) : WGM;
        u.pm = fm + ((wgid % nig) % gsz); u.pn = (wgid % nig) / gsz; return true;
    }
    __device__ __forceinline__ void a_ready(const Unit&) const {}
    __device__ __forceinline__ void done(const Unit&) const {}
};

__device__ __forceinline__ unsigned cvt_pk_bf16(float lo, float hi) { unsigned r; asm volatile("v_cvt_pk_bf16_f32 %0, %1, %2" : "=v"(r) : "v"(lo), "v"(hi)); return r; }
typedef float f32x2 __attribute__((ext_vector_type(2)));
typedef _Float16 h16x4 __attribute__((ext_vector_type(4)));
typedef unsigned u32x2 __attribute__((ext_vector_type(2)));
__device__ __forceinline__ float sigmoidf_(float z) { return 1.0f / (1.0f + __expf(-z)); }
__device__ __forceinline__ float tanhf_(float x) { const float t = __expf(-2.0f * fabsf(x)); const float r = (1.0f - t) / (1.0f + t); return x < 0.f ? -r : r; }
__device__ __forceinline__ float bf_lo(unsigned w) { return __uint_as_float(w << 16); }
__device__ __forceinline__ float bf_hi(unsigned w) { return __uint_as_float(w & 0xffff0000u); }

struct EpiFold {
    static constexpr bool PERM = true, AFTER_DRAIN = false;
    bf16_t *R, *Kb, *V, *G, *H;
    __device__ __forceinline__ void operator()(const f32x4 (&acc)[2][2][4][2], const Unit& u, int wr, int wc, int fr, int fq) const {
        const int row0 = u.pm * BM + wr * 64 + fr;
        const int t = u.pn >> 2;
        bf16_t* base; int ldc, colt;
        if (u.pn < 16) { base = (t == 0) ? R : (t == 1) ? Kb : (t == 2) ? V : G; ldc = 1024; colt = (u.pn & 3) * 256; }
        else { base = H; ldc = 256; colt = 0; }
        const int col0 = colt + wc * 32 + 8 * fq;
        const bool th = (u.pn == 16) && (wc < 2);
#pragma unroll
        for (int ai = 0; ai < 2; ++ai)
#pragma unroll
            for (int m = 0; m < 4; ++m) { bf16_t* rowp = base + (size_t)(row0 + ai * HALF + m * 16) * ldc + col0;
#pragma unroll
                for (int bj = 0; bj < 2; ++bj) { f32x4 v0 = acc[ai][bj][m][0], v1 = acc[ai][bj][m][1];
                    if (th && bj == 0) {
#pragma unroll
                        for (int i = 0; i < 4; ++i) { v0[i] = tanhf_(v0[i]); v1[i] = tanhf_(v1[i]); } }
                    u32x4 w; w.x = cvt_pk_bf16(v0[0], v0[1]); w.y = cvt_pk_bf16(v0[2], v0[3]); w.z = cvt_pk_bf16(v1[0], v1[1]); w.w = cvt_pk_bf16(v1[2], v1[3]);
                    *(u32x4*)(rowp + bj * HALF) = w; }
                asm volatile("" ::: "memory"); }
    }
};

struct EpiLoraUp {
    static constexpr bool PERM = false, AFTER_DRAIN = false;
    const float* bias3; _Float16 *Wb, *Ab; bf16_t* Vb; const bf16_t* Vf;
    __device__ __forceinline__ void operator()(const f32x4 (&acc)[2][2][4][2], const Unit& u, int wr, int wc, int fr_unused, int fq_unused) const {
        int t_ = threadIdx.x; asm volatile("" : "+v"(t_)); const int fr = t_ & 15, fq = (t_ >> 4) & 3;
        const int row0 = u.pm * BM + wr * 64 + fr;
        const int t = u.pn >> 2;
        const int cc0 = (u.pn & 3) * 256 + wc * 32 + 4 * fq;
        const float* bias = bias3 + t * 1024;
#pragma unroll
        for (int bj = 0; bj < 2; ++bj)
#pragma unroll
            for (int n = 0; n < 2; ++n) { const int c = cc0 + bj * HALF + n * 16; const f32x4 bv = *(const f32x4*)(bias + c);
#pragma unroll
                for (int ai = 0; ai < 2; ++ai)
#pragma unroll
                    for (int m = 0; m < 4; ++m) { const size_t off = (size_t)(row0 + ai * HALF + m * 16) * 1024 + c; const f32x4 z = acc[ai][bj][m][n] + bv;
                        if (t == 0) { h16x4 o;
#pragma unroll
                            for (int i = 0; i < 4; ++i) { const float zz = -z[i]; const float sp = fmaxf(zz, 0.f) + __logf(1.0f + __expf(-fabsf(zz))); o[i] = (_Float16)(-sp - 0.5f); }
                            *(h16x4*)(Wb + off) = o; }
                        else if (t == 1) { h16x4 o;
#pragma unroll
                            for (int i = 0; i < 4; ++i) o[i] = (_Float16)sigmoidf_(z[i]);
                            *(h16x4*)(Ab + off) = o; }
                        else { const u32x2 vv = *(const u32x2*)(Vb + off), vf = *(const u32x2*)(Vf + off);
                            const float v_0 = bf_lo(vv.x), v_1 = bf_hi(vv.x), v_2 = bf_lo(vv.y), v_3 = bf_hi(vv.y);
                            const float f_0 = bf_lo(vf.x), f_1 = bf_hi(vf.x), f_2 = bf_lo(vf.y), f_3 = bf_hi(vf.y);
                            u32x2 o; o.x = cvt_pk_bf16(v_0 + (f_0 - v_0) * sigmoidf_(z[0]), v_1 + (f_1 - v_1) * sigmoidf_(z[1]));
                            o.y = cvt_pk_bf16(v_2 + (f_2 - v_2) * sigmoidf_(z[2]), v_3 + (f_3 - v_3) * sigmoidf_(z[3]));
                            *(u32x2*)(Vb + off) = o; }
                        asm volatile("" ::: "memory"); } }
    }
};

struct EpiProj {
    static constexpr bool PERM = true, AFTER_DRAIN = false;
    bf16_t *d0, *d1, *d2, *d3; int ropemask, scalemask; float sc; const float* rc; const float* rs;
    __device__ __forceinline__ void operator()(const f32x4 (&acc)[2][2][4][2], const Unit& u, int wr, int wc, int fr, int fq) const {
        const int row0 = u.pm * BM + wr * 64 + fr;
        const int t = u.pn >> 2;
        bf16_t* base = (t == 0) ? d0 : (t == 1) ? d1 : (t == 2) ? d2 : d3;
        const int col0 = (u.pn & 3) * 256 + wc * 32 + 8 * fq;
        const bool rope = (((ropemask >> t) & 1) != 0) && ((wc & 1) == 0);
        const float s = ((scalemask >> t) & 1) ? sc : 1.0f;
        const float sgn = (fq == 0) ? -1.0f : 1.0f;
#pragma unroll
        for (int ai = 0; ai < 2; ++ai)
#pragma unroll
            for (int m = 0; m < 4; ++m) { const int row = row0 + ai * HALF + m * 16; bf16_t* rowp = base + (size_t)row * 1024 + col0;
                f32x4 c0 = {1.f, 1.f, 1.f, 1.f}, c1 = c0, s0 = {0.f, 0.f, 0.f, 0.f}, s1 = s0;
                if (rope) { c0 = *(const f32x4*)(rc + (size_t)row * 8); c1 = *(const f32x4*)(rc + (size_t)row * 8 + 4); s0 = *(const f32x4*)(rs + (size_t)row * 8); s1 = *(const f32x4*)(rs + (size_t)row * 8 + 4); }
#pragma unroll
                for (int bj = 0; bj < 2; ++bj) { f32x4 v0 = acc[ai][bj][m][0], v1 = acc[ai][bj][m][1];
                    if (rope) { f32x4 p0, p1;
#pragma unroll
                        for (int i = 0; i < 4; ++i) { p0[i] = __shfl_xor(v0[i], 16); p1[i] = __shfl_xor(v1[i], 16); }
                        if (fq < 2) { v0 = v0 * c0 + (p0 * s0) * sgn; v1 = v1 * c1 + (p1 * s1) * sgn; } }
                    v0 = v0 * s; v1 = v1 * s;
                    u32x4 w; w.x = cvt_pk_bf16(v0[0], v0[1]); w.y = cvt_pk_bf16(v0[2], v0[3]); w.z = cvt_pk_bf16(v1[0], v1[1]); w.w = cvt_pk_bf16(v1[2], v1[3]);
                    *(u32x4*)(rowp + bj * HALF) = w; }
                asm volatile("" ::: "memory"); }
    }
};

struct EpiResid {
    static constexpr bool PERM = false, AFTER_DRAIN = false;
    const float* base; float* out;
    __device__ __forceinline__ void operator()(const f32x4 (&acc)[2][2][4][2], const Unit& u, int wr, int wc, int fr, int fq) const {
        const int row0 = u.pm * BM + wr * 64 + fr;
        const int col0 = u.pn * BM + wc * 32 + 4 * fq;
#pragma unroll
        for (int ai = 0; ai < 2; ++ai)
#pragma unroll
            for (int m = 0; m < 4; ++m) { const size_t off = (size_t)(row0 + ai * HALF + m * 16) * 1024 + col0;
#pragma unroll
                for (int bj = 0; bj < 2; ++bj)
#pragma unroll
                    for (int n = 0; n < 2; ++n) { const f32x4 b = *(const f32x4*)(base + off + bj * HALF + n * 16); *(f32x4*)(out + off + bj * HALF + n * 16) = b + acc[ai][bj][m][n]; }
                asm volatile("" ::: "memory"); }
    }
};
template <class Epi, class Sched, bool ALIGN_EPI = false, bool SP2 = false>
__device__ __forceinline__ void gemm_phase(PG8_LAS unsigned char* lds, const Gemm g, const Sched& S, const Epi& E) {
    int tid_ = threadIdx.x; asm volatile("" : "+v"(tid_));
    const int tid = tid_, wid = __builtin_amdgcn_readfirstlane(tid >> 6), lane = tid & 63, wr = wid >> 2, wc = wid & 3, fr = lane & 15, fq = lane >> 4;
    const int K = g.K, nt = K / BK;
    unsigned voffA[2], voffB[2];
#pragma unroll
    for (int i = 0; i < 2; ++i) { int R, C; stage_rc(tid * 16 + i * 8192, R, C); const int Rb = Epi::PERM ? ((R & ~31) + perm32(R & 31)) : R;
        voffA[i] = (unsigned)(R * K + C) * 2u; voffB[i] = (unsigned)(Rb * K + C) * 2u; }
    const size_t kstep = (size_t)(BK * 2);
    const size_t hstep = (size_t)HALF * K * 2;
    const size_t tstep = 2 * hstep;
    const unsigned ldsw = (unsigned)wid * 1024u;
    const int aoff = lds_byte(wr * 64 + fr, fq * 8), boff = lds_byte(wc * 32 + fr, fq * 8);
#define PG8_SA(b, h) (((b) * 2 + (h)) * HTB)
#define PG8_SB(b, h) ((4 + (b) * 2 + (h)) * HTB)
#define PG8_STAGE(bufoff, gbase, voff) do { _Pragma("unroll") for (int _i = 0; _i < 2; ++_i) \
        __builtin_amdgcn_global_load_lds((const unsigned*)((const char*)(gbase) + (voff)[_i]), (PG8_LAS unsigned*)(lds + (bufoff) + ldsw + _i * 8192), 16, 0, 0); } while (0)
#define PG8_LDA(dst, b, h) do { _Pragma("unroll") for (int m = 0; m < 4; ++m) _Pragma("unroll") for (int k = 0; k < 2; ++k) dst[m][k] = *(const PG8_LAS bf16x8*)(lds + PG8_SA(b, h) + aoff + m * 2048 + k * 1024); } while (0)
#define PG8_LDB(dst, b, h) do { _Pragma("unroll") for (int n = 0; n < 2; ++n) _Pragma("unroll") for (int k = 0; k < 2; ++k) dst[n][k] = *(const PG8_LAS bf16x8*)(lds + PG8_SB(b, h) + boff + n * 2048 + k * 1024); } while (0)
#define PG8_MMA(ai, bj, At, Bt) do { __builtin_amdgcn_s_setprio(1); _Pragma("unroll") for (int m = 0; m < 4; ++m) _Pragma("unroll") for (int n = 0; n < 2; ++n) _Pragma("unroll") for (int k = 0; k < 2; ++k) \
        acc[ai][bj][m][n] = __builtin_amdgcn_mfma_f32_16x16x32_bf16(Bt[n][k], At[m][k], acc[ai][bj][m][n], 0, 0, 0); __builtin_amdgcn_s_setprio(0); } while (0)
#define PG8_WAIT_V(n) asm volatile("s_waitcnt vmcnt(" #n ")" ::: "memory")
#define PG8_WAIT_L(n) asm volatile("s_waitcnt lgkmcnt(" #n ")" ::: "memory")
#define PG8_BAR __builtin_amdgcn_s_barrier()
#define PG8_SCHED __builtin_amdgcn_sched_barrier(0)
    Unit cur, nxt; int ui = 0;
    if (!S.next(0, cur)) return;
    f32x4 acc[2][2][4][2];
#pragma unroll
    for (int a = 0; a < 2; ++a)
#pragma unroll
        for (int b = 0; b < 2; ++b)
#pragma unroll
            for (int m = 0; m < 4; ++m)
#pragma unroll
                for (int n = 0; n < 2; ++n) acc[a][b][m][n] = (f32x4){0.f, 0.f, 0.f, 0.f};
    bf16x8 At[4][2], B0[2][2], B1[2][2];
    const char* cA = (const char*)g.A + (size_t)cur.pm * tstep; const char* cB = (const char*)g.Bt + (size_t)cur.pn * tstep;
    S.a_ready(cur);
    if constexpr (SP2) {
        PG8_STAGE(PG8_SB(0, 0), cB, voffB); PG8_STAGE(PG8_SB(0, 1), cB + hstep, voffB); PG8_STAGE(PG8_SA(0, 0), cA, voffA); PG8_STAGE(PG8_SA(0, 1), cA + hstep, voffA);
        if (wr == 1) PG8_BAR;
        PG8_WAIT_V(2); PG8_BAR;
        PG8_STAGE(PG8_SB(1, 0), cB + kstep, voffB); PG8_STAGE(PG8_SA(1, 0), cA + kstep, voffA); PG8_STAGE(PG8_SB(1, 1), cB + hstep + kstep, voffB);
        PG8_WAIT_V(6); PG8_BAR;
    } else {
        PG8_STAGE(PG8_SB(0, 0), cB, voffB); PG8_STAGE(PG8_SA(0, 0), cA, voffA); PG8_STAGE(PG8_SB(0, 1), cB + hstep, voffB); PG8_STAGE(PG8_SA(0, 1), cA + hstep, voffA);
        if (wr == 1) PG8_BAR;
        PG8_WAIT_V(4); PG8_BAR;
        PG8_STAGE(PG8_SB(1, 0), cB + kstep, voffB); PG8_STAGE(PG8_SA(1, 0), cA + kstep, voffA); PG8_STAGE(PG8_SB(1, 1), cB + hstep + kstep, voffB);
        PG8_WAIT_V(6); PG8_BAR;
    }
    for (;;) {
        const bool has_next = S.next(ui + 1, nxt);
        const char* nA = has_next ? (const char*)g.A + (size_t)nxt.pm * tstep : cA; const char* nB = has_next ? (const char*)g.Bt + (size_t)nxt.pn * tstep : cB;
        for (int t = 0; t < nt; t += 2) {
            const bool last = (t == nt - 2);
            const char* a1 = cA + (size_t)(t + 1) * kstep;
            const char* a2 = last ? nA : cA + (size_t)(t + 2) * kstep; const char* b2 = last ? nB : cB + (size_t)(t + 2) * kstep;
            const char* a3 = a2 + kstep; const char* b3 = b2 + kstep;
            if (last && has_next) S.a_ready(nxt);
            if constexpr (SP2) {
            PG8_LDB(B0, 0, 0); PG8_LDB(B1, 0, 1); PG8_SCHED; PG8_LDA(At, 0, 0); PG8_STAGE(PG8_SA(1, 1), a1 + hstep, voffA);
            PG8_WAIT_V(8); PG8_WAIT_L(0); PG8_BAR; PG8_MMA(0, 0, At, B0); PG8_MMA(0, 1, At, B1); PG8_BAR; PG8_SCHED;
            PG8_LDA(At, 0, 1); PG8_STAGE(PG8_SB(0, 0), b2, voffB); PG8_STAGE(PG8_SB(0, 1), b2 + hstep, voffB); PG8_STAGE(PG8_SA(0, 0), a2, voffA);
            PG8_WAIT_V(8); PG8_WAIT_L(0); PG8_BAR; PG8_MMA(1, 0, At, B0); PG8_MMA(1, 1, At, B1); PG8_BAR; PG8_SCHED;
            PG8_LDB(B0, 1, 0); PG8_LDB(B1, 1, 1); PG8_SCHED; PG8_LDA(At, 1, 0); PG8_STAGE(PG8_SA(0, 1), a2 + hstep, voffA);
            PG8_WAIT_V(8); PG8_WAIT_L(0); PG8_BAR; PG8_MMA(0, 0, At, B0); PG8_MMA(0, 1, At, B1); PG8_BAR; PG8_SCHED;
            PG8_LDA(At, 1, 1); PG8_STAGE(PG8_SB(1, 0), b3, voffB); PG8_STAGE(PG8_SB(1, 1), b3 + hstep, voffB); PG8_STAGE(PG8_SA(1, 0), a3, voffA);
            PG8_WAIT_V(8); PG8_WAIT_L(0); PG8_BAR; PG8_MMA(1, 0, At, B0); PG8_MMA(1, 1, At, B1); PG8_BAR; PG8_SCHED;
            } else {
            PG8_LDB(B0, 0, 0); PG8_SCHED; PG8_LDA(At, 0, 0); PG8_STAGE(PG8_SA(1, 1), a1 + hstep, voffA);
            PG8_WAIT_L(8); PG8_BAR; PG8_WAIT_L(0); PG8_MMA(0, 0, At, B0); PG8_BAR; PG8_SCHED;
            PG8_LDB(B1, 0, 1); PG8_STAGE(PG8_SB(0, 0), b2, voffB);
            PG8_BAR; PG8_WAIT_L(0); PG8_MMA(0, 1, At, B1); PG8_BAR;
            PG8_LDA(At, 0, 1); PG8_STAGE(PG8_SA(0, 0), a2, voffA);
            PG8_BAR; PG8_WAIT_L(0); PG8_MMA(1, 0, At, B0); PG8_BAR; PG8_SCHED;
            PG8_STAGE(PG8_SB(0, 1), b2 + hstep, voffB);
            PG8_WAIT_V(6); PG8_BAR; PG8_MMA(1, 1, At, B1); PG8_BAR;
            PG8_LDB(B0, 1, 0); PG8_SCHED; PG8_LDA(At, 1, 0); PG8_STAGE(PG8_SA(0, 1), a2 + hstep, voffA);
            PG8_WAIT_L(8); PG8_BAR; PG8_WAIT_L(0); PG8_MMA(0, 0, At, B0); PG8_BAR; PG8_SCHED;
            PG8_LDB(B1, 1, 1); PG8_STAGE(PG8_SB(1, 0), b3, voffB);
            PG8_BAR; PG8_WAIT_L(0); PG8_MMA(0, 1, At, B1); PG8_BAR;
            PG8_LDA(At, 1, 1); PG8_STAGE(PG8_SA(1, 0), a3, voffA);
            PG8_BAR; PG8_WAIT_L(0); PG8_MMA(1, 0, At, B0); PG8_BAR; PG8_SCHED;
            PG8_STAGE(PG8_SB(1, 1), b3 + hstep, voffB);
            PG8_WAIT_V(6); PG8_BAR; PG8_MMA(1, 1, At, B1); PG8_BAR;
            }
        }
        if constexpr (ALIGN_EPI) { if (wr == 0) PG8_BAR; }
        if constexpr (!Epi::AFTER_DRAIN) { E(acc, cur, wr, wc, fr, fq); S.done(cur); }
        if (!has_next) break;
#pragma unroll
        for (int a = 0; a < 2; ++a)
#pragma unroll
            for (int b = 0; b < 2; ++b)
#pragma unroll
                for (int m = 0; m < 4; ++m)
#pragma unroll
                    for (int n = 0; n < 2; ++n) acc[a][b][m][n] = (f32x4){0.f, 0.f, 0.f, 0.f};
        cur = nxt; cA = nA; cB = nB; ++ui;
        if constexpr (ALIGN_EPI) { if (wr == 1) PG8_BAR; }
    }
    PG8_WAIT_V(0);
    if constexpr (!ALIGN_EPI) { if (wr == 0) PG8_BAR; }
    PG8_BAR;
    if constexpr (Epi::AFTER_DRAIN) { E.fused(acc, cur, wr, wc, fr, fq, lds, wid, lane); S.done(cur); }
#undef PG8_SA
#undef PG8_SB
#undef PG8_STAGE
#undef PG8_LDA
#undef PG8_LDB
#undef PG8_MMA
#undef PG8_WAIT_V
#undef PG8_WAIT_L
#undef PG8_BAR
#undef PG8_SCHED
}
}

#include <hip/hip_bf16.h>
#include <cmath>
namespace attn_body {
using bf16=__hip_bfloat16;
using bf16x8=__attribute__((ext_vector_type(8)))short;
using s16x4=__attribute__((ext_vector_type(4)))short;
using f32x16=__attribute__((ext_vector_type(16)))float;
using u32x4=__attribute__((ext_vector_type(4)))unsigned;
constexpr int BATCH=2,NHEAD=16,SEQ=16384,D=64,DM=NHEAD*D;
constexpr int NW=8,QBLK=32,QB=QBLK*NW,KVBLK=64,NQB=SEQ/QB;
constexpr int ATTN_PITCH=DM, ATTN_UNIT_ROWS=QB;
__device__ __forceinline__ int crow(int r,int hi){return (r&3)+8*(r>>2)+4*hi;}
#define SBAR() __builtin_amdgcn_sched_barrier(0)
__device__ __forceinline__ void cmask(f32x16&p0,f32x16&p1,int jb,int qrel,int hi){
  const float NEG=-INFINITY; int kb=64*jb+4*hi;
  #pragma unroll
  for(int r=0;r<16;++r){int kv=kb+(r&3)+8*(r>>2); if(kv>qrel)p0[r]=NEG; if(kv+32>qrel)p1[r]=NEG;}
}

constexpr int NSLOT=3, SLOTB=8192;
constexpr int LDS_K=0, LDS_V=NSLOT*SLOTB, LDS_WS=2*NSLOT*SLOTB, LDS_OST=LDS_WS+NW*64*4, LDS_BYTES=LDS_OST+NW*4096;
constexpr float C2=0.125f*1.4426950408889634f;
__device__ __forceinline__ void glds16(const void*gsrc,unsigned lds_dst){unsigned keep;
  asm volatile("s_mov_b32 %0, m0\n\ts_mov_b32 m0, %2\n\ts_nop 0\n\tglobal_load_lds_dwordx4 %1, off\n\ts_mov_b32 m0, %0":"=&s"(keep):"v"(gsrc),"s"(lds_dst):"memory");}
__device__ __forceinline__ float max3f(float a,float b,float c){float r;asm("v_max3_f32 %0, %1, %2, %3":"=v"(r):"v"(a),"v"(b),"v"(c));return r;}
__device__ __forceinline__ float max2f(float a,float b){float r;asm("v_max_f32_e32 %0, %1, %2":"=v"(r):"v"(a),"v"(b));return r;}
__device__ __forceinline__ float fadd_s(float a,float b){float r;asm("v_add_f32_e32 %0, %1, %2":"=v"(r):"v"(a),"v"(b));return r;}
__device__ __forceinline__ float fsub_s(float a,float b){float r;asm("v_sub_f32_e32 %0, %1, %2":"=v"(r):"v"(a),"v"(b));return r;}
typedef float f32x2_t __attribute__((ext_vector_type(2))); typedef __bf16 bf16x2_t __attribute__((ext_vector_type(2)));
__device__ __forceinline__ unsigned cvtpk_s(float lo,float hi){f32x2_t v={lo,hi};bf16x2_t b=__builtin_convertvector(v,bf16x2_t);return __builtin_bit_cast(unsigned,b);}
#define WAIT_BAR(N) asm volatile("s_waitcnt vmcnt(" #N ") lgkmcnt(0)\n\ts_barrier":::"memory")

__device__ __forceinline__ void qkt(f32x16&p0,f32x16&p1,const char*Kslot,const bf16x8*qr,const f32x16&negm,int r32,int hi){
  const char*kb=Kslot+hi*1024+r32*16;
  #pragma unroll
  for(int d0=0;d0<4;++d0){
    const bf16x8 b0=*reinterpret_cast<const bf16x8*>(kb+d0*2048);
    const bf16x8 b1=*reinterpret_cast<const bf16x8*>(kb+d0*2048+512);
    if(d0==0){p0=__builtin_amdgcn_mfma_f32_32x32x16_bf16(b0,qr[0],negm,0,0,0);p1=__builtin_amdgcn_mfma_f32_32x32x16_bf16(b1,qr[0],negm,0,0,0);}
    else{p0=__builtin_amdgcn_mfma_f32_32x32x16_bf16(b0,qr[d0],p0,0,0,0);p1=__builtin_amdgcn_mfma_f32_32x32x16_bf16(b1,qr[d0],p1,0,0,0);}}
}
typedef __attribute__((address_space(3))) const char* lds_cptr;
typedef short v4i16_t __attribute__((ext_vector_type(4)));
__device__ __forceinline__ void kload8(bf16x8*kf,lds_cptr kp){
  kf[0]=*(const __attribute__((address_space(3))) bf16x8*)(kp);      kf[1]=*(const __attribute__((address_space(3))) bf16x8*)(kp+512);
  kf[2]=*(const __attribute__((address_space(3))) bf16x8*)(kp+2048); kf[3]=*(const __attribute__((address_space(3))) bf16x8*)(kp+2560);
  kf[4]=*(const __attribute__((address_space(3))) bf16x8*)(kp+4096); kf[5]=*(const __attribute__((address_space(3))) bf16x8*)(kp+4608);
  kf[6]=*(const __attribute__((address_space(3))) bf16x8*)(kp+6144); kf[7]=*(const __attribute__((address_space(3))) bf16x8*)(kp+6656);
}
__device__ __forceinline__ void kload2(bf16x8*kf,lds_cptr kp,int j){ kf[2*j]=*(const __attribute__((address_space(3))) bf16x8*)(kp+j*2048); kf[2*j+1]=*(const __attribute__((address_space(3))) bf16x8*)(kp+j*2048+512); }
__device__ __forceinline__ s16x4 vtr(lds_cptr p){ return __builtin_bit_cast(s16x4,__builtin_amdgcn_ds_read_tr16_b64_v4i16((__attribute__((address_space(3))) v4i16_t*)p)); }
__device__ __forceinline__ float rowmax(const f32x16&p0,const f32x16&p1){
  float a=max3f(p0[0],p0[1],p1[0]),b=max3f(p0[2],p0[3],p1[1]);a=max3f(a,p1[2],p1[3]);
  #pragma unroll
  for(int r=4;r<16;r+=4){a=max3f(a,p0[r],p0[r+1]);b=max3f(b,p0[r+2],p0[r+3]);a=max3f(a,p1[r],p1[r+1]);b=max3f(b,p1[r+2],p1[r+3]);}
  const float m=max2f(a,b);
  auto rr=__builtin_amdgcn_permlane32_swap(__float_as_uint(m),__float_as_uint(m),false,false);
  return max2f(__uint_as_float(rr[0]),__uint_as_float(rr[1]));
}
__device__ __forceinline__ void pv(f32x16*o,int vb,bf16x8 pa0,bf16x8 pa1,bf16x8 pa2,bf16x8 pa3){
  #pragma unroll
  for(int d0=0;d0<2;++d0){s16x4 lo[4],hi[4];
    #pragma unroll
    for(int ks=0;ks<4;++ks){
      asm volatile("ds_read_b64_tr_b16 %0,%1 offset:%c2":"=&v"(lo[ks]):"v"(vb),"i"(d0*4096+ks*1024):"memory");
      asm volatile("ds_read_b64_tr_b16 %0,%1 offset:%c2":"=&v"(hi[ks]):"v"(vb),"i"(d0*4096+ks*1024+512):"memory");}
    asm volatile("s_waitcnt lgkmcnt(0)":::"memory");SBAR();
    #define PK(k) (bf16x8){lo[k][0],lo[k][1],lo[k][2],lo[k][3],hi[k][0],hi[k][1],hi[k][2],hi[k][3]}
    o[d0]=__builtin_amdgcn_mfma_f32_32x32x16_bf16(pa0,PK(0),o[d0],0,0,0);
    o[d0]=__builtin_amdgcn_mfma_f32_32x32x16_bf16(pa1,PK(1),o[d0],0,0,0);
    o[d0]=__builtin_amdgcn_mfma_f32_32x32x16_bf16(pa2,PK(2),o[d0],0,0,0);
    o[d0]=__builtin_amdgcn_mfma_f32_32x32x16_bf16(pa3,PK(3),o[d0],0,0,0);
    #undef PK
  }
}

#ifndef ATTN_STORE16
#define ATTN_STORE16(p,v) (*(u32x4*)(p)=(v))
#endif
template<int THRL> __device__ __forceinline__ void attn_unit(int b,int cq,int cv,int qb,const bf16*Q,const bf16*__restrict__ K,const bf16*__restrict__ V,bf16*O,char*shm){
  int tid_=threadIdx.x; asm volatile("":"+v"(tid_)); const int tid=tid_,lane=tid&63,r32=lane&31,hi=lane>>5; const int wid=__builtin_amdgcn_readfirstlane(tid>>6);
  const long rowbase=(long)b*SEQ; const int q0=qb*QB;
  const bf16*Qw=Q+(rowbase+q0+wid*QBLK)*DM+cq;
  const bf16*Kh=K+rowbase*DM+cq,*Vh=V+rowbase*DM+cv;
  const unsigned lds0=(unsigned)(uintptr_t)shm;
  float*wsf=(float*)(shm+LDS_WS)+wid*64;
  const bf16*ksrc=Kh+(long)lane*DM+wid*8;
  const bf16*vsrc=Vh+(long)(16*(wid&3)+(lane>>2))*DM+(wid>>2)*32+(lane&3)*8;
  const unsigned kdst=lds0+LDS_K+wid*1024, vdst=lds0+LDS_V+wid*1024;
  #define DMA_K(t,slot) glds16(ksrc+(long)(t)*KVBLK*DM,(unsigned)__builtin_amdgcn_readfirstlane(kdst+(slot)))
  #define DMA_V(t,slot) glds16(vsrc+(long)(t)*KVBLK*DM,(unsigned)__builtin_amdgcn_readfirstlane(vdst+(slot)))
  const int vb0=(int)(lds0+LDS_V)+((lane>>4)&1)*32+(lane&3)*8+(4*hi+((lane&15)>>2))*64;
  const char*Kbase=shm+LDS_K; bf16x8 kf[8];
  const lds_cptr shm3=(lds_cptr)shm; const lds_cptr kp0=shm3+LDS_K+hi*1024+r32*16; const lds_cptr vp0=shm3+LDS_V+((lane>>4)&1)*32+(lane&3)*8+(4*hi+((lane&15)>>2))*64;
  const int NT=(q0+QB)/KVBLK;
  DMA_K(0,0);DMA_V(0,0);DMA_K(1,SLOTB);
  bf16x8 qr[4];
  #pragma unroll
  for(int d0=0;d0<4;++d0)qr[d0]=*reinterpret_cast<const bf16x8*>(&Qw[(long)r32*DM+d0*16+hi*8]);
  float mhat=0.f,l_reg=0.f;f32x16 o[2];o[0]=f32x16{};o[1]=f32x16{};f32x16 negm=f32x16{};asm volatile("":"+v"(negm));
  const int qrel=wid*QBLK+r32;
  #define CMASK(P0,P1,t) do{int jb_=(t)-(NT-4); if(jb_>=0)cmask(P0,P1,jb_,qrel,hi);}while(0)
  bool resc=false;
  #define START(P0,P1) do{ const float rm=rowmax(P0,P1); resc=false; \
    { const float dl=rm; mhat=fadd_s(mhat,dl); \
      _Pragma("unroll") for(int r=0;r<16;++r){P0[r]=fsub_s(P0[r],dl);P1[r]=fsub_s(P1[r],dl);} \
      _Pragma("unroll") for(int r=0;r<16;++r)negm[r]=-mhat; asm volatile("":"+v"(negm)); } \
    _Pragma("unroll") for(int r=0;r<16;++r)P0[r]=__builtin_amdgcn_exp2f(P0[r]); }while(0)
  #define RESC() do{ if(resc){ asm volatile("s_waitcnt lgkmcnt(0)":::"memory"); \
      _Pragma("unroll") for(int d_=0;d_<2;++d_) _Pragma("unroll") for(int r=0;r<16;++r)o[d_][r]*=wsf[crow(r,hi)]; } }while(0)
  f32x16 pA0,pA1,pB0,pB1;
  int sl_prev=0,sl_cur=0,sl_next=SLOTB;
  #define ROT() do{sl_prev=sl_cur;sl_cur=sl_next;sl_next=(sl_next==(NSLOT-1)*SLOTB)?0:sl_next+SLOTB;}while(0)
  DMA_K(2,2*SLOTB);
  WAIT_BAR(3);
  qkt(pA0,pA1,Kbase,qr,negm,r32,hi);asm volatile("s_nop 15\n\ts_nop 7":"+v"(pA0),"+v"(pA1));CMASK(pA0,pA1,0);
  START(pA0,pA1);
  _Pragma("unroll") for(int r=0;r<16;++r)pA1[r]=__builtin_amdgcn_exp2f(pA1[r]);
  WAIT_BAR(0);
  DMA_K(3,0);DMA_V(1,SLOTB);
  ROT();
  kload8(kf,kp0+sl_cur);
  WAIT_BAR(2);
  s16x4 vlo[8],vhi[8]; u32x4 pw0,pw1,pw2,pw3;
  #define PKW(P,B) cvtpk_s(P[B],P[B+1])
  #define PAF(k) __builtin_bit_cast(bf16x8,pw##k)
  #define VFR(i) (bf16x8){vlo[i][0],vlo[i][1],vlo[i][2],vlo[i][3],vhi[i][0],vhi[i][1],vhi[i][2],vhi[i][3]}
  #define PIN(x) asm volatile("":"+v"(x))
  #define MX3(a,b,c) __builtin_fmaxf(__builtin_fmaxf((a),(b)),(c))
  #define GAPA(MF,A0,A1,A2,A3,W0,W1,PW) do{ MF; sacc+=A0; sacc+=A1; sacc+=A2; sacc+=A3; PIN(sacc); W0; W1; PIN(PW); SBAR(); }while(0)
  #define EX(v) __builtin_amdgcn_exp2f(v)
  #define GAPB(MF,X,B) do{ MF; X[B]=EX(X[B]); X[B+1]=EX(X[B+1]); X[B+2]=EX(X[B+2]); X[B+3]=EX(X[B+3]); PIN(X); SBAR(); }while(0)
  #define VRD(i) do{ vlo[i]=vtr(vp_+(((i)>>2)*4096+((i)&3)*1024)); vhi[i]=vtr(vp_+(((i)>>2)*4096+((i)&3)*1024+512)); }while(0)
  #define KRD(G,j) do{ if(G){ kload2(kf,kp0+sl_next,j); SBAR(); } }while(0)
  #define STEP(C0,C1,P0,P1,t,GK,GV,GL) do{ SBAR(); \
    const lds_cptr vp_=vp0+sl_prev; \
    VRD(0); SBAR(); float sacc=(P0[0]+P0[1]); \
    GAPA(C0=__builtin_amdgcn_mfma_f32_32x32x16_bf16(kf[0],qr[0],negm,0,0,0), P0[2],P0[3],P0[4],P0[5],     pw0[0]=PKW(P0,0), pw0[1]=PKW(P0,2), pw0); \
    VRD(4); SBAR(); GAPA(C1=__builtin_amdgcn_mfma_f32_32x32x16_bf16(kf[1],qr[0],negm,0,0,0), P0[6],P0[7],P0[8],P0[9],     pw0[2]=PKW(P0,4), pw0[3]=PKW(P0,6), pw0); \
    VRD(1); SBAR(); GAPA(C0=__builtin_amdgcn_mfma_f32_32x32x16_bf16(kf[2],qr[1],C0,0,0,0),   P0[10],P0[11],P0[12],P0[13], pw1[0]=PKW(P0,8), pw1[1]=PKW(P0,10), pw1); \
    VRD(5); SBAR(); GAPA(C1=__builtin_amdgcn_mfma_f32_32x32x16_bf16(kf[3],qr[1],C1,0,0,0),   P0[14],P0[15],P1[0],P1[1],   pw1[2]=PKW(P0,12),pw1[3]=PKW(P0,14), pw1); \
    VRD(2); SBAR(); GAPA(C0=__builtin_amdgcn_mfma_f32_32x32x16_bf16(kf[4],qr[2],C0,0,0,0),   P1[2],P1[3],P1[4],P1[5],     pw2[0]=PKW(P1,0), pw2[1]=PKW(P1,2), pw2); \
    VRD(6); SBAR(); GAPA(C1=__builtin_amdgcn_mfma_f32_32x32x16_bf16(kf[5],qr[2],C1,0,0,0),   P1[6],P1[7],P1[8],P1[9],     pw2[2]=PKW(P1,4), pw2[3]=PKW(P1,6), pw2); \
    VRD(3); SBAR(); GAPA(C0=__builtin_amdgcn_mfma_f32_32x32x16_bf16(kf[6],qr[3],C0,0,0,0),   P1[10],P1[11],P1[12],P1[13], pw3[0]=PKW(P1,8), pw3[1]=PKW(P1,10), pw3); \
    VRD(7); SBAR(); GAPA(C1=__builtin_amdgcn_mfma_f32_32x32x16_bf16(kf[7],qr[3],C1,0,0,0),   P1[14],P1[15],0.f,0.f,       pw3[2]=PKW(P1,12),pw3[3]=PKW(P1,14), pw3); \
    l_reg+=sacc; \
    if(GK){DMA_K((t)+3,sl_cur);} if(GV){DMA_V((t)+1,sl_next);} \
    CMASK(C0,C1,t); \
    { float a=MX3(C0[0],C0[1],C1[0]),b=MX3(C0[2],C0[3],C1[1]); a=MX3(a,C1[2],C1[3]); \
      _Pragma("unroll") for(int r=4;r<16;r+=4){a=MX3(a,C0[r],C0[r+1]);b=MX3(b,C0[r+2],C0[r+3]);a=MX3(a,C1[r],C1[r+1]);b=MX3(b,C1[r+2],C1[r+3]);} \
      float rm=__builtin_fmaxf(a,b); { auto rr=__builtin_amdgcn_permlane32_swap(__float_as_uint(rm),__float_as_uint(rm),false,false); rm=__builtin_fmaxf(__uint_as_float(rr[0]),__uint_as_float(rr[1])); } \
      resc=false; \
      if(__builtin_expect(__any(rm>(float)THRL),0)){ const float dl=__builtin_fmaxf(rm,0.f); mhat+=dl; \
        _Pragma("unroll") for(int r=0;r<16;++r){C0[r]-=dl;C1[r]-=dl;} \
        _Pragma("unroll") for(int r=0;r<16;++r)negm[r]=-mhat; asm volatile("":"+v"(negm)); \
        const float f=__builtin_amdgcn_exp2f(-dl); l_reg*=f; if(hi==0)wsf[r32]=f; resc=true; } } \
    SBAR(); \
    GAPB(o[0]=__builtin_amdgcn_mfma_f32_32x32x16_bf16(PAF(0),VFR(0),o[0],0,0,0), C0,0); \
    GAPB(o[1]=__builtin_amdgcn_mfma_f32_32x32x16_bf16(PAF(0),VFR(4),o[1],0,0,0), C0,4); \
    KRD(GL,0); GAPB(o[0]=__builtin_amdgcn_mfma_f32_32x32x16_bf16(PAF(1),VFR(1),o[0],0,0,0), C0,8); \
    KRD(GL,1); GAPB(o[1]=__builtin_amdgcn_mfma_f32_32x32x16_bf16(PAF(1),VFR(5),o[1],0,0,0), C0,12); \
    KRD(GL,2); GAPB(o[0]=__builtin_amdgcn_mfma_f32_32x32x16_bf16(PAF(2),VFR(2),o[0],0,0,0), C1,0); \
    KRD(GL,3); GAPB(o[1]=__builtin_amdgcn_mfma_f32_32x32x16_bf16(PAF(2),VFR(6),o[1],0,0,0), C1,4); \
    GAPB(o[0]=__builtin_amdgcn_mfma_f32_32x32x16_bf16(PAF(3),VFR(3),o[0],0,0,0), C1,8); \
    GAPB(o[1]=__builtin_amdgcn_mfma_f32_32x32x16_bf16(PAF(3),VFR(7),o[1],0,0,0), C1,12); \
    }while(0)
  int t=1;
  #undef CMASK
  #define CMASK(P0,P1,t) do{}while(0)
  for(;t+5<NT;t+=2){
    STEP(pB0,pB1,pA0,pA1,t,true,true,true);     WAIT_BAR(2); RESC(); ROT();
    STEP(pA0,pA1,pB0,pB1,t+1,true,true,true);   WAIT_BAR(2); RESC(); ROT();
  }
  #undef CMASK
  #define CMASK(P0,P1,t) do{int jb_=(t)-(NT-4); if(jb_>=0)cmask(P0,P1,jb_,qrel,hi);}while(0)
  #define ENDW(tt) do{ if((tt)+3<NT){WAIT_BAR(2);} else if((tt)+2<NT){WAIT_BAR(1);} else {WAIT_BAR(0);} }while(0)
  for(;t+1<NT;t+=2){
    STEP(pB0,pB1,pA0,pA1,t,(t+3<NT),(t+1<NT),(t+1<NT));       ENDW(t);   RESC(); ROT();
    STEP(pA0,pA1,pB0,pB1,t+1,(t+4<NT),(t+2<NT),(t+2<NT));     ENDW(t+1); RESC(); ROT();
  }
  STEP(pB0,pB1,pA0,pA1,NT-1,false,false,false); RESC();
  { float sacc=pB0[0]+pB0[1]; _Pragma("unroll") for(int r=2;r<16;++r)sacc+=pB0[r]; _Pragma("unroll") for(int r=0;r<16;++r)sacc+=pB1[r]; l_reg+=sacc;
    pw0=(u32x4){PKW(pB0,0),PKW(pB0,2),PKW(pB0,4),PKW(pB0,6)};pw1=(u32x4){PKW(pB0,8),PKW(pB0,10),PKW(pB0,12),PKW(pB0,14)};pw2=(u32x4){PKW(pB1,0),PKW(pB1,2),PKW(pB1,4),PKW(pB1,6)};pw3=(u32x4){PKW(pB1,8),PKW(pB1,10),PKW(pB1,12),PKW(pB1,14)};
    SBAR(); pv(o,vb0+sl_cur,PAF(0),PAF(1),PAF(2),PAF(3)); }
  #undef PKW
  #undef PAF
  #undef VFR
  #undef PIN
  #undef MX3
  #undef GAPA
  #undef GAPB
  #undef EX
  #undef VRD
  #undef KRD
  #undef STEP
  #undef ENDW
  {auto rr=__builtin_amdgcn_permlane32_swap(__float_as_uint(l_reg),__float_as_uint(l_reg),false,false);l_reg=__uint_as_float(rr[0])+__uint_as_float(rr[1]);}
  if(hi==0)wsf[32+r32]=l_reg;asm volatile("s_waitcnt lgkmcnt(0)":::"memory");
  float rli[16];
  #pragma unroll
  for(int r=0;r<16;++r)rli[r]=__builtin_amdgcn_rcpf(wsf[32+crow(r,hi)]);
  bf16*Ow=O+(rowbase+q0+wid*QBLK)*DM+cv;
  { bf16*stg=(bf16*)(shm+LDS_OST)+wid*2048;
    #pragma unroll
    for(int r=0;r<16;++r){const int orow=crow(r,hi);
      #pragma unroll
      for(int d0=0;d0<2;++d0)stg[orow*64+d0*32+r32]=__float2bfloat16(o[d0][r]*rli[r]);}
    asm volatile("s_waitcnt lgkmcnt(0)":::"memory");
    #pragma unroll
    for(int i=0;i<4;++i){const int row=i*8+(lane>>3),ch=lane&7; const u32x4 v=*(const u32x4*)(stg+row*64+ch*8); ATTN_STORE16(Ow+(long)row*DM+ch*8,v);} }
  asm volatile("s_waitcnt lgkmcnt(0)\n\ts_barrier":::"memory");
  #undef DMA_K
  #undef DMA_V
  #undef CMASK
  #undef START
  #undef RESC
  #undef ROT
}
constexpr int ATTN_LDS_BYTES=LDS_BYTES;
struct AttnTensors { const bf16* Q; const bf16* K; const bf16* V; bf16* O0; bf16* O1; };
template<int THRL> __device__ __forceinline__ void attn_phase(char*lds,const AttnTensors&T,int vcu,int G){
  for(int v=vcu;v<256;v+=G){
    const int e=v>>2,s=v&3; const int b=e>>5,rem=e&31,h=rem>>2,m=(rem>>1)&1,vh=rem&1;
    const int cq=(2*h+m)*64,cv=(2*h+vh)*64; bf16*O=m?T.O1:T.O0;
    for(int i=0;i<16;++i){ const int j=i>>1; const int qb=(i&1)?(8*j+7-s):(8*j+s); attn_unit<THRL>(b,cq,cv,qb,T.Q,T.K,T.V,O,lds); }
  }
}
#undef SBAR
#undef WAIT_BAR
}

namespace attn128 {
constexpr int D = 128, PITCH = 1024, SEQ = 16384;
constexpr float THR = 8.f; constexpr bool WSKIP = false;
constexpr float SCALE = 0.125f;
constexpr int NW = 8, QBLK = 32, KVBLK = 64, QB = NW * QBLK;
constexpr int SHM_V = KVBLK * D * 2, SHM_K = KVBLK * D * 2;
constexpr int LDS_BYTES = 2 * SHM_V + 2 * SHM_K + NW * 64 * 4;
using bf16 = unsigned short;
typedef short bf16x8 __attribute__((ext_vector_type(8)));
typedef short s16x4 __attribute__((ext_vector_type(4)));
typedef float f32x16 __attribute__((ext_vector_type(16)));
typedef float f32x4 __attribute__((ext_vector_type(4)));
typedef unsigned u32x4 __attribute__((ext_vector_type(4)));
template <class A, class Bt> struct same_t { static constexpr bool v = false; };
template <class A> struct same_t<A, A> { static constexpr bool v = true; };

#define KSWZ(row, colB) ((row) * 256 + ((colB) ^ (((row) & 7) << 4)))
#define SBAR() __builtin_amdgcn_sched_barrier(0)
__device__ __forceinline__ int v_st(int k, int c) { const int kk = (k & ~0xC) | ((k & 4) << 1) | ((k & 8) >> 1); return ((kk >> 3) * 4 + (c >> 5)) * 512 + ((kk & 7) * 32 + (c & 31)) * 2; }
__device__ __forceinline__ int v_rd_base(int lane) { return ((lane & 3) << 3) | (((lane >> 2) & 3) << 6) | (((lane >> 4) & 1) << 5) | (((lane >> 5) & 1) << 8); }
constexpr int v_rd_off(int d0, int ks, int half) { return d0 * 512 + ks * 4096 + half * 2048; }
__device__ __forceinline__ int crow(int r, int hi) { return (r & 3) + 8 * (r >> 2) + 4 * hi; }
__device__ __forceinline__ unsigned cvtpk(float lo, float hi) {
    unsigned r; asm volatile("v_cvt_pk_bf16_f32 %0, %1, %2" : "=v"(r) : "v"(lo), "v"(hi)); return r;
}
__device__ __forceinline__ bf16x8 pack8(f32x4 a, f32x4 b) {
    u32x4 w = {cvtpk(a[0], a[1]), cvtpk(a[2], a[3]), cvtpk(b[0], b[1]), cvtpk(b[2], b[3])};
    return *reinterpret_cast<bf16x8*>(&w);
}
template <class T> __device__ __forceinline__ bf16x8 load8(const T* p) {
    if constexpr (same_t<T, float>::v) { return pack8(*(const f32x4*)p, *(const f32x4*)(p + 4)); }
    else { return *reinterpret_cast<const bf16x8*>(p); }
}
__device__ __forceinline__ void mask_tile(f32x16& p0, f32x16& p1, int dq, unsigned W) {
    const float NEG = -__builtin_inff();
#pragma unroll
    for (int r = 0; r < 16; ++r) {
        const int c = (r & 3) + 8 * (r >> 2);
        if ((unsigned)(dq - c) >= W) p0[r] = NEG;
        if ((unsigned)(dq - c - 32) >= W) p1[r] = NEG;
    }
}
__device__ __forceinline__ void partialSM(f32x16& p0, f32x16& p1, float& m_reg, float& mn, float& alpha) {
    float pmax = p0[0]; for (int r = 1; r < 16; ++r) pmax = fmaxf(pmax, p0[r]); for (int r = 0; r < 16; ++r) pmax = fmaxf(pmax, p1[r]);
    { auto rr = __builtin_amdgcn_permlane32_swap(__float_as_uint(pmax), __float_as_uint(pmax), false, false);
      pmax = fmaxf(__uint_as_float(rr[0]), __uint_as_float(rr[1])); }
    constexpr float C2 = 1.4426950408889634f * SCALE;
    if (__builtin_expect(__all((pmax - m_reg) * SCALE <= THR), 1)) { mn = m_reg; alpha = 1.f; }
    else { mn = fmaxf(m_reg, pmax); alpha = __builtin_amdgcn_exp2f((m_reg - mn) * C2); m_reg = mn; }
    const float mnL = -mn * C2;
    for (int r = 0; r < 16; ++r) p0[r] = fmaf(p0[r], C2, mnL); for (int r = 0; r < 16; ++r) p1[r] = fmaf(p1[r], C2, mnL);
    for (int r = 0; r < 16; ++r) p0[r] = __builtin_amdgcn_exp2f(p0[r]);
}
__device__ __forceinline__ void finishSM(f32x16& p0, f32x16& p1, float alpha, float& l_reg, bf16x8& pa0, bf16x8& pa1, bf16x8& pa2, bf16x8& pa3) {
    for (int r = 0; r < 16; ++r) p1[r] = __builtin_amdgcn_exp2f(p1[r]);
    float ps = 0; for (int r = 0; r < 16; ++r) ps += p0[r]; for (int r = 0; r < 16; ++r) ps += p1[r];
    { auto rr = __builtin_amdgcn_permlane32_swap(__float_as_uint(ps), __float_as_uint(ps), false, false);
      ps = __uint_as_float(rr[0]) + __uint_as_float(rr[1]); }
    l_reg = l_reg * alpha + ps;
#define PK4(P, B_, OUT) do { unsigned a0 = cvtpk(P[B_+0], P[B_+1]), a1 = cvtpk(P[B_+2], P[B_+3]);                          \
        unsigned b0 = cvtpk(P[B_+4], P[B_+5]), b1 = cvtpk(P[B_+6], P[B_+7]);                                             \
        auto r0 = __builtin_amdgcn_permlane32_swap(a0, b0, false, false); auto r1 = __builtin_amdgcn_permlane32_swap(a1, b1, false, false); \
        u32x4 w = {r0[0], r1[0], r0[1], r1[1]}; OUT = *reinterpret_cast<bf16x8*>(&w); } while (0)
    PK4(p0, 0, pa0); PK4(p0, 8, pa1); PK4(p1, 0, pa2); PK4(p1, 8, pa3);
#undef PK4
}
template <int KB, bool SK>
__device__ __forceinline__ void qkt(f32x16& p0, f32x16& p1, const char* K_lds, int r32, int hi, const bf16x8* qr, bool act, int kmo) {
    if (SK && !act) { const float NEG = -__builtin_inff();
#pragma unroll
        for (int r = 0; r < 16; ++r) { p0[r] = NEG; p1[r] = NEG; } return; }
    p0 = f32x16{}; p1 = f32x16{};
    const char* kb[4];
#pragma unroll
    for (int dd = 0; dd < 4; ++dd) kb[dd] = K_lds + KB * SHM_K + KSWZ(r32, (dd * 16 + hi * 8) * 2);
#pragma unroll
    for (int d0 = 0; d0 < 4; ++d0) { const char* a = kb[d0] + kmo;
        bf16x8 b0 = *reinterpret_cast<const bf16x8*>(a);
        bf16x8 b1 = *reinterpret_cast<const bf16x8*>(a + 32 * 256);
        p0 = __builtin_amdgcn_mfma_f32_32x32x16_bf16(b0, qr[d0], p0, 0, 0, 0);
        p1 = __builtin_amdgcn_mfma_f32_32x32x16_bf16(b1, qr[d0], p1, 0, 0, 0); }
}
template <int VB, bool SK>
__device__ __forceinline__ void pv_tile(f32x16* o, int vb0, bf16x8 pa0, bf16x8 pa1, bf16x8 pa2, bf16x8 pa3, bool act) {
    if (SK && !act) return;
#define TRRD(dst, off) asm volatile("ds_read_b64_tr_b16 %0, %1 offset:%2" : "=&v"(dst) : "v"(vb0), "i"(off) : "memory")
#define PV_D0(d0) do { s16x4 l0, l1, l2, l3, h0, h1, h2, h3; constexpr int b_ = VB * SHM_V + v_rd_off(d0, 0, 0);     \
        TRRD(l0, b_); TRRD(h0, b_ + 2048); TRRD(l1, b_ + 4096); TRRD(h1, b_ + 6144); TRRD(l2, b_ + 8192); TRRD(h2, b_ + 10240); TRRD(l3, b_ + 12288); TRRD(h3, b_ + 14336); \
        asm volatile("s_waitcnt lgkmcnt(0)" ::: "memory"); SBAR();                 \
        o[d0] = __builtin_amdgcn_mfma_f32_32x32x16_bf16(pa0, (bf16x8){l0[0], l0[1], l0[2], l0[3], h0[0], h0[1], h0[2], h0[3]}, o[d0], 0, 0, 0);   \
        o[d0] = __builtin_amdgcn_mfma_f32_32x32x16_bf16(pa1, (bf16x8){l1[0], l1[1], l1[2], l1[3], h1[0], h1[1], h1[2], h1[3]}, o[d0], 0, 0, 0);   \
        o[d0] = __builtin_amdgcn_mfma_f32_32x32x16_bf16(pa2, (bf16x8){l2[0], l2[1], l2[2], l2[3], h2[0], h2[1], h2[2], h2[3]}, o[d0], 0, 0, 0);   \
        o[d0] = __builtin_amdgcn_mfma_f32_32x32x16_bf16(pa3, (bf16x8){l3[0], l3[1], l3[2], l3[3], h3[0], h3[1], h3[2], h3[3]}, o[d0], 0, 0, 0); } while (0)
    PV_D0(0); PV_D0(1); PV_D0(2); PV_D0(3);
#undef PV_D0
#undef TRRD
}

template <class TIn, class TOut> struct BlockRef { const TIn* Q; const TIn* K; const TIn* V; TOut* O; int P0; int kmo; };
template <class TIn> struct Seam {
    bf16x8 qr[4];
    bf16x8 st_v0, st_v1, st_k0, st_k1; f32x4 sf0, sf1, sf2, sf3;
    f32x4 tq[1];
};
__device__ __forceinline__ int swa_jlo(int P0, int W) { const int lowk = P0 - W + 1; return lowk > 0 ? lowk / KVBLK : 0; }
#define ROW(p, k0, rr) ((p) + (size_t)((k0) + (rr)) * PITCH + sc)
#define VMW() asm volatile("s_waitcnt vmcnt(0)" ::: "memory")
#define VMWN(n) asm volatile("s_waitcnt vmcnt(%0)" :: "i"(n) : "memory")
#define SLOAD_H(Kp, Vp, k0) do { S.st_v0 = load8<TIn>(ROW(Vp, k0, sr)); S.st_v1 = load8<TIn>(ROW(Vp, k0, 32 + sr));              \
                         S.st_k0 = load8<TIn>(ROW(Kp, k0, sr)); S.st_k1 = load8<TIn>(ROW(Kp, k0, 32 + sr)); } while (0)
#define SWRITE_HK(bf) do { *(bf16x8*)(K_lds + (bf) * SHM_K + kws) = S.st_k0; *(bf16x8*)(K_lds + (bf) * SHM_K + kws + 32 * 256) = S.st_k1; } while (0)
#define SWRITE_HV(bf) do { *(bf16x8*)(V_lds + (bf) * SHM_V + vst0) = S.st_v0; *(bf16x8*)(V_lds + (bf) * SHM_V + vst1) = S.st_v1; } while (0)
#define SWRITE_H(bf) do { SWRITE_HV(bf); SWRITE_HK(bf); } while (0)
#define SLOAD_F(p, k0) do { S.sf0 = *(const f32x4*)ROW(p, k0, sr); S.sf1 = *(const f32x4*)(ROW(p, k0, sr) + 4);                \
                            S.sf2 = *(const f32x4*)ROW(p, k0, 32 + sr); S.sf3 = *(const f32x4*)(ROW(p, k0, 32 + sr) + 4); } while (0)
#define SWRITE_KF(bf) do { *(bf16x8*)(K_lds + (bf) * SHM_K + kws) = pack8(S.sf0, S.sf1); *(bf16x8*)(K_lds + (bf) * SHM_K + kws + 32 * 256) = pack8(S.sf2, S.sf3); } while (0)
#define SWRITE_VF(bf) do { *(bf16x8*)(V_lds + (bf) * SHM_V + vst0) = pack8(S.sf0, S.sf1); *(bf16x8*)(V_lds + (bf) * SHM_V + vst1) = pack8(S.sf2, S.sf3); } while (0)
template <class TIn, class TOut>
__device__ __forceinline__ void causal_swa_prime(const BlockRef<TIn, TOut>& cur, int W, char* lds, Seam<TIn>& S) {
    constexpr bool F32 = same_t<TIn, float>::v;
    int tid_ = threadIdx.x; asm volatile("" : "+v"(tid_)); const int tid = tid_, wid = __builtin_amdgcn_readfirstlane(tid >> 6), lane = tid & 63, r32 = lane & 31, hi = lane >> 5;
    const int sr = tid >> 4, sc = (tid & 15) * 8, kws = KSWZ(sr, sc * 2); char* K_lds = lds + 2 * SHM_V;
    const int kb0 = swa_jlo(cur.P0, W) * KVBLK;
    for (int d0 = 0; d0 < 4; ++d0) S.qr[d0] = load8<TIn>(cur.Q + (size_t)(wid * QBLK + r32) * PITCH + d0 * 16 + hi * 8);
    if constexpr (F32) { SLOAD_F((const float*)cur.K, kb0); VMW(); SWRITE_KF(0); SBAR(); SLOAD_F((const float*)cur.V, kb0); }
    else { SLOAD_H(cur.K, cur.V, kb0); VMW(); SWRITE_HK(0); }
    __syncthreads();
}
template <class TIn, class TOut>
__device__ __forceinline__ void causal_swa_block(const BlockRef<TIn, TOut>& cur, const BlockRef<TIn, TOut>& nxt, int skv, int W, char* lds, Seam<TIn>& S) {
    constexpr bool F32 = same_t<TIn, float>::v;
    int tid_ = threadIdx.x; asm volatile("" : "+v"(tid_)); const int tid = tid_, wid = __builtin_amdgcn_readfirstlane(tid >> 6), lane = tid & 63, r32 = lane & 31, hi = lane >> 5;
    const int j_lo = swa_jlo(cur.P0, W);
    int j_hi = (cur.P0 + QB - 1) / KVBLK + 1; if (j_hi > skv / KVBLK) j_hi = skv / KVBLK;
    const int NT = j_hi - j_lo;
    const int kbn = swa_jlo(nxt.P0, W) * KVBLK;
    const int qlo = cur.P0 + wid * QBLK, qm = qlo + r32 - 4 * hi;
    char* V_lds = lds; char* K_lds = lds + 2 * SHM_V;
    float* ws = (float*)(lds + 2 * SHM_V + 2 * SHM_K) + wid * 64; float* li_l = ws, * al_l = ws + 32;
    float m_reg = -1e30f, l_reg = 0; f32x16 o[4] = {};
    const int sr = tid >> 4, sc = (tid & 15) * 8, vst0 = v_st(sr, sc), vst1 = v_st(32 + sr, sc), kws = KSWZ(sr, sc * 2);
    const int vb0 = (int)(uintptr_t)V_lds + v_rd_base(lane);
    const TIn* Kh = cur.K; const TIn* Vh = cur.V;
#define RESC(a) do { if (__any((a) < 1.f)) { if (hi == 0) al_l[r32] = (a); asm volatile("s_waitcnt lgkmcnt(0)" ::: "memory");              \
                     for (int d_ = 0; d_ < 4; ++d_) for (int r = 0; r < 16; ++r) o[d_][r] *= al_l[crow(r, hi)]; } } while (0)
#define KBASE(t) ((j_lo + (t)) * KVBLK)
#define ACT(t) (KBASE(t) <= qlo + QBLK - 1 && KBASE(t) + KVBLK - 1 >= qlo - W + 1)
#define MASKT(P0_, P1_, t) do { const int kb_ = KBASE(t); if ((!SK || ACT(t)) && (kb_ + KVBLK - 1 > qlo || kb_ <= qlo + QBLK - 1 - W)) mask_tile(P0_, P1_, qm - kb_, (unsigned)W); } while (0)
    constexpr int NQL = F32 ? 16 : 4;
    constexpr bool SK = WSKIP && !F32;
#define SEAM_K0() do { VMWN(NQL); if constexpr (F32) { SWRITE_KF(0); SBAR(); SLOAD_F((const float*)nxt.V, kbn); } else { SWRITE_HK(0); } SBAR(); } while (0)
    f32x16 pA0, pA1, pB0, pB1; float mnA, mnB, alA, alB; bf16x8 pa0, pa1, pa2, pa3;
    if constexpr (F32) { VMW(); SWRITE_VF(0); SBAR(); } else { SWRITE_HV(0); SBAR(); }
    if (NT > 1) { if constexpr (F32) SLOAD_F((const float*)Kh, KBASE(1)); else SLOAD_H(Kh, Vh, KBASE(1)); }
    SBAR(); qkt<0, SK>(pA0, pA1, K_lds, r32, hi, S.qr, ACT(0), cur.kmo);
    if constexpr (F32) { if (NT > 1) { VMW(); SWRITE_KF(1); SBAR(); SLOAD_F((const float*)Vh, KBASE(1)); } }
    MASKT(pA0, pA1, 0); partialSM(pA0, pA1, m_reg, mnA, alA);
    if (NT > 1) { VMW(); if constexpr (F32) { SWRITE_VF(1); SBAR(); if (NT > 2) SLOAD_F((const float*)Kh, KBASE(2)); } else SWRITE_H(1); }
    __syncthreads();
#define HALF_STEP(PX0, PX1, mnX, alX, PY0, PY1, alY, t, KB, VB, SB) do {                                                      \
        SBAR(); qkt<KB, SK>(PX0, PX1, K_lds, r32, hi, S.qr, ACT(t), cur.kmo);                                             \
        finishSM(PY0, PY1, alY, l_reg, pa0, pa1, pa2, pa3); SBAR();                                                           \
        if ((t) + 1 < NT) { if constexpr (F32) { VMW(); SWRITE_KF(SB); SBAR(); SLOAD_F((const float*)Vh, KBASE((t) + 1)); }  \
                            else { SLOAD_H(Kh, Vh, KBASE((t) + 1)); } SBAR(); }                                               \
        pv_tile<VB, SK>(o, vb0, pa0, pa1, pa2, pa3, ACT((t) - 1)); MASKT(PX0, PX1, (t)); partialSM(PX0, PX1, m_reg, mnX, alX);                                        \
        __syncthreads();                                                                                                      \
        if ((t) + 1 < NT) { VMW(); if constexpr (F32) { SWRITE_VF(SB); SBAR(); if ((t) + 2 < NT) SLOAD_F((const float*)Kh, KBASE((t) + 2)); } \
                            else { SWRITE_H(SB); } }                                                                          \
        RESC(alX); __syncthreads(); } while (0)
    for (int t = 1; t + 1 < NT; t += 2) {
        HALF_STEP(pB0, pB1, mnB, alB, pA0, pA1, alA, t, 1, 0, 0);
        HALF_STEP(pA0, pA1, mnA, alA, pB0, pB1, alB, t + 1, 0, 1, 1);
    }
    const bool even = (NT & 1) == 0;
    if (even) { SBAR(); qkt<1, SK>(pB0, pB1, K_lds, r32, hi, S.qr, ACT(NT - 1), cur.kmo); SBAR(); }
#define QROW(e) (nxt.Q + (size_t)(wid * QBLK + r32) * D + ((e) >> 1) * 16 + hi * 8 + ((e) & 1) * 4)
    if constexpr (F32) { SLOAD_F((const float*)nxt.K, kbn); SBAR();
#pragma unroll
        for (int e = 0; e < 8; ++e) S.tq[e] = *(const f32x4*)QROW(e); }
    else { SLOAD_H(nxt.K, nxt.V, kbn); SBAR();
#pragma unroll
        for (int d0 = 0; d0 < 4; ++d0) S.qr[d0] = load8<TIn>(nxt.Q + (size_t)(wid * QBLK + r32) * PITCH + d0 * 16 + hi * 8); }
    SBAR();
    finishSM(pA0, pA1, alA, l_reg, pa0, pa1, pa2, pa3); SBAR();
    if constexpr (F32) {
#pragma unroll
        for (int e = 8; e < 16; ++e) S.tq[e] = *(const f32x4*)QROW(e); SBAR(); }
#undef QROW
    pv_tile<0, SK>(o, vb0, pa0, pa1, pa2, pa3, ACT(even ? NT - 2 : NT - 1));
    if (even) { MASKT(pB0, pB1, NT - 1); partialSM(pB0, pB1, m_reg, mnB, alB); __syncthreads(); RESC(alB);
        finishSM(pB0, pB1, alB, l_reg, pa0, pa1, pa2, pa3); SBAR(); pv_tile<1, SK>(o, vb0, pa0, pa1, pa2, pa3, ACT(NT - 1)); }
    SBAR(); SEAM_K0();
    if (hi == 0) li_l[r32] = l_reg; asm volatile("s_waitcnt lgkmcnt(0)" ::: "memory");
    float rli[16];
#pragma unroll
    for (int r = 0; r < 16; ++r) rli[r] = __builtin_amdgcn_rcpf(li_l[crow(r, hi)]);
    TOut* Ow = cur.O + (size_t)(wid * QBLK) * PITCH;
#pragma unroll
    for (int r = 0; r < 16; ++r) { const int orow = crow(r, hi);
#pragma unroll
        for (int d0 = 0; d0 < 4; ++d0) { const float v = o[d0][r] * rli[r];
            if constexpr (same_t<TOut, float>::v) { Ow[(size_t)orow * PITCH + d0 * 32 + r32] = v; }
            else { const float vn = __shfl_xor(v, 1);
                   if ((r32 & 1) == 0) *(unsigned*)(Ow + (size_t)orow * PITCH + d0 * 32 + r32) = cvtpk(v, vn); } } }
    if constexpr (F32) {
#pragma unroll
        for (int d0 = 0; d0 < 8; ++d0) S.qr[d0] = pack8(S.tq[2 * d0], S.tq[2 * d0 + 1]); }
    __syncthreads();
#undef RESC
#undef KBASE
#undef ACT
#undef MASKT
#undef SEAM_K0
#undef HALF_STEP
}
#undef ROW
#undef VMW
#undef VMWN
#undef SLOAD_H
#undef SWRITE_HK
#undef SWRITE_HV
#undef SWRITE_H
#undef SLOAD_F
#undef SWRITE_KF
#undef SWRITE_VF


struct AttnTensors { const bf16* Q; const bf16* K; const bf16* V; bf16* O0; bf16* O1; };
__device__ __forceinline__ BlockRef<bf16, bf16> blk_ref(const AttnTensors& T, int vcu, int G, int li) {
    const int v = vcu + (li >> 3) * G, i = li & 7, e = v >> 3, s = v & 7, b = e >> 4, h = (e >> 1) & 7, m = e & 1, j = i >> 1;
    const int qb = (i & 1) ? (16 * j + 15 - s) : (16 * j + s);
    BlockRef<bf16, bf16> r;
    r.Q = T.Q + ((size_t)b * SEQ + (size_t)qb * QB) * PITCH + h * 128 + m * 64;
    r.K = T.K + (size_t)b * SEQ * PITCH + h * 128; r.V = T.V + (size_t)b * SEQ * PITCH + h * 128;
    r.O = (m ? T.O1 : T.O0) + ((size_t)b * SEQ + (size_t)qb * QB) * PITCH + h * 128;
    r.P0 = qb * QB; r.kmo = m * 128;
    return r;
}
__device__ __forceinline__ void attn_phase(char* lds, const AttnTensors& T, int vcu, int G) {
    int nv = 0; for (int v = vcu; v < 256; v += G) ++nv;
    const int nblk = nv * 8; if (nblk == 0) return;
    Seam<bf16> S;
    BlockRef<bf16, bf16> cur = blk_ref(T, vcu, G, 0);
    causal_swa_prime<bf16, bf16>(cur, SEQ, lds, S);
    for (int li = 0; li < nblk; ++li) {
        const BlockRef<bf16, bf16> nxt = (li + 1 < nblk) ? blk_ref(T, vcu, G, li + 1) : cur;
        causal_swa_block<bf16, bf16>(cur, nxt, SEQ, SEQ, lds, S);
        cur = nxt;
    }
}
}

#define GAS __attribute__((address_space(1)))
#define LAS __attribute__((address_space(3)))
typedef unsigned short bf16;
typedef unsigned v4u __attribute__((ext_vector_type(4)));
typedef float f32x4 __attribute__((ext_vector_type(4)));
typedef short bf16x8 __attribute__((ext_vector_type(8)));
typedef GAS unsigned gu32;
typedef GAS unsigned long long gu64;
#define RLX_AGENT __ATOMIC_RELAXED, __HIP_MEMORY_SCOPE_AGENT
#define LDS_WAIT() asm volatile("s_waitcnt lgkmcnt(0)" ::: "memory")
#define VM_WAIT() asm volatile("s_waitcnt vmcnt(0)" ::: "memory")
__device__ __forceinline__ unsigned long long rt() { return __builtin_amdgcn_s_memrealtime(); }

#define XB_TMO      128
#define XB_XCNT(j)  (256  + 64 * (j))
#define XB_XSUB(j)  (1280 + 64 * (j))
#define XB_XGEN(j)  (2304 + 64 * (j))
#define XB_TOP      3328
#define XB_TOPGEN   3392
#define XCD_BAR_WORDS 3456
#define XB_SPIN_CAP (1u << 18)

__device__ __forceinline__ unsigned xb_ld(unsigned* p)              { return __hip_atomic_load(p, __ATOMIC_RELAXED, __HIP_MEMORY_SCOPE_AGENT); }
__device__ __forceinline__ unsigned xb_add(unsigned* p, unsigned v) { return __hip_atomic_fetch_add(p, v, __ATOMIC_RELAXED, __HIP_MEMORY_SCOPE_AGENT); }
__device__ __forceinline__ unsigned xb_xcc_id() { return (unsigned)__builtin_amdgcn_s_getreg((3 << 11) | 20) & 0xFu; }
#define XB_SPIN(cond, bar) do { unsigned _sp = 0; while (cond) { __builtin_amdgcn_s_sleep(1); \
    if ((++_sp & 255u) == 0u) { if (xb_ld(&(bar)[XB_TMO])) break; if (_sp > XB_SPIN_CAP) { atomicAdd(&(bar)[XB_TMO], 1u); break; } } } } while (0)

struct XcdBarrier {
    unsigned* bar; unsigned x;
    volatile LAS unsigned* st;
};

__device__ __forceinline__ XcdBarrier xcd_barrier_post(unsigned* bar, volatile LAS unsigned* st) {
    XcdBarrier b; b.bar = bar; b.x = xb_xcc_id(); b.st = st;
    if (threadIdx.x == 0) (void)xb_add(&bar[XB_XCNT(b.x)], 1u);
    return b;
}
__device__ __forceinline__ void xcd_barrier_complete(unsigned* bar, unsigned x, unsigned& nloc, unsigned& nx) {
    const unsigned G = gridDim.x * gridDim.y * gridDim.z;
    unsigned sum, cnt, mine, sp = 0u;
    for (;;) {
        sum = 0u; cnt = 0u; mine = 0u;
#pragma unroll
        for (unsigned j = 0; j < 16; ++j) { const unsigned c = xb_ld(&bar[XB_XCNT(j)]); sum += c; cnt += (c > 0u) ? 1u : 0u; mine = (j == x) ? c : mine; }
        if (sum == G) break;
        __builtin_amdgcn_s_sleep(1);
        if ((++sp & 255u) == 0u) { if (xb_ld(&bar[XB_TMO])) break; if (sp > XB_SPIN_CAP) { atomicAdd(&bar[XB_TMO], 1u); break; } }
    }
    nloc = mine > 0u ? mine : 1u; nx = cnt > 0u ? cnt : 1u;
}

__device__ __forceinline__ void xcd_barrier(const XcdBarrier& b) {
    asm volatile("s_waitcnt vmcnt(0)" ::: "memory");
    __syncthreads();
    if (threadIdx.x == 0) {
        unsigned* bar = b.bar;
        __builtin_amdgcn_s_waitcnt(0);
        unsigned nloc = b.st[0], nx = b.st[1];
        if (nloc == 0u) { xcd_barrier_complete(bar, b.x, nloc, nx); b.st[0] = nloc; b.st[1] = nx; }
        const unsigned old = xb_add(&bar[XB_XSUB(b.x)], 1u);
        const unsigned gen = old / nloc;
        if (old + 1u == (gen + 1u) * nloc) {
            __builtin_amdgcn_fence(__ATOMIC_RELEASE, "agent");
            asm volatile("s_waitcnt vmcnt(0)" ::: "memory");
            const unsigned og = xb_add(&bar[XB_TOP], 1u);
            const unsigned tg = og / nx;
            if (og + 1u == (tg + 1u) * nx) xb_add(&bar[XB_TOPGEN], 1u);
            else XB_SPIN(xb_ld(&bar[XB_TOPGEN]) == tg, bar);
            __builtin_amdgcn_fence(__ATOMIC_ACQUIRE, "agent");
            xb_add(&bar[XB_XGEN(b.x)], 1u);
            asm volatile("s_waitcnt vmcnt(0)" ::: "memory");
        } else {
            XB_SPIN(xb_ld(&bar[XB_XGEN(b.x)]) == gen, bar);
            __builtin_amdgcn_fence(__ATOMIC_ACQUIRE, "agent");
            asm volatile("s_waitcnt vmcnt(0)" ::: "memory");
        }
    }
    __syncthreads();
}
constexpr int NWAVES = 8;
#ifndef REP_SCAN
#define REP_SCAN 1
#endif
#ifndef REP_ATTN
#define REP_ATTN 1
#endif
#ifndef REP_PASS
#define REP_PASS 1
#endif
#ifndef REP_OG
#define REP_OG 1
#endif
#ifndef REP_SYNC
#define REP_SYNC 0
#endif
#ifndef REP_G1
#define REP_G1 1
#endif
constexpr int BATCH = 2, SEQ = 16384, D = 1024, M = BATCH * SEQ;
constexpr size_t MiB = 1u << 20;
constexpr size_t WS_ROPE_C = 1 * MiB, WS_ROPE_S = 2 * MiB, WS_S = 3 * MiB, WS_BIAS = 5 * MiB, WS_W = 6 * MiB, WS_U = 32 * MiB, UNIT = 64 * MiB, WS_H = WS_U + 7 * UNIT, WS_END = WS_H + 16 * MiB;
constexpr size_t W_FOLD = 0, W_UP = 17 * MiB, W_OUT = 19 * MiB;
constexpr size_t W_PROJ = 0, W_BOUT = 8 * MiB;
constexpr int LDS_BYTES = 147456;
constexpr float C2F = 0.125f * 1.4426950408889634f;
#ifdef ATTN_D64
#define QSCALE_MASK0 0x4
#define QSCALE_MASK1 0x1
#else
#define QSCALE_MASK0 0x0
#define QSCALE_MASK1 0x0
#endif

typedef _Float16 h16x4 __attribute__((ext_vector_type(4)));
typedef unsigned u32x2 __attribute__((ext_vector_type(2)));
typedef float f32x2 __attribute__((ext_vector_type(2)));
__device__ __forceinline__ unsigned f2bf(float f) { unsigned u = __builtin_bit_cast(unsigned, f); return (u + 0x7fffu + ((u >> 16) & 1u)) >> 16; }
__device__ __forceinline__ unsigned pk2(float lo, float hi) { return f2bf(lo) | (f2bf(hi) << 16); }
__device__ __forceinline__ float bflo(unsigned w) { return __uint_as_float(w << 16); }
__device__ __forceinline__ float bfhi(unsigned w) { return __uint_as_float(w & 0xffff0000u); }
__device__ __forceinline__ float wave_sum(float v) {
#pragma unroll
    for (int o = 1; o < 64; o <<= 1) v += __shfl_xor(v, o);
    return v;
}
template <int CTRL> __device__ __forceinline__ float dpp_mov(float x) { return __builtin_bit_cast(float, __builtin_amdgcn_update_dpp(0, __builtin_bit_cast(int, x), CTRL, 0xf, 0xf, false)); }
__device__ __forceinline__ float allreduce16(float x) { x += dpp_mov<0x128>(x); x += dpp_mov<0x124>(x); x += dpp_mov<0x122>(x); x += dpp_mov<0x121>(x); return x; }

__device__ __forceinline__ void conv_tile(const float* src, int ldsrc, int k0s, int n0s, int kvalid, const float* sc, int smode, bf16* dst, int pitch, int n0d, int k0d, LAS float* scr, int lane) {
#pragma unroll 8
    for (int i = 0; i < 32; ++i) { const int kk = 2 * i + (lane >> 5), n = lane & 31; float v = 0.f;
        if (kk < kvalid) { v = src[(size_t)(k0s + kk) * ldsrc + n0s + n]; if (smode) { const float s = sc[k0s + kk]; v *= (smode == 1) ? s : (1.0f - s); } }
        scr[kk * 33 + n] = v; }
    LDS_WAIT(); asm volatile("" ::: "memory");
    const int c = lane & 7;
#pragma unroll
    for (int j = 0; j < 4; ++j) { const int n = (lane >> 3) + 8 * j; const LAS float* s = scr + (8 * c) * 33 + n;
        v4u o; o.x = pk2(s[0 * 33], s[1 * 33]); o.y = pk2(s[2 * 33], s[3 * 33]); o.z = pk2(s[4 * 33], s[5 * 33]); o.w = pk2(s[6 * 33], s[7 * 33]);
        *(v4u*)(dst + (size_t)(n0d + n) * pitch + k0d + 8 * c) = o; }
    LDS_WAIT(); asm volatile("" ::: "memory");
}

struct In {
    const float* x; const int* pos; const float *a_norm, *a_mu, *a_w_in, *a_w0, *a_w1, *a_w2, *a_a0, *a_a1, *a_a2, *a_v0, *a_v1, *a_v2, *a_k_k, *a_k_a, *a_r_k, *a_ln_w, *a_ln_b, *a_w_out;
    const float *kv_norm, *w_kv, *b_norm, *b_w_in, *b_lq1, *b_lk1, *b_lq2, *b_lk2, *b_subln, *b_w_out, *final_norm;
};

__device__ __forceinline__ void conv_rwkv(const In& I, int l, unsigned char* wreg, float* bias3, LAS float* scr, int gw, int NGW, int lane) {
    if (gw < 48) { const int i = gw * 64 + lane; const int t = i >> 10, c = i & 1023; bias3[i] = (t == 0) ? I.a_w0[l * 1024 + c] : (t == 1) ? I.a_a0[l * 1024 + c] : I.a_v0[c]; }
    bf16* Wf = (bf16*)(wreg + W_FOLD); bf16* Wu = (bf16*)(wreg + W_UP); bf16* Wo = (bf16*)(wreg + W_OUT);
    const int NUPB = (l == 0 ? 2048 : 3072) / 32;
    const int I_F = 136 * 32, I_U = NUPB * 4, I_O = 32 * 16;
    for (int it = gw; it < I_F + I_U + I_O; it += NGW) {
        int r = it;
        if (r < I_F) { const int nb = r >> 5, kb = r & 31; const int n0d = nb * 32, k0d = kb * 64, half = kb >> 4, k0s = (kb & 15) * 64;
            const float* mu = I.a_mu + (size_t)l * 6 * 1024;
            if (n0d < 4096) { const int p = n0d >> 10; conv_tile(I.a_w_in + (size_t)(l * 4 + p) * 1024 * 1024, 1024, k0s, n0d & 1023, 64, mu + p * 1024, half ? 1 : 2, Wf, 2048, n0d, k0d, scr, lane); }
            else { const int c0 = n0d - 4096;
                if (c0 < 64) conv_tile(I.a_w1 + (size_t)l * 1024 * 64, 64, k0s, c0, 64, mu + 4 * 1024, half ? 1 : 2, Wf, 2048, n0d, k0d, scr, lane);
                else if (c0 < 128) conv_tile(I.a_a1 + (size_t)l * 1024 * 64, 64, k0s, c0 - 64, 64, mu + 5 * 1024, half ? 1 : 2, Wf, 2048, n0d, k0d, scr, lane);
                else if (c0 < 160 && l == 1) conv_tile(I.a_v1, 32, k0s, 0, 64, mu + 2 * 1024, half ? 1 : 2, Wf, 2048, n0d, k0d, scr, lane);
                else conv_tile(I.a_w1, 64, 0, 0, 0, mu, 0, Wf, 2048, n0d, k0d, scr, lane); }
            continue; }
        r -= I_F;
        if (r < I_U) { const int nb = r >> 2, kb = r & 3; const int n0d = nb * 32, k0d = kb * 64, t = n0d >> 10;
            if (kb == t) { if (t == 0) conv_tile(I.a_w2 + (size_t)l * 64 * 1024, 1024, 0, n0d, 64, I.a_mu, 0, Wu, 256, n0d, k0d, scr, lane);
                else if (t == 1) conv_tile(I.a_a2 + (size_t)l * 64 * 1024, 1024, 0, n0d - 1024, 64, I.a_mu, 0, Wu, 256, n0d, k0d, scr, lane);
                else conv_tile(I.a_v2, 1024, 0, n0d - 2048, 32, I.a_mu, 0, Wu, 256, n0d, k0d, scr, lane); }
            else conv_tile(I.a_w2, 1024, 0, 0, 0, I.a_mu, 0, Wu, 256, n0d, k0d, scr, lane);
            continue; }
        r -= I_U;
        { const int nb = r >> 4, kb = r & 15; conv_tile(I.a_w_out + (size_t)l * 1024 * 1024, 1024, kb * 64, nb * 32, 64, I.a_mu, 0, Wo, 1024, nb * 32, kb * 64, scr, lane); }
    }
}
__device__ __forceinline__ void conv_attn(const In& I, int j, unsigned char* wreg, LAS float* scr, int gw, int NGW, int lane) {
    bf16* Wp = (bf16*)(wreg + W_PROJ); bf16* Wo = (bf16*)(wreg + W_BOUT);
    const int NPB = (j == 0 ? 4096 : 2048) / 32;
    const int I_P = NPB * 16, I_O = 32 * 16;
    for (int it = gw; it < I_P + I_O; it += NGW) {
        int r = it;
        if (r < I_P) { const int nb = r >> 4, kb = r & 15; const int n0d = nb * 32, k0 = kb * 64;
            if (j == 0) { if (n0d < 2048) conv_tile(I.w_kv, 2048, k0, n0d, 64, I.kv_norm, 1, Wp, 1024, n0d, k0, scr, lane);
                else conv_tile(I.b_w_in, 2048, k0, n0d - 2048, 64, I.b_norm, 1, Wp, 1024, n0d, k0, scr, lane); }
            else conv_tile(I.b_w_in + (size_t)1024 * 2048, 2048, k0, n0d, 64, I.b_norm + 1024, 1, Wp, 1024, n0d, k0, scr, lane);
            continue; }
        r -= I_P;
        { const int nb = r >> 4, kb = r & 15; conv_tile(I.b_w_out + (size_t)j * 1024 * 1024, 1024, kb * 64, nb * 32, 64, I.kv_norm, 0, Wo, 1024, nb * 32, kb * 64, scr, lane); }
    }
}

__device__ __forceinline__ void rope_tables(const int* pos, float* rc, float* rs, int gtid, int nthr) {
    for (int idx = gtid; idx < M * 8; idx += nthr) { const int m = idx >> 3, i = idx & 7;
        const float inv = (i == 0) ? 1.0f : (i == 1) ? 0.1939227432012558f : (i == 2) ? 0.03760603070259094f : (i == 3) ? 0.007292664609849453f : (i == 4) ? 0.0014142135623842478f : (i == 5) ? 0.00027424818836152554f : (i == 6) ? 5.3182957344688475e-05f : 1.0313385246263351e-05f;
        const float ang = (float)pos[m] * inv;
        const double x = (double)ang; const double k = __builtin_rint(x * 0.15915494309189535); const double r = x - k * 6.283185307179586476925;
        const double r2 = r * r; double sn = 0.0, cs = 0.0;
#pragma unroll
        for (int t = 12; t >= 1; --t) { sn = (1.0 - sn) * r2 / (double)((2 * t) * (2 * t + 1)); cs = (1.0 - cs) * r2 / (double)((2 * t - 1) * (2 * t)); }
        rs[idx] = (float)(r * (1.0 - sn)); rc[idx] = (float)(1.0 - cs); }
}

__device__ __forceinline__ void pre_rwkv(const float* x, const float* g, bf16* XN2, int gw, int NGW, int lane) {
    f32x4 gv[4];
#pragma unroll
    for (int j = 0; j < 4; ++j) gv[j] = *((const f32x4*)g + lane + 64 * j);
    for (int c = gw; c < M / 16; c += NGW) { const int m0 = c * 16;
        f32x4 prev[4];
#pragma unroll
        for (int j = 0; j < 4; ++j) prev[j] = (f32x4){0.f, 0.f, 0.f, 0.f};
        if ((m0 % SEQ) != 0) { const f32x4* xr = (const f32x4*)(x + (size_t)(m0 - 1) * D) + lane; f32x4 v[4]; float s = 0.f;
#pragma unroll
            for (int j = 0; j < 4; ++j) { v[j] = xr[64 * j]; s += (v[j].x * v[j].x + v[j].y * v[j].y) + (v[j].z * v[j].z + v[j].w * v[j].w); }
            const float rstd = 1.0f / sqrtf(wave_sum(s) * (1.0f / D) + 1e-6f);
#pragma unroll
            for (int j = 0; j < 4; ++j) prev[j] = v[j] * rstd * gv[j]; }
        for (int r = 0; r < 16; ++r) { const int m = m0 + r; const f32x4* xr = (const f32x4*)(x + (size_t)m * D) + lane; f32x4 v[4]; float s = 0.f;
#pragma unroll
            for (int j = 0; j < 4; ++j) { v[j] = xr[64 * j]; s += (v[j].x * v[j].x + v[j].y * v[j].y) + (v[j].z * v[j].z + v[j].w * v[j].w); }
            const float rstd = 1.0f / sqrtf(wave_sum(s) * (1.0f / D) + 1e-6f);
            unsigned long long* o8 = (unsigned long long*)(XN2 + (size_t)m * 2048) + lane;
#pragma unroll
            for (int j = 0; j < 4; ++j) { const f32x4 xn = v[j] * rstd * gv[j];
                o8[64 * j] = (unsigned long long)pk2(xn.x, xn.y) | ((unsigned long long)pk2(xn.z, xn.w) << 32);
                o8[256 + 64 * j] = (unsigned long long)pk2(prev[j].x, prev[j].y) | ((unsigned long long)pk2(prev[j].z, prev[j].w) << 32);
                prev[j] = xn; } }
    }
}
__device__ __forceinline__ void pre_attn(const float* x, bf16* XH, int gw, int NGW, int lane) {
    for (int m = gw; m < M; m += NGW) { const f32x4* xr = (const f32x4*)(x + (size_t)m * D) + lane; f32x4 v[4]; float s = 0.f;
#pragma unroll
        for (int j = 0; j < 4; ++j) { v[j] = xr[64 * j]; s += (v[j].x * v[j].x + v[j].y * v[j].y) + (v[j].z * v[j].z + v[j].w * v[j].w); }
        const float rstd = 1.0f / sqrtf(wave_sum(s) * (1.0f / D) + 1e-6f);
        unsigned long long* o8 = (unsigned long long*)(XH + (size_t)m * D) + lane;
#pragma unroll
        for (int j = 0; j < 4; ++j) o8[64 * j] = (unsigned long long)pk2(v[j].x * rstd, v[j].y * rstd) | ((unsigned long long)pk2(v[j].z * rstd, v[j].w * rstd) << 32); }
}
__device__ __forceinline__ void final_norm_rows(const float* x, const float* g, float* out, int gw, int NGW, int lane) {
    f32x4 gv[4];
#pragma unroll
    for (int j = 0; j < 4; ++j) gv[j] = *((const f32x4*)g + lane + 64 * j);
    for (int m = gw; m < M; m += NGW) { const f32x4* xr = (const f32x4*)(x + (size_t)m * D) + lane; f32x4 v[4]; float s = 0.f;
#pragma unroll
        for (int j = 0; j < 4; ++j) { v[j] = xr[64 * j]; s += (v[j].x * v[j].x + v[j].y * v[j].y) + (v[j].z * v[j].z + v[j].w * v[j].w); }
        const float rstd = 1.0f / sqrtf(wave_sum(s) * (1.0f / D) + 1e-6f);
        f32x4* o = (f32x4*)(out + (size_t)m * D) + lane;
#pragma unroll
        for (int j = 0; j < 4; ++j) o[64 * j] = v[j] * rstd * gv[j]; }
}

__device__ __forceinline__ void ld16bf(const bf16* p, float (&f)[16]) { const v4u a = *(const v4u*)p, b = *(const v4u*)(p + 8);
    f[0] = bflo(a.x); f[1] = bfhi(a.x); f[2] = bflo(a.y); f[3] = bfhi(a.y); f[4] = bflo(a.z); f[5] = bfhi(a.z); f[6] = bflo(a.w); f[7] = bfhi(a.w);
    f[8] = bflo(b.x); f[9] = bfhi(b.x); f[10] = bflo(b.y); f[11] = bfhi(b.y); f[12] = bflo(b.z); f[13] = bfhi(b.z); f[14] = bflo(b.w); f[15] = bfhi(b.w); }
__device__ __forceinline__ void st16bf(bf16* p, const float (&f)[16]) { v4u a, b;
    a.x = pk2(f[0], f[1]); a.y = pk2(f[2], f[3]); a.z = pk2(f[4], f[5]); a.w = pk2(f[6], f[7]); b.x = pk2(f[8], f[9]); b.y = pk2(f[10], f[11]); b.z = pk2(f[12], f[13]); b.w = pk2(f[14], f[15]);
    *(v4u*)p = a; *(v4u*)(p + 8) = b; }

__device__ __forceinline__ void post_rwkv(const bf16* Y, const float* S, const bf16* V, const bf16* G, const float* ln_w, const float* ln_b, bf16* O, int gw, int NGW, int lane) {
    float lw[16], lb[16];
#pragma unroll
    for (int i = 0; i < 16; ++i) { lw[i] = ln_w[lane * 16 + i]; lb[i] = ln_b[lane * 16 + i]; }
    for (int m = gw; m < M; m += NGW) { const size_t off = (size_t)m * D + lane * 16;
        float y[16], v[16], g[16], o[16]; ld16bf(Y + off, y); ld16bf(V + off, v); ld16bf(G + off, g);
        const float sb = S[(size_t)m * 16 + (lane >> 2)];
        float sum = 0.f;
#pragma unroll
        for (int i = 0; i < 16; ++i) sum += y[i];
        sum += __shfl_xor(sum, 1); sum += __shfl_xor(sum, 2);
        const float mean = sum * (1.0f / 64.0f); float q = 0.f;
#pragma unroll
        for (int i = 0; i < 16; ++i) { const float d = y[i] - mean; q += d * d; }
        q += __shfl_xor(q, 1); q += __shfl_xor(q, 2);
        const float rstd = 1.0f / sqrtf(q * (1.0f / 64.0f) + 64e-5f);
#pragma unroll
        for (int i = 0; i < 16; ++i) { const float yn = (y[i] - mean) * rstd * lw[i] + lb[i]; o[i] = (yn + sb * v[i]) * (g[i] / (1.0f + __expf(-g[i]))); }
        st16bf(O + off, o); }
}
__device__ __forceinline__ void post_attn(const bf16* O0, const bf16* O1, const bf16* GT, const float* subln, float lam, float lam_init, bf16* O, int gw, int NGW, int lane) {
    float sw[16];
#pragma unroll
    for (int i = 0; i < 16; ++i) sw[i] = subln[(lane & 7) * 16 + i] * (1.0f - lam_init);
    for (int m = gw; m < M; m += NGW) { const size_t off = (size_t)m * D + lane * 16;
        float a[16], b[16], g[16], o[16]; ld16bf(O0 + off, a); ld16bf(O1 + off, b); ld16bf(GT + off, g);
        float q = 0.f;
#pragma unroll
        for (int i = 0; i < 16; ++i) { o[i] = a[i] - lam * b[i]; q += o[i] * o[i]; }
        q += __shfl_xor(q, 1); q += __shfl_xor(q, 2); q += __shfl_xor(q, 4);
        const float rstd = 1.0f / sqrtf(q * (1.0f / 128.0f) + 1e-5f);
#pragma unroll
        for (int i = 0; i < 16; ++i) o[i] = o[i] * rstd * sw[i] * (g[i] / (1.0f + __expf(-g[i])));
        st16bf(O + off, o); }
}

constexpr int SC_T = 32, SC_NB = SEQ / SC_T, SC_OPS = SC_T * 320, SC_TP = SC_T + 4, SC_VB = SC_TP * 8, SC_YP = SC_TP * 128;
struct ScRaw { u32x2 r, k, w, a; };
__device__ __forceinline__ void scan_phase(LAS unsigned char* lds, const bf16* R, const bf16* K, const bf16* V, const _Float16* W, const _Float16* A, const float* k_k, const float* k_a, const float* r_k,
                                           bf16* Y, float* S, int vcu, int G, int tid, int wave, int lane) {
    LAS float* OPS = (LAS float*)lds;
    LAS float* VB = (LAS float*)(lds + 2 * SC_OPS * 4);
    LAS float* YP = (LAS float*)(lds + 2 * SC_OPS * 4 + 2 * SC_VB * 4);
    for (int u = vcu; u < 256; u += G) {
        const int bh = u >> 3, rg = u & 7, b = bh >> 4, h = bh & 15;
        const size_t rowbase = (size_t)b * SEQ; const int cb = h * 64;
        const int pw = (wave == 2) ? 0 : (wave == 3) ? 1 : (wave == 6) ? 2 : 3;
        const int p = pw * 64 + lane, ptt = p >> 4, c4 = (p & 15) * 4;
        f32x4 kkw = {0.f, 0.f, 0.f, 0.f}, kaw = kkw, rkw = kkw;
        ScRaw rawA0, rawA1, rawB0, rawB1; rawA0.r = (u32x2){0u, 0u}; rawA0.k = rawA0.r; rawA0.w = rawA0.r; rawA0.a = rawA0.r; rawA1 = rawA0; rawB0 = rawA0; rawB1 = rawA0;
        v4u rawvA = {0u, 0u, 0u, 0u}, rawvB = rawvA;
        const bool prod = (wave == 2 || wave == 3 || wave == 6 || wave == 7), vld = (wave == 2 && lane < 32), ywr = (wave == 7), cons = (wave < 2);
        if (prod) { kkw = *(const f32x4*)(k_k + cb + c4); kaw = *(const f32x4*)(k_a + cb + c4); rkw = *(const f32x4*)(r_k + cb + c4); }
        const int jq = lane & 15, rl = wave * 4 + (lane >> 4);
        f32x2 S01 = {0.f, 0.f}, S23 = {0.f, 0.f};
#define SC_LOAD1(raw, nblk, tt_) do { const size_t o_ = (rowbase + (size_t)(nblk) * SC_T + (tt_)) * D + cb + c4; raw.r = *(const u32x2*)(R + o_); raw.k = *(const u32x2*)(K + o_); raw.w = *(const u32x2*)(W + o_); raw.a = *(const u32x2*)(A + o_); } while (0)
#define SC_LOAD(raw0, raw1, rawv, nblk) do { if (prod) { SC_LOAD1(raw0, nblk, ptt); SC_LOAD1(raw1, nblk, ptt + 16); } \
        if (vld) { rawv = *(const v4u*)(V + (rowbase + (size_t)(nblk) * SC_T + lane) * D + cb + rg * 8); } } while (0)
#define SC_DERIVE1(raw, nblk, buf, tt_) do { \
            const float r0 = bflo(raw.r.x), r1 = bfhi(raw.r.x), r2 = bflo(raw.r.y), r3 = bfhi(raw.r.y); \
            const float k0 = bflo(raw.k.x), k1 = bfhi(raw.k.x), k2 = bflo(raw.k.y), k3 = bfhi(raw.k.y); \
            const h16x4 wh = __builtin_bit_cast(h16x4, raw.w), ah = __builtin_bit_cast(h16x4, raw.a); \
            const float a0 = (float)ah[0], a1 = (float)ah[1], a2 = (float)ah[2], a3 = (float)ah[3]; \
            const float x0 = k0 * kkw.x, x1 = k1 * kkw.y, x2 = k2 * kkw.z, x3 = k3 * kkw.w; \
            const float ss = allreduce16((x0 * x0 + x1 * x1) + (x2 * x2 + x3 * x3)); \
            const float inv = 1.0f / fmaxf(sqrtf(ss), 1e-12f); \
            const f32x4 kn = {x0 * inv, x1 * inv, x2 * inv, x3 * inv}; \
            const f32x4 km = {k0 * (1.0f + (a0 - 1.0f) * kaw.x), k1 * (1.0f + (a1 - 1.0f) * kaw.y), k2 * (1.0f + (a2 - 1.0f) * kaw.z), k3 * (1.0f + (a3 - 1.0f) * kaw.w)}; \
            const float sp = allreduce16((r0 * km.x * rkw.x + r1 * km.y * rkw.y) + (r2 * km.z * rkw.z + r3 * km.w * rkw.w)); \
            LAS float* op_ = OPS + (buf) * SC_OPS + (tt_) * 320 + c4; \
            *(LAS f32x4*)(op_) = -kn; \
            *(LAS f32x4*)(op_ + 64) = (f32x4){kn.x * a0, kn.y * a1, kn.z * a2, kn.w * a3}; \
            *(LAS f32x4*)(op_ + 128) = (f32x4){__expf(-__expf((float)wh[0])), __expf(-__expf((float)wh[1])), __expf(-__expf((float)wh[2])), __expf(-__expf((float)wh[3]))}; \
            *(LAS f32x4*)(op_ + 192) = km; \
            *(LAS f32x4*)(op_ + 256) = (f32x4){r0, r1, r2, r3}; \
            if (rg == 0 && c4 == 0) S[(rowbase + (size_t)(nblk) * SC_T + (tt_)) * 16 + h] = sp; } while (0)
#define SC_DERIVE(raw0, raw1, rawv, nblk, buf) do { if (prod) { SC_DERIVE1(raw0, nblk, buf, ptt); SC_DERIVE1(raw1, nblk, buf, ptt + 16); } \
        if (vld) { LAS float* vb_ = VB + (buf) * SC_VB + lane; \
            vb_[0] = bflo(rawv.x); vb_[SC_TP] = bfhi(rawv.x); vb_[2 * SC_TP] = bflo(rawv.y); vb_[3 * SC_TP] = bfhi(rawv.y); vb_[4 * SC_TP] = bflo(rawv.z); vb_[5 * SC_TP] = bfhi(rawv.z); vb_[6 * SC_TP] = bflo(rawv.w); vb_[7 * SC_TP] = bfhi(rawv.w); } } while (0)
#define SC_YOUT1(nblk, buf, tt_) do { const int rp_ = lane & 3; const LAS float* yp_ = YP + (buf) * SC_YP + (2 * rp_) * 16 * SC_TP + (tt_); \
            float y0_ = 0.f, y1_ = 0.f; \
            _Pragma("unroll") for (int j_ = 0; j_ < 16; ++j_) { y0_ += yp_[j_ * SC_TP]; y1_ += yp_[(16 + j_) * SC_TP]; } \
            *(unsigned*)(Y + (rowbase + (size_t)(nblk) * SC_T + (tt_)) * D + cb + rg * 8 + 2 * rp_) = pk2(y0_, y1_); } while (0)
#define SC_YOUT(nblk, buf) do { SC_YOUT1(nblk, buf, lane >> 2); SC_YOUT1(nblk, buf, (lane >> 2) + 16); } while (0)
#define SC_LDOPS(N, B, W_, K_, R_, t) do { const LAS float* o_ = ops + (t) * 320; N = *(const LAS f32x4*)(o_); B = *(const LAS f32x4*)(o_ + 64); W_ = *(const LAS f32x4*)(o_ + 128); K_ = *(const LAS f32x4*)(o_ + 192); R_ = *(const LAS f32x4*)(o_ + 256); } while (0)
#define SC_CONSUME(buf) do { const LAS float* ops = OPS + (buf) * SC_OPS + 4 * jq; const LAS float* vb = VB + (buf) * SC_VB + rl * SC_TP; LAS float* yp = YP + (buf) * SC_YP + (rl * 16 + jq) * SC_TP; \
            f32x4 nk, bb, dw, km, rr, nk2, bb2, dw2, km2, rr2; SC_LDOPS(nk, bb, dw, km, rr, 0); SC_LDOPS(nk2, bb2, dw2, km2, rr2, 1); \
            f32x4 v4 = *(const LAS f32x4*)(vb), v4n = *(const LAS f32x4*)(vb + 4), yacc = {0.f, 0.f, 0.f, 0.f}; \
            _Pragma("unroll") for (int tt = 0; tt < SC_T; ++tt) { \
                f32x4 nk3 = nk2, bb3 = bb2, dw3 = dw2, km3 = km2, rr3 = rr2; \
                if (tt + 2 < SC_T) SC_LDOPS(nk3, bb3, dw3, km3, rr3, tt + 2); \
                asm volatile("" ::: "memory"); \
                const float vi = v4[tt & 3]; \
                const f32x2 t_ = S01 * nk.lo + S23 * nk.hi; \
                const f32x2 P01 = S01 * dw.lo + km.lo * vi, P23 = S23 * dw.hi + km.hi * vi; \
                const float sa = allreduce16(t_.x + t_.y); \
                S01 = P01 + bb.lo * sa; S23 = P23 + bb.hi * sa; \
                const f32x2 y_ = S01 * rr.lo + S23 * rr.hi; \
                yacc[tt & 3] = y_.x + y_.y; \
                if ((tt & 3) == 3) { *(LAS f32x4*)(yp + (tt - 3)) = yacc; v4 = v4n; if (tt + 5 < SC_T) v4n = *(const LAS f32x4*)(vb + tt + 5); } \
                nk = nk2; bb = bb2; dw = dw2; km = km2; rr = rr2; nk2 = nk3; bb2 = bb3; dw2 = dw3; km2 = km3; rr2 = rr3; } } while (0)
        SC_LOAD(rawA0, rawA1, rawvA, 0); SC_DERIVE(rawA0, rawA1, rawvA, 0, 0); SC_LOAD(rawB0, rawB1, rawvB, 1); SC_LOAD(rawA0, rawA1, rawvA, 2);
        __syncthreads();
        for (int n = 0; n < SC_NB; n += 2) {
            if (cons) { SC_CONSUME(0); }
            else { SC_DERIVE(rawB0, rawB1, rawvB, n + 1, 1); if (n + 3 < SC_NB) SC_LOAD(rawB0, rawB1, rawvB, n + 3);
                if (ywr && n >= 1) SC_YOUT(n - 1, 1); }
            __syncthreads();
            if (cons) { SC_CONSUME(1); }
            else { if (n + 2 < SC_NB) { SC_DERIVE(rawA0, rawA1, rawvA, n + 2, 0); if (n + 4 < SC_NB) SC_LOAD(rawA0, rawA1, rawvA, n + 4); }
                if (ywr) SC_YOUT(n, 0); }
            __syncthreads();
        }
        if (ywr) SC_YOUT(SC_NB - 1, 1);
        __syncthreads();
#undef SC_LOAD1
#undef SC_LOAD
#undef SC_DERIVE1
#undef SC_DERIVE
#undef SC_YOUT1
#undef SC_YOUT
#undef SC_CONSUME
#undef SC_LDOPS
    }
}

struct Args { const void* in[31]; float* out; unsigned char* ws; };
__global__ void __launch_bounds__(NWAVES * 64, 2) mk_fwd(Args args) {
    extern __shared__ __attribute__((aligned(16))) unsigned char lds[];
    cg::grid_group grid = cg::this_grid();
    LAS unsigned char* L = (LAS unsigned char*)lds;
    const int G = gridDim.x; const int bx = blockIdx.x; const int vcu = (G % 8 == 0) ? (bx % 8) * (G / 8) + bx / 8 : bx;
    const int NGW = G * NWAVES;
    { volatile LAS unsigned* st0 = (volatile LAS unsigned*)(L + 131072 + 1024); if (threadIdx.x < 2) st0[threadIdx.x] = 0u; __syncthreads(); }
    const XcdBarrier xbar = xcd_barrier_post((unsigned*)args.ws, (volatile LAS unsigned*)(L + 131072 + 1024));
#define PH_IDS() int tid_ = threadIdx.x; asm volatile("" : "+v"(tid_)); const int tid = tid_, lane = tid & 63, wave = __builtin_amdgcn_readfirstlane(tid >> 6); const int gw = vcu * NWAVES + wave; LAS float* scr = (LAS float*)(L + wave * 16384); (void)scr; (void)gw; (void)lane
    typedef const void* cvp_t; typedef const __attribute__((address_space(4))) cvp_t* kargp_t;
#define KP_(k) (((kargp_t)kp_)[k])
#define PH_PTRS() const __attribute__((address_space(4))) char* kp_ = (const __attribute__((address_space(4))) char*)__builtin_amdgcn_kernarg_segment_ptr(); asm volatile("" : "+s"(kp_)); \
    In I; I.x = (const float*)KP_(0); I.pos = (const int*)KP_(1); I.a_norm = (const float*)KP_(2); I.a_mu = (const float*)KP_(3); I.a_w_in = (const float*)KP_(4); I.a_w0 = (const float*)KP_(5); I.a_w1 = (const float*)KP_(6); I.a_w2 = (const float*)KP_(7); I.a_a0 = (const float*)KP_(8); I.a_a1 = (const float*)KP_(9); I.a_a2 = (const float*)KP_(10); I.a_v0 = (const float*)KP_(11); I.a_v1 = (const float*)KP_(12); I.a_v2 = (const float*)KP_(13); I.a_k_k = (const float*)KP_(14); I.a_k_a = (const float*)KP_(15); I.a_r_k = (const float*)KP_(16); I.a_ln_w = (const float*)KP_(17); I.a_ln_b = (const float*)KP_(18); I.a_w_out = (const float*)KP_(19); I.kv_norm = (const float*)KP_(20); I.w_kv = (const float*)KP_(21); I.b_norm = (const float*)KP_(22); I.b_w_in = (const float*)KP_(23); I.b_lq1 = (const float*)KP_(24); I.b_lk1 = (const float*)KP_(25); I.b_lq2 = (const float*)KP_(26); I.b_lk2 = (const float*)KP_(27); I.b_subln = (const float*)KP_(28); I.b_w_out = (const float*)KP_(29); I.final_norm = (const float*)KP_(30); \
    float* XS = (float*)KP_(31); unsigned char* ws = (unsigned char*)KP_(32); \
    float* rc = (float*)(ws + WS_ROPE_C); float* rs = (float*)(ws + WS_ROPE_S); float* SB = (float*)(ws + WS_S); unsigned char* wreg = ws + WS_W; \
    bf16* U0 = (bf16*)(ws + WS_U); bf16* U1 = (bf16*)(ws + WS_U + UNIT); bf16* U2 = (bf16*)(ws + WS_U + 2 * UNIT); bf16* U3 = (bf16*)(ws + WS_U + 3 * UNIT); \
    bf16* U4 = (bf16*)(ws + WS_U + 4 * UNIT); bf16* U5 = (bf16*)(ws + WS_U + 5 * UNIT); bf16* U6 = (bf16*)(ws + WS_U + 6 * UNIT); bf16* HB = (bf16*)(ws + WS_H); \
    (void)I; (void)XS; (void)rc; (void)rs; (void)SB; (void)wreg; (void)U0; (void)U1; (void)U2; (void)U3; (void)U4; (void)U5; (void)U6; (void)HB

    for (int rp = 0; rp < REP_PASS; ++rp) { PH_IDS(); PH_PTRS(); rope_tables(I.pos, rc, rs, vcu * 512 + tid, G * 512);
    conv_rwkv(I, 0, wreg, (float*)(ws + WS_BIAS), scr, gw, NGW, lane);
    pre_rwkv(I.x, I.a_norm, U0, gw, NGW, lane); }
    grid.sync();

    for (int rp = 0; rp < REP_SYNC; ++rp) xcd_barrier(xbar);
#pragma nounroll
    for (int l = 0; l < 2; ++l) {
#pragma nounroll
        for (int rp = 0; rp < REP_G1; ++rp) {
            if (rp) xcd_barrier(xbar);
            PH_PTRS(); bf16* Vl = (l == 0) ? U4 : U6;
            pg8::Gemm g{U0, (const bf16*)(wreg + W_FOLD), M, 4352, 2048}; pg8::StaticOrder S; S.init(M, 4352, G, bx);
            pg8::EpiFold E{U2, U3, Vl, U5, HB};
            pg8::gemm_phase<pg8::EpiFold, pg8::StaticOrder, true, true>(L, g, S, E);
        }
        xcd_barrier(xbar);
        {
            PH_PTRS(); bf16* Vl = (l == 0) ? U4 : U6;
            const int NUP = (l == 0) ? 2048 : 3072;
            pg8::Gemm g{HB, (const bf16*)(wreg + W_UP), M, NUP, 256}; pg8::StaticOrder S; S.init(M, NUP, G, bx);
            pg8::EpiLoraUp E{(const float*)(ws + WS_BIAS), (_Float16*)U0, (_Float16*)U1, Vl, U4};
            pg8::gemm_phase<pg8::EpiLoraUp, pg8::StaticOrder, true, false>(L, g, S, E);
        }
        xcd_barrier(xbar);
#pragma nounroll
        for (int rp = 0; rp < REP_SCAN; ++rp) { if (rp) xcd_barrier(xbar); PH_IDS(); PH_PTRS(); bf16* Vl = (l == 0) ? U4 : U6; bf16* Yl = (l == 0) ? U6 : U4; scan_phase(L, U2, U3, Vl, (const _Float16*)U0, (const _Float16*)U1, I.a_k_k + l * 1024, I.a_k_a + l * 1024, I.a_r_k + l * 1024, Yl, SB, vcu, G, tid, wave, lane); }
        xcd_barrier(xbar);
        for (int rp = 0; rp < REP_PASS; ++rp) { PH_IDS(); PH_PTRS(); bf16* Vl = (l == 0) ? U4 : U6; bf16* Yl = (l == 0) ? U6 : U4; post_rwkv(Yl, SB, Vl, U5, I.a_ln_w + l * 1024, I.a_ln_b + l * 1024, U2, gw, NGW, lane); }
        xcd_barrier(xbar);
        {
            PH_PTRS(); const float* xin = (l == 0) ? I.x : XS;
            pg8::Gemm g{U2, (const bf16*)(wreg + W_OUT), M, 1024, 1024}; pg8::StaticOrder S; S.init(M, 1024, G, bx);
            pg8::EpiResid E{xin, XS};
            pg8::gemm_phase<pg8::EpiResid, pg8::StaticOrder, true, true>(L, g, S, E);
        }
        xcd_barrier(xbar);
        for (int rp = 0; rp < REP_PASS; ++rp) { PH_IDS(); PH_PTRS(); if (l == 0) { conv_rwkv(I, 1, wreg, (float*)(ws + WS_BIAS), scr, gw, NGW, lane); pre_rwkv(XS, I.a_norm + 1024, U0, gw, NGW, lane); }
        else { conv_attn(I, 0, wreg, scr, gw, NGW, lane); pre_attn(XS, U0, gw, NGW, lane); } }
        xcd_barrier(xbar);
    }

#pragma nounroll
    for (int j = 0; j < 2; ++j) {
        {
            PH_PTRS();
            const int NP = (j == 0) ? 4096 : 2048;
            pg8::Gemm g{U0, (const bf16*)(wreg + W_PROJ), M, NP, 1024}; pg8::StaticOrder S; S.init(M, NP, G, bx);
            pg8::EpiProj E;
            if (j == 0) { E.d0 = U1; E.d1 = U2; E.d2 = U3; E.d3 = U4; E.ropemask = 0x5; E.scalemask = QSCALE_MASK0; }
            else { E.d0 = U3; E.d1 = U4; E.d2 = U3; E.d3 = U4; E.ropemask = 0x1; E.scalemask = QSCALE_MASK1; }
            E.sc = C2F; E.rc = rc; E.rs = rs;
            pg8::gemm_phase<pg8::EpiProj, pg8::StaticOrder, true, true>(L, g, S, E);
        }
        xcd_barrier(xbar);
#pragma nounroll
        for (int rp = 0; rp < REP_ATTN; ++rp) {
            if (rp) xcd_barrier(xbar);
            PH_PTRS();
#ifdef ATTN_D64
            const attn_body::AttnTensors AT{(const attn_body::bf16*)U3, (const attn_body::bf16*)U1, (const attn_body::bf16*)U2, (attn_body::bf16*)U5, (attn_body::bf16*)U6};
            attn_body::attn_phase<8>((char*)lds, AT, vcu, G);
#else
            const attn128::AttnTensors AT{U3, U1, U2, U5, U6};
            attn128::attn_phase((char*)lds, AT, vcu, G);
#endif
        }
        xcd_barrier(xbar);
        for (int rp = 0; rp < REP_PASS; ++rp) {
            PH_IDS(); PH_PTRS();
            const float e1 = __expf(wave_sum(I.b_lq1[j * 64 + lane] * I.b_lk1[j * 64 + lane])), e2 = __expf(wave_sum(I.b_lq2[j * 64 + lane] * I.b_lk2[j * 64 + lane]));
            const float lam_init = (j == 0) ? 0.4707130183435842f : 0.5560582041556406f;
            post_attn(U5, U6, U4, I.b_subln + j * 128, e1 - e2 + lam_init, lam_init, U0, gw, NGW, lane);
        }
        xcd_barrier(xbar);
        {
            PH_PTRS();
            pg8::Gemm g{U0, (const bf16*)(wreg + W_BOUT), M, 1024, 1024}; pg8::StaticOrder S; S.init(M, 1024, G, bx);
            pg8::EpiResid E{XS, XS};
            pg8::gemm_phase<pg8::EpiResid, pg8::StaticOrder, true, true>(L, g, S, E);
        }
        xcd_barrier(xbar);
        if (j == 0) { for (int rp = 0; rp < REP_PASS; ++rp) { PH_IDS(); PH_PTRS(); conv_attn(I, 1, wreg, scr, gw, NGW, lane); pre_attn(XS, U0, gw, NGW, lane); } xcd_barrier(xbar); }
    }
    { PH_IDS(); PH_PTRS(); final_norm_rows(XS, I.final_norm, XS, gw, NGW, lane); }
}

extern "C" void kernel_launch(void* const* d_in, const int* in_sizes, int n_in, void* d_out, int out_size, void* d_ws, size_t ws_size, hipStream_t stream) {
    static int grid = 0;
    if (grid == 0) {
        if (n_in != 31 || in_sizes[0] != M * D || out_size != M * D || ws_size < WS_END) { fprintf(stderr, "kernel_launch: unexpected shapes (n_in %d, in0 %d, out %d, ws %zu < %zu)\n", n_in, n_in > 0 ? in_sizes[0] : -1, out_size, ws_size, (size_t)WS_END); grid = -1; return; }
        int dev = 0, cus = 0, per_cu = 0;
        hipGetDevice(&dev); hipDeviceGetAttribute(&cus, hipDeviceAttributeMultiprocessorCount, dev);
        if (hipFuncSetAttribute((const void*)mk_fwd, hipFuncAttributeMaxDynamicSharedMemorySize, LDS_BYTES) != hipSuccess) { fprintf(stderr, "kernel_launch: hipFuncSetAttribute failed\n"); grid = -1; return; }
        if (hipOccupancyMaxActiveBlocksPerMultiprocessor(&per_cu, (const void*)mk_fwd, NWAVES * 64, LDS_BYTES) != hipSuccess || per_cu < 1) { fprintf(stderr, "kernel_launch: occupancy query says %d\n", per_cu); per_cu = 1; }
        (void)hipGetLastError();
        grid = cus;
    }
    if (grid < 0) return;
    if (hipMemsetAsync(d_ws, 0, 16384, stream) != hipSuccess) { fprintf(stderr, "kernel_launch: memset of the barrier words failed\n"); return; }
    Args a{};
    for (int i = 0; i < 31; ++i) a.in[i] = d_in[i];
    a.out = (float*)d_out; a.ws = (unsigned char*)d_ws;
    void* kargs[] = {&a};
    hipError_t e = hipLaunchCooperativeKernel((const void*)mk_fwd, dim3(grid), dim3(NWAVES * 64), kargs, LDS_BYTES, stream);
    if (e != hipSuccess) fprintf(stderr, "kernel_launch: cooperative launch failed: %s (grid %d)\n", hipGetErrorString(e), grid);
}
```

```cpp
#include <hip/hip_runtime.h>
#include <hip/hip_cooperative_groups.h>
#include <cstdio>
#include <cstdint>
namespace cg = cooperative_groups;
namespace pg8 {
#define PG8_LAS __attribute__((address_space(3)))
typedef unsigned short bf16_t;
typedef short bf16x8 __attribute__((ext_vector_type(8)));
typedef float f32x4 __attribute__((ext_vector_type(4)));
typedef unsigned u32x4 __attribute__((ext_vector_type(4)));
constexpr int BM = 256, BK = 64, HALF = 128, HTB = HALF * BK * 2  , STAGE_BYTES = 8 * HTB, NXCD = 8, WGM = 8;

__host__ __device__ __forceinline__ int lds_byte(int r, int c) { const int st = (r >> 4) * 2 + (c >> 5), rr = r & 15, cc = c & 31, ob = rr * 64 + cc * 2; return st * 1024 + (ob ^ (((ob >> 9) & 1) << 5)); }
__host__ __device__ __forceinline__ void stage_rc(int b, int& R, int& C) { const int st = b / 1024, sb = b % 1024, swz = sb ^ (((sb >> 9) & 1) << 5); R = (st >> 1) * 16 + swz / 64; C = (st & 1) * 32 + (swz % 64) / 2; }
__host__ __device__ __forceinline__ int perm32(int rho) { const int n = rho >> 4, i = rho & 15; return 8 * (i >> 2) + 4 * n + (i & 3); }

struct Unit { int pm, pn; };
struct Gemm { const bf16_t* A; const bf16_t* Bt; int M, N, K; };

struct StaticOrder {
    int nM, nN, nwg, G, c;
    __host__ __device__ void init(int M, int N, int G_, int c_) { nM = M / BM; nN = N / BM; nwg = nM * nN; G = G_; c = c_; }
    __host__ __device__ bool next(int i, Unit& u) const {
        const long L = (long)i * G + c; if (L >= nwg) return false;
        int wgid = (int)L; { const int q = nwg / NXCD, r = nwg % NXCD, xcd = wgid % NXCD, off = wgid / NXCD; wgid = (xcd < r ? xcd * (q + 1) : r * (q + 1) + (xcd - r) * q) + off; }
        const int nig = WGM * nN, gid = wgid / nig, fm = gid * WGM, gsz = (nM - fm) < WGM ? (nM - fm) : WGM;
        u.pm = fm + ((wgid % nig) % gsz); u.pn = (wgid % nig) / gsz; return true;
    }
    __device__ __forceinline__ void a_ready(const Unit&) const {}
    __device__ __forceinline__ void done(const Unit&) const {}
};

__device__ __forceinline__ unsigned cvt_pk_bf16(float lo, float hi) { unsigned r; asm volatile("v_cvt_pk_bf16_f32 %0, %1, %2" : "=v"(r) : "v"(lo), "v"(hi)); return r; }
typedef float f32x2 __attribute__((ext_vector_type(2)));
typedef _Float16 h16x4 __attribute__((ext_vector_type(4)));
typedef unsigned u32x2 __attribute__((ext_vector_type(2)));
__device__ __forceinline__ float sigmoidf_(float z) { return 1.0f / (1.0f + __expf(-z)); }
__device__ __forceinline__ float tanhf_(float x) { const float t = __expf(-2.0f * fabsf(x)); const float r = (1.0f - t) / (1.0f + t); return x < 0.f ? -r : r; }
__device__ __forceinline__ float bf_lo(unsigned w) { return __uint_as_float(w << 16); }
__device__ __forceinline__ float bf_hi(unsigned w) { return __uint_as_float(w & 0xffff0000u); }

struct EpiFold {
    static constexpr bool PERM = true, AFTER_DRAIN = false;
    bf16_t *R, *Kb, *V, *G, *H;
    __device__ __forceinline__ void operator()(const f32x4 (&acc)[2][2][4][2], const Unit& u, int wr, int wc, int fr, int fq) const {
        const int row0 = u.pm * BM + wr * 64 + fr;
        const int t = u.pn >> 2;
        bf16_t* base; int ldc, colt;
        if (u.pn < 16) { base = (t == 0) ? R : (t == 1) ? Kb : (t == 2) ? V : G; ldc = 1024; colt = (u.pn & 3) * 256; }
        else { base = H; ldc = 256; colt = 0; }
        const int col0 = colt + wc * 32 + 8 * fq;
        const bool th = (u.pn == 16) && (wc < 2);
#pragma unroll
        for (int ai = 0; ai < 2; ++ai)
#pragma unroll
            for (int m = 0; m < 4; ++m) { bf16_t* rowp = base + (size_t)(row0 + ai * HALF + m * 16) * ldc + col0;
#pragma unroll
                for (int bj = 0; bj < 2; ++bj) { f32x4 v0 = acc[ai][bj][m][0], v1 = acc[ai][bj][m][1];
                    if (th && bj == 0) {
#pragma unroll
                        for (int i = 0; i < 4; ++i) { v0[i] = tanhf_(v0[i]); v1[i] = tanhf_(v1[i]); } }
                    u32x4 w; w.x = cvt_pk_bf16(v0[0], v0[1]); w.y = cvt_pk_bf16(v0[2], v0[3]); w.z = cvt_pk_bf16(v1[0], v1[1]); w.w = cvt_pk_bf16(v1[2], v1[3]);
                    *(u32x4*)(rowp + bj * HALF) = w; }
                asm volatile("" ::: "memory"); }
    }
};

struct EpiLoraUp {
    static constexpr bool PERM = false, AFTER_DRAIN = false;
    const float* bias3; _Float16 *Wb, *Ab; bf16_t* Vb; const bf16_t* Vf;
    __device__ __forceinline__ void operator()(const f32x4 (&acc)[2][2][4][2], const Unit& u, int wr, int wc, int fr_unused, int fq_unused) const {
        int t_ = threadIdx.x; asm volatile("" : "+v"(t_)); const int fr = t_ & 15, fq = (t_ >> 4) & 3;
        const int row0 = u.pm * BM + wr * 64 + fr;
        const int t = u.pn >> 2;
        const int cc0 = (u.pn & 3) * 256 + wc * 32 + 4 * fq;
        const float* bias = bias3 + t * 1024;
#pragma unroll
        for (int bj = 0; bj < 2; ++bj)
#pragma unroll
            for (int n = 0; n < 2; ++n) { const int c = cc0 + bj * HALF + n * 16; const f32x4 bv = *(const f32x4*)(bias + c);
#pragma unroll
                for (int ai = 0; ai < 2; ++ai)
#pragma unroll
                    for (int m = 0; m < 4; ++m) { const size_t off = (size_t)(row0 + ai * HALF + m * 16) * 1024 + c; const f32x4 z = acc[ai][bj][m][n] + bv;
                        if (t == 0) { h16x4 o;
#pragma unroll
                            for (int i = 0; i < 4; ++i) { const float zz = -z[i]; const float sp = fmaxf(zz, 0.f) + __logf(1.0f + __expf(-fabsf(zz))); o[i] = (_Float16)(-sp - 0.5f); }
                            *(h16x4*)(Wb + off) = o; }
                        else if (t == 1) { h16x4 o;
#pragma unroll
                            for (int i = 0; i < 4; ++i) o[i] = (_Float16)sigmoidf_(z[i]);
                            *(h16x4*)(Ab + off) = o; }
                        else { const u32x2 vv = *(const u32x2*)(Vb + off), vf = *(const u32x2*)(Vf + off);
                            const float v_0 = bf_lo(vv.x), v_1 = bf_hi(vv.x), v_2 = bf_lo(vv.y), v_3 = bf_hi(vv.y);
                            const float f_0 = bf_lo(vf.x), f_1 = bf_hi(vf.x), f_2 = bf_lo(vf.y), f_3 = bf_hi(vf.y);
                            u32x2 o; o.x = cvt_pk_bf16(v_0 + (f_0 - v_0) * sigmoidf_(z[0]), v_1 + (f_1 - v_1) * sigmoidf_(z[1]));
                            o.y = cvt_pk_bf16(v_2 + (f_2 - v_2) * sigmoidf_(z[2]), v_3 + (f_3 - v_3) * sigmoidf_(z[3]));
                            *(u32x2*)(Vb + off) = o; }
                        asm volatile("" ::: "memory"); } }
    }
};

struct EpiProj {
    static constexpr bool PERM = true, AFTER_DRAIN = false;
    bf16_t *d0, *d1, *d2, *d3; int ropemask, scalemask; float sc; const float* rc; const float* rs;
    __device__ __forceinline__ void operator()(const f32x4 (&acc)[2][2][4][2], const Unit& u, int wr, int wc, int fr, int fq) const {
        const int row0 = u.pm * BM + wr * 64 + fr;
        const int t = u.pn >> 2;
        bf16_t* base = (t == 0) ? d0 : (t == 1) ? d1 : (t == 2) ? d2 : d3;
        const int col0 = (u.pn & 3) * 256 + wc * 32 + 8 * fq;
        const bool rope = (((ropemask >> t) & 1) != 0) && ((wc & 1) == 0);
        const float s = ((scalemask >> t) & 1) ? sc : 1.0f;
        const float sgn = (fq == 0) ? -1.0f : 1.0f;
#pragma unroll
        for (int ai = 0; ai < 2; ++ai)
#pragma unroll
            for (int m = 0; m < 4; ++m) { const int row = row0 + ai * HALF + m * 16; bf16_t* rowp = base + (size_t)row * 1024 + col0;
                f32x4 c0 = {1.f, 1.f, 1.f, 1.f}, c1 = c0, s0 = {0.f, 0.f, 0.f, 0.f}, s1 = s0;
                if (rope) { c0 = *(const f32x4*)(rc + (size_t)row * 8); c1 = *(const f32x4*)(rc + (size_t)row * 8 + 4); s0 = *(const f32x4*)(rs + (size_t)row * 8); s1 = *(const f32x4*)(rs + (size_t)row * 8 + 4); }
#pragma unroll
                for (int bj = 0; bj < 2; ++bj) { f32x4 v0 = acc[ai][bj][m][0], v1 = acc[ai][bj][m][1];
                    if (rope) { f32x4 p0, p1;
#pragma unroll
                        for (int i = 0; i < 4; ++i) { p0[i] = __shfl_xor(v0[i], 16); p1[i] = __shfl_xor(v1[i], 16); }
                        if (fq < 2) { v0 = v0 * c0 + (p0 * s0) * sgn; v1 = v1 * c1 + (p1 * s1) * sgn; } }
                    v0 = v0 * s; v1 = v1 * s;
                    u32x4 w; w.x = cvt_pk_bf16(v0[0], v0[1]); w.y = cvt_pk_bf16(v0[2], v0[3]); w.z = cvt_pk_bf16(v1[0], v1[1]); w.w = cvt_pk_bf16(v1[2], v1[3]);
                    *(u32x4*)(rowp + bj * HALF) = w; }
                asm volatile("" ::: "memory"); }
    }
};

struct EpiResid {
    static constexpr bool PERM = false, AFTER_DRAIN = false;
    const float* base; float* out;
    __device__ __forceinline__ void operator()(const f32x4 (&acc)[2][2][4][2], const Unit& u, int wr, int wc, int fr, int fq) const {
        const int row0 = u.pm * BM + wr * 64 + fr;
        const int col0 = u.pn * BM + wc * 32 + 4 * fq;
#pragma unroll
        for (int ai = 0; ai < 2; ++ai)
#pragma unroll
            for (int m = 0; m < 4; ++m) { const size_t off = (size_t)(row0 + ai * HALF + m * 16) * 1024 + col0;
#pragma unroll
                for (int bj = 0; bj < 2; ++bj)
#pragma unroll
                    for (int n = 0; n < 2; ++n) { const f32x4 b = *(const f32x4*)(base + off + bj * HALF + n * 16); *(f32x4*)(out + off + bj * HALF + n * 16) = b + acc[ai][bj][m][n]; }
                asm volatile("" ::: "memory"); }
    }
};
template <class Epi, class Sched, bool ALIGN_EPI = false, bool SP2 = false>
__device__ __forceinline__ void gemm_phase(PG8_LAS unsigned char* lds, const Gemm g, const Sched& S, const Epi& E) {
    int tid_ = threadIdx.x; asm volatile("" : "+v"(tid_));
    const int tid = tid_, wid = __builtin_amdgcn_readfirstlane(tid >> 6), lane = tid & 63, wr = wid >> 2, wc = wid & 3, fr = lane & 15, fq = lane >> 4;
    const int K = g.K, nt = K / BK;
    unsigned voffA[2], voffB[2];
#pragma unroll
    for (int i = 0; i < 2; ++i) { int R, C; stage_rc(tid * 16 + i * 8192, R, C); const int Rb = Epi::PERM ? ((R & ~31) + perm32(R & 31)) : R;
        voffA[i] = (unsigned)(R * K + C) * 2u; voffB[i] = (unsigned)(Rb * K + C) * 2u; }
    const size_t kstep = (size_t)(BK * 2);
    const size_t hstep = (size_t)HALF * K * 2;
    const size_t tstep = 2 * hstep;
    const unsigned ldsw = (unsigned)wid * 1024u;
    const int aoff = lds_byte(wr * 64 + fr, fq * 8), boff = lds_byte(wc * 32 + fr, fq * 8);
#define PG8_SA(b, h) (((b) * 2 + (h)) * HTB)
#define PG8_SB(b, h) ((4 + (b) * 2 + (h)) * HTB)
#define PG8_STAGE(bufoff, gbase, voff) do { _Pragma("unroll") for (int _i = 0; _i < 2; ++_i) \
        __builtin_amdgcn_global_load_lds((const unsigned*)((const char*)(gbase) + (voff)[_i]), (PG8_LAS unsigned*)(lds + (bufoff) + ldsw + _i * 8192), 16, 0, 0); } while (0)
#define PG8_LDA(dst, b, h) do { _Pragma("unroll") for (int m = 0; m < 4; ++m) _Pragma("unroll") for (int k = 0; k < 2; ++k) dst[m][k] = *(const PG8_LAS bf16x8*)(lds + PG8_SA(b, h) + aoff + m * 2048 + k * 1024); } while (0)
#define PG8_LDB(dst, b, h) do { _Pragma("unroll") for (int n = 0; n < 2; ++n) _Pragma("unroll") for (int k = 0; k < 2; ++k) dst[n][k] = *(const PG8_LAS bf16x8*)(lds + PG8_SB(b, h) + boff + n * 2048 + k * 1024); } while (0)
#define PG8_MMA(ai, bj, At, Bt) do { __builtin_amdgcn_s_setprio(1); _Pragma("unroll") for (int m = 0; m < 4; ++m) _Pragma("unroll") for (int n = 0; n < 2; ++n) _Pragma("unroll") for (int k = 0; k < 2; ++k) \
        acc[ai][bj][m][n] = __builtin_amdgcn_mfma_f32_16x16x32_bf16(Bt[n][k], At[m][k], acc[ai][bj][m][n], 0, 0, 0); __builtin_amdgcn_s_setprio(0); } while (0)
#define PG8_WAIT_V(n) asm volatile("s_waitcnt vmcnt(" #n ")" ::: "memory")
#define PG8_WAIT_L(n) asm volatile("s_waitcnt lgkmcnt(" #n ")" ::: "memory")
#define PG8_BAR __builtin_amdgcn_s_barrier()
#define PG8_SCHED __builtin_amdgcn_sched_barrier(0)
    Unit cur, nxt; int ui = 0;
    if (!S.next(0, cur)) return;
    f32x4 acc[2][2][4][2];
#pragma unroll
    for (int a = 0; a < 2; ++a)
#pragma unroll
        for (int b = 0; b < 2; ++b)
#pragma unroll
            for (int m = 0; m < 4; ++m)
#pragma unroll
                for (int n = 0; n < 2; ++n) acc[a][b][m][n] = (f32x4){0.f, 0.f, 0.f, 0.f};
    bf16x8 At[4][2], B0[2][2], B1[2][2];
    const char* cA = (const char*)g.A + (size_t)cur.pm * tstep; const char* cB = (const char*)g.Bt + (size_t)cur.pn * tstep;
    S.a_ready(cur);
    if constexpr (SP2) {
        PG8_STAGE(PG8_SB(0, 0), cB, voffB); PG8_STAGE(PG8_SB(0, 1), cB + hstep, voffB); PG8_STAGE(PG8_SA(0, 0), cA, voffA); PG8_STAGE(PG8_SA(0, 1), cA + hstep, voffA);
        if (wr == 1) PG8_BAR;
        PG8_WAIT_V(2); PG8_BAR;
        PG8_STAGE(PG8_SB(1, 0), cB + kstep, voffB); PG8_STAGE(PG8_SA(1, 0), cA + kstep, voffA); PG8_STAGE(PG8_SB(1, 1), cB + hstep + kstep, voffB);
        PG8_WAIT_V(6); PG8_BAR;
    } else {
        PG8_STAGE(PG8_SB(0, 0), cB, voffB); PG8_STAGE(PG8_SA(0, 0), cA, voffA); PG8_STAGE(PG8_SB(0, 1), cB + hstep, voffB); PG8_STAGE(PG8_SA(0, 1), cA + hstep, voffA);
        if (wr == 1) PG8_BAR;
        PG8_WAIT_V(4); PG8_BAR;
        PG8_STAGE(PG8_SB(1, 0), cB + kstep, voffB); PG8_STAGE(PG8_SA(1, 0), cA + kstep, voffA); PG8_STAGE(PG8_SB(1, 1), cB + hstep + kstep, voffB);
        PG8_WAIT_V(6); PG8_BAR;
    }
    for (;;) {
        const bool has_next = S.next(ui + 1, nxt);
        const char* nA = has_next ? (const char*)g.A + (size_t)nxt.pm * tstep : cA; const char* nB = has_next ? (const char*)g.Bt + (size_t)nxt.pn * tstep : cB;
        for (int t = 0; t < nt; t += 2) {
            const bool last = (t == nt - 2);
            const char* a1 = cA + (size_t)(t + 1) * kstep;
            const char* a2 = last ? nA : cA + (size_t)(t + 2) * kstep; const char* b2 = last ? nB : cB + (size_t)(t + 2) * kstep;
            const char* a3 = a2 + kstep; const char* b3 = b2 + kstep;
            if (last && has_next) S.a_ready(nxt);
            if constexpr (SP2) {
            PG8_LDB(B0, 0, 0); PG8_LDB(B1, 0, 1); PG8_SCHED; PG8_LDA(At, 0, 0); PG8_STAGE(PG8_SA(1, 1), a1 + hstep, voffA);
            PG8_WAIT_V(8); PG8_WAIT_L(0); PG8_BAR; PG8_MMA(0, 0, At, B0); PG8_MMA(0, 1, At, B1); PG8_BAR; PG8_SCHED;
            PG8_LDA(At, 0, 1); PG8_STAGE(PG8_SB(0, 0), b2, voffB); PG8_STAGE(PG8_SB(0, 1), b2 + hstep, voffB); PG8_STAGE(PG8_SA(0, 0), a2, voffA);
            PG8_WAIT_V(8); PG8_WAIT_L(0); PG8_BAR; PG8_MMA(1, 0, At, B0); PG8_MMA(1, 1, At, B1); PG8_BAR; PG8_SCHED;
            PG8_LDB(B0, 1, 0); PG8_LDB(B1, 1, 1); PG8_SCHED; PG8_LDA(At, 1, 0); PG8_STAGE(PG8_SA(0, 1), a2 + hstep, voffA);
            PG8_WAIT_V(8); PG8_WAIT_L(0); PG8_BAR; PG8_MMA(0, 0, At, B0); PG8_MMA(0, 1, At, B1); PG8_BAR; PG8_SCHED;
            PG8_LDA(At, 1, 1); PG8_STAGE(PG8_SB(1, 0), b3, voffB); PG8_STAGE(PG8_SB(1, 1), b3 + hstep, voffB); PG8_STAGE(PG8_SA(1, 0), a3, voffA);
            PG8_WAIT_V(8); PG8_WAIT_L(0); PG8_BAR; PG8_MMA(1, 0, At, B0); PG8_MMA(1, 1, At, B1); PG8_BAR; PG8_SCHED;
            } else {
            PG8_LDB(B0, 0, 0); PG8_SCHED; PG8_LDA(At, 0, 0); PG8_STAGE(PG8_SA(1, 1), a1 + hstep, voffA);
            PG8_WAIT_L(8); PG8_BAR; PG8_WAIT_L(0); PG8_MMA(0, 0, At, B0); PG8_BAR; PG8_SCHED;
            PG8_LDB(B1, 0, 1); PG8_STAGE(PG8_SB(0, 0), b2, voffB);
            PG8_BAR; PG8_WAIT_L(0); PG8_MMA(0, 1, At, B1); PG8_BAR;
            PG8_LDA(At, 0, 1); PG8_STAGE(PG8_SA(0, 0), a2, voffA);
            PG8_BAR; PG8_WAIT_L(0); PG8_MMA(1, 0, At, B0); PG8_BAR; PG8_SCHED;
            PG8_STAGE(PG8_SB(0, 1), b2 + hstep, voffB);
            PG8_WAIT_V(6); PG8_BAR; PG8_MMA(1, 1, At, B1); PG8_BAR;
            PG8_LDB(B0, 1, 0); PG8_SCHED; PG8_LDA(At, 1, 0); PG8_STAGE(PG8_SA(0, 1), a2 + hstep, voffA);
            PG8_WAIT_L(8); PG8_BAR; PG8_WAIT_L(0); PG8_MMA(0, 0, At, B0); PG8_BAR; PG8_SCHED;
            PG8_LDB(B1, 1, 1); PG8_STAGE(PG8_SB(1, 0), b3, voffB);
            PG8_BAR; PG8_WAIT_L(0); PG8_MMA(0, 1, At, B1); PG8_BAR;
            PG8_LDA(At, 1, 1); PG8_STAGE(PG8_SA(1, 0), a3, voffA);
            PG8_BAR; PG8_WAIT_L(0); PG8_MMA(1, 0, At, B0); PG8_BAR; PG8_SCHED;
            PG8_STAGE(PG8_SB(1, 1), b3 + hstep, voffB);
            PG8_WAIT_V(6); PG8_BAR; PG8_MMA(1, 1, At, B1); PG8_BAR;
            }
        }
        if constexpr (ALIGN_EPI) { if (wr == 0) PG8_BAR; }
        if constexpr (!Epi::AFTER_DRAIN) { E(acc, cur, wr, wc, fr, fq); S.done(cur); }
        if (!has_next) break;
#pragma unroll
        for (int a = 0; a < 2; ++a)
#pragma unroll
            for (int b = 0; b < 2; ++b)
#pragma unroll
                for (int m = 0; m < 4; ++m)
#pragma unroll
                    for (int n = 0; n < 2; ++n) acc[a][b][m][n] = (f32x4){0.f, 0.f, 0.f, 0.f};
        cur = nxt; cA = nA; cB = nB; ++ui;
        if constexpr (ALIGN_EPI) { if (wr == 1) PG8_BAR; }
    }
    PG8_WAIT_V(0);
    if constexpr (!ALIGN_EPI) { if (wr == 0) PG8_BAR; }
    PG8_BAR;
    if constexpr (Epi::AFTER_DRAIN) { E.fused(acc, cur, wr, wc, fr, fq, lds, wid, lane); S.done(cur); }
#undef PG8_SA
#undef PG8_SB
#undef PG8_STAGE
#undef PG8_LDA
#undef PG8_LDB
#undef PG8_MMA
#undef PG8_WAIT_V
#undef PG8_WAIT_L
#undef PG8_BAR
#undef PG8_SCHED
}
}

#include <hip/hip_bf16.h>
#include <cmath>
namespace attn_body {
using bf16=__hip_bfloat16;
using bf16x8=__attribute__((ext_vector_type(8)))short;
using s16x4=__attribute__((ext_vector_type(4)))short;
using f32x16=__attribute__((ext_vector_type(16)))float;
using u32x4=__attribute__((ext_vector_type(4)))unsigned;
constexpr int BATCH=2,NHEAD=16,SEQ=16384,D=64,DM=NHEAD*D;
constexpr int NW=8,QBLK=32,QB=QBLK*NW,KVBLK=64,NQB=SEQ/QB;
constexpr int ATTN_PITCH=DM, ATTN_UNIT_ROWS=QB;
__device__ __forceinline__ int crow(int r,int hi){return (r&3)+8*(r>>2)+4*hi;}
#define SBAR() __builtin_amdgcn_sched_barrier(0)
__device__ __forceinline__ void cmask(f32x16&p0,f32x16&p1,int jb,int qrel,int hi){
  const float NEG=-INFINITY; int kb=64*jb+4*hi;
  #pragma unroll
  for(int r=0;r<16;++r){int kv=kb+(r&3)+8*(r>>2); if(kv>qrel)p0[r]=NEG; if(kv+32>qrel)p1[r]=NEG;}
}

constexpr int NSLOT=3, SLOTB=8192;
constexpr int LDS_K=0, LDS_V=NSLOT*SLOTB, LDS_WS=2*NSLOT*SLOTB, LDS_OST=LDS_WS+NW*64*4, LDS_BYTES=LDS_OST+NW*4096;
constexpr float C2=0.125f*1.4426950408889634f;
__device__ __forceinline__ void glds16(const void*gsrc,unsigned lds_dst){unsigned keep;
  asm volatile("s_mov_b32 %0, m0\n\ts_mov_b32 m0, %2\n\ts_nop 0\n\tglobal_load_lds_dwordx4 %1, off\n\ts_mov_b32 m0, %0":"=&s"(keep):"v"(gsrc),"s"(lds_dst):"memory");}
__device__ __forceinline__ float max3f(float a,float b,float c){float r;asm("v_max3_f32 %0, %1, %2, %3":"=v"(r):"v"(a),"v"(b),"v"(c));return r;}
__device__ __forceinline__ float max2f(float a,float b){float r;asm("v_max_f32_e32 %0, %1, %2":"=v"(r):"v"(a),"v"(b));return r;}
__device__ __forceinline__ float fadd_s(float a,float b){float r;asm("v_add_f32_e32 %0, %1, %2":"=v"(r):"v"(a),"v"(b));return r;}
__device__ __forceinline__ float fsub_s(float a,float b){float r;asm("v_sub_f32_e32 %0, %1, %2":"=v"(r):"v"(a),"v"(b));return r;}
typedef float f32x2_t __attribute__((ext_vector_type(2))); typedef __bf16 bf16x2_t __attribute__((ext_vector_type(2)));
__device__ __forceinline__ unsigned cvtpk_s(float lo,float hi){f32x2_t v={lo,hi};bf16x2_t b=__builtin_convertvector(v,bf16x2_t);return __builtin_bit_cast(unsigned,b);}
#define WAIT_BAR(N) asm volatile("s_waitcnt vmcnt(" #N ") lgkmcnt(0)\n\ts_barrier":::"memory")

__device__ __forceinline__ void qkt(f32x16&p0,f32x16&p1,const char*Kslot,const bf16x8*qr,const f32x16&negm,int r32,int hi){
  const char*kb=Kslot+hi*1024+r32*16;
  #pragma unroll
  for(int d0=0;d0<4;++d0){
    const bf16x8 b0=*reinterpret_cast<const bf16x8*>(kb+d0*2048);
    const bf16x8 b1=*reinterpret_cast<const bf16x8*>(kb+d0*2048+512);
    if(d0==0){p0=__builtin_amdgcn_mfma_f32_32x32x16_bf16(b0,qr[0],negm,0,0,0);p1=__builtin_amdgcn_mfma_f32_32x32x16_bf16(b1,qr[0],negm,0,0,0);}
    else{p0=__builtin_amdgcn_mfma_f32_32x32x16_bf16(b0,qr[d0],p0,0,0,0);p1=__builtin_amdgcn_mfma_f32_32x32x16_bf16(b1,qr[d0],p1,0,0,0);}}
}
typedef __attribute__((address_space(3))) const char* lds_cptr;
typedef short v4i16_t __attribute__((ext_vector_type(4)));
__device__ __forceinline__ void kload8(bf16x8*kf,lds_cptr kp){
  kf[0]=*(const __attribute__((address_space(3))) bf16x8*)(kp);      kf[1]=*(const __attribute__((address_space(3))) bf16x8*)(kp+512);
  kf[2]=*(const __attribute__((address_space(3))) bf16x8*)(kp+2048); kf[3]=*(const __attribute__((address_space(3))) bf16x8*)(kp+2560);
  kf[4]=*(const __attribute__((address_space(3))) bf16x8*)(kp+4096); kf[5]=*(const __attribute__((address_space(3))) bf16x8*)(kp+4608);
  kf[6]=*(const __attribute__((address_space(3))) bf16x8*)(kp+6144); kf[7]=*(const __attribute__((address_space(3))) bf16x8*)(kp+6656);
}
__device__ __forceinline__ void kload2(bf16x8*kf,lds_cptr kp,int j){ kf[2*j]=*(const __attribute__((address_space(3))) bf16x8*)(kp+j*2048); kf[2*j+1]=*(const __attribute__((address_space(3))) bf16x8*)(kp+j*2048+512); }
__device__ __forceinline__ s16x4 vtr(lds_cptr p){ return __builtin_bit_cast(s16x4,__builtin_amdgcn_ds_read_tr16_b64_v4i16((__attribute__((address_space(3))) v4i16_t*)p)); }
__device__ __forceinline__ float rowmax(const f32x16&p0,const f32x16&p1){
  float a=max3f(p0[0],p0[1],p1[0]),b=max3f(p0[2],p0[3],p1[1]);a=max3f(a,p1[2],p1[3]);
  #pragma unroll
  for(int r=4;r<16;r+=4){a=max3f(a,p0[r],p0[r+1]);b=max3f(b,p0[r+2],p0[r+3]);a=max3f(a,p1[r],p1[r+1]);b=max3f(b,p1[r+2],p1[r+3]);}
  const float m=max2f(a,b);
  auto rr=__builtin_amdgcn_permlane32_swap(__float_as_uint(m),__float_as_uint(m),false,false);
  return max2f(__uint_as_float(rr[0]),__uint_as_float(rr[1]));
}
__device__ __forceinline__ void pv(f32x16*o,int vb,bf16x8 pa0,bf16x8 pa1,bf16x8 pa2,bf16x8 pa3){
  #pragma unroll
  for(int d0=0;d0<2;++d0){s16x4 lo[4],hi[4];
    #pragma unroll
    for(int ks=0;ks<4;++ks){
      asm volatile("ds_read_b64_tr_b16 %0,%1 offset:%c2":"=&v"(lo[ks]):"v"(vb),"i"(d0*4096+ks*1024):"memory");
      asm volatile("ds_read_b64_tr_b16 %0,%1 offset:%c2":"=&v"(hi[ks]):"v"(vb),"i"(d0*4096+ks*1024+512):"memory");}
    asm volatile("s_waitcnt lgkmcnt(0)":::"memory");SBAR();
    #define PK(k) (bf16x8){lo[k][0],lo[k][1],lo[k][2],lo[k][3],hi[k][0],hi[k][1],hi[k][2],hi[k][3]}
    o[d0]=__builtin_amdgcn_mfma_f32_32x32x16_bf16(pa0,PK(0),o[d0],0,0,0);
    o[d0]=__builtin_amdgcn_mfma_f32_32x32x16_bf16(pa1,PK(1),o[d0],0,0,0);
    o[d0]=__builtin_amdgcn_mfma_f32_32x32x16_bf16(pa2,PK(2),o[d0],0,0,0);
    o[d0]=__builtin_amdgcn_mfma_f32_32x32x16_bf16(pa3,PK(3),o[d0],0,0,0);
    #undef PK
  }
}

#ifndef ATTN_STORE16
#define ATTN_STORE16(p,v) (*(u32x4*)(p)=(v))
#endif
template<int THRL> __device__ __forceinline__ void attn_unit(int b,int cq,int cv,int qb,const bf16*Q,const bf16*__restrict__ K,const bf16*__restrict__ V,bf16*O,char*shm){
  int tid_=threadIdx.x; asm volatile("":"+v"(tid_)); const int tid=tid_,lane=tid&63,r32=lane&31,hi=lane>>5; const int wid=__builtin_amdgcn_readfirstlane(tid>>6);
  const long rowbase=(long)b*SEQ; const int q0=qb*QB;
  const bf16*Qw=Q+(rowbase+q0+wid*QBLK)*DM+cq;
  const bf16*Kh=K+rowbase*DM+cq,*Vh=V+rowbase*DM+cv;
  const unsigned lds0=(unsigned)(uintptr_t)shm;
  float*wsf=(float*)(shm+LDS_WS)+wid*64;
  const bf16*ksrc=Kh+(long)lane*DM+wid*8;
  const bf16*vsrc=Vh+(long)(16*(wid&3)+(lane>>2))*DM+(wid>>2)*32+(lane&3)*8;
  const unsigned kdst=lds0+LDS_K+wid*1024, vdst=lds0+LDS_V+wid*1024;
  #define DMA_K(t,slot) glds16(ksrc+(long)(t)*KVBLK*DM,(unsigned)__builtin_amdgcn_readfirstlane(kdst+(slot)))
  #define DMA_V(t,slot) glds16(vsrc+(long)(t)*KVBLK*DM,(unsigned)__builtin_amdgcn_readfirstlane(vdst+(slot)))
  const int vb0=(int)(lds0+LDS_V)+((lane>>4)&1)*32+(lane&3)*8+(4*hi+((lane&15)>>2))*64;
  const char*Kbase=shm+LDS_K; bf16x8 kf[8];
  const lds_cptr shm3=(lds_cptr)shm; const lds_cptr kp0=shm3+LDS_K+hi*1024+r32*16; const lds_cptr vp0=shm3+LDS_V+((lane>>4)&1)*32+(lane&3)*8+(4*hi+((lane&15)>>2))*64;
  const int NT=(q0+QB)/KVBLK;
  DMA_K(0,0);DMA_V(0,0);DMA_K(1,SLOTB);
  bf16x8 qr[4];
  #pragma unroll
  for(int d0=0;d0<4;++d0)qr[d0]=*reinterpret_cast<const bf16x8*>(&Qw[(long)r32*DM+d0*16+hi*8]);
  float mhat=0.f,l_reg=0.f;f32x16 o[2];o[0]=f32x16{};o[1]=f32x16{};f32x16 negm=f32x16{};asm volatile("":"+v"(negm));
  const int qrel=wid*QBLK+r32;
  #define CMASK(P0,P1,t) do{int jb_=(t)-(NT-4); if(jb_>=0)cmask(P0,P1,jb_,qrel,hi);}while(0)
  bool resc=false;
  #define START(P0,P1) do{ const float rm=rowmax(P0,P1); resc=false; \
    { const float dl=rm; mhat=fadd_s(mhat,dl); \
      _Pragma("unroll") for(int r=0;r<16;++r){P0[r]=fsub_s(P0[r],dl);P1[r]=fsub_s(P1[r],dl);} \
      _Pragma("unroll") for(int r=0;r<16;++r)negm[r]=-mhat; asm volatile("":"+v"(negm)); } \
    _Pragma("unroll") for(int r=0;r<16;++r)P0[r]=__builtin_amdgcn_exp2f(P0[r]); }while(0)
  #define RESC() do{ if(resc){ asm volatile("s_waitcnt lgkmcnt(0)":::"memory"); \
      _Pragma("unroll") for(int d_=0;d_<2;++d_) _Pragma("unroll") for(int r=0;r<16;++r)o[d_][r]*=wsf[crow(r,hi)]; } }while(0)
  f32x16 pA0,pA1,pB0,pB1;
  int sl_prev=0,sl_cur=0,sl_next=SLOTB;
  #define ROT() do{sl_prev=sl_cur;sl_cur=sl_next;sl_next=(sl_next==(NSLOT-1)*SLOTB)?0:sl_next+SLOTB;}while(0)
  DMA_K(2,2*SLOTB);
  WAIT_BAR(3);
  qkt(pA0,pA1,Kbase,qr,negm,r32,hi);asm volatile("s_nop 15\n\ts_nop 7":"+v"(pA0),"+v"(pA1));CMASK(pA0,pA1,0);
  START(pA0,pA1);
  _Pragma("unroll") for(int r=0;r<16;++r)pA1[r]=__builtin_amdgcn_exp2f(pA1[r]);
  WAIT_BAR(0);
  DMA_K(3,0);DMA_V(1,SLOTB);
  ROT();
  kload8(kf,kp0+sl_cur);
  WAIT_BAR(2);
  s16x4 vlo[8],vhi[8]; u32x4 pw0,pw1,pw2,pw3;
  #define PKW(P,B) cvtpk_s(P[B],P[B+1])
  #define PAF(k) __builtin_bit_cast(bf16x8,pw##k)
  #define VFR(i) (bf16x8){vlo[i][0],vlo[i][1],vlo[i][2],vlo[i][3],vhi[i][0],vhi[i][1],vhi[i][2],vhi[i][3]}
  #define PIN(x) asm volatile("":"+v"(x))
  #define MX3(a,b,c) __builtin_fmaxf(__builtin_fmaxf((a),(b)),(c))
  #define GAPA(MF,A0,A1,A2,A3,W0,W1,PW) do{ MF; sacc+=A0; sacc+=A1; sacc+=A2; sacc+=A3; PIN(sacc); W0; W1; PIN(PW); SBAR(); }while(0)
  #define EX(v) __builtin_amdgcn_exp2f(v)
  #define GAPB(MF,X,B) do{ MF; X[B]=EX(X[B]); X[B+1]=EX(X[B+1]); X[B+2]=EX(X[B+2]); X[B+3]=EX(X[B+3]); PIN(X); SBAR(); }while(0)
  #define VRD(i) do{ vlo[i]=vtr(vp_+(((i)>>2)*4096+((i)&3)*1024)); vhi[i]=vtr(vp_+(((i)>>2)*4096+((i)&3)*1024+512)); }while(0)
  #define KRD(G,j) do{ if(G){ kload2(kf,kp0+sl_next,j); SBAR(); } }while(0)
  #define STEP(C0,C1,P0,P1,t,GK,GV,GL) do{ SBAR(); \
    const lds_cptr vp_=vp0+sl_prev; \
    VRD(0); SBAR(); float sacc=(P0[0]+P0[1]); \
    GAPA(C0=__builtin_amdgcn_mfma_f32_32x32x16_bf16(kf[0],qr[0],negm,0,0,0), P0[2],P0[3],P0[4],P0[5],     pw0[0]=PKW(P0,0), pw0[1]=PKW(P0,2), pw0); \
    VRD(4); SBAR(); GAPA(C1=__builtin_amdgcn_mfma_f32_32x32x16_bf16(kf[1],qr[0],negm,0,0,0), P0[6],P0[7],P0[8],P0[9],     pw0[2]=PKW(P0,4), pw0[3]=PKW(P0,6), pw0); \
    VRD(1); SBAR(); GAPA(C0=__builtin_amdgcn_mfma_f32_32x32x16_bf16(kf[2],qr[1],C0,0,0,0),   P0[10],P0[11],P0[12],P0[13], pw1[0]=PKW(P0,8), pw1[1]=PKW(P0,10), pw1); \
    VRD(5); SBAR(); GAPA(C1=__builtin_amdgcn_mfma_f32_32x32x16_bf16(kf[3],qr[1],C1,0,0,0),   P0[14],P0[15],P1[0],P1[1],   pw1[2]=PKW(P0,12),pw1[3]=PKW(P0,14), pw1); \
    VRD(2); SBAR(); GAPA(C0=__builtin_amdgcn_mfma_f32_32x32x16_bf16(kf[4],qr[2],C0,0,0,0),   P1[2],P1[3],P1[4],P1[5],     pw2[0]=PKW(P1,0), pw2[1]=PKW(P1,2), pw2); \
    VRD(6); SBAR(); GAPA(C1=__builtin_amdgcn_mfma_f32_32x32x16_bf16(kf[5],qr[2],C1,0,0,0),   P1[6],P1[7],P1[8],P1[9],     pw2[2]=PKW(P1,4), pw2[3]=PKW(P1,6), pw2); \
    VRD(3); SBAR(); GAPA(C0=__builtin_amdgcn_mfma_f32_32x32x16_bf16(kf[6],qr[3],C0,0,0,0),   P1[10],P1[11],P1[12],P1[13], pw3[0]=PKW(P1,8), pw3[1]=PKW(P1,10), pw3); \
    VRD(7); SBAR(); GAPA(C1=__builtin_amdgcn_mfma_f32_32x32x16_bf16(kf[7],qr[3],C1,0,0,0),   P1[14],P1[15],0.f,0.f,       pw3[2]=PKW(P1,12),pw3[3]=PKW(P1,14), pw3); \
    l_reg+=sacc; \
    if(GK){DMA_K((t)+3,sl_cur);} if(GV){DMA_V((t)+1,sl_next);} \
    CMASK(C0,C1,t); \
    { float a=MX3(C0[0],C0[1],C1[0]),b=MX3(C0[2],C0[3],C1[1]); a=MX3(a,C1[2],C1[3]); \
      _Pragma("unroll") for(int r=4;r<16;r+=4){a=MX3(a,C0[r],C0[r+1]);b=MX3(b,C0[r+2],C0[r+3]);a=MX3(a,C1[r],C1[r+1]);b=MX3(b,C1[r+2],C1[r+3]);} \
      float rm=__builtin_fmaxf(a,b); { auto rr=__builtin_amdgcn_permlane32_swap(__float_as_uint(rm),__float_as_uint(rm),false,false); rm=__builtin_fmaxf(__uint_as_float(rr[0]),__uint_as_float(rr[1])); } \
      resc=false; \
      if(__builtin_expect(__any(rm>(float)THRL),0)){ const float dl=__builtin_fmaxf(rm,0.f); mhat+=dl; \
        _Pragma("unroll") for(int r=0;r<16;++r){C0[r]-=dl;C1[r]-=dl;} \
        _Pragma("unroll") for(int r=0;r<16;++r)negm[r]=-mhat; asm volatile("":"+v"(negm)); \
        const float f=__builtin_amdgcn_exp2f(-dl); l_reg*=f; if(hi==0)wsf[r32]=f; resc=true; } } \
    SBAR(); \
    GAPB(o[0]=__builtin_amdgcn_mfma_f32_32x32x16_bf16(PAF(0),VFR(0),o[0],0,0,0), C0,0); \
    GAPB(o[1]=__builtin_amdgcn_mfma_f32_32x32x16_bf16(PAF(0),VFR(4),o[1],0,0,0), C0,4); \
    KRD(GL,0); GAPB(o[0]=__builtin_amdgcn_mfma_f32_32x32x16_bf16(PAF(1),VFR(1),o[0],0,0,0), C0,8); \
    KRD(GL,1); GAPB(o[1]=__builtin_amdgcn_mfma_f32_32x32x16_bf16(PAF(1),VFR(5),o[1],0,0,0), C0,12); \
    KRD(GL,2); GAPB(o[0]=__builtin_amdgcn_mfma_f32_32x32x16_bf16(PAF(2),VFR(2),o[0],0,0,0), C1,0); \
    KRD(GL,3); GAPB(o[1]=__builtin_amdgcn_mfma_f32_32x32x16_bf16(PAF(2),VFR(6),o[1],0,0,0), C1,4); \
    GAPB(o[0]=__builtin_amdgcn_mfma_f32_32x32x16_bf16(PAF(3),VFR(3),o[0],0,0,0), C1,8); \
    GAPB(o[1]=__builtin_amdgcn_mfma_f32_32x32x16_bf16(PAF(3),VFR(7),o[1],0,0,0), C1,12); \
    }while(0)
  int t=1;
  #undef CMASK
  #define CMASK(P0,P1,t) do{}while(0)
  for(;t+5<NT;t+=2){
    STEP(pB0,pB1,pA0,pA1,t,true,true,true);     WAIT_BAR(2); RESC(); ROT();
    STEP(pA0,pA1,pB0,pB1,t+1,true,true,true);   WAIT_BAR(2); RESC(); ROT();
  }
  #undef CMASK
  #define CMASK(P0,P1,t) do{int jb_=(t)-(NT-4); if(jb_>=0)cmask(P0,P1,jb_,qrel,hi);}while(0)
  #define ENDW(tt) do{ if((tt)+3<NT){WAIT_BAR(2);} else if((tt)+2<NT){WAIT_BAR(1);} else {WAIT_BAR(0);} }while(0)
  for(;t+1<NT;t+=2){
    STEP(pB0,pB1,pA0,pA1,t,(t+3<NT),(t+1<NT),(t+1<NT));       ENDW(t);   RESC(); ROT();
    STEP(pA0,pA1,pB0,pB1,t+1,(t+4<NT),(t+2<NT),(t+2<NT));     ENDW(t+1); RESC(); ROT();
  }
  STEP(pB0,pB1,pA0,pA1,NT-1,false,false,false); RESC();
  { float sacc=pB0[0]+pB0[1]; _Pragma("unroll") for(int r=2;r<16;++r)sacc+=pB0[r]; _Pragma("unroll") for(int r=0;r<16;++r)sacc+=pB1[r]; l_reg+=sacc;
    pw0=(u32x4){PKW(pB0,0),PKW(pB0,2),PKW(pB0,4),PKW(pB0,6)};pw1=(u32x4){PKW(pB0,8),PKW(pB0,10),PKW(pB0,12),PKW(pB0,14)};pw2=(u32x4){PKW(pB1,0),PKW(pB1,2),PKW(pB1,4),PKW(pB1,6)};pw3=(u32x4){PKW(pB1,8),PKW(pB1,10),PKW(pB1,12),PKW(pB1,14)};
    SBAR(); pv(o,vb0+sl_cur,PAF(0),PAF(1),PAF(2),PAF(3)); }
  #undef PKW
  #undef PAF
  #undef VFR
  #undef PIN
  #undef MX3
  #undef GAPA
  #undef GAPB
  #undef EX
  #undef VRD
  #undef KRD
  #undef STEP
  #undef ENDW
  {auto rr=__builtin_amdgcn_permlane32_swap(__float_as_uint(l_reg),__float_as_uint(l_reg),false,false);l_reg=__uint_as_float(rr[0])+__uint_as_float(rr[1]);}
  if(hi==0)wsf[32+r32]=l_reg;asm volatile("s_waitcnt lgkmcnt(0)":::"memory");
  float rli[16];
  #pragma unroll
  for(int r=0;r<16;++r)rli[r]=__builtin_amdgcn_rcpf(wsf[32+crow(r,hi)]);
  bf16*Ow=O+(rowbase+q0+wid*QBLK)*DM+cv;
  { bf16*stg=(bf16*)(shm+LDS_OST)+wid*2048;
    #pragma unroll
    for(int r=0;r<16;++r){const int orow=crow(r,hi);
      #pragma unroll
      for(int d0=0;d0<2;++d0)stg[orow*64+d0*32+r32]=__float2bfloat16(o[d0][r]*rli[r]);}
    asm volatile("s_waitcnt lgkmcnt(0)":::"memory");
    #pragma unroll
    for(int i=0;i<4;++i){const int row=i*8+(lane>>3),ch=lane&7; const u32x4 v=*(const u32x4*)(stg+row*64+ch*8); ATTN_STORE16(Ow+(long)row*DM+ch*8,v);} }
  asm volatile("s_waitcnt lgkmcnt(0)\n\ts_barrier":::"memory");
  #undef DMA_K
  #undef DMA_V
  #undef CMASK
  #undef START
  #undef RESC
  #undef ROT
}
constexpr int ATTN_LDS_BYTES=LDS_BYTES;
struct AttnTensors { const bf16* Q; const bf16* K; const bf16* V; bf16* O0; bf16* O1; };
template<int THRL> __device__ __forceinline__ void attn_phase(char*lds,const AttnTensors&T,int vcu,int G){
  for(int v=vcu;v<256;v+=G){
    const int e=v>>2,s=v&3; const int b=e>>5,rem=e&31,h=rem>>2,m=(rem>>1)&1,vh=rem&1;
    const int cq=(2*h+m)*64,cv=(2*h+vh)*64; bf16*O=m?T.O1:T.O0;
    for(int i=0;i<16;++i){ const int j=i>>1; const int qb=(i&1)?(8*j+7-s):(8*j+s); attn_unit<THRL>(b,cq,cv,qb,T.Q,T.K,T.V,O,lds); }
  }
}
#undef SBAR
#undef WAIT_BAR
}

namespace attn128 {
constexpr int D = 128, PITCH = 1024, SEQ = 16384;
constexpr float THR = 8.f; constexpr bool WSKIP = false;
constexpr float SCALE = 0.125f;
constexpr int NW = 8, QBLK = 32, KVBLK = 64, QB = NW * QBLK;
constexpr int SHM_V = KVBLK * D * 2, SHM_K = KVBLK * D * 2;
constexpr int LDS_BYTES = 2 * SHM_V + 2 * SHM_K + NW * 64 * 4;
using bf16 = unsigned short;
typedef short bf16x8 __attribute__((ext_vector_type(8)));
typedef short s16x4 __attribute__((ext_vector_type(4)));
typedef float f32x16 __attribute__((ext_vector_type(16)));
typedef float f32x4 __attribute__((ext_vector_type(4)));
typedef unsigned u32x4 __attribute__((ext_vector_type(4)));
template <class A, class Bt> struct same_t { static constexpr bool v = false; };
template <class A> struct same_t<A, A> { static constexpr bool v = true; };

#define KSWZ(row, colB) ((row) * 256 + ((colB) ^ (((row) & 7) << 4)))
#define SBAR() __builtin_amdgcn_sched_barrier(0)
__device__ __forceinline__ int v_st(int k, int c) { const int kk = (k & ~0xC) | ((k & 4) << 1) | ((k & 8) >> 1); return ((kk >> 3) * 4 + (c >> 5)) * 512 + ((kk & 7) * 32 + (c & 31)) * 2; }
__device__ __forceinline__ int v_rd_base(int lane) { return ((lane & 3) << 3) | (((lane >> 2) & 3) << 6) | (((lane >> 4) & 1) << 5) | (((lane >> 5) & 1) << 8); }
constexpr int v_rd_off(int d0, int ks, int half) { return d0 * 512 + ks * 4096 + half * 2048; }
__device__ __forceinline__ int crow(int r, int hi) { return (r & 3) + 8 * (r >> 2) + 4 * hi; }
__device__ __forceinline__ unsigned cvtpk(float lo, float hi) {
    unsigned r; asm volatile("v_cvt_pk_bf16_f32 %0, %1, %2" : "=v"(r) : "v"(lo), "v"(hi)); return r;
}
__device__ __forceinline__ bf16x8 pack8(f32x4 a, f32x4 b) {
    u32x4 w = {cvtpk(a[0], a[1]), cvtpk(a[2], a[3]), cvtpk(b[0], b[1]), cvtpk(b[2], b[3])};
    return *reinterpret_cast<bf16x8*>(&w);
}
template <class T> __device__ __forceinline__ bf16x8 load8(const T* p) {
    if constexpr (same_t<T, float>::v) { return pack8(*(const f32x4*)p, *(const f32x4*)(p + 4)); }
    else { return *reinterpret_cast<const bf16x8*>(p); }
}
__device__ __forceinline__ void mask_tile(f32x16& p0, f32x16& p1, int dq, unsigned W) {
    const float NEG = -__builtin_inff();
#pragma unroll
    for (int r = 0; r < 16; ++r) {
        const int c = (r & 3) + 8 * (r >> 2);
        if ((unsigned)(dq - c) >= W) p0[r] = NEG;
        if ((unsigned)(dq - c - 32) >= W) p1[r] = NEG;
    }
}
__device__ __forceinline__ void partialSM(f32x16& p0, f32x16& p1, float& m_reg, float& mn, float& alpha) {
    float pmax = p0[0]; for (int r = 1; r < 16; ++r) pmax = fmaxf(pmax, p0[r]); for (int r = 0; r < 16; ++r) pmax = fmaxf(pmax, p1[r]);
    { auto rr = __builtin_amdgcn_permlane32_swap(__float_as_uint(pmax), __float_as_uint(pmax), false, false);
      pmax = fmaxf(__uint_as_float(rr[0]), __uint_as_float(rr[1])); }
    constexpr float C2 = 1.4426950408889634f * SCALE;
    if (__builtin_expect(__all((pmax - m_reg) * SCALE <= THR), 1)) { mn = m_reg; alpha = 1.f; }
    else { mn = fmaxf(m_reg, pmax); alpha = __builtin_amdgcn_exp2f((m_reg - mn) * C2); m_reg = mn; }
    const float mnL = -mn * C2;
    for (int r = 0; r < 16; ++r) p0[r] = fmaf(p0[r], C2, mnL); for (int r = 0; r < 16; ++r) p1[r] = fmaf(p1[r], C2, mnL);
    for (int r = 0; r < 16; ++r) p0[r] = __builtin_amdgcn_exp2f(p0[r]);
}
__device__ __forceinline__ void finishSM(f32x16& p0, f32x16& p1, float alpha, float& l_reg, bf16x8& pa0, bf16x8& pa1, bf16x8& pa2, bf16x8& pa3) {
    for (int r = 0; r < 16; ++r) p1[r] = __builtin_amdgcn_exp2f(p1[r]);
    float ps = 0; for (int r = 0; r < 16; ++r) ps += p0[r]; for (int r = 0; r < 16; ++r) ps += p1[r];
    { auto rr = __builtin_amdgcn_permlane32_swap(__float_as_uint(ps), __float_as_uint(ps), false, false);
      ps = __uint_as_float(rr[0]) + __uint_as_float(rr[1]); }
    l_reg = l_reg * alpha + ps;
#define PK4(P, B_, OUT) do { unsigned a0 = cvtpk(P[B_+0], P[B_+1]), a1 = cvtpk(P[B_+2], P[B_+3]);                          \
        unsigned b0 = cvtpk(P[B_+4], P[B_+5]), b1 = cvtpk(P[B_+6], P[B_+7]);                                             \
        auto r0 = __builtin_amdgcn_permlane32_swap(a0, b0, false, false); auto r1 = __builtin_amdgcn_permlane32_swap(a1, b1, false, false); \
        u32x4 w = {r0[0], r1[0], r0[1], r1[1]}; OUT = *reinterpret_cast<bf16x8*>(&w); } while (0)
    PK4(p0, 0, pa0); PK4(p0, 8, pa1); PK4(p1, 0, pa2); PK4(p1, 8, pa3);
#undef PK4
}
template <int KB, bool SK>
__device__ __forceinline__ void qkt(f32x16& p0, f32x16& p1, const char* K_lds, int r32, int hi, const bf16x8* qr, bool act, int kmo) {
    if (SK && !act) { const float NEG = -__builtin_inff();
#pragma unroll
        for (int r = 0; r < 16; ++r) { p0[r] = NEG; p1[r] = NEG; } return; }
    p0 = f32x16{}; p1 = f32x16{};
    const char* kb[4];
#pragma unroll
    for (int dd = 0; dd < 4; ++dd) kb[dd] = K_lds + KB * SHM_K + KSWZ(r32, (dd * 16 + hi * 8) * 2);
#pragma unroll
    for (int d0 = 0; d0 < 4; ++d0) { const char* a = kb[d0] + kmo;
        bf16x8 b0 = *reinterpret_cast<const bf16x8*>(a);
        bf16x8 b1 = *reinterpret_cast<const bf16x8*>(a + 32 * 256);
        p0 = __builtin_amdgcn_mfma_f32_32x32x16_bf16(b0, qr[d0], p0, 0, 0, 0);
        p1 = __builtin_amdgcn_mfma_f32_32x32x16_bf16(b1, qr[d0], p1, 0, 0, 0); }
}
template <int VB, bool SK>
__device__ __forceinline__ void pv_tile(f32x16* o, int vb0, bf16x8 pa0, bf16x8 pa1, bf16x8 pa2, bf16x8 pa3, bool act) {
    if (SK && !act) return;
#define TRRD(dst, off) asm volatile("ds_read_b64_tr_b16 %0, %1 offset:%2" : "=&v"(dst) : "v"(vb0), "i"(off) : "memory")
#define PV_D0(d0) do { s16x4 l0, l1, l2, l3, h0, h1, h2, h3; constexpr int b_ = VB * SHM_V + v_rd_off(d0, 0, 0);     \
        TRRD(l0, b_); TRRD(h0, b_ + 2048); TRRD(l1, b_ + 4096); TRRD(h1, b_ + 6144); TRRD(l2, b_ + 8192); TRRD(h2, b_ + 10240); TRRD(l3, b_ + 12288); TRRD(h3, b_ + 14336); \
        asm volatile("s_waitcnt lgkmcnt(0)" ::: "memory"); SBAR();                 \
        o[d0] = __builtin_amdgcn_mfma_f32_32x32x16_bf16(pa0, (bf16x8){l0[0], l0[1], l0[2], l0[3], h0[0], h0[1], h0[2], h0[3]}, o[d0], 0, 0, 0);   \
        o[d0] = __builtin_amdgcn_mfma_f32_32x32x16_bf16(pa1, (bf16x8){l1[0], l1[1], l1[2], l1[3], h1[0], h1[1], h1[2], h1[3]}, o[d0], 0, 0, 0);   \
        o[d0] = __builtin_amdgcn_mfma_f32_32x32x16_bf16(pa2, (bf16x8){l2[0], l2[1], l2[2], l2[3], h2[0], h2[1], h2[2], h2[3]}, o[d0], 0, 0, 0);   \
        o[d0] = __builtin_amdgcn_mfma_f32_32x32x16_bf16(pa3, (bf16x8){l3[0], l3[1], l3[2], l3[3], h3[0], h3[1], h3[2], h3[3]}, o[d0], 0, 0, 0); } while (0)
    PV_D0(0); PV_D0(1); PV_D0(2); PV_D0(3);
#undef PV_D0
#undef TRRD
}

template <class TIn, class TOut> struct BlockRef { const TIn* Q; const TIn* K; const TIn* V; TOut* O; int P0; int kmo; };
template <class TIn> struct Seam {
    bf16x8 qr[4];
    bf16x8 st_v0, st_v1, st_k0, st_k1; f32x4 sf0, sf1, sf2, sf3;
    f32x4 tq[1];
};
__device__ __forceinline__ int swa_jlo(int P0, int W) { const int lowk = P0 - W + 1; return lowk > 0 ? lowk / KVBLK : 0; }
#define ROW(p, k0, rr) ((p) + (size_t)((k0) + (rr)) * PITCH + sc)
#define VMW() asm volatile("s_waitcnt vmcnt(0)" ::: "memory")
#define VMWN(n) asm volatile("s_waitcnt vmcnt(%0)" :: "i"(n) : "memory")
#define SLOAD_H(Kp, Vp, k0) do { S.st_v0 = load8<TIn>(ROW(Vp, k0, sr)); S.st_v1 = load8<TIn>(ROW(Vp, k0, 32 + sr));              \
                         S.st_k0 = load8<TIn>(ROW(Kp, k0, sr)); S.st_k1 = load8<TIn>(ROW(Kp, k0, 32 + sr)); } while (0)
#define SWRITE_HK(bf) do { *(bf16x8*)(K_lds + (bf) * SHM_K + kws) = S.st_k0; *(bf16x8*)(K_lds + (bf) * SHM_K + kws + 32 * 256) = S.st_k1; } while (0)
#define SWRITE_HV(bf) do { *(bf16x8*)(V_lds + (bf) * SHM_V + vst0) = S.st_v0; *(bf16x8*)(V_lds + (bf) * SHM_V + vst1) = S.st_v1; } while (0)
#define SWRITE_H(bf) do { SWRITE_HV(bf); SWRITE_HK(bf); } while (0)
#define SLOAD_F(p, k0) do { S.sf0 = *(const f32x4*)ROW(p, k0, sr); S.sf1 = *(const f32x4*)(ROW(p, k0, sr) + 4);                \
                            S.sf2 = *(const f32x4*)ROW(p, k0, 32 + sr); S.sf3 = *(const f32x4*)(ROW(p, k0, 32 + sr) + 4); } while (0)
#define SWRITE_KF(bf) do { *(bf16x8*)(K_lds + (bf) * SHM_K + kws) = pack8(S.sf0, S.sf1); *(bf16x8*)(K_lds + (bf) * SHM_K + kws + 32 * 256) = pack8(S.sf2, S.sf3); } while (0)
#define SWRITE_VF(bf) do { *(bf16x8*)(V_lds + (bf) * SHM_V + vst0) = pack8(S.sf0, S.sf1); *(bf16x8*)(V_lds + (bf) * SHM_V + vst1) = pack8(S.sf2, S.sf3); } while (0)
template <class TIn, class TOut>
__device__ __forceinline__ void causal_swa_prime(const BlockRef<TIn, TOut>& cur, int W, char* lds, Seam<TIn>& S) {
    constexpr bool F32 = same_t<TIn, float>::v;
    int tid_ = threadIdx.x; asm volatile("" : "+v"(tid_)); const int tid = tid_, wid = __builtin_amdgcn_readfirstlane(tid >> 6), lane = tid & 63, r32 = lane & 31, hi = lane >> 5;
    const int sr = tid >> 4, sc = (tid & 15) * 8, kws = KSWZ(sr, sc * 2); char* K_lds = lds + 2 * SHM_V;
    const int kb0 = swa_jlo(cur.P0, W) * KVBLK;
    for (int d0 = 0; d0 < 4; ++d0) S.qr[d0] = load8<TIn>(cur.Q + (size_t)(wid * QBLK + r32) * PITCH + d0 * 16 + hi * 8);
    if constexpr (F32) { SLOAD_F((const float*)cur.K, kb0); VMW(); SWRITE_KF(0); SBAR(); SLOAD_F((const float*)cur.V, kb0); }
    else { SLOAD_H(cur.K, cur.V, kb0); VMW(); SWRITE_HK(0); }
    __syncthreads();
}
template <class TIn, class TOut>
__device__ __forceinline__ void causal_swa_block(const BlockRef<TIn, TOut>& cur, const BlockRef<TIn, TOut>& nxt, int skv, int W, char* lds, Seam<TIn>& S) {
    constexpr bool F32 = same_t<TIn, float>::v;
    int tid_ = threadIdx.x; asm volatile("" : "+v"(tid_)); const int tid = tid_, wid = __builtin_amdgcn_readfirstlane(tid >> 6), lane = tid & 63, r32 = lane & 31, hi = lane >> 5;
    const int j_lo = swa_jlo(cur.P0, W);
    int j_hi = (cur.P0 + QB - 1) / KVBLK + 1; if (j_hi > skv / KVBLK) j_hi = skv / KVBLK;
    const int NT = j_hi - j_lo;
    const int kbn = swa_jlo(nxt.P0, W) * KVBLK;
    const int qlo = cur.P0 + wid * QBLK, qm = qlo + r32 - 4 * hi;
    char* V_lds = lds; char* K_lds = lds + 2 * SHM_V;
    float* ws = (float*)(lds + 2 * SHM_V + 2 * SHM_K) + wid * 64; float* li_l = ws, * al_l = ws + 32;
    float m_reg = -1e30f, l_reg = 0; f32x16 o[4] = {};
    const int sr = tid >> 4, sc = (tid & 15) * 8, vst0 = v_st(sr, sc), vst1 = v_st(32 + sr, sc), kws = KSWZ(sr, sc * 2);
    const int vb0 = (int)(uintptr_t)V_lds + v_rd_base(lane);
    const TIn* Kh = cur.K; const TIn* Vh = cur.V;
#define RESC(a) do { if (__any((a) < 1.f)) { if (hi == 0) al_l[r32] = (a); asm volatile("s_waitcnt lgkmcnt(0)" ::: "memory");              \
                     for (int d_ = 0; d_ < 4; ++d_) for (int r = 0; r < 16; ++r) o[d_][r] *= al_l[crow(r, hi)]; } } while (0)
#define KBASE(t) ((j_lo + (t)) * KVBLK)
#define ACT(t) (KBASE(t) <= qlo + QBLK - 1 && KBASE(t) + KVBLK - 1 >= qlo - W + 1)
#define MASKT(P0_, P1_, t) do { const int kb_ = KBASE(t); if ((!SK || ACT(t)) && (kb_ + KVBLK - 1 > qlo || kb_ <= qlo + QBLK - 1 - W)) mask_tile(P0_, P1_, qm - kb_, (unsigned)W); } while (0)
    constexpr int NQL = F32 ? 16 : 4;
    constexpr bool SK = WSKIP && !F32;
#define SEAM_K0() do { VMWN(NQL); if constexpr (F32) { SWRITE_KF(0); SBAR(); SLOAD_F((const float*)nxt.V, kbn); } else { SWRITE_HK(0); } SBAR(); } while (0)
    f32x16 pA0, pA1, pB0, pB1; float mnA, mnB, alA, alB; bf16x8 pa0, pa1, pa2, pa3;
    if constexpr (F32) { VMW(); SWRITE_VF(0); SBAR(); } else { SWRITE_HV(0); SBAR(); }
    if (NT > 1) { if constexpr (F32) SLOAD_F((const float*)Kh, KBASE(1)); else SLOAD_H(Kh, Vh, KBASE(1)); }
    SBAR(); qkt<0, SK>(pA0, pA1, K_lds, r32, hi, S.qr, ACT(0), cur.kmo);
    if constexpr (F32) { if (NT > 1) { VMW(); SWRITE_KF(1); SBAR(); SLOAD_F((const float*)Vh, KBASE(1)); } }
    MASKT(pA0, pA1, 0); partialSM(pA0, pA1, m_reg, mnA, alA);
    if (NT > 1) { VMW(); if constexpr (F32) { SWRITE_VF(1); SBAR(); if (NT > 2) SLOAD_F((const float*)Kh, KBASE(2)); } else SWRITE_H(1); }
    __syncthreads();
#define HALF_STEP(PX0, PX1, mnX, alX, PY0, PY1, alY, t, KB, VB, SB) do {                                                      \
        SBAR(); qkt<KB, SK>(PX0, PX1, K_lds, r32, hi, S.qr, ACT(t), cur.kmo);                                             \
        finishSM(PY0, PY1, alY, l_reg, pa0, pa1, pa2, pa3); SBAR();                                                           \
        if ((t) + 1 < NT) { if constexpr (F32) { VMW(); SWRITE_KF(SB); SBAR(); SLOAD_F((const float*)Vh, KBASE((t) + 1)); }  \
                            else { SLOAD_H(Kh, Vh, KBASE((t) + 1)); } SBAR(); }                                               \
        pv_tile<VB, SK>(o, vb0, pa0, pa1, pa2, pa3, ACT((t) - 1)); MASKT(PX0, PX1, (t)); partialSM(PX0, PX1, m_reg, mnX, alX);                                        \
        __syncthreads();                                                                                                      \
        if ((t) + 1 < NT) { VMW(); if constexpr (F32) { SWRITE_VF(SB); SBAR(); if ((t) + 2 < NT) SLOAD_F((const float*)Kh, KBASE((t) + 2)); } \
                            else { SWRITE_H(SB); } }                                                                          \
        RESC(alX); __syncthreads(); } while (0)
    for (int t = 1; t + 1 < NT; t += 2) {
        HALF_STEP(pB0, pB1, mnB, alB, pA0, pA1, alA, t, 1, 0, 0);
        HALF_STEP(pA0, pA1, mnA, alA, pB0, pB1, alB, t + 1, 0, 1, 1);
    }
    const bool even = (NT & 1) == 0;
    if (even) { SBAR(); qkt<1, SK>(pB0, pB1, K_lds, r32, hi, S.qr, ACT(NT - 1), cur.kmo); SBAR(); }
#define QROW(e) (nxt.Q + (size_t)(wid * QBLK + r32) * D + ((e) >> 1) * 16 + hi * 8 + ((e) & 1) * 4)
    if constexpr (F32) { SLOAD_F((const float*)nxt.K, kbn); SBAR();
#pragma unroll
        for (int e = 0; e < 8; ++e) S.tq[e] = *(const f32x4*)QROW(e); }
    else { SLOAD_H(nxt.K, nxt.V, kbn); SBAR();
#pragma unroll
        for (int d0 = 0; d0 < 4; ++d0) S.qr[d0] = load8<TIn>(nxt.Q + (size_t)(wid * QBLK + r32) * PITCH + d0 * 16 + hi * 8); }
    SBAR();
    finishSM(pA0, pA1, alA, l_reg, pa0, pa1, pa2, pa3); SBAR();
    if constexpr (F32) {
#pragma unroll
        for (int e = 8; e < 16; ++e) S.tq[e] = *(const f32x4*)QROW(e); SBAR(); }
#undef QROW
    pv_tile<0, SK>(o, vb0, pa0, pa1, pa2, pa3, ACT(even ? NT - 2 : NT - 1));
    if (even) { MASKT(pB0, pB1, NT - 1); partialSM(pB0, pB1, m_reg, mnB, alB); __syncthreads(); RESC(alB);
        finishSM(pB0, pB1, alB, l_reg, pa0, pa1, pa2, pa3); SBAR(); pv_tile<1, SK>(o, vb0, pa0, pa1, pa2, pa3, ACT(NT - 1)); }
    SBAR(); SEAM_K0();
    if (hi == 0) li_l[r32] = l_reg; asm volatile("s_waitcnt lgkmcnt(0)" ::: "memory");
    float rli[16];
#pragma unroll
    for (int r = 0; r < 16; ++r) rli[r] = __builtin_amdgcn_rcpf(li_l[crow(r, hi)]);
    TOut* Ow = cur.O + (size_t)(wid * QBLK) * PITCH;
#pragma unroll
    for (int r = 0; r < 16; ++r) { const int orow = crow(r, hi);
#pragma unroll
        for (int d0 = 0; d0 < 4; ++d0) { const float v = o[d0][r] * rli[r];
            if constexpr (same_t<TOut, float>::v) { Ow[(size_t)orow * PITCH + d0 * 32 + r32] = v; }
            else { const float vn = __shfl_xor(v, 1);
                   if ((r32 & 1) == 0) *(unsigned*)(Ow + (size_t)orow * PITCH + d0 * 32 + r32) = cvtpk(v, vn); } } }
    if constexpr (F32) {
#pragma unroll
        for (int d0 = 0; d0 < 8; ++d0) S.qr[d0] = pack8(S.tq[2 * d0], S.tq[2 * d0 + 1]); }
    __syncthreads();
#undef RESC
#undef KBASE
#undef ACT
#undef MASKT
#undef SEAM_K0
#undef HALF_STEP
}
#undef ROW
#undef VMW
#undef VMWN
#undef SLOAD_H
#undef SWRITE_HK
#undef SWRITE_HV
#undef SWRITE_H
#undef SLOAD_F
#undef SWRITE_KF
#undef SWRITE_VF


struct AttnTensors { const bf16* Q; const bf16* K; const bf16* V; bf16* O0; bf16* O1; };
__device__ __forceinline__ BlockRef<bf16, bf16> blk_ref(const AttnTensors& T, int vcu, int G, int li) {
    const int v = vcu + (li >> 3) * G, i = li & 7, e = v >> 3, s = v & 7, b = e >> 4, h = (e >> 1) & 7, m = e & 1, j = i >> 1;
    const int qb = (i & 1) ? (16 * j + 15 - s) : (16 * j + s);
    BlockRef<bf16, bf16> r;
    r.Q = T.Q + ((size_t)b * SEQ + (size_t)qb * QB) * PITCH + h * 128 + m * 64;
    r.K = T.K + (size_t)b * SEQ * PITCH + h * 128; r.V = T.V + (size_t)b * SEQ * PITCH + h * 128;
    r.O = (m ? T.O1 : T.O0) + ((size_t)b * SEQ + (size_t)qb * QB) * PITCH + h * 128;
    r.P0 = qb * QB; r.kmo = m * 128;
    return r;
}
__device__ __forceinline__ void attn_phase(char* lds, const AttnTensors& T, int vcu, int G) {
    int nv = 0; for (int v = vcu; v < 256; v += G) ++nv;
    const int nblk = nv * 8; if (nblk == 0) return;
    Seam<bf16> S;
    BlockRef<bf16, bf16> cur = blk_ref(T, vcu, G, 0);
    causal_swa_prime<bf16, bf16>(cur, SEQ, lds, S);
    for (int li = 0; li < nblk; ++li) {
        const BlockRef<bf16, bf16> nxt = (li + 1 < nblk) ? blk_ref(T, vcu, G, li + 1) : cur;
        causal_swa_block<bf16, bf16>(cur, nxt, SEQ, SEQ, lds, S);
        cur = nxt;
    }
}
}

#define GAS __attribute__((address_space(1)))
#define LAS __attribute__((address_space(3)))
typedef unsigned short bf16;
typedef unsigned v4u __attribute__((ext_vector_type(4)));
typedef float f32x4 __attribute__((ext_vector_type(4)));
typedef short bf16x8 __attribute__((ext_vector_type(8)));
typedef GAS unsigned gu32;
typedef GAS unsigned long long gu64;
#define RLX_AGENT __ATOMIC_RELAXED, __HIP_MEMORY_SCOPE_AGENT
#define LDS_WAIT() asm volatile("s_waitcnt lgkmcnt(0)" ::: "memory")
#define VM_WAIT() asm volatile("s_waitcnt vmcnt(0)" ::: "memory")
__device__ __forceinline__ unsigned long long rt() { return __builtin_amdgcn_s_memrealtime(); }

#define XB_TMO      128
#define XB_XCNT(j)  (256  + 64 * (j))
#define XB_XSUB(j)  (1280 + 64 * (j))
#define XB_XGEN(j)  (2304 + 64 * (j))
#define XB_TOP      3328
#define XB_TOPGEN   3392
#define XCD_BAR_WORDS 3456
#define XB_SPIN_CAP (1u << 18)

__device__ __forceinline__ unsigned xb_ld(unsigned* p)              { return __hip_atomic_load(p, __ATOMIC_RELAXED, __HIP_MEMORY_SCOPE_AGENT); }
__device__ __forceinline__ unsigned xb_add(unsigned* p, unsigned v) { return __hip_atomic_fetch_add(p, v, __ATOMIC_RELAXED, __HIP_MEMORY_SCOPE_AGENT); }
__device__ __forceinline__ unsigned xb_xcc_id() { return (unsigned)__builtin_amdgcn_s_getreg((3 << 11) | 20) & 0xFu; }
#define XB_SPIN(cond, bar) do { unsigned _sp = 0; while (cond) { __builtin_amdgcn_s_sleep(1); \
    if ((++_sp & 255u) == 0u) { if (xb_ld(&(bar)[XB_TMO])) break; if (_sp > XB_SPIN_CAP) { atomicAdd(&(bar)[XB_TMO], 1u); break; } } } } while (0)

struct XcdBarrier {
    unsigned* bar; unsigned x;
    volatile LAS unsigned* st;
};

__device__ __forceinline__ XcdBarrier xcd_barrier_post(unsigned* bar, volatile LAS unsigned* st) {
    XcdBarrier b; b.bar = bar; b.x = xb_xcc_id(); b.st = st;
    if (threadIdx.x == 0) (void)xb_add(&bar[XB_XCNT(b.x)], 1u);
    return b;
}
__device__ __forceinline__ void xcd_barrier_complete(unsigned* bar, unsigned x, unsigned& nloc, unsigned& nx) {
    const unsigned G = gridDim.x * gridDim.y * gridDim.z;
    unsigned sum, cnt, mine, sp = 0u;
    for (;;) {
        sum = 0u; cnt = 0u; mine = 0u;
#pragma unroll
        for (unsigned j = 0; j < 16; ++j) { const unsigned c = xb_ld(&bar[XB_XCNT(j)]); sum += c; cnt += (c > 0u) ? 1u : 0u; mine = (j == x) ? c : mine; }
        if (sum == G) break;
        __builtin_amdgcn_s_sleep(1);
        if ((++sp & 255u) == 0u) { if (xb_ld(&bar[XB_TMO])) break; if (sp > XB_SPIN_CAP) { atomicAdd(&bar[XB_TMO], 1u); break; } }
    }
    nloc = mine > 0u ? mine : 1u; nx = cnt > 0u ? cnt : 1u;
}

__device__ __forceinline__ void xcd_barrier(const XcdBarrier& b) {
    asm volatile("s_waitcnt vmcnt(0)" ::: "memory");
    __syncthreads();
    if (threadIdx.x == 0) {
        unsigned* bar = b.bar;
        __builtin_amdgcn_s_waitcnt(0);
        unsigned nloc = b.st[0], nx = b.st[1];
        if (nloc == 0u) { xcd_barrier_complete(bar, b.x, nloc, nx); b.st[0] = nloc; b.st[1] = nx; }
        const unsigned old = xb_add(&bar[XB_XSUB(b.x)], 1u);
        const unsigned gen = old / nloc;
        if (old + 1u == (gen + 1u) * nloc) {
            __builtin_amdgcn_fence(__ATOMIC_RELEASE, "agent");
            asm volatile("s_waitcnt vmcnt(0)" ::: "memory");
            const unsigned og = xb_add(&bar[XB_TOP], 1u);
            const unsigned tg = og / nx;
            if (og + 1u == (tg + 1u) * nx) xb_add(&bar[XB_TOPGEN], 1u);
            else XB_SPIN(xb_ld(&bar[XB_TOPGEN]) == tg, bar);
            __builtin_amdgcn_fence(__ATOMIC_ACQUIRE, "agent");
            xb_add(&bar[XB_XGEN(b.x)], 1u);
            asm volatile("s_waitcnt vmcnt(0)" ::: "memory");
        } else {
            XB_SPIN(xb_ld(&bar[XB_XGEN(b.x)]) == gen, bar);
            __builtin_amdgcn_fence(__ATOMIC_ACQUIRE, "agent");
            asm volatile("s_waitcnt vmcnt(0)" ::: "memory");
        }
    }
    __syncthreads();
}
constexpr int NWAVES = 8;
#ifndef REP_SCAN
#define REP_SCAN 1
#endif
#ifndef REP_ATTN
#define REP_ATTN 1
#endif
#ifndef REP_PASS
#define REP_PASS 1
#endif
#ifndef REP_OG
#define REP_OG 1
#endif
#ifndef REP_SYNC
#define REP_SYNC 0
#endif
#ifndef REP_G1
#define REP_G1 1
#endif
constexpr int BATCH = 2, SEQ = 16384, D = 1024, M = BATCH * SEQ;
constexpr size_t MiB = 1u << 20;
constexpr size_t WS_ROPE_C = 1 * MiB, WS_ROPE_S = 2 * MiB, WS_S = 3 * MiB, WS_BIAS = 5 * MiB, WS_W = 6 * MiB, WS_U = 32 * MiB, UNIT = 64 * MiB, WS_H = WS_U + 7 * UNIT, WS_END = WS_H + 16 * MiB;
constexpr size_t W_FOLD = 0, W_UP = 17 * MiB, W_OUT = 19 * MiB;
constexpr size_t W_PROJ = 0, W_BOUT = 8 * MiB;
constexpr int LDS_BYTES = 147456;
constexpr float C2F = 0.125f * 1.4426950408889634f;
#ifdef ATTN_D64
#define QSCALE_MASK0 0x4
#define QSCALE_MASK1 0x1
#else
#define QSCALE_MASK0 0x0
#define QSCALE_MASK1 0x0
#endif

typedef _Float16 h16x4 __attribute__((ext_vector_type(4)));
typedef unsigned u32x2 __attribute__((ext_vector_type(2)));
typedef float f32x2 __attribute__((ext_vector_type(2)));
__device__ __forceinline__ unsigned f2bf(float f) { unsigned u = __builtin_bit_cast(unsigned, f); return (u + 0x7fffu + ((u >> 16) & 1u)) >> 16; }
__device__ __forceinline__ unsigned pk2(float lo, float hi) { return f2bf(lo) | (f2bf(hi) << 16); }
__device__ __forceinline__ float bflo(unsigned w) { return __uint_as_float(w << 16); }
__device__ __forceinline__ float bfhi(unsigned w) { return __uint_as_float(w & 0xffff0000u); }
__device__ __forceinline__ float wave_sum(float v) {
#pragma unroll
    for (int o = 1; o < 64; o <<= 1) v += __shfl_xor(v, o);
    return v;
}
template <int CTRL> __device__ __forceinline__ float dpp_mov(float x) { return __builtin_bit_cast(float, __builtin_amdgcn_update_dpp(0, __builtin_bit_cast(int, x), CTRL, 0xf, 0xf, false)); }
__device__ __forceinline__ float allreduce16(float x) { x += dpp_mov<0x128>(x); x += dpp_mov<0x124>(x); x += dpp_mov<0x122>(x); x += dpp_mov<0x121>(x); return x; }

__device__ __forceinline__ void conv_tile(const float* src, int ldsrc, int k0s, int n0s, int kvalid, const float* sc, int smode, bf16* dst, int pitch, int n0d, int k0d, LAS float* scr, int lane) {
#pragma unroll 8
    for (int i = 0; i < 32; ++i) { const int kk = 2 * i + (lane >> 5), n = lane & 31; float v = 0.f;
        if (kk < kvalid) { v = src[(size_t)(k0s + kk) * ldsrc + n0s + n]; if (smode) { const float s = sc[k0s + kk]; v *= (smode == 1) ? s : (1.0f - s); } }
        scr[kk * 33 + n] = v; }
    LDS_WAIT(); asm volatile("" ::: "memory");
    const int c = lane & 7;
#pragma unroll
    for (int j = 0; j < 4; ++j) { const int n = (lane >> 3) + 8 * j; const LAS float* s = scr + (8 * c) * 33 + n;
        v4u o; o.x = pk2(s[0 * 33], s[1 * 33]); o.y = pk2(s[2 * 33], s[3 * 33]); o.z = pk2(s[4 * 33], s[5 * 33]); o.w = pk2(s[6 * 33], s[7 * 33]);
        *(v4u*)(dst + (size_t)(n0d + n) * pitch + k0d + 8 * c) = o; }
    LDS_WAIT(); asm volatile("" ::: "memory");
}

struct In {
    const float* x; const int* pos; const float *a_norm, *a_mu, *a_w_in, *a_w0, *a_w1, *a_w2, *a_a0, *a_a1, *a_a2, *a_v0, *a_v1, *a_v2, *a_k_k, *a_k_a, *a_r_k, *a_ln_w, *a_ln_b, *a_w_out;
    const float *kv_norm, *w_kv, *b_norm, *b_w_in, *b_lq1, *b_lk1, *b_lq2, *b_lk2, *b_subln, *b_w_out, *final_norm;
};

__device__ __forceinline__ void conv_rwkv(const In& I, int l, unsigned char* wreg, float* bias3, LAS float* scr, int gw, int NGW, int lane) {
    if (gw < 48) { const int i = gw * 64 + lane; const int t = i >> 10, c = i & 1023; bias3[i] = (t == 0) ? I.a_w0[l * 1024 + c] : (t == 1) ? I.a_a0[l * 1024 + c] : I.a_v0[c]; }
    bf16* Wf = (bf16*)(wreg + W_FOLD); bf16* Wu = (bf16*)(wreg + W_UP); bf16* Wo = (bf16*)(wreg + W_OUT);
    const int NUPB = (l == 0 ? 2048 : 3072) / 32;
    const int I_F = 136 * 32, I_U = NUPB * 4, I_O = 32 * 16;
    for (int it = gw; it < I_F + I_U + I_O; it += NGW) {
        int r = it;
        if (r < I_F) { const int nb = r >> 5, kb = r & 31; const int n0d = nb * 32, k0d = kb * 64, half = kb >> 4, k0s = (kb & 15) * 64;
            const float* mu = I.a_mu + (size_t)l * 6 * 1024;
            if (n0d < 4096) { const int p = n0d >> 10; conv_tile(I.a_w_in + (size_t)(l * 4 + p) * 1024 * 1024, 1024, k0s, n0d & 1023, 64, mu + p * 1024, half ? 1 : 2, Wf, 2048, n0d, k0d, scr, lane); }
            else { const int c0 = n0d - 4096;
                if (c0 < 64) conv_tile(I.a_w1 + (size_t)l * 1024 * 64, 64, k0s, c0, 64, mu + 4 * 1024, half ? 1 : 2, Wf, 2048, n0d, k0d, scr, lane);
                else if (c0 < 128) conv_tile(I.a_a1 + (size_t)l * 1024 * 64, 64, k0s, c0 - 64, 64, mu + 5 * 1024, half ? 1 : 2, Wf, 2048, n0d, k0d, scr, lane);
                else if (c0 < 160 && l == 1) conv_tile(I.a_v1, 32, k0s, 0, 64, mu + 2 * 1024, half ? 1 : 2, Wf, 2048, n0d, k0d, scr, lane);
                else conv_tile(I.a_w1, 64, 0, 0, 0, mu, 0, Wf, 2048, n0d, k0d, scr, lane); }
            continue; }
        r -= I_F;
        if (r < I_U) { const int nb = r >> 2, kb = r & 3; const int n0d = nb * 32, k0d = kb * 64, t = n0d >> 10;
            if (kb == t) { if (t == 0) conv_tile(I.a_w2 + (size_t)l * 64 * 1024, 1024, 0, n0d, 64, I.a_mu, 0, Wu, 256, n0d, k0d, scr, lane);
                else if (t == 1) conv_tile(I.a_a2 + (size_t)l * 64 * 1024, 1024, 0, n0d - 1024, 64, I.a_mu, 0, Wu, 256, n0d, k0d, scr, lane);
                else conv_tile(I.a_v2, 1024, 0, n0d - 2048, 32, I.a_mu, 0, Wu, 256, n0d, k0d, scr, lane); }
            else conv_tile(I.a_w2, 1024, 0, 0, 0, I.a_mu, 0, Wu, 256, n0d, k0d, scr, lane);
            continue; }
        r -= I_U;
        { const int nb = r >> 4, kb = r & 15; conv_tile(I.a_w_out + (size_t)l * 1024 * 1024, 1024, kb * 64, nb * 32, 64, I.a_mu, 0, Wo, 1024, nb * 32, kb * 64, scr, lane); }
    }
}
__device__ __forceinline__ void conv_attn(const In& I, int j, unsigned char* wreg, LAS float* scr, int gw, int NGW, int lane) {
    bf16* Wp = (bf16*)(wreg + W_PROJ); bf16* Wo = (bf16*)(wreg + W_BOUT);
    const int NPB = (j == 0 ? 4096 : 2048) / 32;
    const int I_P = NPB * 16, I_O = 32 * 16;
    for (int it = gw; it < I_P + I_O; it += NGW) {
        int r = it;
        if (r < I_P) { const int nb = r >> 4, kb = r & 15; const int n0d = nb * 32, k0 = kb * 64;
            if (j == 0) { if (n0d < 2048) conv_tile(I.w_kv, 2048, k0, n0d, 64, I.kv_norm, 1, Wp, 1024, n0d, k0, scr, lane);
                else conv_tile(I.b_w_in, 2048, k0, n0d - 2048, 64, I.b_norm, 1, Wp, 1024, n0d, k0, scr, lane); }
            else conv_tile(I.b_w_in + (size_t)1024 * 2048, 2048, k0, n0d, 64, I.b_norm + 1024, 1, Wp, 1024, n0d, k0, scr, lane);
            continue; }
        r -= I_P;
        { const int nb = r >> 4, kb = r & 15; conv_tile(I.b_w_out + (size_t)j * 1024 * 1024, 1024, kb * 64, nb * 32, 64, I.kv_norm, 0, Wo, 1024, nb * 32, kb * 64, scr, lane); }
    }
}

__device__ __forceinline__ void rope_tables(const int* pos, float* rc, float* rs, int gtid, int nthr) {
    for (int idx = gtid; idx < M * 8; idx += nthr) { const int m = idx >> 3, i = idx & 7;
        const float inv = (i == 0) ? 1.0f : (i == 1) ? 0.1939227432012558f : (i == 2) ? 0.03760603070259094f : (i == 3) ? 0.007292664609849453f : (i == 4) ? 0.0014142135623842478f : (i == 5) ? 0.00027424818836152554f : (i == 6) ? 5.3182957344688475e-05f : 1.0313385246263351e-05f;
        const float ang = (float)pos[m] * inv;
        const double x = (double)ang; const double k = __builtin_rint(x * 0.15915494309189535); const double r = x - k * 6.283185307179586476925;
        const double r2 = r * r; double sn = 0.0, cs = 0.0;
#pragma unroll
        for (int t = 12; t >= 1; --t) { sn = (1.0 - sn) * r2 / (double)((2 * t) * (2 * t + 1)); cs = (1.0 - cs) * r2 / (double)((2 * t - 1) * (2 * t)); }
        rs[idx] = (float)(r * (1.0 - sn)); rc[idx] = (float)(1.0 - cs); }
}

__device__ __forceinline__ void pre_rwkv(const float* x, const float* g, bf16* XN2, int gw, int NGW, int lane) {
    f32x4 gv[4];
#pragma unroll
    for (int j = 0; j < 4; ++j) gv[j] = *((const f32x4*)g + lane + 64 * j);
    for (int c = gw; c < M / 16; c += NGW) { const int m0 = c * 16;
        f32x4 prev[4];
#pragma unroll
        for (int j = 0; j < 4; ++j) prev[j] = (f32x4){0.f, 0.f, 0.f, 0.f};
        if ((m0 % SEQ) != 0) { const f32x4* xr = (const f32x4*)(x + (size_t)(m0 - 1) * D) + lane; f32x4 v[4]; float s = 0.f;
#pragma unroll
            for (int j = 0; j < 4; ++j) { v[j] = xr[64 * j]; s += (v[j].x * v[j].x + v[j].y * v[j].y) + (v[j].z * v[j].z + v[j].w * v[j].w); }
            const float rstd = 1.0f / sqrtf(wave_sum(s) * (1.0f / D) + 1e-6f);
#pragma unroll
            for (int j = 0; j < 4; ++j) prev[j] = v[j] * rstd * gv[j]; }
        for (int r = 0; r < 16; ++r) { const int m = m0 + r; const f32x4* xr = (const f32x4*)(x + (size_t)m * D) + lane; f32x4 v[4]; float s = 0.f;
#pragma unroll
            for (int j = 0; j < 4; ++j) { v[j] = xr[64 * j]; s += (v[j].x * v[j].x + v[j].y * v[j].y) + (v[j].z * v[j].z + v[j].w * v[j].w); }
            const float rstd = 1.0f / sqrtf(wave_sum(s) * (1.0f / D) + 1e-6f);
            unsigned long long* o8 = (unsigned long long*)(XN2 + (size_t)m * 2048) + lane;
#pragma unroll
            for (int j = 0; j < 4; ++j) { const f32x4 xn = v[j] * rstd * gv[j];
                o8[64 * j] = (unsigned long long)pk2(xn.x, xn.y) | ((unsigned long long)pk2(xn.z, xn.w) << 32);
                o8[256 + 64 * j] = (unsigned long long)pk2(prev[j].x, prev[j].y) | ((unsigned long long)pk2(prev[j].z, prev[j].w) << 32);
                prev[j] = xn; } }
    }
}
__device__ __forceinline__ void pre_attn(const float* x, bf16* XH, int gw, int NGW, int lane) {
    for (int m = gw; m < M; m += NGW) { const f32x4* xr = (const f32x4*)(x + (size_t)m * D) + lane; f32x4 v[4]; float s = 0.f;
#pragma unroll
        for (int j = 0; j < 4; ++j) { v[j] = xr[64 * j]; s += (v[j].x * v[j].x + v[j].y * v[j].y) + (v[j].z * v[j].z + v[j].w * v[j].w); }
        const float rstd = 1.0f / sqrtf(wave_sum(s) * (1.0f / D) + 1e-6f);
        unsigned long long* o8 = (unsigned long long*)(XH + (size_t)m * D) + lane;
#pragma unroll
        for (int j = 0; j < 4; ++j) o8[64 * j] = (unsigned long long)pk2(v[j].x * rstd, v[j].y * rstd) | ((unsigned long long)pk2(v[j].z * rstd, v[j].w * rstd) << 32); }
}
__device__ __forceinline__ void final_norm_rows(const float* x, const float* g, float* out, int gw, int NGW, int lane) {
    f32x4 gv[4];
#pragma unroll
    for (int j = 0; j < 4; ++j) gv[j] = *((const f32x4*)g + lane + 64 * j);
    for (int m = gw; m < M; m += NGW) { const f32x4* xr = (const f32x4*)(x + (size_t)m * D) + lane; f32x4 v[4]; float s = 0.f;
#pragma unroll
        for (int j = 0; j < 4; ++j) { v[j] = xr[64 * j]; s += (v[j].x * v[j].x + v[j].y * v[j].y) + (v[j].z * v[j].z + v[j].w * v[j].w); }
        const float rstd = 1.0f / sqrtf(wave_sum(s) * (1.0f / D) + 1e-6f);
        f32x4* o = (f32x4*)(out + (size_t)m * D) + lane;
#pragma unroll
        for (int j = 0; j < 4; ++j) o[64 * j] = v[j] * rstd * gv[j]; }
}

__device__ __forceinline__ void ld16bf(const bf16* p, float (&f)[16]) { const v4u a = *(const v4u*)p, b = *(const v4u*)(p + 8);
    f[0] = bflo(a.x); f[1] = bfhi(a.x); f[2] = bflo(a.y); f[3] = bfhi(a.y); f[4] = bflo(a.z); f[5] = bfhi(a.z); f[6] = bflo(a.w); f[7] = bfhi(a.w);
    f[8] = bflo(b.x); f[9] = bfhi(b.x); f[10] = bflo(b.y); f[11] = bfhi(b.y); f[12] = bflo(b.z); f[13] = bfhi(b.z); f[14] = bflo(b.w); f[15] = bfhi(b.w); }
__device__ __forceinline__ void st16bf(bf16* p, const float (&f)[16]) { v4u a, b;
    a.x = pk2(f[0], f[1]); a.y = pk2(f[2], f[3]); a.z = pk2(f[4], f[5]); a.w = pk2(f[6], f[7]); b.x = pk2(f[8], f[9]); b.y = pk2(f[10], f[11]); b.z = pk2(f[12], f[13]); b.w = pk2(f[14], f[15]);
    *(v4u*)p = a; *(v4u*)(p + 8) = b; }

__device__ __forceinline__ void post_rwkv(const bf16* Y, const float* S, const bf16* V, const bf16* G, const float* ln_w, const float* ln_b, bf16* O, int gw, int NGW, int lane) {
    float lw[16], lb[16];
#pragma unroll
    for (int i = 0; i < 16; ++i) { lw[i] = ln_w[lane * 16 + i]; lb[i] = ln_b[lane * 16 + i]; }
    for (int m = gw; m < M; m += NGW) { const size_t off = (size_t)m * D + lane * 16;
        float y[16], v[16], g[16], o[16]; ld16bf(Y + off, y); ld16bf(V + off, v); ld16bf(G + off, g);
        const float sb = S[(size_t)m * 16 + (lane >> 2)];
        float sum = 0.f;
#pragma unroll
        for (int i = 0; i < 16; ++i) sum += y[i];
        sum += __shfl_xor(sum, 1); sum += __shfl_xor(sum, 2);
        const float mean = sum * (1.0f / 64.0f); float q = 0.f;
#pragma unroll
        for (int i = 0; i < 16; ++i) { const float d = y[i] - mean; q += d * d; }
        q += __shfl_xor(q, 1); q += __shfl_xor(q, 2);
        const float rstd = 1.0f / sqrtf(q * (1.0f / 64.0f) + 64e-5f);
#pragma unroll
        for (int i = 0; i < 16; ++i) { const float yn = (y[i] - mean) * rstd * lw[i] + lb[i]; o[i] = (yn + sb * v[i]) * (g[i] / (1.0f + __expf(-g[i]))); }
        st16bf(O + off, o); }
}
__device__ __forceinline__ void post_attn(const bf16* O0, const bf16* O1, const bf16* GT, const float* subln, float lam, float lam_init, bf16* O, int gw, int NGW, int lane) {
    float sw[16];
#pragma unroll
    for (int i = 0; i < 16; ++i) sw[i] = subln[(lane & 7) * 16 + i] * (1.0f - lam_init);
    for (int m = gw; m < M; m += NGW) { const size_t off = (size_t)m * D + lane * 16;
        float a[16], b[16], g[16], o[16]; ld16bf(O0 + off, a); ld16bf(O1 + off, b); ld16bf(GT + off, g);
        float q = 0.f;
#pragma unroll
        for (int i = 0; i < 16; ++i) { o[i] = a[i] - lam * b[i]; q += o[i] * o[i]; }
        q += __shfl_xor(q, 1); q += __shfl_xor(q, 2); q += __shfl_xor(q, 4);
        const float rstd = 1.0f / sqrtf(q * (1.0f / 128.0f) + 1e-5f);
#pragma unroll
        for (int i = 0; i < 16; ++i) o[i] = o[i] * rstd * sw[i] * (g[i] / (1.0f + __expf(-g[i])));
        st16bf(O + off, o); }
}

constexpr int SC_T = 32, SC_NB = SEQ / SC_T, SC_OPS = SC_T * 320, SC_TP = SC_T + 4, SC_VB = SC_TP * 8, SC_YP = SC_TP * 128;
struct ScRaw { u32x2 r, k, w, a; };
__device__ __forceinline__ void scan_phase(LAS unsigned char* lds, const bf16* R, const bf16* K, const bf16* V, const _Float16* W, const _Float16* A, const float* k_k, const float* k_a, const float* r_k,
                                           bf16* Y, float* S, int vcu, int G, int tid, int wave, int lane) {
    LAS float* OPS = (LAS float*)lds;
    LAS float* VB = (LAS float*)(lds + 2 * SC_OPS * 4);
    LAS float* YP = (LAS float*)(lds + 2 * SC_OPS * 4 + 2 * SC_VB * 4);
    for (int u = vcu; u < 256; u += G) {
        const int bh = u >> 3, rg = u & 7, b = bh >> 4, h = bh & 15;
        const size_t rowbase = (size_t)b * SEQ; const int cb = h * 64;
        const int pw = (wave == 2) ? 0 : (wave == 3) ? 1 : (wave == 6) ? 2 : 3;
        const int p = pw * 64 + lane, ptt = p >> 4, c4 = (p & 15) * 4;
        f32x4 kkw = {0.f, 0.f, 0.f, 0.f}, kaw = kkw, rkw = kkw;
        ScRaw rawA0, rawA1, rawB0, rawB1; rawA0.r = (u32x2){0u, 0u}; rawA0.k = rawA0.r; rawA0.w = rawA0.r; rawA0.a = rawA0.r; rawA1 = rawA0; rawB0 = rawA0; rawB1 = rawA0;
        v4u rawvA = {0u, 0u, 0u, 0u}, rawvB = rawvA;
        const bool prod = (wave == 2 || wave == 3 || wave == 6 || wave == 7), vld = (wave == 2 && lane < 32), ywr = (wave == 7), cons = (wave < 2);
        if (prod) { kkw = *(const f32x4*)(k_k + cb + c4); kaw = *(const f32x4*)(k_a + cb + c4); rkw = *(const f32x4*)(r_k + cb + c4); }
        const int jq = lane & 15, rl = wave * 4 + (lane >> 4);
        f32x2 S01 = {0.f, 0.f}, S23 = {0.f, 0.f};
#define SC_LOAD1(raw, nblk, tt_) do { const size_t o_ = (rowbase + (size_t)(nblk) * SC_T + (tt_)) * D + cb + c4; raw.r = *(const u32x2*)(R + o_); raw.k = *(const u32x2*)(K + o_); raw.w = *(const u32x2*)(W + o_); raw.a = *(const u32x2*)(A + o_); } while (0)
#define SC_LOAD(raw0, raw1, rawv, nblk) do { if (prod) { SC_LOAD1(raw0, nblk, ptt); SC_LOAD1(raw1, nblk, ptt + 16); } \
        if (vld) { rawv = *(const v4u*)(V + (rowbase + (size_t)(nblk) * SC_T + lane) * D + cb + rg * 8); } } while (0)
#define SC_DERIVE1(raw, nblk, buf, tt_) do { \
            const float r0 = bflo(raw.r.x), r1 = bfhi(raw.r.x), r2 = bflo(raw.r.y), r3 = bfhi(raw.r.y); \
            const float k0 = bflo(raw.k.x), k1 = bfhi(raw.k.x), k2 = bflo(raw.k.y), k3 = bfhi(raw.k.y); \
            const h16x4 wh = __builtin_bit_cast(h16x4, raw.w), ah = __builtin_bit_cast(h16x4, raw.a); \
            const float a0 = (float)ah[0], a1 = (float)ah[1], a2 = (float)ah[2], a3 = (float)ah[3]; \
            const float x0 = k0 * kkw.x, x1 = k1 * kkw.y, x2 = k2 * kkw.z, x3 = k3 * kkw.w; \
            const float ss = allreduce16((x0 * x0 + x1 * x1) + (x2 * x2 + x3 * x3)); \
            const float inv = 1.0f / fmaxf(sqrtf(ss), 1e-12f); \
            const f32x4 kn = {x0 * inv, x1 * inv, x2 * inv, x3 * inv}; \
            const f32x4 km = {k0 * (1.0f + (a0 - 1.0f) * kaw.x), k1 * (1.0f + (a1 - 1.0f) * kaw.y), k2 * (1.0f + (a2 - 1.0f) * kaw.z), k3 * (1.0f + (a3 - 1.0f) * kaw.w)}; \
            const float sp = allreduce16((r0 * km.x * rkw.x + r1 * km.y * rkw.y) + (r2 * km.z * rkw.z + r3 * km.w * rkw.w)); \
            LAS float* op_ = OPS + (buf) * SC_OPS + (tt_) * 320 + c4; \
            *(LAS f32x4*)(op_) = -kn; \
            *(LAS f32x4*)(op_ + 64) = (f32x4){kn.x * a0, kn.y * a1, kn.z * a2, kn.w * a3}; \
            *(LAS f32x4*)(op_ + 128) = (f32x4){__expf(-__expf((float)wh[0])), __expf(-__expf((float)wh[1])), __expf(-__expf((float)wh[2])), __expf(-__expf((float)wh[3]))}; \
            *(LAS f32x4*)(op_ + 192) = km; \
            *(LAS f32x4*)(op_ + 256) = (f32x4){r0, r1, r2, r3}; \
            if (rg == 0 && c4 == 0) S[(rowbase + (size_t)(nblk) * SC_T + (tt_)) * 16 + h] = sp; } while (0)
#define SC_DERIVE(raw0, raw1, rawv, nblk, buf) do { if (prod) { SC_DERIVE1(raw0, nblk, buf, ptt); SC_DERIVE1(raw1, nblk, buf, ptt + 16); } \
        if (vld) { LAS float* vb_ = VB + (buf) * SC_VB + lane; \
            vb_[0] = bflo(rawv.x); vb_[SC_TP] = bfhi(rawv.x); vb_[2 * SC_TP] = bflo(rawv.y); vb_[3 * SC_TP] = bfhi(rawv.y); vb_[4 * SC_TP] = bflo(rawv.z); vb_[5 * SC_TP] = bfhi(rawv.z); vb_[6 * SC_TP] = bflo(rawv.w); vb_[7 * SC_TP] = bfhi(rawv.w); } } while (0)
#define SC_YOUT1(nblk, buf, tt_) do { const int rp_ = lane & 3; const LAS float* yp_ = YP + (buf) * SC_YP + (2 * rp_) * 16 * SC_TP + (tt_); \
            float y0_ = 0.f, y1_ = 0.f; \
            _Pragma("unroll") for (int j_ = 0; j_ < 16; ++j_) { y0_ += yp_[j_ * SC_TP]; y1_ += yp_[(16 + j_) * SC_TP]; } \
            *(unsigned*)(Y + (rowbase + (size_t)(nblk) * SC_T + (tt_)) * D + cb + rg * 8 + 2 * rp_) = pk2(y0_, y1_); } while (0)
#define SC_YOUT(nblk, buf) do { SC_YOUT1(nblk, buf, lane >> 2); SC_YOUT1(nblk, buf, (lane >> 2) + 16); } while (0)
#define SC_BAR() asm volatile("s_waitcnt lgkmcnt(0)\n\ts_barrier" ::: "memory")
#define SC_LDOPS(N, B, W_, K_, R_, t) do { const LAS float* o_ = ops + (t) * 320; N = *(const LAS f32x4*)(o_); B = *(const LAS f32x4*)(o_ + 64); W_ = *(const LAS f32x4*)(o_ + 128); K_ = *(const LAS f32x4*)(o_ + 192); R_ = *(const LAS f32x4*)(o_ + 256); } while (0)
#define SC_CONSUME(buf) do { const LAS float* ops = OPS + (buf) * SC_OPS + 4 * jq; const LAS float* vb = VB + (buf) * SC_VB + rl * SC_TP; LAS float* yp = YP + (buf) * SC_YP + (rl * 16 + jq) * SC_TP; \
            f32x4 nk, bb, dw, km, rr, nk2, bb2, dw2, km2, rr2; SC_LDOPS(nk, bb, dw, km, rr, 0); SC_LDOPS(nk2, bb2, dw2, km2, rr2, 1); \
            f32x4 v4 = *(const LAS f32x4*)(vb), v4n = *(const LAS f32x4*)(vb + 4), yacc = {0.f, 0.f, 0.f, 0.f}; \
            _Pragma("unroll") for (int tt = 0; tt < SC_T; ++tt) { \
                f32x4 nk3 = nk2, bb3 = bb2, dw3 = dw2, km3 = km2, rr3 = rr2; \
                if (tt + 2 < SC_T) SC_LDOPS(nk3, bb3, dw3, km3, rr3, tt + 2); \
                asm volatile("" ::: "memory"); \
                const float vi = v4[tt & 3]; \
                const f32x2 t_ = S01 * nk.lo + S23 * nk.hi; \
                const f32x2 P01 = S01 * dw.lo + km.lo * vi, P23 = S23 * dw.hi + km.hi * vi; \
                const float sa = allreduce16(t_.x + t_.y); \
                S01 = P01 + bb.lo * sa; S23 = P23 + bb.hi * sa; \
                const f32x2 y_ = S01 * rr.lo + S23 * rr.hi; \
                yacc[tt & 3] = y_.x + y_.y; \
                if ((tt & 3) == 3) { *(LAS f32x4*)(yp + (tt - 3)) = yacc; v4 = v4n; if (tt + 5 < SC_T) v4n = *(const LAS f32x4*)(vb + tt + 5); } \
                nk = nk2; bb = bb2; dw = dw2; km = km2; rr = rr2; nk2 = nk3; bb2 = bb3; dw2 = dw3; km2 = km3; rr2 = rr3; } } while (0)
        SC_LOAD(rawA0, rawA1, rawvA, 0); SC_DERIVE(rawA0, rawA1, rawvA, 0, 0); SC_LOAD(rawB0, rawB1, rawvB, 1); SC_LOAD(rawA0, rawA1, rawvA, 2);
        __syncthreads();
        for (int n = 0; n < SC_NB; n += 2) {
            if (cons) { SC_CONSUME(0); }
            else { SC_DERIVE(rawB0, rawB1, rawvB, n + 1, 1); if (n + 3 < SC_NB) SC_LOAD(rawB0, rawB1, rawvB, n + 3);
                if (ywr && n >= 1) SC_YOUT(n - 1, 1); }
            SC_BAR();
            if (cons) { SC_CONSUME(1); }
            else { if (n + 2 < SC_NB) { SC_DERIVE(rawA0, rawA1, rawvA, n + 2, 0); if (n + 4 < SC_NB) SC_LOAD(rawA0, rawA1, rawvA, n + 4); }
                if (ywr) SC_YOUT(n, 0); }
            SC_BAR();
        }
        if (ywr) SC_YOUT(SC_NB - 1, 1);
        __syncthreads();
#undef SC_LOAD1
#undef SC_LOAD
#undef SC_DERIVE1
#undef SC_DERIVE
#undef SC_YOUT1
#undef SC_YOUT
#undef SC_CONSUME
#undef SC_LDOPS
#undef SC_BAR
    }
}

struct Args { const void* in[31]; float* out; unsigned char* ws; };
__global__ void __launch_bounds__(NWAVES * 64, 2) mk_fwd(Args args) {
    extern __shared__ __attribute__((aligned(16))) unsigned char lds[];
    cg::grid_group grid = cg::this_grid();
    LAS unsigned char* L = (LAS unsigned char*)lds;
    const int G = gridDim.x; const int bx = blockIdx.x; const int vcu = (G % 8 == 0) ? (bx % 8) * (G / 8) + bx / 8 : bx;
    const int NGW = G * NWAVES;
    { volatile LAS unsigned* st0 = (volatile LAS unsigned*)(L + 131072 + 1024); if (threadIdx.x < 2) st0[threadIdx.x] = 0u; __syncthreads(); }
    const XcdBarrier xbar = xcd_barrier_post((unsigned*)args.ws, (volatile LAS unsigned*)(L + 131072 + 1024));
#define PH_IDS() int tid_ = threadIdx.x; asm volatile("" : "+v"(tid_)); const int tid = tid_, lane = tid & 63, wave = __builtin_amdgcn_readfirstlane(tid >> 6); const int gw = vcu * NWAVES + wave; LAS float* scr = (LAS float*)(L + wave * 16384); (void)scr; (void)gw; (void)lane
    typedef const void* cvp_t; typedef const __attribute__((address_space(4))) cvp_t* kargp_t;
#define KP_(k) (((kargp_t)kp_)[k])
#define PH_PTRS() const __attribute__((address_space(4))) char* kp_ = (const __attribute__((address_space(4))) char*)__builtin_amdgcn_kernarg_segment_ptr(); asm volatile("" : "+s"(kp_)); \
    In I; I.x = (const float*)KP_(0); I.pos = (const int*)KP_(1); I.a_norm = (const float*)KP_(2); I.a_mu = (const float*)KP_(3); I.a_w_in = (const float*)KP_(4); I.a_w0 = (const float*)KP_(5); I.a_w1 = (const float*)KP_(6); I.a_w2 = (const float*)KP_(7); I.a_a0 = (const float*)KP_(8); I.a_a1 = (const float*)KP_(9); I.a_a2 = (const float*)KP_(10); I.a_v0 = (const float*)KP_(11); I.a_v1 = (const float*)KP_(12); I.a_v2 = (const float*)KP_(13); I.a_k_k = (const float*)KP_(14); I.a_k_a = (const float*)KP_(15); I.a_r_k = (const float*)KP_(16); I.a_ln_w = (const float*)KP_(17); I.a_ln_b = (const float*)KP_(18); I.a_w_out = (const float*)KP_(19); I.kv_norm = (const float*)KP_(20); I.w_kv = (const float*)KP_(21); I.b_norm = (const float*)KP_(22); I.b_w_in = (const float*)KP_(23); I.b_lq1 = (const float*)KP_(24); I.b_lk1 = (const float*)KP_(25); I.b_lq2 = (const float*)KP_(26); I.b_lk2 = (const float*)KP_(27); I.b_subln = (const float*)KP_(28); I.b_w_out = (const float*)KP_(29); I.final_norm = (const float*)KP_(30); \
    float* XS = (float*)KP_(31); unsigned char* ws = (unsigned char*)KP_(32); \
    float* rc = (float*)(ws + WS_ROPE_C); float* rs = (float*)(ws + WS_ROPE_S); float* SB = (float*)(ws + WS_S); unsigned char* wreg = ws + WS_W; \
    bf16* U0 = (bf16*)(ws + WS_U); bf16* U1 = (bf16*)(ws + WS_U + UNIT); bf16* U2 = (bf16*)(ws + WS_U + 2 * UNIT); bf16* U3 = (bf16*)(ws + WS_U + 3 * UNIT); \
    bf16* U4 = (bf16*)(ws + WS_U + 4 * UNIT); bf16* U5 = (bf16*)(ws + WS_U + 5 * UNIT); bf16* U6 = (bf16*)(ws + WS_U + 6 * UNIT); bf16* HB = (bf16*)(ws + WS_H); \
    (void)I; (void)XS; (void)rc; (void)rs; (void)SB; (void)wreg; (void)U0; (void)U1; (void)U2; (void)U3; (void)U4; (void)U5; (void)U6; (void)HB

    for (int rp = 0; rp < REP_PASS; ++rp) { PH_IDS(); PH_PTRS(); rope_tables(I.pos, rc, rs, vcu * 512 + tid, G * 512);
    conv_rwkv(I, 0, wreg, (float*)(ws + WS_BIAS), scr, gw, NGW, lane);
    pre_rwkv(I.x, I.a_norm, U0, gw, NGW, lane); }
    grid.sync();

    for (int rp = 0; rp < REP_SYNC; ++rp) xcd_barrier(xbar);
#pragma nounroll
    for (int l = 0; l < 2; ++l) {
#pragma nounroll
        for (int rp = 0; rp < REP_G1; ++rp) {
            if (rp) xcd_barrier(xbar);
            PH_PTRS(); bf16* Vl = (l == 0) ? U4 : U6;
            pg8::Gemm g{U0, (const bf16*)(wreg + W_FOLD), M, 4352, 2048}; pg8::StaticOrder S; S.init(M, 4352, G, bx);
            pg8::EpiFold E{U2, U3, Vl, U5, HB};
            pg8::gemm_phase<pg8::EpiFold, pg8::StaticOrder, true, true>(L, g, S, E);
        }
        xcd_barrier(xbar);
        {
            PH_PTRS(); bf16* Vl = (l == 0) ? U4 : U6;
            const int NUP = (l == 0) ? 2048 : 3072;
            pg8::Gemm g{HB, (const bf16*)(wreg + W_UP), M, NUP, 256}; pg8::StaticOrder S; S.init(M, NUP, G, bx);
            pg8::EpiLoraUp E{(const float*)(ws + WS_BIAS), (_Float16*)U0, (_Float16*)U1, Vl, U4};
            pg8::gemm_phase<pg8::EpiLoraUp, pg8::StaticOrder, true, false>(L, g, S, E);
        }
        xcd_barrier(xbar);
#pragma nounroll
        for (int rp = 0; rp < REP_SCAN; ++rp) { if (rp) xcd_barrier(xbar); PH_IDS(); PH_PTRS(); bf16* Vl = (l == 0) ? U4 : U6; bf16* Yl = (l == 0) ? U6 : U4; scan_phase(L, U2, U3, Vl, (const _Float16*)U0, (const _Float16*)U1, I.a_k_k + l * 1024, I.a_k_a + l * 1024, I.a_r_k + l * 1024, Yl, SB, vcu, G, tid, wave, lane); }
        xcd_barrier(xbar);
        for (int rp = 0; rp < REP_PASS; ++rp) { PH_IDS(); PH_PTRS(); bf16* Vl = (l == 0) ? U4 : U6; bf16* Yl = (l == 0) ? U6 : U4; post_rwkv(Yl, SB, Vl, U5, I.a_ln_w + l * 1024, I.a_ln_b + l * 1024, U2, gw, NGW, lane); }
        xcd_barrier(xbar);
        {
            PH_PTRS(); const float* xin = (l == 0) ? I.x : XS;
            pg8::Gemm g{U2, (const bf16*)(wreg + W_OUT), M, 1024, 1024}; pg8::StaticOrder S; S.init(M, 1024, G, bx);
            pg8::EpiResid E{xin, XS};
            pg8::gemm_phase<pg8::EpiResid, pg8::StaticOrder, true, true>(L, g, S, E);
        }
        xcd_barrier(xbar);
        for (int rp = 0; rp < REP_PASS; ++rp) { PH_IDS(); PH_PTRS(); if (l == 0) { conv_rwkv(I, 1, wreg, (float*)(ws + WS_BIAS), scr, gw, NGW, lane); pre_rwkv(XS, I.a_norm + 1024, U0, gw, NGW, lane); }
        else { conv_attn(I, 0, wreg, scr, gw, NGW, lane); pre_attn(XS, U0, gw, NGW, lane); } }
        xcd_barrier(xbar);
    }

#pragma nounroll
    for (int j = 0; j < 2; ++j) {
        {
            PH_PTRS();
            const int NP = (j == 0) ? 4096 : 2048;
            pg8::Gemm g{U0, (const bf16*)(wreg + W_PROJ), M, NP, 1024}; pg8::StaticOrder S; S.init(M, NP, G, bx);
            pg8::EpiProj E;
            if (j == 0) { E.d0 = U1; E.d1 = U2; E.d2 = U3; E.d3 = U4; E.ropemask = 0x5; E.scalemask = QSCALE_MASK0; }
            else { E.d0 = U3; E.d1 = U4; E.d2 = U3; E.d3 = U4; E.ropemask = 0x1; E.scalemask = QSCALE_MASK1; }
            E.sc = C2F; E.rc = rc; E.rs = rs;
            pg8::gemm_phase<pg8::EpiProj, pg8::StaticOrder, true, true>(L, g, S, E);
        }
        xcd_barrier(xbar);
#pragma nounroll
        for (int rp = 0; rp < REP_ATTN; ++rp) {
            if (rp) xcd_barrier(xbar);
            PH_PTRS();
#ifdef ATTN_D64
            const attn_body::AttnTensors AT{(const attn_body::bf16*)U3, (const attn_body::bf16*)U1, (const attn_body::bf16*)U2, (attn_body::bf16*)U5, (attn_body::bf16*)U6};
            attn_body::attn_phase<8>((char*)lds, AT, vcu, G);
#else
            const attn128::AttnTensors AT{U3, U1, U2, U5, U6};
            attn128::attn_phase((char*)lds, AT, vcu, G);
#endif
        }
        xcd_barrier(xbar);
        for (int rp = 0; rp < REP_PASS; ++rp) {
            PH_IDS(); PH_PTRS();
            const float e1 = __expf(wave_sum(I.b_lq1[j * 64 + lane] * I.b_lk1[j * 64 + lane])), e2 = __expf(wave_sum(I.b_lq2[j * 64 + lane] * I.b_lk2[j * 64 + lane]));
            const float lam_init = (j == 0) ? 0.4707130183435842f : 0.5560582041556406f;
            post_attn(U5, U6, U4, I.b_subln + j * 128, e1 - e2 + lam_init, lam_init, U0, gw, NGW, lane);
        }
        xcd_barrier(xbar);
        {
            PH_PTRS();
            pg8::Gemm g{U0, (const bf16*)(wreg + W_BOUT), M, 1024, 1024}; pg8::StaticOrder S; S.init(M, 1024, G, bx);
            pg8::EpiResid E{XS, XS};
            pg8::gemm_phase<pg8::EpiResid, pg8::StaticOrder, true, true>(L, g, S, E);
        }
        xcd_barrier(xbar);
        if (j == 0) { for (int rp = 0; rp < REP_PASS; ++rp) { PH_IDS(); PH_PTRS(); conv_attn(I, 1, wreg, scr, gw, NGW, lane); pre_attn(XS, U0, gw, NGW, lane); } xcd_barrier(xbar); }
    }
    { PH_IDS(); PH_PTRS(); final_norm_rows(XS, I.final_norm, XS, gw, NGW, lane); }
}

extern "C" void kernel_launch(void* const* d_in, const int* in_sizes, int n_in, void* d_out, int out_size, void* d_ws, size_t ws_size, hipStream_t stream) {
    static int grid = 0;
    if (grid == 0) {
        if (n_in != 31 || in_sizes[0] != M * D || out_size != M * D || ws_size < WS_END) { fprintf(stderr, "kernel_launch: unexpected shapes (n_in %d, in0 %d, out %d, ws %zu < %zu)\n", n_in, n_in > 0 ? in_sizes[0] : -1, out_size, ws_size, (size_t)WS_END); grid = -1; return; }
        int dev = 0, cus = 0, per_cu = 0;
        hipGetDevice(&dev); hipDeviceGetAttribute(&cus, hipDeviceAttributeMultiprocessorCount, dev);
        if (hipFuncSetAttribute((const void*)mk_fwd, hipFuncAttributeMaxDynamicSharedMemorySize, LDS_BYTES) != hipSuccess) { fprintf(stderr, "kernel_launch: hipFuncSetAttribute failed\n"); grid = -1; return; }
        if (hipOccupancyMaxActiveBlocksPerMultiprocessor(&per_cu, (const void*)mk_fwd, NWAVES * 64, LDS_BYTES) != hipSuccess || per_cu < 1) { fprintf(stderr, "kernel_launch: occupancy query says %d\n", per_cu); per_cu = 1; }
        (void)hipGetLastError();
        grid = cus;
    }
    if (grid < 0) return;
    if (hipMemsetAsync(d_ws, 0, 16384, stream) != hipSuccess) { fprintf(stderr, "kernel_launch: memset of the barrier words failed\n"); return; }
    Args a{};
    for (int i = 0; i < 31; ++i) a.in[i] = d_in[i];
    a.out = (float*)d_out; a.ws = (unsigned char*)d_ws;
    void* kargs[] = {&a};
    hipError_t e = hipLaunchCooperativeKernel((const void*)mk_fwd, dim3(grid), dim3(NWAVES * 64), kargs, LDS_BYTES, stream);
    if (e != hipSuccess) fprintf(stderr, "kernel_launch: cooperative launch failed: %s (grid %d)\n", hipGetErrorString(e), grid);
}
```

```cpp
#include <hip/hip_runtime.h>
#include <hip/hip_cooperative_groups.h>
#include <cstdio>
#include <cstdint>
namespace cg = cooperative_groups;
namespace pg8 {
#define PG8_LAS __attribute__((address_space(3)))
typedef unsigned short bf16_t;
typedef short bf16x8 __attribute__((ext_vector_type(8)));
typedef float f32x4 __attribute__((ext_vector_type(4)));
typedef unsigned u32x4 __attribute__((ext_vector_type(4)));
constexpr int BM = 256, BK = 64, HALF = 128, HTB = HALF * BK * 2  , STAGE_BYTES = 8 * HTB, NXCD = 8, WGM = 8;

__host__ __device__ __forceinline__ int lds_byte(int r, int c) { const int st = (r >> 4) * 2 + (c >> 5), rr = r & 15, cc = c & 31, ob = rr * 64 + cc * 2; return st * 1024 + (ob ^ (((ob >> 9) & 1) << 5)); }
__host__ __device__ __forceinline__ void stage_rc(int b, int& R, int& C) { const int st = b / 1024, sb = b % 1024, swz = sb ^ (((sb >> 9) & 1) << 5); R = (st >> 1) * 16 + swz / 64; C = (st & 1) * 32 + (swz % 64) / 2; }
__host__ __device__ __forceinline__ int perm32(int rho) { const int n = rho >> 4, i = rho & 15; return 8 * (i >> 2) + 4 * n + (i & 3); }

struct Unit { int pm, pn; };
struct Gemm { const bf16_t* A; const bf16_t* Bt; int M, N, K; };

struct StaticOrder {
    int nM, nN, nwg, G, c;
    __host__ __device__ void init(int M, int N, int G_, int c_) { nM = M / BM; nN = N / BM; nwg = nM * nN; G = G_; c = c_; }
    __host__ __device__ bool next(int i, Unit& u) const {
        const long L = (long)i * G + c; if (L >= nwg) return false;
        int wgid = (int)L; { const int q = nwg / NXCD, r = nwg % NXCD, xcd = wgid % NXCD, off = wgid / NXCD; wgid = (xcd < r ? xcd * (q + 1) : r * (q + 1) + (xcd - r) * q) + off; }
        const int nig = WGM * nN, gid = wgid / nig, fm = gid * WGM, gsz = (nM - fm) < WGM ? (nM - fm) : WGM;
        u.pm = fm + ((wgid % nig) % gsz); u.pn = (wgid % nig) / gsz; return true;
    }
    __device__ __forceinline__ void a_ready(const Unit&) const {}
    __device__ __forceinline__ void done(const Unit&) const {}
};

__device__ __forceinline__ unsigned cvt_pk_bf16(float lo, float hi) { unsigned r; asm volatile("v_cvt_pk_bf16_f32 %0, %1, %2" : "=v"(r) : "v"(lo), "v"(hi)); return r; }
typedef float f32x2 __attribute__((ext_vector_type(2)));
typedef _Float16 h16x4 __attribute__((ext_vector_type(4)));
typedef unsigned u32x2 __attribute__((ext_vector_type(2)));
__device__ __forceinline__ float sigmoidf_(float z) { return 1.0f / (1.0f + __expf(-z)); }
__device__ __forceinline__ float tanhf_(float x) { const float t = __expf(-2.0f * fabsf(x)); const float r = (1.0f - t) / (1.0f + t); return x < 0.f ? -r : r; }
__device__ __forceinline__ float bf_lo(unsigned w) { return __uint_as_float(w << 16); }
__device__ __forceinline__ float bf_hi(unsigned w) { return __uint_as_float(w & 0xffff0000u); }

struct EpiFold {
    static constexpr bool PERM = true, AFTER_DRAIN = false;
    bf16_t *R, *H; int hmode;
    __device__ __forceinline__ void operator()(const f32x4 (&acc)[2][2][4][2], const Unit& u, int wr, int wc, int fr, int fq) const {
        const int row0 = u.pm * BM + wr * 64 + fr;
        bf16_t* base = hmode ? H : R; const int ldc = hmode ? 256 : 1024;
        const int col0 = u.pn * 256 + wc * 32 + 8 * fq;
        const bool th = (hmode != 0) && (wc < 2);
#pragma unroll
        for (int ai = 0; ai < 2; ++ai)
#pragma unroll
            for (int m = 0; m < 4; ++m) { bf16_t* rowp = base + (size_t)(row0 + ai * HALF + m * 16) * ldc + col0;
#pragma unroll
                for (int bj = 0; bj < 2; ++bj) { f32x4 v0 = acc[ai][bj][m][0], v1 = acc[ai][bj][m][1];
                    if (th && bj == 0) {
#pragma unroll
                        for (int i = 0; i < 4; ++i) { v0[i] = tanhf_(v0[i]); v1[i] = tanhf_(v1[i]); } }
                    u32x4 w; w.x = cvt_pk_bf16(v0[0], v0[1]); w.y = cvt_pk_bf16(v0[2], v0[3]); w.z = cvt_pk_bf16(v1[0], v1[1]); w.w = cvt_pk_bf16(v1[2], v1[3]);
                    *(u32x4*)(rowp + bj * HALF) = w; }
                asm volatile("" ::: "memory"); }
    }
};

struct EpiLoraUp {
    static constexpr bool PERM = false, AFTER_DRAIN = false;
    const float* bias3; _Float16 *Wb, *Ab; bf16_t* Vb; const bf16_t* Vf;
    __device__ __forceinline__ void operator()(const f32x4 (&acc)[2][2][4][2], const Unit& u, int wr, int wc, int fr_unused, int fq_unused) const {
        int t_ = threadIdx.x; asm volatile("" : "+v"(t_)); const int fr = t_ & 15, fq = (t_ >> 4) & 3;
        const int row0 = u.pm * BM + wr * 64 + fr;
        const int t = u.pn >> 2;
        const int cc0 = (u.pn & 3) * 256 + wc * 32 + 4 * fq;
        const float* bias = bias3 + t * 1024;
#pragma unroll
        for (int bj = 0; bj < 2; ++bj)
#pragma unroll
            for (int n = 0; n < 2; ++n) { const int c = cc0 + bj * HALF + n * 16; const f32x4 bv = *(const f32x4*)(bias + c);
#pragma unroll
                for (int ai = 0; ai < 2; ++ai)
#pragma unroll
                    for (int m = 0; m < 4; ++m) { const size_t off = (size_t)(row0 + ai * HALF + m * 16) * 1024 + c; const f32x4 z = acc[ai][bj][m][n] + bv;
                        if (t == 0) { h16x4 o;
#pragma unroll
                            for (int i = 0; i < 4; ++i) { const float zz = -z[i]; const float sp = fmaxf(zz, 0.f) + __logf(1.0f + __expf(-fabsf(zz))); o[i] = (_Float16)(-sp - 0.5f); }
                            *(h16x4*)(Wb + off) = o; }
                        else if (t == 1) { h16x4 o;
#pragma unroll
                            for (int i = 0; i < 4; ++i) o[i] = (_Float16)sigmoidf_(z[i]);
                            *(h16x4*)(Ab + off) = o; }
                        else { const u32x2 vv = *(const u32x2*)(Vb + off), vf = *(const u32x2*)(Vf + off);
                            const float v_0 = bf_lo(vv.x), v_1 = bf_hi(vv.x), v_2 = bf_lo(vv.y), v_3 = bf_hi(vv.y);
                            const float f_0 = bf_lo(vf.x), f_1 = bf_hi(vf.x), f_2 = bf_lo(vf.y), f_3 = bf_hi(vf.y);
                            u32x2 o; o.x = cvt_pk_bf16(v_0 + (f_0 - v_0) * sigmoidf_(z[0]), v_1 + (f_1 - v_1) * sigmoidf_(z[1]));
                            o.y = cvt_pk_bf16(v_2 + (f_2 - v_2) * sigmoidf_(z[2]), v_3 + (f_3 - v_3) * sigmoidf_(z[3]));
                            *(u32x2*)(Vb + off) = o; }
                        asm volatile("" ::: "memory"); } }
    }
};

struct EpiProj {
    static constexpr bool PERM = true, AFTER_DRAIN = false;
    bf16_t *d0, *d1, *d2, *d3; int ropemask, scalemask; float sc; const float* rc; const float* rs;
    __device__ __forceinline__ void operator()(const f32x4 (&acc)[2][2][4][2], const Unit& u, int wr, int wc, int fr, int fq) const {
        const int row0 = u.pm * BM + wr * 64 + fr;
        const int t = u.pn >> 2;
        bf16_t* base = (t == 0) ? d0 : (t == 1) ? d1 : (t == 2) ? d2 : d3;
        const int col0 = (u.pn & 3) * 256 + wc * 32 + 8 * fq;
        const bool rope = (((ropemask >> t) & 1) != 0) && ((wc & 1) == 0);
        const float s = ((scalemask >> t) & 1) ? sc : 1.0f;
        const float sgn = (fq == 0) ? -1.0f : 1.0f;
#pragma unroll
        for (int ai = 0; ai < 2; ++ai)
#pragma unroll
            for (int m = 0; m < 4; ++m) { const int row = row0 + ai * HALF + m * 16; bf16_t* rowp = base + (size_t)row * 1024 + col0;
                f32x4 c0 = {1.f, 1.f, 1.f, 1.f}, c1 = c0, s0 = {0.f, 0.f, 0.f, 0.f}, s1 = s0;
                if (rope) { c0 = *(const f32x4*)(rc + (size_t)row * 8); c1 = *(const f32x4*)(rc + (size_t)row * 8 + 4); s0 = *(const f32x4*)(rs + (size_t)row * 8); s1 = *(const f32x4*)(rs + (size_t)row * 8 + 4); }
#pragma unroll
                for (int bj = 0; bj < 2; ++bj) { f32x4 v0 = acc[ai][bj][m][0], v1 = acc[ai][bj][m][1];
                    if (rope) { f32x4 p0, p1;
#pragma unroll
                        for (int i = 0; i < 4; ++i) { p0[i] = __shfl_xor(v0[i], 16); p1[i] = __shfl_xor(v1[i], 16); }
                        if (fq < 2) { v0 = v0 * c0 + (p0 * s0) * sgn; v1 = v1 * c1 + (p1 * s1) * sgn; } }
                    v0 = v0 * s; v1 = v1 * s;
                    u32x4 w; w.x = cvt_pk_bf16(v0[0], v0[1]); w.y = cvt_pk_bf16(v0[2], v0[3]); w.z = cvt_pk_bf16(v1[0], v1[1]); w.w = cvt_pk_bf16(v1[2], v1[3]);
                    *(u32x4*)(rowp + bj * HALF) = w; }
                asm volatile("" ::: "memory"); }
    }
};

struct EpiResid {
    static constexpr bool PERM = false, AFTER_DRAIN = false;
    const float* base; float* out;
    __device__ __forceinline__ void operator()(const f32x4 (&acc)[2][2][4][2], const Unit& u, int wr, int wc, int fr, int fq) const {
        const int row0 = u.pm * BM + wr * 64 + fr;
        const int col0 = u.pn * BM + wc * 32 + 4 * fq;
#pragma unroll
        for (int ai = 0; ai < 2; ++ai)
#pragma unroll
            for (int m = 0; m < 4; ++m) { const size_t off = (size_t)(row0 + ai * HALF + m * 16) * 1024 + col0;
#pragma unroll
                for (int bj = 0; bj < 2; ++bj)
#pragma unroll
                    for (int n = 0; n < 2; ++n) { const f32x4 b = *(const f32x4*)(base + off + bj * HALF + n * 16); *(f32x4*)(out + off + bj * HALF + n * 16) = b + acc[ai][bj][m][n]; }
                asm volatile("" ::: "memory"); }
    }
};
template <class Epi, class Sched, bool ALIGN_EPI = false, bool SP2 = false>
__device__ __forceinline__ void gemm_phase(PG8_LAS unsigned char* lds, const Gemm g, const Sched& S, const Epi& E) {
    int tid_ = threadIdx.x; asm volatile("" : "+v"(tid_));
    const int tid = tid_, wid = __builtin_amdgcn_readfirstlane(tid >> 6), lane = tid & 63, wr = wid >> 2, wc = wid & 3, fr = lane & 15, fq = lane >> 4;
    const int K = g.K, nt = K / BK;
    unsigned voffA[2], voffB[2];
#pragma unroll
    for (int i = 0; i < 2; ++i) { int R, C; stage_rc(tid * 16 + i * 8192, R, C); const int Rb = Epi::PERM ? ((R & ~31) + perm32(R & 31)) : R;
        voffA[i] = (unsigned)(R * K + C) * 2u; voffB[i] = (unsigned)(Rb * K + C) * 2u; }
    const size_t kstep = (size_t)(BK * 2);
    const size_t hstep = (size_t)HALF * K * 2;
    const size_t tstep = 2 * hstep;
    const unsigned ldsw = (unsigned)wid * 1024u;
    const int aoff = lds_byte(wr * 64 + fr, fq * 8), boff = lds_byte(wc * 32 + fr, fq * 8);
#define PG8_SA(b, h) (((b) * 2 + (h)) * HTB)
#define PG8_SB(b, h) ((4 + (b) * 2 + (h)) * HTB)
#define PG8_STAGE(bufoff, gbase, voff) do { _Pragma("unroll") for (int _i = 0; _i < 2; ++_i) \
        __builtin_amdgcn_global_load_lds((const unsigned*)((const char*)(gbase) + (voff)[_i]), (PG8_LAS unsigned*)(lds + (bufoff) + ldsw + _i * 8192), 16, 0, 0); } while (0)
#define PG8_LDA(dst, b, h) do { _Pragma("unroll") for (int m = 0; m < 4; ++m) _Pragma("unroll") for (int k = 0; k < 2; ++k) dst[m][k] = *(const PG8_LAS bf16x8*)(lds + PG8_SA(b, h) + aoff + m * 2048 + k * 1024); } while (0)
#define PG8_LDB(dst, b, h) do { _Pragma("unroll") for (int n = 0; n < 2; ++n) _Pragma("unroll") for (int k = 0; k < 2; ++k) dst[n][k] = *(const PG8_LAS bf16x8*)(lds + PG8_SB(b, h) + boff + n * 2048 + k * 1024); } while (0)
#define PG8_MMA(ai, bj, At, Bt) do { __builtin_amdgcn_s_setprio(1); _Pragma("unroll") for (int m = 0; m < 4; ++m) _Pragma("unroll") for (int n = 0; n < 2; ++n) _Pragma("unroll") for (int k = 0; k < 2; ++k) \
        acc[ai][bj][m][n] = __builtin_amdgcn_mfma_f32_16x16x32_bf16(Bt[n][k], At[m][k], acc[ai][bj][m][n], 0, 0, 0); __builtin_amdgcn_s_setprio(0); } while (0)
#define PG8_WAIT_V(n) asm volatile("s_waitcnt vmcnt(" #n ")" ::: "memory")
#define PG8_WAIT_L(n) asm volatile("s_waitcnt lgkmcnt(" #n ")" ::: "memory")
#define PG8_BAR __builtin_amdgcn_s_barrier()
#define PG8_SCHED __builtin_amdgcn_sched_barrier(0)
    Unit cur, nxt; int ui = 0;
    if (!S.next(0, cur)) return;
    f32x4 acc[2][2][4][2];
#pragma unroll
    for (int a = 0; a < 2; ++a)
#pragma unroll
        for (int b = 0; b < 2; ++b)
#pragma unroll
            for (int m = 0; m < 4; ++m)
#pragma unroll
                for (int n = 0; n < 2; ++n) acc[a][b][m][n] = (f32x4){0.f, 0.f, 0.f, 0.f};
    bf16x8 At[4][2], B0[2][2], B1[2][2];
    const char* cA = (const char*)g.A + (size_t)cur.pm * tstep; const char* cB = (const char*)g.Bt + (size_t)cur.pn * tstep;
    S.a_ready(cur);
    if constexpr (SP2) {
        PG8_STAGE(PG8_SB(0, 0), cB, voffB); PG8_STAGE(PG8_SB(0, 1), cB + hstep, voffB); PG8_STAGE(PG8_SA(0, 0), cA, voffA); PG8_STAGE(PG8_SA(0, 1), cA + hstep, voffA);
        if (wr == 1) PG8_BAR;
        PG8_WAIT_V(2); PG8_BAR;
        PG8_STAGE(PG8_SB(1, 0), cB + kstep, voffB); PG8_STAGE(PG8_SA(1, 0), cA + kstep, voffA); PG8_STAGE(PG8_SB(1, 1), cB + hstep + kstep, voffB);
        PG8_WAIT_V(6); PG8_BAR;
    } else {
        PG8_STAGE(PG8_SB(0, 0), cB, voffB); PG8_STAGE(PG8_SA(0, 0), cA, voffA); PG8_STAGE(PG8_SB(0, 1), cB + hstep, voffB); PG8_STAGE(PG8_SA(0, 1), cA + hstep, voffA);
        if (wr == 1) PG8_BAR;
        PG8_WAIT_V(4); PG8_BAR;
        PG8_STAGE(PG8_SB(1, 0), cB + kstep, voffB); PG8_STAGE(PG8_SA(1, 0), cA + kstep, voffA); PG8_STAGE(PG8_SB(1, 1), cB + hstep + kstep, voffB);
        PG8_WAIT_V(6); PG8_BAR;
    }
    for (;;) {
        const bool has_next = S.next(ui + 1, nxt);
        const char* nA = has_next ? (const char*)g.A + (size_t)nxt.pm * tstep : cA; const char* nB = has_next ? (const char*)g.Bt + (size_t)nxt.pn * tstep : cB;
        for (int t = 0; t < nt; t += 2) {
            const bool last = (t == nt - 2);
            const char* a1 = cA + (size_t)(t + 1) * kstep;
            const char* a2 = last ? nA : cA + (size_t)(t + 2) * kstep; const char* b2 = last ? nB : cB + (size_t)(t + 2) * kstep;
            const char* a3 = a2 + kstep; const char* b3 = b2 + kstep;
            if (last && has_next) S.a_ready(nxt);
            if constexpr (SP2) {
            PG8_LDB(B0, 0, 0); PG8_LDB(B1, 0, 1); PG8_SCHED; PG8_LDA(At, 0, 0); PG8_STAGE(PG8_SA(1, 1), a1 + hstep, voffA);
            PG8_WAIT_V(8); PG8_WAIT_L(0); PG8_BAR; PG8_MMA(0, 0, At, B0); PG8_MMA(0, 1, At, B1); PG8_BAR; PG8_SCHED;
            PG8_LDA(At, 0, 1); PG8_STAGE(PG8_SB(0, 0), b2, voffB); PG8_STAGE(PG8_SB(0, 1), b2 + hstep, voffB); PG8_STAGE(PG8_SA(0, 0), a2, voffA);
            PG8_WAIT_V(8); PG8_WAIT_L(0); PG8_BAR; PG8_MMA(1, 0, At, B0); PG8_MMA(1, 1, At, B1); PG8_BAR; PG8_SCHED;
            PG8_LDB(B0, 1, 0); PG8_LDB(B1, 1, 1); PG8_SCHED; PG8_LDA(At, 1, 0); PG8_STAGE(PG8_SA(0, 1), a2 + hstep, voffA);
            PG8_WAIT_V(8); PG8_WAIT_L(0); PG8_BAR; PG8_MMA(0, 0, At, B0); PG8_MMA(0, 1, At, B1); PG8_BAR; PG8_SCHED;
            PG8_LDA(At, 1, 1); PG8_STAGE(PG8_SB(1, 0), b3, voffB); PG8_STAGE(PG8_SB(1, 1), b3 + hstep, voffB); PG8_STAGE(PG8_SA(1, 0), a3, voffA);
            PG8_WAIT_V(8); PG8_WAIT_L(0); PG8_BAR; PG8_MMA(1, 0, At, B0); PG8_MMA(1, 1, At, B1); PG8_BAR; PG8_SCHED;
            } else {
            PG8_LDB(B0, 0, 0); PG8_SCHED; PG8_LDA(At, 0, 0); PG8_STAGE(PG8_SA(1, 1), a1 + hstep, voffA);
            PG8_WAIT_L(8); PG8_BAR; PG8_WAIT_L(0); PG8_MMA(0, 0, At, B0); PG8_BAR; PG8_SCHED;
            PG8_LDB(B1, 0, 1); PG8_STAGE(PG8_SB(0, 0), b2, voffB);
            PG8_BAR; PG8_WAIT_L(0); PG8_MMA(0, 1, At, B1); PG8_BAR;
            PG8_LDA(At, 0, 1); PG8_STAGE(PG8_SA(0, 0), a2, voffA);
            PG8_BAR; PG8_WAIT_L(0); PG8_MMA(1, 0, At, B0); PG8_BAR; PG8_SCHED;
            PG8_STAGE(PG8_SB(0, 1), b2 + hstep, voffB);
            PG8_WAIT_V(6); PG8_BAR; PG8_MMA(1, 1, At, B1); PG8_BAR;
            PG8_LDB(B0, 1, 0); PG8_SCHED; PG8_LDA(At, 1, 0); PG8_STAGE(PG8_SA(0, 1), a2 + hstep, voffA);
            PG8_WAIT_L(8); PG8_BAR; PG8_WAIT_L(0); PG8_MMA(0, 0, At, B0); PG8_BAR; PG8_SCHED;
            PG8_LDB(B1, 1, 1); PG8_STAGE(PG8_SB(1, 0), b3, voffB);
            PG8_BAR; PG8_WAIT_L(0); PG8_MMA(0, 1, At, B1); PG8_BAR;
            PG8_LDA(At, 1, 1); PG8_STAGE(PG8_SA(1, 0), a3, voffA);
            PG8_BAR; PG8_WAIT_L(0); PG8_MMA(1, 0, At, B0); PG8_BAR; PG8_SCHED;
            PG8_STAGE(PG8_SB(1, 1), b3 + hstep, voffB);
            PG8_WAIT_V(6); PG8_BAR; PG8_MMA(1, 1, At, B1); PG8_BAR;
            }
        }
        if constexpr (ALIGN_EPI) { if (wr == 0) PG8_BAR; }
        if constexpr (!Epi::AFTER_DRAIN) { E(acc, cur, wr, wc, fr, fq); S.done(cur); }
        if (!has_next) break;
#pragma unroll
        for (int a = 0; a < 2; ++a)
#pragma unroll
            for (int b = 0; b < 2; ++b)
#pragma unroll
                for (int m = 0; m < 4; ++m)
#pragma unroll
                    for (int n = 0; n < 2; ++n) acc[a][b][m][n] = (f32x4){0.f, 0.f, 0.f, 0.f};
        cur = nxt; cA = nA; cB = nB; ++ui;
        if constexpr (ALIGN_EPI) { if (wr == 1) PG8_BAR; }
    }
    PG8_WAIT_V(0);
    if constexpr (!ALIGN_EPI) { if (wr == 0) PG8_BAR; }
    PG8_BAR;
    if constexpr (Epi::AFTER_DRAIN) { E.fused(acc, cur, wr, wc, fr, fq, lds, wid, lane); S.done(cur); }
#undef PG8_SA
#undef PG8_SB
#undef PG8_STAGE
#undef PG8_LDA
#undef PG8_LDB
#undef PG8_MMA
#undef PG8_WAIT_V
#undef PG8_WAIT_L
#undef PG8_BAR
#undef PG8_SCHED
}
}

#include <hip/hip_bf16.h>
#include <cmath>
namespace attn_body {
using bf16=__hip_bfloat16;
using bf16x8=__attribute__((ext_vector_type(8)))short;
using s16x4=__attribute__((ext_vector_type(4)))short;
using f32x16=__attribute__((ext_vector_type(16)))float;
using u32x4=__attribute__((ext_vector_type(4)))unsigned;
constexpr int BATCH=2,NHEAD=16,SEQ=16384,D=64,DM=NHEAD*D;
constexpr int NW=8,QBLK=32,QB=QBLK*NW,KVBLK=64,NQB=SEQ/QB;
constexpr int ATTN_PITCH=DM, ATTN_UNIT_ROWS=QB;
__device__ __forceinline__ int crow(int r,int hi){return (r&3)+8*(r>>2)+4*hi;}
#define SBAR() __builtin_amdgcn_sched_barrier(0)
__device__ __forceinline__ void cmask(f32x16&p0,f32x16&p1,int jb,int qrel,int hi){
  const float NEG=-INFINITY; int kb=64*jb+4*hi;
  #pragma unroll
  for(int r=0;r<16;++r){int kv=kb+(r&3)+8*(r>>2); if(kv>qrel)p0[r]=NEG; if(kv+32>qrel)p1[r]=NEG;}
}

constexpr int NSLOT=3, SLOTB=8192;
constexpr int LDS_K=0, LDS_V=NSLOT*SLOTB, LDS_WS=2*NSLOT*SLOTB, LDS_OST=LDS_WS+NW*64*4, LDS_BYTES=LDS_OST+NW*4096;
constexpr float C2=0.125f*1.4426950408889634f;
__device__ __forceinline__ void glds16(const void*gsrc,unsigned lds_dst){unsigned keep;
  asm volatile("s_mov_b32 %0, m0\n\ts_mov_b32 m0, %2\n\ts_nop 0\n\tglobal_load_lds_dwordx4 %1, off\n\ts_mov_b32 m0, %0":"=&s"(keep):"v"(gsrc),"s"(lds_dst):"memory");}
__device__ __forceinline__ float max3f(float a,float b,float c){float r;asm("v_max3_f32 %0, %1, %2, %3":"=v"(r):"v"(a),"v"(b),"v"(c));return r;}
__device__ __forceinline__ float max2f(float a,float b){float r;asm("v_max_f32_e32 %0, %1, %2":"=v"(r):"v"(a),"v"(b));return r;}
__device__ __forceinline__ float fadd_s(float a,float b){float r;asm("v_add_f32_e32 %0, %1, %2":"=v"(r):"v"(a),"v"(b));return r;}
__device__ __forceinline__ float fsub_s(float a,float b){float r;asm("v_sub_f32_e32 %0, %1, %2":"=v"(r):"v"(a),"v"(b));return r;}
typedef float f32x2_t __attribute__((ext_vector_type(2))); typedef __bf16 bf16x2_t __attribute__((ext_vector_type(2)));
__device__ __forceinline__ unsigned cvtpk_s(float lo,float hi){f32x2_t v={lo,hi};bf16x2_t b=__builtin_convertvector(v,bf16x2_t);return __builtin_bit_cast(unsigned,b);}
#define WAIT_BAR(N) asm volatile("s_waitcnt vmcnt(" #N ") lgkmcnt(0)\n\ts_barrier":::"memory")

__device__ __forceinline__ void qkt(f32x16&p0,f32x16&p1,const char*Kslot,const bf16x8*qr,const f32x16&negm,int r32,int hi){
  const char*kb=Kslot+hi*1024+r32*16;
  #pragma unroll
  for(int d0=0;d0<4;++d0){
    const bf16x8 b0=*reinterpret_cast<const bf16x8*>(kb+d0*2048);
    const bf16x8 b1=*reinterpret_cast<const bf16x8*>(kb+d0*2048+512);
    if(d0==0){p0=__builtin_amdgcn_mfma_f32_32x32x16_bf16(b0,qr[0],negm,0,0,0);p1=__builtin_amdgcn_mfma_f32_32x32x16_bf16(b1,qr[0],negm,0,0,0);}
    else{p0=__builtin_amdgcn_mfma_f32_32x32x16_bf16(b0,qr[d0],p0,0,0,0);p1=__builtin_amdgcn_mfma_f32_32x32x16_bf16(b1,qr[d0],p1,0,0,0);}}
}
typedef __attribute__((address_space(3))) const char* lds_cptr;
typedef short v4i16_t __attribute__((ext_vector_type(4)));
__device__ __forceinline__ void kload8(bf16x8*kf,lds_cptr kp){
  kf[0]=*(const __attribute__((address_space(3))) bf16x8*)(kp);      kf[1]=*(const __attribute__((address_space(3))) bf16x8*)(kp+512);
  kf[2]=*(const __attribute__((address_space(3))) bf16x8*)(kp+2048); kf[3]=*(const __attribute__((address_space(3))) bf16x8*)(kp+2560);
  kf[4]=*(const __attribute__((address_space(3))) bf16x8*)(kp+4096); kf[5]=*(const __attribute__((address_space(3))) bf16x8*)(kp+4608);
  kf[6]=*(const __attribute__((address_space(3))) bf16x8*)(kp+6144); kf[7]=*(const __attribute__((address_space(3))) bf16x8*)(kp+6656);
}
__device__ __forceinline__ void kload2(bf16x8*kf,lds_cptr kp,int j){ kf[2*j]=*(const __attribute__((address_space(3))) bf16x8*)(kp+j*2048); kf[2*j+1]=*(const __attribute__((address_space(3))) bf16x8*)(kp+j*2048+512); }
__device__ __forceinline__ s16x4 vtr(lds_cptr p){ return __builtin_bit_cast(s16x4,__builtin_amdgcn_ds_read_tr16_b64_v4i16((__attribute__((address_space(3))) v4i16_t*)p)); }
__device__ __forceinline__ float rowmax(const f32x16&p0,const f32x16&p1){
  float a=max3f(p0[0],p0[1],p1[0]),b=max3f(p0[2],p0[3],p1[1]);a=max3f(a,p1[2],p1[3]);
  #pragma unroll
  for(int r=4;r<16;r+=4){a=max3f(a,p0[r],p0[r+1]);b=max3f(b,p0[r+2],p0[r+3]);a=max3f(a,p1[r],p1[r+1]);b=max3f(b,p1[r+2],p1[r+3]);}
  const float m=max2f(a,b);
  auto rr=__builtin_amdgcn_permlane32_swap(__float_as_uint(m),__float_as_uint(m),false,false);
  return max2f(__uint_as_float(rr[0]),__uint_as_float(rr[1]));
}
__device__ __forceinline__ void pv(f32x16*o,int vb,bf16x8 pa0,bf16x8 pa1,bf16x8 pa2,bf16x8 pa3){
  #pragma unroll
  for(int d0=0;d0<2;++d0){s16x4 lo[4],hi[4];
    #pragma unroll
    for(int ks=0;ks<4;++ks){
      asm volatile("ds_read_b64_tr_b16 %0,%1 offset:%c2":"=&v"(lo[ks]):"v"(vb),"i"(d0*4096+ks*1024):"memory");
      asm volatile("ds_read_b64_tr_b16 %0,%1 offset:%c2":"=&v"(hi[ks]):"v"(vb),"i"(d0*4096+ks*1024+512):"memory");}
    asm volatile("s_waitcnt lgkmcnt(0)":::"memory");SBAR();
    #define PK(k) (bf16x8){lo[k][0],lo[k][1],lo[k][2],lo[k][3],hi[k][0],hi[k][1],hi[k][2],hi[k][3]}
    o[d0]=__builtin_amdgcn_mfma_f32_32x32x16_bf16(pa0,PK(0),o[d0],0,0,0);
    o[d0]=__builtin_amdgcn_mfma_f32_32x32x16_bf16(pa1,PK(1),o[d0],0,0,0);
    o[d0]=__builtin_amdgcn_mfma_f32_32x32x16_bf16(pa2,PK(2),o[d0],0,0,0);
    o[d0]=__builtin_amdgcn_mfma_f32_32x32x16_bf16(pa3,PK(3),o[d0],0,0,0);
    #undef PK
  }
}

#ifndef ATTN_STORE16
#define ATTN_STORE16(p,v) (*(u32x4*)(p)=(v))
#endif
template<int THRL> __device__ __forceinline__ void attn_unit(int b,int cq,int cv,int qb,const bf16*Q,const bf16*__restrict__ K,const bf16*__restrict__ V,bf16*O,char*shm){
  int tid_=threadIdx.x; asm volatile("":"+v"(tid_)); const int tid=tid_,lane=tid&63,r32=lane&31,hi=lane>>5; const int wid=__builtin_amdgcn_readfirstlane(tid>>6);
  const long rowbase=(long)b*SEQ; const int q0=qb*QB;
  const bf16*Qw=Q+(rowbase+q0+wid*QBLK)*DM+cq;
  const bf16*Kh=K+rowbase*DM+cq,*Vh=V+rowbase*DM+cv;
  const unsigned lds0=(unsigned)(uintptr_t)shm;
  float*wsf=(float*)(shm+LDS_WS)+wid*64;
  const bf16*ksrc=Kh+(long)lane*DM+wid*8;
  const bf16*vsrc=Vh+(long)(16*(wid&3)+(lane>>2))*DM+(wid>>2)*32+(lane&3)*8;
  const unsigned kdst=lds0+LDS_K+wid*1024, vdst=lds0+LDS_V+wid*1024;
  #define DMA_K(t,slot) glds16(ksrc+(long)(t)*KVBLK*DM,(unsigned)__builtin_amdgcn_readfirstlane(kdst+(slot)))
  #define DMA_V(t,slot) glds16(vsrc+(long)(t)*KVBLK*DM,(unsigned)__builtin_amdgcn_readfirstlane(vdst+(slot)))
  const int vb0=(int)(lds0+LDS_V)+((lane>>4)&1)*32+(lane&3)*8+(4*hi+((lane&15)>>2))*64;
  const char*Kbase=shm+LDS_K; bf16x8 kf[8];
  const lds_cptr shm3=(lds_cptr)shm; const lds_cptr kp0=shm3+LDS_K+hi*1024+r32*16; const lds_cptr vp0=shm3+LDS_V+((lane>>4)&1)*32+(lane&3)*8+(4*hi+((lane&15)>>2))*64;
  const int NT=(q0+QB)/KVBLK;
  DMA_K(0,0);DMA_V(0,0);DMA_K(1,SLOTB);
  bf16x8 qr[4];
  #pragma unroll
  for(int d0=0;d0<4;++d0)qr[d0]=*reinterpret_cast<const bf16x8*>(&Qw[(long)r32*DM+d0*16+hi*8]);
  float mhat=0.f,l_reg=0.f;f32x16 o[2];o[0]=f32x16{};o[1]=f32x16{};f32x16 negm=f32x16{};asm volatile("":"+v"(negm));
  const int qrel=wid*QBLK+r32;
  #define CMASK(P0,P1,t) do{int jb_=(t)-(NT-4); if(jb_>=0)cmask(P0,P1,jb_,qrel,hi);}while(0)
  bool resc=false;
  #define START(P0,P1) do{ const float rm=rowmax(P0,P1); resc=false; \
    { const float dl=rm; mhat=fadd_s(mhat,dl); \
      _Pragma("unroll") for(int r=0;r<16;++r){P0[r]=fsub_s(P0[r],dl);P1[r]=fsub_s(P1[r],dl);} \
      _Pragma("unroll") for(int r=0;r<16;++r)negm[r]=-mhat; asm volatile("":"+v"(negm)); } \
    _Pragma("unroll") for(int r=0;r<16;++r)P0[r]=__builtin_amdgcn_exp2f(P0[r]); }while(0)
  #define RESC() do{ if(resc){ asm volatile("s_waitcnt lgkmcnt(0)":::"memory"); \
      _Pragma("unroll") for(int d_=0;d_<2;++d_) _Pragma("unroll") for(int r=0;r<16;++r)o[d_][r]*=wsf[crow(r,hi)]; } }while(0)
  f32x16 pA0,pA1,pB0,pB1;
  int sl_prev=0,sl_cur=0,sl_next=SLOTB;
  #define ROT() do{sl_prev=sl_cur;sl_cur=sl_next;sl_next=(sl_next==(NSLOT-1)*SLOTB)?0:sl_next+SLOTB;}while(0)
  DMA_K(2,2*SLOTB);
  WAIT_BAR(3);
  qkt(pA0,pA1,Kbase,qr,negm,r32,hi);asm volatile("s_nop 15\n\ts_nop 7":"+v"(pA0),"+v"(pA1));CMASK(pA0,pA1,0);
  START(pA0,pA1);
  _Pragma("unroll") for(int r=0;r<16;++r)pA1[r]=__builtin_amdgcn_exp2f(pA1[r]);
  WAIT_BAR(0);
  DMA_K(3,0);DMA_V(1,SLOTB);
  ROT();
  kload8(kf,kp0+sl_cur);
  WAIT_BAR(2);
  s16x4 vlo[8],vhi[8]; u32x4 pw0,pw1,pw2,pw3;
  #define PKW(P,B) cvtpk_s(P[B],P[B+1])
  #define PAF(k) __builtin_bit_cast(bf16x8,pw##k)
  #define VFR(i) (bf16x8){vlo[i][0],vlo[i][1],vlo[i][2],vlo[i][3],vhi[i][0],vhi[i][1],vhi[i][2],vhi[i][3]}
  #define PIN(x) asm volatile("":"+v"(x))
  #define MX3(a,b,c) __builtin_fmaxf(__builtin_fmaxf((a),(b)),(c))
  #define GAPA(MF,A0,A1,A2,A3,W0,W1,PW) do{ MF; sacc+=A0; sacc+=A1; sacc+=A2; sacc+=A3; PIN(sacc); W0; W1; PIN(PW); SBAR(); }while(0)
  #define EX(v) __builtin_amdgcn_exp2f(v)
  #define GAPB(MF,X,B) do{ MF; X[B]=EX(X[B]); X[B+1]=EX(X[B+1]); X[B+2]=EX(X[B+2]); X[B+3]=EX(X[B+3]); PIN(X); SBAR(); }while(0)
  #define VRD(i) do{ vlo[i]=vtr(vp_+(((i)>>2)*4096+((i)&3)*1024)); vhi[i]=vtr(vp_+(((i)>>2)*4096+((i)&3)*1024+512)); }while(0)
  #define KRD(G,j) do{ if(G){ kload2(kf,kp0+sl_next,j); SBAR(); } }while(0)
  #define STEP(C0,C1,P0,P1,t,GK,GV,GL) do{ SBAR(); \
    const lds_cptr vp_=vp0+sl_prev; \
    VRD(0); SBAR(); float sacc=(P0[0]+P0[1]); \
    GAPA(C0=__builtin_amdgcn_mfma_f32_32x32x16_bf16(kf[0],qr[0],negm,0,0,0), P0[2],P0[3],P0[4],P0[5],     pw0[0]=PKW(P0,0), pw0[1]=PKW(P0,2), pw0); \
    VRD(4); SBAR(); GAPA(C1=__builtin_amdgcn_mfma_f32_32x32x16_bf16(kf[1],qr[0],negm,0,0,0), P0[6],P0[7],P0[8],P0[9],     pw0[2]=PKW(P0,4), pw0[3]=PKW(P0,6), pw0); \
    VRD(1); SBAR(); GAPA(C0=__builtin_amdgcn_mfma_f32_32x32x16_bf16(kf[2],qr[1],C0,0,0,0),   P0[10],P0[11],P0[12],P0[13], pw1[0]=PKW(P0,8), pw1[1]=PKW(P0,10), pw1); \
    VRD(5); SBAR(); GAPA(C1=__builtin_amdgcn_mfma_f32_32x32x16_bf16(kf[3],qr[1],C1,0,0,0),   P0[14],P0[15],P1[0],P1[1],   pw1[2]=PKW(P0,12),pw1[3]=PKW(P0,14), pw1); \
    VRD(2); SBAR(); GAPA(C0=__builtin_amdgcn_mfma_f32_32x32x16_bf16(kf[4],qr[2],C0,0,0,0),   P1[2],P1[3],P1[4],P1[5],     pw2[0]=PKW(P1,0), pw2[1]=PKW(P1,2), pw2); \
    VRD(6); SBAR(); GAPA(C1=__builtin_amdgcn_mfma_f32_32x32x16_bf16(kf[5],qr[2],C1,0,0,0),   P1[6],P1[7],P1[8],P1[9],     pw2[2]=PKW(P1,4), pw2[3]=PKW(P1,6), pw2); \
    VRD(3); SBAR(); GAPA(C0=__builtin_amdgcn_mfma_f32_32x32x16_bf16(kf[6],qr[3],C0,0,0,0),   P1[10],P1[11],P1[12],P1[13], pw3[0]=PKW(P1,8), pw3[1]=PKW(P1,10), pw3); \
    VRD(7); SBAR(); GAPA(C1=__builtin_amdgcn_mfma_f32_32x32x16_bf16(kf[7],qr[3],C1,0,0,0),   P1[14],P1[15],0.f,0.f,       pw3[2]=PKW(P1,12),pw3[3]=PKW(P1,14), pw3); \
    l_reg+=sacc; \
    if(GK){DMA_K((t)+3,sl_cur);} if(GV){DMA_V((t)+1,sl_next);} \
    CMASK(C0,C1,t); \
    { float a=MX3(C0[0],C0[1],C1[0]),b=MX3(C0[2],C0[3],C1[1]); a=MX3(a,C1[2],C1[3]); \
      _Pragma("unroll") for(int r=4;r<16;r+=4){a=MX3(a,C0[r],C0[r+1]);b=MX3(b,C0[r+2],C0[r+3]);a=MX3(a,C1[r],C1[r+1]);b=MX3(b,C1[r+2],C1[r+3]);} \
      float rm=__builtin_fmaxf(a,b); { auto rr=__builtin_amdgcn_permlane32_swap(__float_as_uint(rm),__float_as_uint(rm),false,false); rm=__builtin_fmaxf(__uint_as_float(rr[0]),__uint_as_float(rr[1])); } \
      resc=false; \
      if(__builtin_expect(__any(rm>(float)THRL),0)){ const float dl=__builtin_fmaxf(rm,0.f); mhat+=dl; \
        _Pragma("unroll") for(int r=0;r<16;++r){C0[r]-=dl;C1[r]-=dl;} \
        _Pragma("unroll") for(int r=0;r<16;++r)negm[r]=-mhat; asm volatile("":"+v"(negm)); \
        const float f=__builtin_amdgcn_exp2f(-dl); l_reg*=f; if(hi==0)wsf[r32]=f; resc=true; } } \
    SBAR(); \
    GAPB(o[0]=__builtin_amdgcn_mfma_f32_32x32x16_bf16(PAF(0),VFR(0),o[0],0,0,0), C0,0); \
    GAPB(o[1]=__builtin_amdgcn_mfma_f32_32x32x16_bf16(PAF(0),VFR(4),o[1],0,0,0), C0,4); \
    KRD(GL,0); GAPB(o[0]=__builtin_amdgcn_mfma_f32_32x32x16_bf16(PAF(1),VFR(1),o[0],0,0,0), C0,8); \
    KRD(GL,1); GAPB(o[1]=__builtin_amdgcn_mfma_f32_32x32x16_bf16(PAF(1),VFR(5),o[1],0,0,0), C0,12); \
    KRD(GL,2); GAPB(o[0]=__builtin_amdgcn_mfma_f32_32x32x16_bf16(PAF(2),VFR(2),o[0],0,0,0), C1,0); \
    KRD(GL,3); GAPB(o[1]=__builtin_amdgcn_mfma_f32_32x32x16_bf16(PAF(2),VFR(6),o[1],0,0,0), C1,4); \
    GAPB(o[0]=__builtin_amdgcn_mfma_f32_32x32x16_bf16(PAF(3),VFR(3),o[0],0,0,0), C1,8); \
    GAPB(o[1]=__builtin_amdgcn_mfma_f32_32x32x16_bf16(PAF(3),VFR(7),o[1],0,0,0), C1,12); \
    }while(0)
  int t=1;
  #undef CMASK
  #define CMASK(P0,P1,t) do{}while(0)
  for(;t+5<NT;t+=2){
    STEP(pB0,pB1,pA0,pA1,t,true,true,true);     WAIT_BAR(2); RESC(); ROT();
    STEP(pA0,pA1,pB0,pB1,t+1,true,true,true);   WAIT_BAR(2); RESC(); ROT();
  }
  #undef CMASK
  #define CMASK(P0,P1,t) do{int jb_=(t)-(NT-4); if(jb_>=0)cmask(P0,P1,jb_,qrel,hi);}while(0)
  #define ENDW(tt) do{ if((tt)+3<NT){WAIT_BAR(2);} else if((tt)+2<NT){WAIT_BAR(1);} else {WAIT_BAR(0);} }while(0)
  for(;t+1<NT;t+=2){
    STEP(pB0,pB1,pA0,pA1,t,(t+3<NT),(t+1<NT),(t+1<NT));       ENDW(t);   RESC(); ROT();
    STEP(pA0,pA1,pB0,pB1,t+1,(t+4<NT),(t+2<NT),(t+2<NT));     ENDW(t+1); RESC(); ROT();
  }
  STEP(pB0,pB1,pA0,pA1,NT-1,false,false,false); RESC();
  { float sacc=pB0[0]+pB0[1]; _Pragma("unroll") for(int r=2;r<16;++r)sacc+=pB0[r]; _Pragma("unroll") for(int r=0;r<16;++r)sacc+=pB1[r]; l_reg+=sacc;
    pw0=(u32x4){PKW(pB0,0),PKW(pB0,2),PKW(pB0,4),PKW(pB0,6)};pw1=(u32x4){PKW(pB0,8),PKW(pB0,10),PKW(pB0,12),PKW(pB0,14)};pw2=(u32x4){PKW(pB1,0),PKW(pB1,2),PKW(pB1,4),PKW(pB1,6)};pw3=(u32x4){PKW(pB1,8),PKW(pB1,10),PKW(pB1,12),PKW(pB1,14)};
    SBAR(); pv(o,vb0+sl_cur,PAF(0),PAF(1),PAF(2),PAF(3)); }
  #undef PKW
  #undef PAF
  #undef VFR
  #undef PIN
  #undef MX3
  #undef GAPA
  #undef GAPB
  #undef EX
  #undef VRD
  #undef KRD
  #undef STEP
  #undef ENDW
  {auto rr=__builtin_amdgcn_permlane32_swap(__float_as_uint(l_reg),__float_as_uint(l_reg),false,false);l_reg=__uint_as_float(rr[0])+__uint_as_float(rr[1]);}
  if(hi==0)wsf[32+r32]=l_reg;asm volatile("s_waitcnt lgkmcnt(0)":::"memory");
  float rli[16];
  #pragma unroll
  for(int r=0;r<16;++r)rli[r]=__builtin_amdgcn_rcpf(wsf[32+crow(r,hi)]);
  bf16*Ow=O+(rowbase+q0+wid*QBLK)*DM+cv;
  { bf16*stg=(bf16*)(shm+LDS_OST)+wid*2048;
    #pragma unroll
    for(int r=0;r<16;++r){const int orow=crow(r,hi);
      #pragma unroll
      for(int d0=0;d0<2;++d0)stg[orow*64+d0*32+r32]=__float2bfloat16(o[d0][r]*rli[r]);}
    asm volatile("s_waitcnt lgkmcnt(0)":::"memory");
    #pragma unroll
    for(int i=0;i<4;++i){const int row=i*8+(lane>>3),ch=lane&7; const u32x4 v=*(const u32x4*)(stg+row*64+ch*8); ATTN_STORE16(Ow+(long)row*DM+ch*8,v);} }
  asm volatile("s_waitcnt lgkmcnt(0)\n\ts_barrier":::"memory");
  #undef DMA_K
  #undef DMA_V
  #undef CMASK
  #undef START
  #undef RESC
  #undef ROT
}
constexpr int ATTN_LDS_BYTES=LDS_BYTES;
struct AttnTensors { const bf16* Q; const bf16* K; const bf16* V; bf16* O0; bf16* O1; };
template<int THRL> __device__ __forceinline__ void attn_phase(char*lds,const AttnTensors&T,int vcu,int G){
  for(int v=vcu;v<256;v+=G){
    const int e=v>>2,s=v&3; const int b=e>>5,rem=e&31,h=rem>>2,m=(rem>>1)&1,vh=rem&1;
    const int cq=(2*h+m)*64,cv=(2*h+vh)*64; bf16*O=m?T.O1:T.O0;
    for(int i=0;i<16;++i){ const int j=i>>1; const int qb=(i&1)?(8*j+7-s):(8*j+s); attn_unit<THRL>(b,cq,cv,qb,T.Q,T.K,T.V,O,lds); }
  }
}
#undef SBAR
#undef WAIT_BAR
}

namespace attn128 {
constexpr int D = 128, PITCH = 1024, SEQ = 16384;
constexpr float THR = 8.f; constexpr bool WSKIP = false;
constexpr float SCALE = 0.125f;
constexpr int NW = 8, QBLK = 32, KVBLK = 64, QB = NW * QBLK;
constexpr int SHM_V = KVBLK * D * 2, SHM_K = KVBLK * D * 2;
constexpr int LDS_BYTES = 2 * SHM_V + 2 * SHM_K + NW * 64 * 4;
using bf16 = unsigned short;
typedef short bf16x8 __attribute__((ext_vector_type(8)));
typedef short s16x4 __attribute__((ext_vector_type(4)));
typedef float f32x16 __attribute__((ext_vector_type(16)));
typedef float f32x4 __attribute__((ext_vector_type(4)));
typedef unsigned u32x4 __attribute__((ext_vector_type(4)));
template <class A, class Bt> struct same_t { static constexpr bool v = false; };
template <class A> struct same_t<A, A> { static constexpr bool v = true; };

#define KSWZ(row, colB) ((row) * 256 + ((colB) ^ (((row) & 7) << 4)))
#define SBAR() __builtin_amdgcn_sched_barrier(0)
__device__ __forceinline__ int v_st(int k, int c) { const int kk = (k & ~0xC) | ((k & 4) << 1) | ((k & 8) >> 1); return ((kk >> 3) * 4 + (c >> 5)) * 512 + ((kk & 7) * 32 + (c & 31)) * 2; }
__device__ __forceinline__ int v_rd_base(int lane) { return ((lane & 3) << 3) | (((lane >> 2) & 3) << 6) | (((lane >> 4) & 1) << 5) | (((lane >> 5) & 1) << 8); }
constexpr int v_rd_off(int d0, int ks, int half) { return d0 * 512 + ks * 4096 + half * 2048; }
__device__ __forceinline__ int crow(int r, int hi) { return (r & 3) + 8 * (r >> 2) + 4 * hi; }
__device__ __forceinline__ unsigned cvtpk(float lo, float hi) {
    unsigned r; asm volatile("v_cvt_pk_bf16_f32 %0, %1, %2" : "=v"(r) : "v"(lo), "v"(hi)); return r;
}
__device__ __forceinline__ bf16x8 pack8(f32x4 a, f32x4 b) {
    u32x4 w = {cvtpk(a[0], a[1]), cvtpk(a[2], a[3]), cvtpk(b[0], b[1]), cvtpk(b[2], b[3])};
    return *reinterpret_cast<bf16x8*>(&w);
}
template <class T> __device__ __forceinline__ bf16x8 load8(const T* p) {
    if constexpr (same_t<T, float>::v) { return pack8(*(const f32x4*)p, *(const f32x4*)(p + 4)); }
    else { return *reinterpret_cast<const bf16x8*>(p); }
}
__device__ __forceinline__ void mask_tile(f32x16& p0, f32x16& p1, int dq, unsigned W) {
    const float NEG = -__builtin_inff();
#pragma unroll
    for (int r = 0; r < 16; ++r) {
        const int c = (r & 3) + 8 * (r >> 2);
        if ((unsigned)(dq - c) >= W) p0[r] = NEG;
        if ((unsigned)(dq - c - 32) >= W) p1[r] = NEG;
    }
}
__device__ __forceinline__ void partialSM(f32x16& p0, f32x16& p1, float& m_reg, float& mn, float& alpha) {
    float pmax = p0[0]; for (int r = 1; r < 16; ++r) pmax = fmaxf(pmax, p0[r]); for (int r = 0; r < 16; ++r) pmax = fmaxf(pmax, p1[r]);
    { auto rr = __builtin_amdgcn_permlane32_swap(__float_as_uint(pmax), __float_as_uint(pmax), false, false);
      pmax = fmaxf(__uint_as_float(rr[0]), __uint_as_float(rr[1])); }
    constexpr float C2 = 1.4426950408889634f * SCALE;
    if (__builtin_expect(__all((pmax - m_reg) * SCALE <= THR), 1)) { mn = m_reg; alpha = 1.f; }
    else { mn = fmaxf(m_reg, pmax); alpha = __builtin_amdgcn_exp2f((m_reg - mn) * C2); m_reg = mn; }
    const float mnL = -mn * C2;
    for (int r = 0; r < 16; ++r) p0[r] = fmaf(p0[r], C2, mnL); for (int r = 0; r < 16; ++r) p1[r] = fmaf(p1[r], C2, mnL);
    for (int r = 0; r < 16; ++r) p0[r] = __builtin_amdgcn_exp2f(p0[r]);
}
__device__ __forceinline__ void finishSM(f32x16& p0, f32x16& p1, float alpha, float& l_reg, bf16x8& pa0, bf16x8& pa1, bf16x8& pa2, bf16x8& pa3) {
    for (int r = 0; r < 16; ++r) p1[r] = __builtin_amdgcn_exp2f(p1[r]);
    float ps = 0; for (int r = 0; r < 16; ++r) ps += p0[r]; for (int r = 0; r < 16; ++r) ps += p1[r];
    { auto rr = __builtin_amdgcn_permlane32_swap(__float_as_uint(ps), __float_as_uint(ps), false, false);
      ps = __uint_as_float(rr[0]) + __uint_as_float(rr[1]); }
    l_reg = l_reg * alpha + ps;
#define PK4(P, B_, OUT) do { unsigned a0 = cvtpk(P[B_+0], P[B_+1]), a1 = cvtpk(P[B_+2], P[B_+3]);                          \
        unsigned b0 = cvtpk(P[B_+4], P[B_+5]), b1 = cvtpk(P[B_+6], P[B_+7]);                                             \
        auto r0 = __builtin_amdgcn_permlane32_swap(a0, b0, false, false); auto r1 = __builtin_amdgcn_permlane32_swap(a1, b1, false, false); \
        u32x4 w = {r0[0], r1[0], r0[1], r1[1]}; OUT = *reinterpret_cast<bf16x8*>(&w); } while (0)
    PK4(p0, 0, pa0); PK4(p0, 8, pa1); PK4(p1, 0, pa2); PK4(p1, 8, pa3);
#undef PK4
}
template <int KB, bool SK>
__device__ __forceinline__ void qkt(f32x16& p0, f32x16& p1, const char* K_lds, int r32, int hi, const bf16x8* qr, bool act, int kmo) {
    if (SK && !act) { const float NEG = -__builtin_inff();
#pragma unroll
        for (int r = 0; r < 16; ++r) { p0[r] = NEG; p1[r] = NEG; } return; }
    p0 = f32x16{}; p1 = f32x16{};
    const char* kb[4];
#pragma unroll
    for (int dd = 0; dd < 4; ++dd) kb[dd] = K_lds + KB * SHM_K + KSWZ(r32, (dd * 16 + hi * 8) * 2);
#pragma unroll
    for (int d0 = 0; d0 < 4; ++d0) { const char* a = kb[d0] + kmo;
        bf16x8 b0 = *reinterpret_cast<const bf16x8*>(a);
        bf16x8 b1 = *reinterpret_cast<const bf16x8*>(a + 32 * 256);
        p0 = __builtin_amdgcn_mfma_f32_32x32x16_bf16(b0, qr[d0], p0, 0, 0, 0);
        p1 = __builtin_amdgcn_mfma_f32_32x32x16_bf16(b1, qr[d0], p1, 0, 0, 0); }
}
template <int VB, bool SK>
__device__ __forceinline__ void pv_tile(f32x16* o, int vb0, bf16x8 pa0, bf16x8 pa1, bf16x8 pa2, bf16x8 pa3, bool act) {
    if (SK && !act) return;
#define TRRD(dst, off) asm volatile("ds_read_b64_tr_b16 %0, %1 offset:%2" : "=&v"(dst) : "v"(vb0), "i"(off) : "memory")
#define PV_D0(d0) do { s16x4 l0, l1, l2, l3, h0, h1, h2, h3; constexpr int b_ = VB * SHM_V + v_rd_off(d0, 0, 0);     \
        TRRD(l0, b_); TRRD(h0, b_ + 2048); TRRD(l1, b_ + 4096); TRRD(h1, b_ + 6144); TRRD(l2, b_ + 8192); TRRD(h2, b_ + 10240); TRRD(l3, b_ + 12288); TRRD(h3, b_ + 14336); \
        asm volatile("s_waitcnt lgkmcnt(0)" ::: "memory"); SBAR();                 \
        o[d0] = __builtin_amdgcn_mfma_f32_32x32x16_bf16(pa0, (bf16x8){l0[0], l0[1], l0[2], l0[3], h0[0], h0[1], h0[2], h0[3]}, o[d0], 0, 0, 0);   \
        o[d0] = __builtin_amdgcn_mfma_f32_32x32x16_bf16(pa1, (bf16x8){l1[0], l1[1], l1[2], l1[3], h1[0], h1[1], h1[2], h1[3]}, o[d0], 0, 0, 0);   \
        o[d0] = __builtin_amdgcn_mfma_f32_32x32x16_bf16(pa2, (bf16x8){l2[0], l2[1], l2[2], l2[3], h2[0], h2[1], h2[2], h2[3]}, o[d0], 0, 0, 0);   \
        o[d0] = __builtin_amdgcn_mfma_f32_32x32x16_bf16(pa3, (bf16x8){l3[0], l3[1], l3[2], l3[3], h3[0], h3[1], h3[2], h3[3]}, o[d0], 0, 0, 0); } while (0)
    PV_D0(0); PV_D0(1); PV_D0(2); PV_D0(3);
#undef PV_D0
#undef TRRD
}

template <class TIn, class TOut> struct BlockRef { const TIn* Q; const TIn* K; const TIn* V; TOut* O; int P0; int kmo; };
template <class TIn> struct Seam {
    bf16x8 qr[4];
    bf16x8 st_v0, st_v1, st_k0, st_k1; f32x4 sf0, sf1, sf2, sf3;
    f32x4 tq[1];
};
__device__ __forceinline__ int swa_jlo(int P0, int W) { const int lowk = P0 - W + 1; return lowk > 0 ? lowk / KVBLK : 0; }
#define ROW(p, k0, rr) ((p) + (size_t)((k0) + (rr)) * PITCH + sc)
#define VMW() asm volatile("s_waitcnt vmcnt(0)" ::: "memory")
#define VMWN(n) asm volatile("s_waitcnt vmcnt(%0)" :: "i"(n) : "memory")
#define SLOAD_H(Kp, Vp, k0) do { S.st_v0 = load8<TIn>(ROW(Vp, k0, sr)); S.st_v1 = load8<TIn>(ROW(Vp, k0, 32 + sr));              \
                         S.st_k0 = load8<TIn>(ROW(Kp, k0, sr)); S.st_k1 = load8<TIn>(ROW(Kp, k0, 32 + sr)); } while (0)
#define SWRITE_HK(bf) do { *(bf16x8*)(K_lds + (bf) * SHM_K + kws) = S.st_k0; *(bf16x8*)(K_lds + (bf) * SHM_K + kws + 32 * 256) = S.st_k1; } while (0)
#define SWRITE_HV(bf) do { *(bf16x8*)(V_lds + (bf) * SHM_V + vst0) = S.st_v0; *(bf16x8*)(V_lds + (bf) * SHM_V + vst1) = S.st_v1; } while (0)
#define SWRITE_H(bf) do { SWRITE_HV(bf); SWRITE_HK(bf); } while (0)
#define SLOAD_F(p, k0) do { S.sf0 = *(const f32x4*)ROW(p, k0, sr); S.sf1 = *(const f32x4*)(ROW(p, k0, sr) + 4);                \
                            S.sf2 = *(const f32x4*)ROW(p, k0, 32 + sr); S.sf3 = *(const f32x4*)(ROW(p, k0, 32 + sr) + 4); } while (0)
#define SWRITE_KF(bf) do { *(bf16x8*)(K_lds + (bf) * SHM_K + kws) = pack8(S.sf0, S.sf1); *(bf16x8*)(K_lds + (bf) * SHM_K + kws + 32 * 256) = pack8(S.sf2, S.sf3); } while (0)
#define SWRITE_VF(bf) do { *(bf16x8*)(V_lds + (bf) * SHM_V + vst0) = pack8(S.sf0, S.sf1); *(bf16x8*)(V_lds + (bf) * SHM_V + vst1) = pack8(S.sf2, S.sf3); } while (0)
template <class TIn, class TOut>
__device__ __forceinline__ void causal_swa_prime(const BlockRef<TIn, TOut>& cur, int W, char* lds, Seam<TIn>& S) {
    constexpr bool F32 = same_t<TIn, float>::v;
    int tid_ = threadIdx.x; asm volatile("" : "+v"(tid_)); const int tid = tid_, wid = __builtin_amdgcn_readfirstlane(tid >> 6), lane = tid & 63, r32 = lane & 31, hi = lane >> 5;
    const int sr = tid >> 4, sc = (tid & 15) * 8, kws = KSWZ(sr, sc * 2); char* K_lds = lds + 2 * SHM_V;
    const int kb0 = swa_jlo(cur.P0, W) * KVBLK;
    for (int d0 = 0; d0 < 4; ++d0) S.qr[d0] = load8<TIn>(cur.Q + (size_t)(wid * QBLK + r32) * PITCH + d0 * 16 + hi * 8);
    if constexpr (F32) { SLOAD_F((const float*)cur.K, kb0); VMW(); SWRITE_KF(0); SBAR(); SLOAD_F((const float*)cur.V, kb0); }
    else { SLOAD_H(cur.K, cur.V, kb0); VMW(); SWRITE_HK(0); }
    __syncthreads();
}
template <class TIn, class TOut>
__device__ __forceinline__ void causal_swa_block(const BlockRef<TIn, TOut>& cur, const BlockRef<TIn, TOut>& nxt, int skv, int W, char* lds, Seam<TIn>& S) {
    constexpr bool F32 = same_t<TIn, float>::v;
    int tid_ = threadIdx.x; asm volatile("" : "+v"(tid_)); const int tid = tid_, wid = __builtin_amdgcn_readfirstlane(tid >> 6), lane = tid & 63, r32 = lane & 31, hi = lane >> 5;
    const int j_lo = swa_jlo(cur.P0, W);
    int j_hi = (cur.P0 + QB - 1) / KVBLK + 1; if (j_hi > skv / KVBLK) j_hi = skv / KVBLK;
    const int NT = j_hi - j_lo;
    const int kbn = swa_jlo(nxt.P0, W) * KVBLK;
    const int qlo = cur.P0 + wid * QBLK, qm = qlo + r32 - 4 * hi;
    char* V_lds = lds; char* K_lds = lds + 2 * SHM_V;
    float* ws = (float*)(lds + 2 * SHM_V + 2 * SHM_K) + wid * 64; float* li_l = ws, * al_l = ws + 32;
    float m_reg = -1e30f, l_reg = 0; f32x16 o[4] = {};
    const int sr = tid >> 4, sc = (tid & 15) * 8, vst0 = v_st(sr, sc), vst1 = v_st(32 + sr, sc), kws = KSWZ(sr, sc * 2);
    const int vb0 = (int)(uintptr_t)V_lds + v_rd_base(lane);
    const TIn* Kh = cur.K; const TIn* Vh = cur.V;
#define RESC(a) do { if (__any((a) < 1.f)) { if (hi == 0) al_l[r32] = (a); asm volatile("s_waitcnt lgkmcnt(0)" ::: "memory");              \
                     for (int d_ = 0; d_ < 4; ++d_) for (int r = 0; r < 16; ++r) o[d_][r] *= al_l[crow(r, hi)]; } } while (0)
#define KBASE(t) ((j_lo + (t)) * KVBLK)
#define ACT(t) (KBASE(t) <= qlo + QBLK - 1 && KBASE(t) + KVBLK - 1 >= qlo - W + 1)
#define MASKT(P0_, P1_, t) do { const int kb_ = KBASE(t); if ((!SK || ACT(t)) && (kb_ + KVBLK - 1 > qlo || kb_ <= qlo + QBLK - 1 - W)) mask_tile(P0_, P1_, qm - kb_, (unsigned)W); } while (0)
    constexpr int NQL = F32 ? 16 : 4;
    constexpr bool SK = WSKIP && !F32;
#define SEAM_K0() do { VMWN(NQL); if constexpr (F32) { SWRITE_KF(0); SBAR(); SLOAD_F((const float*)nxt.V, kbn); } else { SWRITE_HK(0); } SBAR(); } while (0)
    f32x16 pA0, pA1, pB0, pB1; float mnA, mnB, alA, alB; bf16x8 pa0, pa1, pa2, pa3;
    if constexpr (F32) { VMW(); SWRITE_VF(0); SBAR(); } else { SWRITE_HV(0); SBAR(); }
    if (NT > 1) { if constexpr (F32) SLOAD_F((const float*)Kh, KBASE(1)); else SLOAD_H(Kh, Vh, KBASE(1)); }
    SBAR(); qkt<0, SK>(pA0, pA1, K_lds, r32, hi, S.qr, ACT(0), cur.kmo);
    if constexpr (F32) { if (NT > 1) { VMW(); SWRITE_KF(1); SBAR(); SLOAD_F((const float*)Vh, KBASE(1)); } }
    MASKT(pA0, pA1, 0); partialSM(pA0, pA1, m_reg, mnA, alA);
    if (NT > 1) { VMW(); if constexpr (F32) { SWRITE_VF(1); SBAR(); if (NT > 2) SLOAD_F((const float*)Kh, KBASE(2)); } else SWRITE_H(1); }
    __syncthreads();
#define HALF_STEP(PX0, PX1, mnX, alX, PY0, PY1, alY, t, KB, VB, SB) do {                                                      \
        SBAR(); qkt<KB, SK>(PX0, PX1, K_lds, r32, hi, S.qr, ACT(t), cur.kmo);                                             \
        finishSM(PY0, PY1, alY, l_reg, pa0, pa1, pa2, pa3); SBAR();                                                           \
        if ((t) + 1 < NT) { if constexpr (F32) { VMW(); SWRITE_KF(SB); SBAR(); SLOAD_F((const float*)Vh, KBASE((t) + 1)); }  \
                            else { SLOAD_H(Kh, Vh, KBASE((t) + 1)); } SBAR(); }                                               \
        pv_tile<VB, SK>(o, vb0, pa0, pa1, pa2, pa3, ACT((t) - 1)); MASKT(PX0, PX1, (t)); partialSM(PX0, PX1, m_reg, mnX, alX);                                        \
        __syncthreads();                                                                                                      \
        if ((t) + 1 < NT) { VMW(); if constexpr (F32) { SWRITE_VF(SB); SBAR(); if ((t) + 2 < NT) SLOAD_F((const float*)Kh, KBASE((t) + 2)); } \
                            else { SWRITE_H(SB); } }                                                                          \
        RESC(alX); __syncthreads(); } while (0)
    for (int t = 1; t + 1 < NT; t += 2) {
        HALF_STEP(pB0, pB1, mnB, alB, pA0, pA1, alA, t, 1, 0, 0);
        HALF_STEP(pA0, pA1, mnA, alA, pB0, pB1, alB, t + 1, 0, 1, 1);
    }
    const bool even = (NT & 1) == 0;
    if (even) { SBAR(); qkt<1, SK>(pB0, pB1, K_lds, r32, hi, S.qr, ACT(NT - 1), cur.kmo); SBAR(); }
#define QROW(e) (nxt.Q + (size_t)(wid * QBLK + r32) * D + ((e) >> 1) * 16 + hi * 8 + ((e) & 1) * 4)
    if constexpr (F32) { SLOAD_F((const float*)nxt.K, kbn); SBAR();
#pragma unroll
        for (int e = 0; e < 8; ++e) S.tq[e] = *(const f32x4*)QROW(e); }
    else { SLOAD_H(nxt.K, nxt.V, kbn); SBAR();
#pragma unroll
        for (int d0 = 0; d0 < 4; ++d0) S.qr[d0] = load8<TIn>(nxt.Q + (size_t)(wid * QBLK + r32) * PITCH + d0 * 16 + hi * 8); }
    SBAR();
    finishSM(pA0, pA1, alA, l_reg, pa0, pa1, pa2, pa3); SBAR();
    if constexpr (F32) {
#pragma unroll
        for (int e = 8; e < 16; ++e) S.tq[e] = *(const f32x4*)QROW(e); SBAR(); }
#undef QROW
    pv_tile<0, SK>(o, vb0, pa0, pa1, pa2, pa3, ACT(even ? NT - 2 : NT - 1));
    if (even) { MASKT(pB0, pB1, NT - 1); partialSM(pB0, pB1, m_reg, mnB, alB); __syncthreads(); RESC(alB);
        finishSM(pB0, pB1, alB, l_reg, pa0, pa1, pa2, pa3); SBAR(); pv_tile<1, SK>(o, vb0, pa0, pa1, pa2, pa3, ACT(NT - 1)); }
    SBAR(); SEAM_K0();
    if (hi == 0) li_l[r32] = l_reg; asm volatile("s_waitcnt lgkmcnt(0)" ::: "memory");
    float rli[16];
#pragma unroll
    for (int r = 0; r < 16; ++r) rli[r] = __builtin_amdgcn_rcpf(li_l[crow(r, hi)]);
    TOut* Ow = cur.O + (size_t)(wid * QBLK) * PITCH;
#pragma unroll
    for (int r = 0; r < 16; ++r) { const int orow = crow(r, hi);
#pragma unroll
        for (int d0 = 0; d0 < 4; ++d0) { const float v = o[d0][r] * rli[r];
            if constexpr (same_t<TOut, float>::v) { Ow[(size_t)orow * PITCH + d0 * 32 + r32] = v; }
            else { const float vn = __shfl_xor(v, 1);
                   if ((r32 & 1) == 0) *(unsigned*)(Ow + (size_t)orow * PITCH + d0 * 32 + r32) = cvtpk(v, vn); } } }
    if constexpr (F32) {
#pragma unroll
        for (int d0 = 0; d0 < 8; ++d0) S.qr[d0] = pack8(S.tq[2 * d0], S.tq[2 * d0 + 1]); }
    __syncthreads();
#undef RESC
#undef KBASE
#undef ACT
#undef MASKT
#undef SEAM_K0
#undef HALF_STEP
}
#undef ROW
#undef VMW
#undef VMWN
#undef SLOAD_H
#undef SWRITE_HK
#undef SWRITE_HV
#undef SWRITE_H
#undef SLOAD_F
#undef SWRITE_KF
#undef SWRITE_VF


struct AttnTensors { const bf16* Q; const bf16* K; const bf16* V; bf16* O0; bf16* O1; };
__device__ __forceinline__ BlockRef<bf16, bf16> blk_ref(const AttnTensors& T, int vcu, int G, int li) {
    const int v = vcu + (li >> 3) * G, i = li & 7, e = v >> 3, s = v & 7, b = e >> 4, h = (e >> 1) & 7, m = e & 1, j = i >> 1;
    const int qb = (i & 1) ? (16 * j + 15 - s) : (16 * j + s);
    BlockRef<bf16, bf16> r;
    r.Q = T.Q + ((size_t)b * SEQ + (size_t)qb * QB) * PITCH + h * 128 + m * 64;
    r.K = T.K + (size_t)b * SEQ * PITCH + h * 128; r.V = T.V + (size_t)b * SEQ * PITCH + h * 128;
    r.O = (m ? T.O1 : T.O0) + ((size_t)b * SEQ + (size_t)qb * QB) * PITCH + h * 128;
    r.P0 = qb * QB; r.kmo = m * 128;
    return r;
}
__device__ __forceinline__ void attn_phase(char* lds, const AttnTensors& T, int vcu, int G) {
    int nv = 0; for (int v = vcu; v < 256; v += G) ++nv;
    const int nblk = nv * 8; if (nblk == 0) return;
    Seam<bf16> S;
    BlockRef<bf16, bf16> cur = blk_ref(T, vcu, G, 0);
    causal_swa_prime<bf16, bf16>(cur, SEQ, lds, S);
    for (int li = 0; li < nblk; ++li) {
        const BlockRef<bf16, bf16> nxt = (li + 1 < nblk) ? blk_ref(T, vcu, G, li + 1) : cur;
        causal_swa_block<bf16, bf16>(cur, nxt, SEQ, SEQ, lds, S);
        cur = nxt;
    }
}
}

#define GAS __attribute__((address_space(1)))
#define LAS __attribute__((address_space(3)))
typedef unsigned short bf16;
typedef unsigned v4u __attribute__((ext_vector_type(4)));
typedef float f32x4 __attribute__((ext_vector_type(4)));
typedef short bf16x8 __attribute__((ext_vector_type(8)));
typedef GAS unsigned gu32;
typedef GAS unsigned long long gu64;
#define RLX_AGENT __ATOMIC_RELAXED, __HIP_MEMORY_SCOPE_AGENT
#define LDS_WAIT() asm volatile("s_waitcnt lgkmcnt(0)" ::: "memory")
#define VM_WAIT() asm volatile("s_waitcnt vmcnt(0)" ::: "memory")
__device__ __forceinline__ unsigned long long rt() { return __builtin_amdgcn_s_memrealtime(); }

#define XB_TMO      128
#define XB_XCNT(j)  (256  + 64 * (j))
#define XB_XSUB(j)  (1280 + 64 * (j))
#define XB_XGEN(j)  (2304 + 64 * (j))
#define XB_TOP      3328
#define XB_TOPGEN   3392
#define XCD_BAR_WORDS 3456
#define XB_SPIN_CAP (1u << 18)

__device__ __forceinline__ unsigned xb_ld(unsigned* p)              { return __hip_atomic_load(p, __ATOMIC_RELAXED, __HIP_MEMORY_SCOPE_AGENT); }
__device__ __forceinline__ unsigned xb_add(unsigned* p, unsigned v) { return __hip_atomic_fetch_add(p, v, __ATOMIC_RELAXED, __HIP_MEMORY_SCOPE_AGENT); }
__device__ __forceinline__ unsigned xb_xcc_id() { return (unsigned)__builtin_amdgcn_s_getreg((3 << 11) | 20) & 0xFu; }
#define XB_SPIN(cond, bar) do { unsigned _sp = 0; while (cond) { __builtin_amdgcn_s_sleep(1); \
    if ((++_sp & 255u) == 0u) { if (xb_ld(&(bar)[XB_TMO])) break; if (_sp > XB_SPIN_CAP) { atomicAdd(&(bar)[XB_TMO], 1u); break; } } } } while (0)

struct XcdBarrier {
    unsigned* bar; unsigned x;
    volatile LAS unsigned* st;
};

__device__ __forceinline__ XcdBarrier xcd_barrier_post(unsigned* bar, volatile LAS unsigned* st) {
    XcdBarrier b; b.bar = bar; b.x = xb_xcc_id(); b.st = st;
    if (threadIdx.x == 0) (void)xb_add(&bar[XB_XCNT(b.x)], 1u);
    return b;
}
__device__ __forceinline__ void xcd_barrier_complete(unsigned* bar, unsigned x, unsigned& nloc, unsigned& nx) {
    const unsigned G = gridDim.x * gridDim.y * gridDim.z;
    unsigned sum, cnt, mine, sp = 0u;
    for (;;) {
        sum = 0u; cnt = 0u; mine = 0u;
#pragma unroll
        for (unsigned j = 0; j < 16; ++j) { const unsigned c = xb_ld(&bar[XB_XCNT(j)]); sum += c; cnt += (c > 0u) ? 1u : 0u; mine = (j == x) ? c : mine; }
        if (sum == G) break;
        __builtin_amdgcn_s_sleep(1);
        if ((++sp & 255u) == 0u) { if (xb_ld(&bar[XB_TMO])) break; if (sp > XB_SPIN_CAP) { atomicAdd(&bar[XB_TMO], 1u); break; } }
    }
    nloc = mine > 0u ? mine : 1u; nx = cnt > 0u ? cnt : 1u;
}

__device__ __forceinline__ void xcd_barrier(const XcdBarrier& b) {
    asm volatile("s_waitcnt vmcnt(0)" ::: "memory");
    __syncthreads();
    if (threadIdx.x == 0) {
        unsigned* bar = b.bar;
        __builtin_amdgcn_s_waitcnt(0);
        unsigned nloc = b.st[0], nx = b.st[1];
        if (nloc == 0u) { xcd_barrier_complete(bar, b.x, nloc, nx); b.st[0] = nloc; b.st[1] = nx; }
        const unsigned old = xb_add(&bar[XB_XSUB(b.x)], 1u);
        const unsigned gen = old / nloc;
        if (old + 1u == (gen + 1u) * nloc) {
            __builtin_amdgcn_fence(__ATOMIC_RELEASE, "agent");
            asm volatile("s_waitcnt vmcnt(0)" ::: "memory");
            const unsigned og = xb_add(&bar[XB_TOP], 1u);
            const unsigned tg = og / nx;
            if (og + 1u == (tg + 1u) * nx) xb_add(&bar[XB_TOPGEN], 1u);
            else XB_SPIN(xb_ld(&bar[XB_TOPGEN]) == tg, bar);
            __builtin_amdgcn_fence(__ATOMIC_ACQUIRE, "agent");
            xb_add(&bar[XB_XGEN(b.x)], 1u);
            asm volatile("s_waitcnt vmcnt(0)" ::: "memory");
        } else {
            XB_SPIN(xb_ld(&bar[XB_XGEN(b.x)]) == gen, bar);
            __builtin_amdgcn_fence(__ATOMIC_ACQUIRE, "agent");
            asm volatile("s_waitcnt vmcnt(0)" ::: "memory");
        }
    }
    __syncthreads();
}
constexpr int NWAVES = 8;
#ifndef REP_SCAN
#define REP_SCAN 1
#endif
#ifndef REP_ATTN
#define REP_ATTN 1
#endif
#ifndef REP_PASS
#define REP_PASS 1
#endif
#ifndef REP_OG
#define REP_OG 1
#endif
#ifndef REP_SYNC
#define REP_SYNC 0
#endif
#ifndef REP_G1
#define REP_G1 1
#endif
constexpr int BATCH = 2, SEQ = 16384, D = 1024, M = BATCH * SEQ;
constexpr size_t MiB = 1u << 20;
constexpr size_t WS_ROPE_C = 1 * MiB, WS_ROPE_S = 2 * MiB, WS_S = 3 * MiB, WS_BIAS = 5 * MiB, WS_W = 6 * MiB, WS_U = 32 * MiB, UNIT = 64 * MiB, WS_H = WS_U + 7 * UNIT, WS_END = WS_H + 16 * MiB;
constexpr size_t W_RKVG = 0, W_DOWN = 8 * MiB, W_UP = 17 * MiB, W_OUT = 19 * MiB;
constexpr size_t W_PROJ = 0, W_BOUT = 8 * MiB;
constexpr int LDS_BYTES = 147456;
constexpr float C2F = 0.125f * 1.4426950408889634f;
#ifdef ATTN_D64
#define QSCALE_MASK0 0x4
#define QSCALE_MASK1 0x1
#else
#define QSCALE_MASK0 0x0
#define QSCALE_MASK1 0x0
#endif

typedef _Float16 h16x4 __attribute__((ext_vector_type(4)));
typedef unsigned u32x2 __attribute__((ext_vector_type(2)));
typedef float f32x2 __attribute__((ext_vector_type(2)));
__device__ __forceinline__ unsigned f2bf(float f) { unsigned u = __builtin_bit_cast(unsigned, f); return (u + 0x7fffu + ((u >> 16) & 1u)) >> 16; }
__device__ __forceinline__ unsigned pk2(float lo, float hi) { return f2bf(lo) | (f2bf(hi) << 16); }
__device__ __forceinline__ float bflo(unsigned w) { return __uint_as_float(w << 16); }
__device__ __forceinline__ float bfhi(unsigned w) { return __uint_as_float(w & 0xffff0000u); }
__device__ __forceinline__ float wave_sum(float v) {
#pragma unroll
    for (int o = 1; o < 64; o <<= 1) v += __shfl_xor(v, o);
    return v;
}
template <int CTRL> __device__ __forceinline__ float dpp_mov(float x) { return __builtin_bit_cast(float, __builtin_amdgcn_update_dpp(0, __builtin_bit_cast(int, x), CTRL, 0xf, 0xf, false)); }
__device__ __forceinline__ float allreduce16(float x) { x += dpp_mov<0x128>(x); x += dpp_mov<0x124>(x); x += dpp_mov<0x122>(x); x += dpp_mov<0x121>(x); return x; }

__device__ __forceinline__ void conv_tile(const float* src, int ldsrc, int k0s, int n0s, int kvalid, const float* sc, int smode, bf16* dst, int pitch, int n0d, int k0d, LAS float* scr, int lane) {
#pragma unroll 8
    for (int i = 0; i < 32; ++i) { const int kk = 2 * i + (lane >> 5), n = lane & 31; float v = 0.f;
        if (kk < kvalid) { v = src[(size_t)(k0s + kk) * ldsrc + n0s + n]; if (smode) { const float s = sc[k0s + kk]; v *= (smode == 1) ? s : (1.0f - s); } }
        scr[kk * 33 + n] = v; }
    LDS_WAIT(); asm volatile("" ::: "memory");
    const int c = lane & 7;
#pragma unroll
    for (int j = 0; j < 4; ++j) { const int n = (lane >> 3) + 8 * j; const LAS float* s = scr + (8 * c) * 33 + n;
        v4u o; o.x = pk2(s[0 * 33], s[1 * 33]); o.y = pk2(s[2 * 33], s[3 * 33]); o.z = pk2(s[4 * 33], s[5 * 33]); o.w = pk2(s[6 * 33], s[7 * 33]);
        *(v4u*)(dst + (size_t)(n0d + n) * pitch + k0d + 8 * c) = o; }
    LDS_WAIT(); asm volatile("" ::: "memory");
}

struct In {
    const float* x; const int* pos; const float *a_norm, *a_mu, *a_w_in, *a_w0, *a_w1, *a_w2, *a_a0, *a_a1, *a_a2, *a_v0, *a_v1, *a_v2, *a_k_k, *a_k_a, *a_r_k, *a_ln_w, *a_ln_b, *a_w_out;
    const float *kv_norm, *w_kv, *b_norm, *b_w_in, *b_lq1, *b_lk1, *b_lq2, *b_lk2, *b_subln, *b_w_out, *final_norm;
};

__device__ __forceinline__ void conv_rwkv(const In& I, int l, unsigned char* wreg, float* bias3, LAS float* scr, int gw, int NGW, int lane) {
    if (gw < 48) { const int i = gw * 64 + lane; const int t = i >> 10, c = i & 1023; bias3[i] = (t == 0) ? I.a_w0[l * 1024 + c] : (t == 1) ? I.a_a0[l * 1024 + c] : I.a_v0[c]; }
    bf16* Wq = (bf16*)(wreg + W_RKVG); bf16* Wd = (bf16*)(wreg + W_DOWN); bf16* Wu = (bf16*)(wreg + W_UP); bf16* Wo = (bf16*)(wreg + W_OUT);
    const int NUPB = (l == 0 ? 2048 : 3072) / 32;
    const int I_Q = 4 * 32 * 16, I_D = 8 * 32, I_F = I_Q + I_D, I_U = NUPB * 4, I_O = 32 * 16;
    for (int it = gw; it < I_F + I_U + I_O; it += NGW) {
        int r = it;
        if (r < I_Q) { const int p = r >> 9, nb = (r >> 4) & 31, kb = r & 15;
            conv_tile(I.a_w_in + (size_t)(l * 4 + p) * 1024 * 1024, 1024, kb * 64, nb * 32, 64, I.a_mu, 0, Wq + (size_t)p * 1024 * 1024, 1024, nb * 32, kb * 64, scr, lane); continue; }
        if (r < I_F) { const int rr = r - I_Q, nb = rr >> 5, kb = rr & 31; const int c0 = nb * 32, k0d = kb * 64, half = kb >> 4, k0s = (kb & 15) * 64;
            const float* mu = I.a_mu + (size_t)l * 6 * 1024;
            if (c0 < 64) conv_tile(I.a_w1 + (size_t)l * 1024 * 64, 64, k0s, c0, 64, mu + 4 * 1024, half ? 1 : 2, Wd, 2048, c0, k0d, scr, lane);
            else if (c0 < 128) conv_tile(I.a_a1 + (size_t)l * 1024 * 64, 64, k0s, c0 - 64, 64, mu + 5 * 1024, half ? 1 : 2, Wd, 2048, c0, k0d, scr, lane);
            else if (c0 < 160 && l == 1) conv_tile(I.a_v1, 32, k0s, 0, 64, mu + 2 * 1024, half ? 1 : 2, Wd, 2048, c0, k0d, scr, lane);
            else conv_tile(I.a_w1, 64, 0, 0, 0, mu, 0, Wd, 2048, c0, k0d, scr, lane);
            continue; }
        r -= I_F;
        if (r < I_U) { const int nb = r >> 2, kb = r & 3; const int n0d = nb * 32, k0d = kb * 64, t = n0d >> 10;
            if (kb == t) { if (t == 0) conv_tile(I.a_w2 + (size_t)l * 64 * 1024, 1024, 0, n0d, 64, I.a_mu, 0, Wu, 256, n0d, k0d, scr, lane);
                else if (t == 1) conv_tile(I.a_a2 + (size_t)l * 64 * 1024, 1024, 0, n0d - 1024, 64, I.a_mu, 0, Wu, 256, n0d, k0d, scr, lane);
                else conv_tile(I.a_v2, 1024, 0, n0d - 2048, 32, I.a_mu, 0, Wu, 256, n0d, k0d, scr, lane); }
            else conv_tile(I.a_w2, 1024, 0, 0, 0, I.a_mu, 0, Wu, 256, n0d, k0d, scr, lane);
            continue; }
        r -= I_U;
        { const int nb = r >> 4, kb = r & 15; conv_tile(I.a_w_out + (size_t)l * 1024 * 1024, 1024, kb * 64, nb * 32, 64, I.a_mu, 0, Wo, 1024, nb * 32, kb * 64, scr, lane); }
    }
}
__device__ __forceinline__ void conv_attn(const In& I, int j, unsigned char* wreg, LAS float* scr, int gw, int NGW, int lane) {
    bf16* Wp = (bf16*)(wreg + W_PROJ); bf16* Wo = (bf16*)(wreg + W_BOUT);
    const int NPB = (j == 0 ? 4096 : 2048) / 32;
    const int I_P = NPB * 16, I_O = 32 * 16;
    for (int it = gw; it < I_P + I_O; it += NGW) {
        int r = it;
        if (r < I_P) { const int nb = r >> 4, kb = r & 15; const int n0d = nb * 32, k0 = kb * 64;
            if (j == 0) { if (n0d < 2048) conv_tile(I.w_kv, 2048, k0, n0d, 64, I.kv_norm, 1, Wp, 1024, n0d, k0, scr, lane);
                else conv_tile(I.b_w_in, 2048, k0, n0d - 2048, 64, I.b_norm, 1, Wp, 1024, n0d, k0, scr, lane); }
            else conv_tile(I.b_w_in + (size_t)1024 * 2048, 2048, k0, n0d, 64, I.b_norm + 1024, 1, Wp, 1024, n0d, k0, scr, lane);
            continue; }
        r -= I_P;
        { const int nb = r >> 4, kb = r & 15; conv_tile(I.b_w_out + (size_t)j * 1024 * 1024, 1024, kb * 64, nb * 32, 64, I.kv_norm, 0, Wo, 1024, nb * 32, kb * 64, scr, lane); }
    }
}

__device__ __forceinline__ void rope_tables(const int* pos, float* rc, float* rs, int gtid, int nthr) {
    for (int idx = gtid; idx < M * 8; idx += nthr) { const int m = idx >> 3, i = idx & 7;
        const float inv = (i == 0) ? 1.0f : (i == 1) ? 0.1939227432012558f : (i == 2) ? 0.03760603070259094f : (i == 3) ? 0.007292664609849453f : (i == 4) ? 0.0014142135623842478f : (i == 5) ? 0.00027424818836152554f : (i == 6) ? 5.3182957344688475e-05f : 1.0313385246263351e-05f;
        const float ang = (float)pos[m] * inv;
        const double x = (double)ang; const double k = __builtin_rint(x * 0.15915494309189535); const double r = x - k * 6.283185307179586476925;
        const double r2 = r * r; double sn = 0.0, cs = 0.0;
#pragma unroll
        for (int t = 12; t >= 1; --t) { sn = (1.0 - sn) * r2 / (double)((2 * t) * (2 * t + 1)); cs = (1.0 - cs) * r2 / (double)((2 * t - 1) * (2 * t)); }
        rs[idx] = (float)(r * (1.0 - sn)); rc[idx] = (float)(1.0 - cs); }
}

__device__ __forceinline__ void pre_rwkv(const float* x, const float* g, const float* mu, bf16* XM, size_t xm_stride, bf16* XN2, int gw, int NGW, int lane) {
    f32x4 gv[4], mv[4][4];
#pragma unroll
    for (int j = 0; j < 4; ++j) { gv[j] = *((const f32x4*)g + lane + 64 * j);
#pragma unroll
        for (int p = 0; p < 4; ++p) mv[p][j] = *((const f32x4*)(mu + p * 1024) + lane + 64 * j); }
    for (int c = gw; c < M / 16; c += NGW) { const int m0 = c * 16;
        f32x4 prev[4];
#pragma unroll
        for (int j = 0; j < 4; ++j) prev[j] = (f32x4){0.f, 0.f, 0.f, 0.f};
        if ((m0 % SEQ) != 0) { const f32x4* xr = (const f32x4*)(x + (size_t)(m0 - 1) * D) + lane; f32x4 v[4]; float s = 0.f;
#pragma unroll
            for (int j = 0; j < 4; ++j) { v[j] = xr[64 * j]; s += (v[j].x * v[j].x + v[j].y * v[j].y) + (v[j].z * v[j].z + v[j].w * v[j].w); }
            const float rstd = 1.0f / sqrtf(wave_sum(s) * (1.0f / D) + 1e-6f);
#pragma unroll
            for (int j = 0; j < 4; ++j) prev[j] = v[j] * rstd * gv[j]; }
        for (int r = 0; r < 16; ++r) { const int m = m0 + r; const f32x4* xr = (const f32x4*)(x + (size_t)m * D) + lane; f32x4 v[4]; float s = 0.f;
#pragma unroll
            for (int j = 0; j < 4; ++j) { v[j] = xr[64 * j]; s += (v[j].x * v[j].x + v[j].y * v[j].y) + (v[j].z * v[j].z + v[j].w * v[j].w); }
            const float rstd = 1.0f / sqrtf(wave_sum(s) * (1.0f / D) + 1e-6f);
            unsigned long long* o8 = (unsigned long long*)(XN2 + (size_t)m * 2048) + lane;
#pragma unroll
            for (int j = 0; j < 4; ++j) { const f32x4 xn = v[j] * rstd * gv[j]; const f32x4 xx = prev[j] - xn;
                o8[64 * j] = (unsigned long long)pk2(xn.x, xn.y) | ((unsigned long long)pk2(xn.z, xn.w) << 32);
                o8[256 + 64 * j] = (unsigned long long)pk2(prev[j].x, prev[j].y) | ((unsigned long long)pk2(prev[j].z, prev[j].w) << 32);
#pragma unroll
                for (int p = 0; p < 4; ++p) { const f32x4 xm = xn + xx * mv[p][j];
                    ((unsigned long long*)(XM + (size_t)p * xm_stride + (size_t)m * D) + lane)[64 * j] = (unsigned long long)pk2(xm.x, xm.y) | ((unsigned long long)pk2(xm.z, xm.w) << 32); }
                prev[j] = xn; } }
    }
}
__device__ __forceinline__ void pre_attn(const float* x, bf16* XH, int gw, int NGW, int lane) {
    for (int m = gw; m < M; m += NGW) { const f32x4* xr = (const f32x4*)(x + (size_t)m * D) + lane; f32x4 v[4]; float s = 0.f;
#pragma unroll
        for (int j = 0; j < 4; ++j) { v[j] = xr[64 * j]; s += (v[j].x * v[j].x + v[j].y * v[j].y) + (v[j].z * v[j].z + v[j].w * v[j].w); }
        const float rstd = 1.0f / sqrtf(wave_sum(s) * (1.0f / D) + 1e-6f);
        unsigned long long* o8 = (unsigned long long*)(XH + (size_t)m * D) + lane;
#pragma unroll
        for (int j = 0; j < 4; ++j) o8[64 * j] = (unsigned long long)pk2(v[j].x * rstd, v[j].y * rstd) | ((unsigned long long)pk2(v[j].z * rstd, v[j].w * rstd) << 32); }
}
__device__ __forceinline__ void final_norm_rows(const float* x, const float* g, float* out, int gw, int NGW, int lane) {
    f32x4 gv[4];
#pragma unroll
    for (int j = 0; j < 4; ++j) gv[j] = *((const f32x4*)g + lane + 64 * j);
    for (int m = gw; m < M; m += NGW) { const f32x4* xr = (const f32x4*)(x + (size_t)m * D) + lane; f32x4 v[4]; float s = 0.f;
#pragma unroll
        for (int j = 0; j < 4; ++j) { v[j] = xr[64 * j]; s += (v[j].x * v[j].x + v[j].y * v[j].y) + (v[j].z * v[j].z + v[j].w * v[j].w); }
        const float rstd = 1.0f / sqrtf(wave_sum(s) * (1.0f / D) + 1e-6f);
        f32x4* o = (f32x4*)(out + (size_t)m * D) + lane;
#pragma unroll
        for (int j = 0; j < 4; ++j) o[64 * j] = v[j] * rstd * gv[j]; }
}

__device__ __forceinline__ void ld16bf(const bf16* p, float (&f)[16]) { const v4u a = *(const v4u*)p, b = *(const v4u*)(p + 8);
    f[0] = bflo(a.x); f[1] = bfhi(a.x); f[2] = bflo(a.y); f[3] = bfhi(a.y); f[4] = bflo(a.z); f[5] = bfhi(a.z); f[6] = bflo(a.w); f[7] = bfhi(a.w);
    f[8] = bflo(b.x); f[9] = bfhi(b.x); f[10] = bflo(b.y); f[11] = bfhi(b.y); f[12] = bflo(b.z); f[13] = bfhi(b.z); f[14] = bflo(b.w); f[15] = bfhi(b.w); }
__device__ __forceinline__ void st16bf(bf16* p, const float (&f)[16]) { v4u a, b;
    a.x = pk2(f[0], f[1]); a.y = pk2(f[2], f[3]); a.z = pk2(f[4], f[5]); a.w = pk2(f[6], f[7]); b.x = pk2(f[8], f[9]); b.y = pk2(f[10], f[11]); b.z = pk2(f[12], f[13]); b.w = pk2(f[14], f[15]);
    *(v4u*)p = a; *(v4u*)(p + 8) = b; }

__device__ __forceinline__ void post_rwkv(const bf16* Y, const float* S, const bf16* V, const bf16* G, const float* ln_w, const float* ln_b, bf16* O, int gw, int NGW, int lane) {
    float lw[16], lb[16];
#pragma unroll
    for (int i = 0; i < 16; ++i) { lw[i] = ln_w[lane * 16 + i]; lb[i] = ln_b[lane * 16 + i]; }
    for (int m = gw; m < M; m += NGW) { const size_t off = (size_t)m * D + lane * 16;
        float y[16], v[16], g[16], o[16]; ld16bf(Y + off, y); ld16bf(V + off, v); ld16bf(G + off, g);
        const float sb = S[(size_t)m * 16 + (lane >> 2)];
        float sum = 0.f;
#pragma unroll
        for (int i = 0; i < 16; ++i) sum += y[i];
        sum += __shfl_xor(sum, 1); sum += __shfl_xor(sum, 2);
        const float mean = sum * (1.0f / 64.0f); float q = 0.f;
#pragma unroll
        for (int i = 0; i < 16; ++i) { const float d = y[i] - mean; q += d * d; }
        q += __shfl_xor(q, 1); q += __shfl_xor(q, 2);
        const float rstd = 1.0f / sqrtf(q * (1.0f / 64.0f) + 64e-5f);
#pragma unroll
        for (int i = 0; i < 16; ++i) { const float yn = (y[i] - mean) * rstd * lw[i] + lb[i]; o[i] = (yn + sb * v[i]) * (g[i] / (1.0f + __expf(-g[i]))); }
        st16bf(O + off, o); }
}
__device__ __forceinline__ void post_attn(const bf16* O0, const bf16* O1, const bf16* GT, const float* subln, float lam, float lam_init, bf16* O, int gw, int NGW, int lane) {
    float sw[16];
#pragma unroll
    for (int i = 0; i < 16; ++i) sw[i] = subln[(lane & 7) * 16 + i] * (1.0f - lam_init);
    for (int m = gw; m < M; m += NGW) { const size_t off = (size_t)m * D + lane * 16;
        float a[16], b[16], g[16], o[16]; ld16bf(O0 + off, a); ld16bf(O1 + off, b); ld16bf(GT + off, g);
        float q = 0.f;
#pragma unroll
        for (int i = 0; i < 16; ++i) { o[i] = a[i] - lam * b[i]; q += o[i] * o[i]; }
        q += __shfl_xor(q, 1); q += __shfl_xor(q, 2); q += __shfl_xor(q, 4);
        const float rstd = 1.0f / sqrtf(q * (1.0f / 128.0f) + 1e-5f);
#pragma unroll
        for (int i = 0; i < 16; ++i) o[i] = o[i] * rstd * sw[i] * (g[i] / (1.0f + __expf(-g[i])));
        st16bf(O + off, o); }
}

constexpr int SC_T = 32, SC_NB = SEQ / SC_T, SC_OPS = SC_T * 320, SC_TP = SC_T + 4, SC_VB = SC_TP * 8, SC_YP = SC_TP * 128;
struct ScRaw { u32x2 r, k, w, a; };
__device__ __forceinline__ void scan_phase(LAS unsigned char* lds, const bf16* R, const bf16* K, const bf16* V, const _Float16* W, const _Float16* A, const float* k_k, const float* k_a, const float* r_k,
                                           bf16* Y, float* S, int vcu, int G, int tid, int wave, int lane) {
    LAS float* OPS = (LAS float*)lds;
    LAS float* VB = (LAS float*)(lds + 2 * SC_OPS * 4);
    LAS float* YP = (LAS float*)(lds + 2 * SC_OPS * 4 + 2 * SC_VB * 4);
    for (int u = vcu; u < 256; u += G) {
        const int bh = u >> 3, rg = u & 7, b = bh >> 4, h = bh & 15;
        const size_t rowbase = (size_t)b * SEQ; const int cb = h * 64;
        const int pw = (wave == 2) ? 0 : (wave == 3) ? 1 : (wave == 6) ? 2 : 3;
        const int p = pw * 64 + lane, ptt = p >> 4, c4 = (p & 15) * 4;
        f32x4 kkw = {0.f, 0.f, 0.f, 0.f}, kaw = kkw, rkw = kkw;
        ScRaw rawA0, rawA1, rawB0, rawB1; rawA0.r = (u32x2){0u, 0u}; rawA0.k = rawA0.r; rawA0.w = rawA0.r; rawA0.a = rawA0.r; rawA1 = rawA0; rawB0 = rawA0; rawB1 = rawA0;
        v4u rawvA = {0u, 0u, 0u, 0u}, rawvB = rawvA;
        const bool prod = (wave == 2 || wave == 3 || wave == 6 || wave == 7), vld = (wave == 2 && lane < 32), ywr = (wave == 7), cons = (wave < 2);
        if (prod) { kkw = *(const f32x4*)(k_k + cb + c4); kaw = *(const f32x4*)(k_a + cb + c4); rkw = *(const f32x4*)(r_k + cb + c4); }
        const int jq = lane & 15, rl = wave * 4 + (lane >> 4);
        f32x2 S01 = {0.f, 0.f}, S23 = {0.f, 0.f};
#define SC_LOAD1(raw, nblk, tt_) do { const size_t o_ = (rowbase + (size_t)(nblk) * SC_T + (tt_)) * D + cb + c4; raw.r = *(const u32x2*)(R + o_); raw.k = *(const u32x2*)(K + o_); raw.w = *(const u32x2*)(W + o_); raw.a = *(const u32x2*)(A + o_); } while (0)
#define SC_LOAD(raw0, raw1, rawv, nblk) do { if (prod) { SC_LOAD1(raw0, nblk, ptt); SC_LOAD1(raw1, nblk, ptt + 16); } \
        if (vld) { rawv = *(const v4u*)(V + (rowbase + (size_t)(nblk) * SC_T + lane) * D + cb + rg * 8); } } while (0)
#define SC_DERIVE1(raw, nblk, buf, tt_) do { \
            const float r0 = bflo(raw.r.x), r1 = bfhi(raw.r.x), r2 = bflo(raw.r.y), r3 = bfhi(raw.r.y); \
            const float k0 = bflo(raw.k.x), k1 = bfhi(raw.k.x), k2 = bflo(raw.k.y), k3 = bfhi(raw.k.y); \
            const h16x4 wh = __builtin_bit_cast(h16x4, raw.w), ah = __builtin_bit_cast(h16x4, raw.a); \
            const float a0 = (float)ah[0], a1 = (float)ah[1], a2 = (float)ah[2], a3 = (float)ah[3]; \
            const float x0 = k0 * kkw.x, x1 = k1 * kkw.y, x2 = k2 * kkw.z, x3 = k3 * kkw.w; \
            const float ss = allreduce16((x0 * x0 + x1 * x1) + (x2 * x2 + x3 * x3)); \
            const float inv = 1.0f / fmaxf(sqrtf(ss), 1e-12f); \
            const f32x4 kn = {x0 * inv, x1 * inv, x2 * inv, x3 * inv}; \
            const f32x4 km = {k0 * (1.0f + (a0 - 1.0f) * kaw.x), k1 * (1.0f + (a1 - 1.0f) * kaw.y), k2 * (1.0f + (a2 - 1.0f) * kaw.z), k3 * (1.0f + (a3 - 1.0f) * kaw.w)}; \
            const float sp = allreduce16((r0 * km.x * rkw.x + r1 * km.y * rkw.y) + (r2 * km.z * rkw.z + r3 * km.w * rkw.w)); \
            LAS float* op_ = OPS + (buf) * SC_OPS + (tt_) * 320 + c4; \
            *(LAS f32x4*)(op_) = -kn; \
            *(LAS f32x4*)(op_ + 64) = (f32x4){kn.x * a0, kn.y * a1, kn.z * a2, kn.w * a3}; \
            *(LAS f32x4*)(op_ + 128) = (f32x4){__expf(-__expf((float)wh[0])), __expf(-__expf((float)wh[1])), __expf(-__expf((float)wh[2])), __expf(-__expf((float)wh[3]))}; \
            *(LAS f32x4*)(op_ + 192) = km; \
            *(LAS f32x4*)(op_ + 256) = (f32x4){r0, r1, r2, r3}; \
            if (rg == 0 && c4 == 0) S[(rowbase + (size_t)(nblk) * SC_T + (tt_)) * 16 + h] = sp; } while (0)
#define SC_DERIVE(raw0, raw1, rawv, nblk, buf) do { if (prod) { SC_DERIVE1(raw0, nblk, buf, ptt); SC_DERIVE1(raw1, nblk, buf, ptt + 16); } \
        if (vld) { LAS float* vb_ = VB + (buf) * SC_VB + lane; \
            vb_[0] = bflo(rawv.x); vb_[SC_TP] = bfhi(rawv.x); vb_[2 * SC_TP] = bflo(rawv.y); vb_[3 * SC_TP] = bfhi(rawv.y); vb_[4 * SC_TP] = bflo(rawv.z); vb_[5 * SC_TP] = bfhi(rawv.z); vb_[6 * SC_TP] = bflo(rawv.w); vb_[7 * SC_TP] = bfhi(rawv.w); } } while (0)
#define SC_YOUT1(nblk, buf, tt_) do { const int rp_ = lane & 3; const LAS float* yp_ = YP + (buf) * SC_YP + (2 * rp_) * 16 * SC_TP + (tt_); \
            float y0_ = 0.f, y1_ = 0.f; \
            _Pragma("unroll") for (int j_ = 0; j_ < 16; ++j_) { y0_ += yp_[j_ * SC_TP]; y1_ += yp_[(16 + j_) * SC_TP]; } \
            *(unsigned*)(Y + (rowbase + (size_t)(nblk) * SC_T + (tt_)) * D + cb + rg * 8 + 2 * rp_) = pk2(y0_, y1_); } while (0)
#define SC_YOUT(nblk, buf) do { SC_YOUT1(nblk, buf, lane >> 2); SC_YOUT1(nblk, buf, (lane >> 2) + 16); } while (0)
#define SC_BAR() asm volatile("s_waitcnt lgkmcnt(0)\n\ts_barrier" ::: "memory")
#define SC_LDOPS(N, B, W_, K_, R_, t) do { const LAS float* o_ = ops + (t) * 320; N = *(const LAS f32x4*)(o_); B = *(const LAS f32x4*)(o_ + 64); W_ = *(const LAS f32x4*)(o_ + 128); K_ = *(const LAS f32x4*)(o_ + 192); R_ = *(const LAS f32x4*)(o_ + 256); } while (0)
#define SC_CONSUME(buf) do { const LAS float* ops = OPS + (buf) * SC_OPS + 4 * jq; const LAS float* vb = VB + (buf) * SC_VB + rl * SC_TP; LAS float* yp = YP + (buf) * SC_YP + (rl * 16 + jq) * SC_TP; \
            f32x4 nk, bb, dw, km, rr, nk2, bb2, dw2, km2, rr2; SC_LDOPS(nk, bb, dw, km, rr, 0); SC_LDOPS(nk2, bb2, dw2, km2, rr2, 1); \
            f32x4 v4 = *(const LAS f32x4*)(vb), v4n = *(const LAS f32x4*)(vb + 4), yacc = {0.f, 0.f, 0.f, 0.f}; \
            _Pragma("unroll") for (int tt = 0; tt < SC_T; ++tt) { \
                f32x4 nk3 = nk2, bb3 = bb2, dw3 = dw2, km3 = km2, rr3 = rr2; \
                if (tt + 2 < SC_T) SC_LDOPS(nk3, bb3, dw3, km3, rr3, tt + 2); \
                asm volatile("" ::: "memory"); \
                const float vi = v4[tt & 3]; \
                const f32x2 t_ = S01 * nk.lo + S23 * nk.hi; \
                const f32x2 P01 = S01 * dw.lo + km.lo * vi, P23 = S23 * dw.hi + km.hi * vi; \
                const float sa = allreduce16(t_.x + t_.y); \
                S01 = P01 + bb.lo * sa; S23 = P23 + bb.hi * sa; \
                const f32x2 y_ = S01 * rr.lo + S23 * rr.hi; \
                yacc[tt & 3] = y_.x + y_.y; \
                if ((tt & 3) == 3) { *(LAS f32x4*)(yp + (tt - 3)) = yacc; v4 = v4n; if (tt + 5 < SC_T) v4n = *(const LAS f32x4*)(vb + tt + 5); } \
                nk = nk2; bb = bb2; dw = dw2; km = km2; rr = rr2; nk2 = nk3; bb2 = bb3; dw2 = dw3; km2 = km3; rr2 = rr3; } } while (0)
        SC_LOAD(rawA0, rawA1, rawvA, 0); SC_DERIVE(rawA0, rawA1, rawvA, 0, 0); SC_LOAD(rawB0, rawB1, rawvB, 1); SC_LOAD(rawA0, rawA1, rawvA, 2);
        __syncthreads();
        for (int n = 0; n < SC_NB; n += 2) {
            if (cons) { SC_CONSUME(0); }
            else { SC_DERIVE(rawB0, rawB1, rawvB, n + 1, 1); if (n + 3 < SC_NB) SC_LOAD(rawB0, rawB1, rawvB, n + 3);
                if (ywr && n >= 1) SC_YOUT(n - 1, 1); }
            SC_BAR();
            if (cons) { SC_CONSUME(1); }
            else { if (n + 2 < SC_NB) { SC_DERIVE(rawA0, rawA1, rawvA, n + 2, 0); if (n + 4 < SC_NB) SC_LOAD(rawA0, rawA1, rawvA, n + 4); }
                if (ywr) SC_YOUT(n, 0); }
            SC_BAR();
        }
        if (ywr) SC_YOUT(SC_NB - 1, 1);
        __syncthreads();
#undef SC_LOAD1
#undef SC_LOAD
#undef SC_DERIVE1
#undef SC_DERIVE
#undef SC_YOUT1
#undef SC_YOUT
#undef SC_CONSUME
#undef SC_LDOPS
#undef SC_BAR
    }
}

struct Args { const void* in[31]; float* out; unsigned char* ws; };
__global__ void __launch_bounds__(NWAVES * 64, 2) mk_fwd(Args args) {
    extern __shared__ __attribute__((aligned(16))) unsigned char lds[];
    cg::grid_group grid = cg::this_grid();
    LAS unsigned char* L = (LAS unsigned char*)lds;
    const int G = gridDim.x; const int bx = blockIdx.x; const int vcu = (G % 8 == 0) ? (bx % 8) * (G / 8) + bx / 8 : bx;
    const int NGW = G * NWAVES;
    { volatile LAS unsigned* st0 = (volatile LAS unsigned*)(L + 131072 + 1024); if (threadIdx.x < 2) st0[threadIdx.x] = 0u; __syncthreads(); }
    const XcdBarrier xbar = xcd_barrier_post((unsigned*)args.ws, (volatile LAS unsigned*)(L + 131072 + 1024));
#define PH_IDS() int tid_ = threadIdx.x; asm volatile("" : "+v"(tid_)); const int tid = tid_, lane = tid & 63, wave = __builtin_amdgcn_readfirstlane(tid >> 6); const int gw = vcu * NWAVES + wave; LAS float* scr = (LAS float*)(L + wave * 16384); (void)scr; (void)gw; (void)lane
    typedef const void* cvp_t; typedef const __attribute__((address_space(4))) cvp_t* kargp_t;
#define KP_(k) (((kargp_t)kp_)[k])
#define PH_PTRS() const __attribute__((address_space(4))) char* kp_ = (const __attribute__((address_space(4))) char*)__builtin_amdgcn_kernarg_segment_ptr(); asm volatile("" : "+s"(kp_)); \
    In I; I.x = (const float*)KP_(0); I.pos = (const int*)KP_(1); I.a_norm = (const float*)KP_(2); I.a_mu = (const float*)KP_(3); I.a_w_in = (const float*)KP_(4); I.a_w0 = (const float*)KP_(5); I.a_w1 = (const float*)KP_(6); I.a_w2 = (const float*)KP_(7); I.a_a0 = (const float*)KP_(8); I.a_a1 = (const float*)KP_(9); I.a_a2 = (const float*)KP_(10); I.a_v0 = (const float*)KP_(11); I.a_v1 = (const float*)KP_(12); I.a_v2 = (const float*)KP_(13); I.a_k_k = (const float*)KP_(14); I.a_k_a = (const float*)KP_(15); I.a_r_k = (const float*)KP_(16); I.a_ln_w = (const float*)KP_(17); I.a_ln_b = (const float*)KP_(18); I.a_w_out = (const float*)KP_(19); I.kv_norm = (const float*)KP_(20); I.w_kv = (const float*)KP_(21); I.b_norm = (const float*)KP_(22); I.b_w_in = (const float*)KP_(23); I.b_lq1 = (const float*)KP_(24); I.b_lk1 = (const float*)KP_(25); I.b_lq2 = (const float*)KP_(26); I.b_lk2 = (const float*)KP_(27); I.b_subln = (const float*)KP_(28); I.b_w_out = (const float*)KP_(29); I.final_norm = (const float*)KP_(30); \
    float* XS = (float*)KP_(31); unsigned char* ws = (unsigned char*)KP_(32); \
    float* rc = (float*)(ws + WS_ROPE_C); float* rs = (float*)(ws + WS_ROPE_S); float* SB = (float*)(ws + WS_S); unsigned char* wreg = ws + WS_W; \
    bf16* U0 = (bf16*)(ws + WS_U); bf16* U1 = (bf16*)(ws + WS_U + UNIT); bf16* U2 = (bf16*)(ws + WS_U + 2 * UNIT); bf16* U3 = (bf16*)(ws + WS_U + 3 * UNIT); \
    bf16* U4 = (bf16*)(ws + WS_U + 4 * UNIT); bf16* U5 = (bf16*)(ws + WS_U + 5 * UNIT); bf16* U6 = (bf16*)(ws + WS_U + 6 * UNIT); bf16* HB = (bf16*)(ws + WS_H); \
    (void)I; (void)XS; (void)rc; (void)rs; (void)SB; (void)wreg; (void)U0; (void)U1; (void)U2; (void)U3; (void)U4; (void)U5; (void)U6; (void)HB

    for (int rp = 0; rp < REP_PASS; ++rp) { PH_IDS(); PH_PTRS(); rope_tables(I.pos, rc, rs, vcu * 512 + tid, G * 512);
    conv_rwkv(I, 0, wreg, (float*)(ws + WS_BIAS), scr, gw, NGW, lane);
    pre_rwkv(I.x, I.a_norm, I.a_mu, U0, UNIT / 2, U4, gw, NGW, lane); }
    grid.sync();

    for (int rp = 0; rp < REP_SYNC; ++rp) xcd_barrier(xbar);
#pragma nounroll
    for (int l = 0; l < 2; ++l) {
#pragma nounroll
        for (int ph = 0; ph < 3; ++ph) {
            const int nq = (ph == 0) ? 1 : 2;
#pragma nounroll
            for (int q = 0; q < nq; ++q) {
                PH_PTRS();
                const int gi = (ph == 0) ? 4 : (ph - 1) * 2 + q;
                const bf16* Ag = (gi == 4) ? U4 : (const bf16*)(ws + WS_U + (size_t)gi * UNIT);
                const bf16* Bg = (gi == 4) ? (const bf16*)(wreg + W_DOWN) : (const bf16*)(wreg + W_RKVG) + (size_t)gi * 1024 * 1024;
                bf16* Dg = (gi == 0) ? U4 : (gi == 1) ? U5 : (gi == 2) ? ((l == 0) ? U6 : U0) : U1;
                const int Ng = (gi == 4) ? 256 : 1024, Kg = (gi == 4) ? 2048 : 1024;
                pg8::Gemm g{Ag, Bg, M, Ng, Kg}; pg8::StaticOrder S; S.init(M, Ng, G, bx);
                pg8::EpiFold E{Dg, HB, (gi == 4) ? 1 : 0};
                pg8::gemm_phase<pg8::EpiFold, pg8::StaticOrder, true, true>(L, g, S, E);
            }
            if (ph < 2) xcd_barrier(xbar);
        }
        xcd_barrier(xbar);
        {
            PH_PTRS(); bf16* Vl = (l == 0) ? U6 : U0;
            const int NUP = (l == 0) ? 2048 : 3072;
            pg8::Gemm g{HB, (const bf16*)(wreg + W_UP), M, NUP, 256}; pg8::StaticOrder S; S.init(M, NUP, G, bx);
            pg8::EpiLoraUp E{(const float*)(ws + WS_BIAS), (_Float16*)U2, (_Float16*)U3, Vl, U6};
            pg8::gemm_phase<pg8::EpiLoraUp, pg8::StaticOrder, true, false>(L, g, S, E);
        }
        xcd_barrier(xbar);
#pragma nounroll
        for (int rp = 0; rp < REP_SCAN; ++rp) { if (rp) xcd_barrier(xbar); PH_IDS(); PH_PTRS(); bf16* Vl = (l == 0) ? U6 : U0; bf16* Yl = (l == 0) ? U0 : U6; scan_phase(L, U4, U5, Vl, (const _Float16*)U2, (const _Float16*)U3, I.a_k_k + l * 1024, I.a_k_a + l * 1024, I.a_r_k + l * 1024, Yl, SB, vcu, G, tid, wave, lane); }
        xcd_barrier(xbar);
        for (int rp = 0; rp < REP_PASS; ++rp) { PH_IDS(); PH_PTRS(); bf16* Vl = (l == 0) ? U6 : U0; bf16* Yl = (l == 0) ? U0 : U6; post_rwkv(Yl, SB, Vl, U1, I.a_ln_w + l * 1024, I.a_ln_b + l * 1024, U4, gw, NGW, lane); }
        xcd_barrier(xbar);
        {
            PH_PTRS(); const float* xin = (l == 0) ? I.x : XS;
            pg8::Gemm g{U4, (const bf16*)(wreg + W_OUT), M, 1024, 1024}; pg8::StaticOrder S; S.init(M, 1024, G, bx);
            pg8::EpiResid E{xin, XS};
            pg8::gemm_phase<pg8::EpiResid, pg8::StaticOrder, true, true>(L, g, S, E);
        }
        xcd_barrier(xbar);
        for (int rp = 0; rp < REP_PASS; ++rp) { PH_IDS(); PH_PTRS(); if (l == 0) { conv_rwkv(I, 1, wreg, (float*)(ws + WS_BIAS), scr, gw, NGW, lane); pre_rwkv(XS, I.a_norm + 1024, I.a_mu + 6 * 1024, U0, UNIT / 2, U4, gw, NGW, lane); }
        else { conv_attn(I, 0, wreg, scr, gw, NGW, lane); pre_attn(XS, U0, gw, NGW, lane); } }
        xcd_barrier(xbar);
    }

#pragma nounroll
    for (int j = 0; j < 2; ++j) {
        {
            PH_PTRS();
            const int NP = (j == 0) ? 4096 : 2048;
            pg8::Gemm g{U0, (const bf16*)(wreg + W_PROJ), M, NP, 1024}; pg8::StaticOrder S; S.init(M, NP, G, bx);
            pg8::EpiProj E;
            if (j == 0) { E.d0 = U1; E.d1 = U2; E.d2 = U3; E.d3 = U4; E.ropemask = 0x5; E.scalemask = QSCALE_MASK0; }
            else { E.d0 = U3; E.d1 = U4; E.d2 = U3; E.d3 = U4; E.ropemask = 0x1; E.scalemask = QSCALE_MASK1; }
            E.sc = C2F; E.rc = rc; E.rs = rs;
            pg8::gemm_phase<pg8::EpiProj, pg8::StaticOrder, true, true>(L, g, S, E);
        }
        xcd_barrier(xbar);
#pragma nounroll
        for (int rp = 0; rp < REP_ATTN; ++rp) {
            if (rp) xcd_barrier(xbar);
            PH_PTRS();
#ifdef ATTN_D64
            const attn_body::AttnTensors AT{(const attn_body::bf16*)U3, (const attn_body::bf16*)U1, (const attn_body::bf16*)U2, (attn_body::bf16*)U5, (attn_body::bf16*)U6};
            attn_body::attn_phase<8>((char*)lds, AT, vcu, G);
#else
            const attn128::AttnTensors AT{U3, U1, U2, U5, U6};
            attn128::attn_phase((char*)lds, AT, vcu, G);
#endif
        }
        xcd_barrier(xbar);
        for (int rp = 0; rp < REP_PASS; ++rp) {
            PH_IDS(); PH_PTRS();
            const float e1 = __expf(wave_sum(I.b_lq1[j * 64 + lane] * I.b_lk1[j * 64 + lane])), e2 = __expf(wave_sum(I.b_lq2[j * 64 + lane] * I.b_lk2[j * 64 + lane]));
            const float lam_init = (j == 0) ? 0.4707130183435842f : 0.5560582041556406f;
            post_attn(U5, U6, U4, I.b_subln + j * 128, e1 - e2 + lam_init, lam_init, U0, gw, NGW, lane);
        }
        xcd_barrier(xbar);
        {
            PH_PTRS();
            pg8::Gemm g{U0, (const bf16*)(wreg + W_BOUT), M, 1024, 1024}; pg8::StaticOrder S; S.init(M, 1024, G, bx);
            pg8::EpiResid E{XS, XS};
            pg8::gemm_phase<pg8::EpiResid, pg8::StaticOrder, true, true>(L, g, S, E);
        }
        xcd_barrier(xbar);
        if (j == 0) { for (int rp = 0; rp < REP_PASS; ++rp) { PH_IDS(); PH_PTRS(); conv_attn(I, 1, wreg, scr, gw, NGW, lane); pre_attn(XS, U0, gw, NGW, lane); } xcd_barrier(xbar); }
    }
    { PH_IDS(); PH_PTRS(); final_norm_rows(XS, I.final_norm, XS, gw, NGW, lane); }
}

extern "C" void kernel_launch(void* const* d_in, const int* in_sizes, int n_in, void* d_out, int out_size, void* d_ws, size_t ws_size, hipStream_t stream) {
    static int grid = 0;
    if (grid == 0) {
        if (n_in != 31 || in_sizes[0] != M * D || out_size != M * D || ws_size < WS_END) { fprintf(stderr, "kernel_launch: unexpected shapes (n_in %d, in0 %d, out %d, ws %zu < %zu)\n", n_in, n_in > 0 ? in_sizes[0] : -1, out_size, ws_size, (size_t)WS_END); grid = -1; return; }
        int dev = 0, cus = 0, per_cu = 0;
        hipGetDevice(&dev); hipDeviceGetAttribute(&cus, hipDeviceAttributeMultiprocessorCount, dev);
        if (hipFuncSetAttribute((const void*)mk_fwd, hipFuncAttributeMaxDynamicSharedMemorySize, LDS_BYTES) != hipSuccess) { fprintf(stderr, "kernel_launch: hipFuncSetAttribute failed\n"); grid = -1; return; }
        if (hipOccupancyMaxActiveBlocksPerMultiprocessor(&per_cu, (const void*)mk_fwd, NWAVES * 64, LDS_BYTES) != hipSuccess || per_cu < 1) { fprintf(stderr, "kernel_launch: occupancy query says %d\n", per_cu); per_cu = 1; }
        (void)hipGetLastError();
        grid = cus;
    }
    if (grid < 0) return;
    if (hipMemsetAsync(d_ws, 0, 16384, stream) != hipSuccess) { fprintf(stderr, "kernel_launch: memset of the barrier words failed\n"); return; }
    Args a{};
    for (int i = 0; i < 31; ++i) a.in[i] = d_in[i];
    a.out = (float*)d_out; a.ws = (unsigned char*)d_ws;
    void* kargs[] = {&a};
    hipError_t e = hipLaunchCooperativeKernel((const void*)mk_fwd, dim3(grid), dim3(NWAVES * 64), kargs, LDS_BYTES, stream);
    if (e != hipSuccess) fprintf(stderr, "kernel_launch: cooperative launch failed: %s (grid %d)\n", hipGetErrorString(e), grid);
}
```

```cpp
#include <hip/hip_runtime.h>
#include <hip/hip_cooperative_groups.h>
#include <cstdio>
#include <cstdint>
namespace cg = cooperative_groups;
namespace pg8 {
#define PG8_LAS __attribute__((address_space(3)))
typedef unsigned short bf16_t;
typedef short bf16x8 __attribute__((ext_vector_type(8)));
typedef float f32x4 __attribute__((ext_vector_type(4)));
typedef unsigned u32x4 __attribute__((ext_vector_type(4)));
constexpr int BM = 256, BK = 64, HALF = 128, HTB = HALF * BK * 2  , STAGE_BYTES = 8 * HTB, NXCD = 8, WGM = 8;

__host__ __device__ __forceinline__ int lds_byte(int r, int c) { const int st = (r >> 4) * 2 + (c >> 5), rr = r & 15, cc = c & 31, ob = rr * 64 + cc * 2; return st * 1024 + (ob ^ (((ob >> 9) & 1) << 5)); }
__host__ __device__ __forceinline__ void stage_rc(int b, int& R, int& C) { const int st = b / 1024, sb = b % 1024, swz = sb ^ (((sb >> 9) & 1) << 5); R = (st >> 1) * 16 + swz / 64; C = (st & 1) * 32 + (swz % 64) / 2; }
__host__ __device__ __forceinline__ int perm32(int rho) { const int n = rho >> 4, i = rho & 15; return 8 * (i >> 2) + 4 * n + (i & 3); }

struct Unit { int pm, pn; };
struct Gemm { const bf16_t* A; const bf16_t* Bt; int M, N, K; };

struct StaticOrder {
    int nM, nN, nwg, G, c;
    __host__ __device__ void init(int M, int N, int G_, int c_) { nM = M / BM; nN = N / BM; nwg = nM * nN; G = G_; c = c_; }
    __host__ __device__ bool next(int i, Unit& u) const {
        const long L = (long)i * G + c; if (L >= nwg) return false;
        int wgid = (int)L; { const int q = nwg / NXCD, r = nwg % NXCD, xcd = wgid % NXCD, off = wgid / NXCD; wgid = (xcd < r ? xcd * (q + 1) : r * (q + 1) + (xcd - r) * q) + off; }
        const int nig = WGM * nN, gid = wgid / nig, fm = gid * WGM, gsz = (nM - fm) < WGM ? (nM - fm) : WGM;
        u.pm = fm + ((wgid % nig) % gsz); u.pn = (wgid % nig) / gsz; return true;
    }
    __device__ __forceinline__ void a_ready(const Unit&) const {}
    __device__ __forceinline__ void done(const Unit&) const {}
};

__device__ __forceinline__ unsigned cvt_pk_bf16(float lo, float hi) { unsigned r; asm volatile("v_cvt_pk_bf16_f32 %0, %1, %2" : "=v"(r) : "v"(lo), "v"(hi)); return r; }
typedef float f32x2 __attribute__((ext_vector_type(2)));
typedef _Float16 h16x4 __attribute__((ext_vector_type(4)));
typedef unsigned u32x2 __attribute__((ext_vector_type(2)));
__device__ __forceinline__ float sigmoidf_(float z) { return 1.0f / (1.0f + __expf(-z)); }
__device__ __forceinline__ float tanhf_(float x) { const float t = __expf(-2.0f * fabsf(x)); const float r = (1.0f - t) / (1.0f + t); return x < 0.f ? -r : r; }
__device__ __forceinline__ float bf_lo(unsigned w) { return __uint_as_float(w << 16); }
__device__ __forceinline__ float bf_hi(unsigned w) { return __uint_as_float(w & 0xffff0000u); }

struct EpiFold {
    static constexpr bool PERM = true, AFTER_DRAIN = false;
    bf16_t *R, *H; int hmode;
    __device__ __forceinline__ void operator()(const f32x4 (&acc)[2][2][4][2], const Unit& u, int wr, int wc, int fr, int fq) const {
        const int row0 = u.pm * BM + wr * 64 + fr;
        bf16_t* base = hmode ? H : R; const int ldc = hmode ? 256 : 1024;
        const int col0 = u.pn * 256 + wc * 32 + 8 * fq;
        const bool th = (hmode != 0) && (wc < 2);
#pragma unroll
        for (int ai = 0; ai < 2; ++ai)
#pragma unroll
            for (int m = 0; m < 4; ++m) { bf16_t* rowp = base + (size_t)(row0 + ai * HALF + m * 16) * ldc + col0;
#pragma unroll
                for (int bj = 0; bj < 2; ++bj) { f32x4 v0 = acc[ai][bj][m][0], v1 = acc[ai][bj][m][1];
                    if (th && bj == 0) {
#pragma unroll
                        for (int i = 0; i < 4; ++i) { v0[i] = tanhf_(v0[i]); v1[i] = tanhf_(v1[i]); } }
                    u32x4 w; w.x = cvt_pk_bf16(v0[0], v0[1]); w.y = cvt_pk_bf16(v0[2], v0[3]); w.z = cvt_pk_bf16(v1[0], v1[1]); w.w = cvt_pk_bf16(v1[2], v1[3]);
                    *(u32x4*)(rowp + bj * HALF) = w; }
                asm volatile("" ::: "memory"); }
    }
};

struct EpiLoraUp {
    static constexpr bool PERM = false, AFTER_DRAIN = false;
    const float* bias3; _Float16 *Wb, *Ab; bf16_t* Vb; const bf16_t* Vf;
    __device__ __forceinline__ void operator()(const f32x4 (&acc)[2][2][4][2], const Unit& u, int wr, int wc, int fr_unused, int fq_unused) const {
        int t_ = threadIdx.x; asm volatile("" : "+v"(t_)); const int fr = t_ & 15, fq = (t_ >> 4) & 3;
        const int row0 = u.pm * BM + wr * 64 + fr;
        const int t = u.pn >> 2;
        const int cc0 = (u.pn & 3) * 256 + wc * 32 + 4 * fq;
        const float* bias = bias3 + t * 1024;
#pragma unroll
        for (int bj = 0; bj < 2; ++bj)
#pragma unroll
            for (int n = 0; n < 2; ++n) { const int c = cc0 + bj * HALF + n * 16; const f32x4 bv = *(const f32x4*)(bias + c);
#pragma unroll
                for (int ai = 0; ai < 2; ++ai)
#pragma unroll
                    for (int m = 0; m < 4; ++m) { const size_t off = (size_t)(row0 + ai * HALF + m * 16) * 1024 + c; const f32x4 z = acc[ai][bj][m][n] + bv;
                        if (t == 0) { h16x4 o;
#pragma unroll
                            for (int i = 0; i < 4; ++i) { const float zz = -z[i]; const float sp = fmaxf(zz, 0.f) + __logf(1.0f + __expf(-fabsf(zz))); o[i] = (_Float16)(-sp - 0.5f); }
                            *(h16x4*)(Wb + off) = o; }
                        else if (t == 1) { h16x4 o;
#pragma unroll
                            for (int i = 0; i < 4; ++i) o[i] = (_Float16)sigmoidf_(z[i]);
                            *(h16x4*)(Ab + off) = o; }
                        else { const u32x2 vv = *(const u32x2*)(Vb + off), vf = *(const u32x2*)(Vf + off);
                            const float v_0 = bf_lo(vv.x), v_1 = bf_hi(vv.x), v_2 = bf_lo(vv.y), v_3 = bf_hi(vv.y);
                            const float f_0 = bf_lo(vf.x), f_1 = bf_hi(vf.x), f_2 = bf_lo(vf.y), f_3 = bf_hi(vf.y);
                            u32x2 o; o.x = cvt_pk_bf16(v_0 + (f_0 - v_0) * sigmoidf_(z[0]), v_1 + (f_1 - v_1) * sigmoidf_(z[1]));
                            o.y = cvt_pk_bf16(v_2 + (f_2 - v_2) * sigmoidf_(z[2]), v_3 + (f_3 - v_3) * sigmoidf_(z[3]));
                            *(u32x2*)(Vb + off) = o; }
                        asm volatile("" ::: "memory"); } }
    }
};

struct EpiProj {
    static constexpr bool PERM = true, AFTER_DRAIN = false;
    bf16_t *d0, *d1, *d2, *d3; int ropemask, scalemask; float sc; const float* rc; const float* rs;
    __device__ __forceinline__ void operator()(const f32x4 (&acc)[2][2][4][2], const Unit& u, int wr, int wc, int fr, int fq) const {
        const int row0 = u.pm * BM + wr * 64 + fr;
        const int t = u.pn >> 2;
        bf16_t* base = (t == 0) ? d0 : (t == 1) ? d1 : (t == 2) ? d2 : d3;
        const int col0 = (u.pn & 3) * 256 + wc * 32 + 8 * fq;
        const bool rope = (((ropemask >> t) & 1) != 0) && ((wc & 1) == 0);
        const float s = ((scalemask >> t) & 1) ? sc : 1.0f;
        const float sgn = (fq == 0) ? -1.0f : 1.0f;
#pragma unroll
        for (int ai = 0; ai < 2; ++ai)
#pragma unroll
            for (int m = 0; m < 4; ++m) { const int row = row0 + ai * HALF + m * 16; bf16_t* rowp = base + (size_t)row * 1024 + col0;
                f32x4 c0 = {1.f, 1.f, 1.f, 1.f}, c1 = c0, s0 = {0.f, 0.f, 0.f, 0.f}, s1 = s0;
                if (rope) { c0 = *(const f32x4*)(rc + (size_t)row * 8); c1 = *(const f32x4*)(rc + (size_t)row * 8 + 4); s0 = *(const f32x4*)(rs + (size_t)row * 8); s1 = *(const f32x4*)(rs + (size_t)row * 8 + 4); }
#pragma unroll
                for (int bj = 0; bj < 2; ++bj) { f32x4 v0 = acc[ai][bj][m][0], v1 = acc[ai][bj][m][1];
                    if (rope) { f32x4 p0, p1;
#pragma unroll
                        for (int i = 0; i < 4; ++i) { p0[i] = __shfl_xor(v0[i], 16); p1[i] = __shfl_xor(v1[i], 16); }
                        if (fq < 2) { v0 = v0 * c0 + (p0 * s0) * sgn; v1 = v1 * c1 + (p1 * s1) * sgn; } }
                    v0 = v0 * s; v1 = v1 * s;
                    u32x4 w; w.x = cvt_pk_bf16(v0[0], v0[1]); w.y = cvt_pk_bf16(v0[2], v0[3]); w.z = cvt_pk_bf16(v1[0], v1[1]); w.w = cvt_pk_bf16(v1[2], v1[3]);
                    *(u32x4*)(rowp + bj * HALF) = w; }
                asm volatile("" ::: "memory"); }
    }
};

struct EpiResid {
    static constexpr bool PERM = false, AFTER_DRAIN = false;
    const float* base; float* out;
    __device__ __forceinline__ void operator()(const f32x4 (&acc)[2][2][4][2], const Unit& u, int wr, int wc, int fr, int fq) const {
        const int row0 = u.pm * BM + wr * 64 + fr;
        const int col0 = u.pn * BM + wc * 32 + 4 * fq;
#pragma unroll
        for (int ai = 0; ai < 2; ++ai)
#pragma unroll
            for (int m = 0; m < 4; ++m) { const size_t off = (size_t)(row0 + ai * HALF + m * 16) * 1024 + col0;
#pragma unroll
                for (int bj = 0; bj < 2; ++bj)
#pragma unroll
                    for (int n = 0; n < 2; ++n) { const f32x4 b = *(const f32x4*)(base + off + bj * HALF + n * 16); *(f32x4*)(out + off + bj * HALF + n * 16) = b + acc[ai][bj][m][n]; }
                asm volatile("" ::: "memory"); }
    }
};
template <class Epi, class Sched, bool ALIGN_EPI = false, bool SP2 = false>
__device__ __forceinline__ void gemm_phase(PG8_LAS unsigned char* lds, const Gemm g, const Sched& S, const Epi& E) {
    int tid_ = threadIdx.x; asm volatile("" : "+v"(tid_));
    const int tid = tid_, wid = __builtin_amdgcn_readfirstlane(tid >> 6), lane = tid & 63, wr = wid >> 2, wc = wid & 3, fr = lane & 15, fq = lane >> 4;
    const int K = g.K, nt = K / BK;
    unsigned voffA[2], voffB[2];
#pragma unroll
    for (int i = 0; i < 2; ++i) { int R, C; stage_rc(tid * 16 + i * 8192, R, C); const int Rb = Epi::PERM ? ((R & ~31) + perm32(R & 31)) : R;
        voffA[i] = (unsigned)(R * K + C) * 2u; voffB[i] = (unsigned)(Rb * K + C) * 2u; }
    const size_t kstep = (size_t)(BK * 2);
    const size_t hstep = (size_t)HALF * K * 2;
    const size_t tstep = 2 * hstep;
    const unsigned ldsw = (unsigned)wid * 1024u;
    const int aoff = lds_byte(wr * 64 + fr, fq * 8), boff = lds_byte(wc * 32 + fr, fq * 8);
#define PG8_SA(b, h) (((b) * 2 + (h)) * HTB)
#define PG8_SB(b, h) ((4 + (b) * 2 + (h)) * HTB)
#define PG8_STAGE(bufoff, gbase, voff) do { _Pragma("unroll") for (int _i = 0; _i < 2; ++_i) \
        __builtin_amdgcn_global_load_lds((const unsigned*)((const char*)(gbase) + (voff)[_i]), (PG8_LAS unsigned*)(lds + (bufoff) + ldsw + _i * 8192), 16, 0, 0); } while (0)
#define PG8_LDA(dst, b, h) do { _Pragma("unroll") for (int m = 0; m < 4; ++m) _Pragma("unroll") for (int k = 0; k < 2; ++k) dst[m][k] = *(const PG8_LAS bf16x8*)(lds + PG8_SA(b, h) + aoff + m * 2048 + k * 1024); } while (0)
#define PG8_LDB(dst, b, h) do { _Pragma("unroll") for (int n = 0; n < 2; ++n) _Pragma("unroll") for (int k = 0; k < 2; ++k) dst[n][k] = *(const PG8_LAS bf16x8*)(lds + PG8_SB(b, h) + boff + n * 2048 + k * 1024); } while (0)
#define PG8_MMA(ai, bj, At, Bt) do { __builtin_amdgcn_s_setprio(1); _Pragma("unroll") for (int m = 0; m < 4; ++m) _Pragma("unroll") for (int n = 0; n < 2; ++n) _Pragma("unroll") for (int k = 0; k < 2; ++k) \
        acc[ai][bj][m][n] = __builtin_amdgcn_mfma_f32_16x16x32_bf16(Bt[n][k], At[m][k], acc[ai][bj][m][n], 0, 0, 0); __builtin_amdgcn_s_setprio(0); } while (0)
#define PG8_WAIT_V(n) asm volatile("s_waitcnt vmcnt(" #n ")" ::: "memory")
#define PG8_WAIT_L(n) asm volatile("s_waitcnt lgkmcnt(" #n ")" ::: "memory")
#define PG8_BAR __builtin_amdgcn_s_barrier()
#define PG8_SCHED __builtin_amdgcn_sched_barrier(0)
    Unit cur, nxt; int ui = 0;
    if (!S.next(0, cur)) return;
    f32x4 acc[2][2][4][2];
#pragma unroll
    for (int a = 0; a < 2; ++a)
#pragma unroll
        for (int b = 0; b < 2; ++b)
#pragma unroll
            for (int m = 0; m < 4; ++m)
#pragma unroll
                for (int n = 0; n < 2; ++n) acc[a][b][m][n] = (f32x4){0.f, 0.f, 0.f, 0.f};
    bf16x8 At[4][2], B0[2][2], B1[2][2];
    const char* cA = (const char*)g.A + (size_t)cur.pm * tstep; const char* cB = (const char*)g.Bt + (size_t)cur.pn * tstep;
    S.a_ready(cur);
    if constexpr (SP2) {
        PG8_STAGE(PG8_SB(0, 0), cB, voffB); PG8_STAGE(PG8_SB(0, 1), cB + hstep, voffB); PG8_STAGE(PG8_SA(0, 0), cA, voffA); PG8_STAGE(PG8_SA(0, 1), cA + hstep, voffA);
        if (wr == 1) PG8_BAR;
        PG8_WAIT_V(2); PG8_BAR;
        PG8_STAGE(PG8_SB(1, 0), cB + kstep, voffB); PG8_STAGE(PG8_SA(1, 0), cA + kstep, voffA); PG8_STAGE(PG8_SB(1, 1), cB + hstep + kstep, voffB);
        PG8_WAIT_V(6); PG8_BAR;
    } else {
        PG8_STAGE(PG8_SB(0, 0), cB, voffB); PG8_STAGE(PG8_SA(0, 0), cA, voffA); PG8_STAGE(PG8_SB(0, 1), cB + hstep, voffB); PG8_STAGE(PG8_SA(0, 1), cA + hstep, voffA);
        if (wr == 1) PG8_BAR;
        PG8_WAIT_V(4); PG8_BAR;
        PG8_STAGE(PG8_SB(1, 0), cB + kstep, voffB); PG8_STAGE(PG8_SA(1, 0), cA + kstep, voffA); PG8_STAGE(PG8_SB(1, 1), cB + hstep + kstep, voffB);
        PG8_WAIT_V(6); PG8_BAR;
    }
    for (;;) {
        const bool has_next = S.next(ui + 1, nxt);
        const char* nA = has_next ? (const char*)g.A + (size_t)nxt.pm * tstep : cA; const char* nB = has_next ? (const char*)g.Bt + (size_t)nxt.pn * tstep : cB;
        for (int t = 0; t < nt; t += 2) {
            const bool last = (t == nt - 2);
            const char* a1 = cA + (size_t)(t + 1) * kstep;
            const char* a2 = last ? nA : cA + (size_t)(t + 2) * kstep; const char* b2 = last ? nB : cB + (size_t)(t + 2) * kstep;
            const char* a3 = a2 + kstep; const char* b3 = b2 + kstep;
            if (last && has_next) S.a_ready(nxt);
            if constexpr (SP2) {
            PG8_LDB(B0, 0, 0); PG8_LDB(B1, 0, 1); PG8_SCHED; PG8_LDA(At, 0, 0); PG8_STAGE(PG8_SA(1, 1), a1 + hstep, voffA);
            PG8_WAIT_V(8); PG8_WAIT_L(0); PG8_BAR; PG8_MMA(0, 0, At, B0); PG8_MMA(0, 1, At, B1); PG8_BAR; PG8_SCHED;
            PG8_LDA(At, 0, 1); PG8_STAGE(PG8_SB(0, 0), b2, voffB); PG8_STAGE(PG8_SB(0, 1), b2 + hstep, voffB); PG8_STAGE(PG8_SA(0, 0), a2, voffA);
            PG8_WAIT_V(8); PG8_WAIT_L(0); PG8_BAR; PG8_MMA(1, 0, At, B0); PG8_MMA(1, 1, At, B1); PG8_BAR; PG8_SCHED;
            PG8_LDB(B0, 1, 0); PG8_LDB(B1, 1, 1); PG8_SCHED; PG8_LDA(At, 1, 0); PG8_STAGE(PG8_SA(0, 1), a2 + hstep, voffA);
            PG8_WAIT_V(8); PG8_WAIT_L(0); PG8_BAR; PG8_MMA(0, 0, At, B0); PG8_MMA(0, 1, At, B1); PG8_BAR; PG8_SCHED;
            PG8_LDA(At, 1, 1); PG8_STAGE(PG8_SB(1, 0), b3, voffB); PG8_STAGE(PG8_SB(1, 1), b3 + hstep, voffB); PG8_STAGE(PG8_SA(1, 0), a3, voffA);
            PG8_WAIT_V(8); PG8_WAIT_L(0); PG8_BAR; PG8_MMA(1, 0, At, B0); PG8_MMA(1, 1, At, B1); PG8_BAR; PG8_SCHED;
            } else {
            PG8_LDB(B0, 0, 0); PG8_SCHED; PG8_LDA(At, 0, 0); PG8_STAGE(PG8_SA(1, 1), a1 + hstep, voffA);
            PG8_WAIT_L(8); PG8_BAR; PG8_WAIT_L(0); PG8_MMA(0, 0, At, B0); PG8_BAR; PG8_SCHED;
            PG8_LDB(B1, 0, 1); PG8_STAGE(PG8_SB(0, 0), b2, voffB);
            PG8_BAR; PG8_WAIT_L(0); PG8_MMA(0, 1, At, B1); PG8_BAR;
            PG8_LDA(At, 0, 1); PG8_STAGE(PG8_SA(0, 0), a2, voffA);
            PG8_BAR; PG8_WAIT_L(0); PG8_MMA(1, 0, At, B0); PG8_BAR; PG8_SCHED;
            PG8_STAGE(PG8_SB(0, 1), b2 + hstep, voffB);
            PG8_WAIT_V(6); PG8_BAR; PG8_MMA(1, 1, At, B1); PG8_BAR;
            PG8_LDB(B0, 1, 0); PG8_SCHED; PG8_LDA(At, 1, 0); PG8_STAGE(PG8_SA(0, 1), a2 + hstep, voffA);
            PG8_WAIT_L(8); PG8_BAR; PG8_WAIT_L(0); PG8_MMA(0, 0, At, B0); PG8_BAR; PG8_SCHED;
            PG8_LDB(B1, 1, 1); PG8_STAGE(PG8_SB(1, 0), b3, voffB);
            PG8_BAR; PG8_WAIT_L(0); PG8_MMA(0, 1, At, B1); PG8_BAR;
            PG8_LDA(At, 1, 1); PG8_STAGE(PG8_SA(1, 0), a3, voffA);
            PG8_BAR; PG8_WAIT_L(0); PG8_MMA(1, 0, At, B0); PG8_BAR; PG8_SCHED;
            PG8_STAGE(PG8_SB(1, 1), b3 + hstep, voffB);
            PG8_WAIT_V(6); PG8_BAR; PG8_MMA(1, 1, At, B1); PG8_BAR;
            }
        }
        if constexpr (ALIGN_EPI) { if (wr == 0) PG8_BAR; }
        if constexpr (!Epi::AFTER_DRAIN) { E(acc, cur, wr, wc, fr, fq); S.done(cur); }
        if (!has_next) break;
#pragma unroll
        for (int a = 0; a < 2; ++a)
#pragma unroll
            for (int b = 0; b < 2; ++b)
#pragma unroll
                for (int m = 0; m < 4; ++m)
#pragma unroll
                    for (int n = 0; n < 2; ++n) acc[a][b][m][n] = (f32x4){0.f, 0.f, 0.f, 0.f};
        cur = nxt; cA = nA; cB = nB; ++ui;
        if constexpr (ALIGN_EPI) { if (wr == 1) PG8_BAR; }
    }
    PG8_WAIT_V(0);
    if constexpr (!ALIGN_EPI) { if (wr == 0) PG8_BAR; }
    PG8_BAR;
    if constexpr (Epi::AFTER_DRAIN) { E.fused(acc, cur, wr, wc, fr, fq, lds, wid, lane); S.done(cur); }
#undef PG8_SA
#undef PG8_SB
#undef PG8_STAGE
#undef PG8_LDA
#undef PG8_LDB
#undef PG8_MMA
#undef PG8_WAIT_V
#undef PG8_WAIT_L
#undef PG8_BAR
#undef PG8_SCHED
}
}

#include <hip/hip_bf16.h>
#include <cmath>
namespace attn_body {
using bf16=__hip_bfloat16;
using bf16x8=__attribute__((ext_vector_type(8)))short;
using s16x4=__attribute__((ext_vector_type(4)))short;
using f32x16=__attribute__((ext_vector_type(16)))float;
using u32x4=__attribute__((ext_vector_type(4)))unsigned;
constexpr int BATCH=2,NHEAD=16,SEQ=16384,D=64,DM=NHEAD*D;
constexpr int NW=8,QBLK=32,QB=QBLK*NW,KVBLK=64,NQB=SEQ/QB;
constexpr int ATTN_PITCH=DM, ATTN_UNIT_ROWS=QB;
__device__ __forceinline__ int crow(int r,int hi){return (r&3)+8*(r>>2)+4*hi;}
#define SBAR() __builtin_amdgcn_sched_barrier(0)
__device__ __forceinline__ void cmask(f32x16&p0,f32x16&p1,int jb,int qrel,int hi){
  const float NEG=-INFINITY; int kb=64*jb+4*hi;
  #pragma unroll
  for(int r=0;r<16;++r){int kv=kb+(r&3)+8*(r>>2); if(kv>qrel)p0[r]=NEG; if(kv+32>qrel)p1[r]=NEG;}
}

constexpr int NSLOT=3, SLOTB=8192;
constexpr int LDS_K=0, LDS_V=NSLOT*SLOTB, LDS_WS=2*NSLOT*SLOTB, LDS_OST=LDS_WS+NW*64*4, LDS_BYTES=LDS_OST+NW*4096;
constexpr float C2=0.125f*1.4426950408889634f;
__device__ __forceinline__ void glds16(const void*gsrc,unsigned lds_dst){unsigned keep;
  asm volatile("s_mov_b32 %0, m0\n\ts_mov_b32 m0, %2\n\ts_nop 0\n\tglobal_load_lds_dwordx4 %1, off\n\ts_mov_b32 m0, %0":"=&s"(keep):"v"(gsrc),"s"(lds_dst):"memory");}
__device__ __forceinline__ float max3f(float a,float b,float c){float r;asm("v_max3_f32 %0, %1, %2, %3":"=v"(r):"v"(a),"v"(b),"v"(c));return r;}
__device__ __forceinline__ float max2f(float a,float b){float r;asm("v_max_f32_e32 %0, %1, %2":"=v"(r):"v"(a),"v"(b));return r;}
__device__ __forceinline__ float fadd_s(float a,float b){float r;asm("v_add_f32_e32 %0, %1, %2":"=v"(r):"v"(a),"v"(b));return r;}
__device__ __forceinline__ float fsub_s(float a,float b){float r;asm("v_sub_f32_e32 %0, %1, %2":"=v"(r):"v"(a),"v"(b));return r;}
typedef float f32x2_t __attribute__((ext_vector_type(2))); typedef __bf16 bf16x2_t __attribute__((ext_vector_type(2)));
__device__ __forceinline__ unsigned cvtpk_s(float lo,float hi){f32x2_t v={lo,hi};bf16x2_t b=__builtin_convertvector(v,bf16x2_t);return __builtin_bit_cast(unsigned,b);}
#define WAIT_BAR(N) asm volatile("s_waitcnt vmcnt(" #N ") lgkmcnt(0)\n\ts_barrier":::"memory")

__device__ __forceinline__ void qkt(f32x16&p0,f32x16&p1,const char*Kslot,const bf16x8*qr,const f32x16&negm,int r32,int hi){
  const char*kb=Kslot+hi*1024+r32*16;
  #pragma unroll
  for(int d0=0;d0<4;++d0){
    const bf16x8 b0=*reinterpret_cast<const bf16x8*>(kb+d0*2048);
    const bf16x8 b1=*reinterpret_cast<const bf16x8*>(kb+d0*2048+512);
    if(d0==0){p0=__builtin_amdgcn_mfma_f32_32x32x16_bf16(b0,qr[0],negm,0,0,0);p1=__builtin_amdgcn_mfma_f32_32x32x16_bf16(b1,qr[0],negm,0,0,0);}
    else{p0=__builtin_amdgcn_mfma_f32_32x32x16_bf16(b0,qr[d0],p0,0,0,0);p1=__builtin_amdgcn_mfma_f32_32x32x16_bf16(b1,qr[d0],p1,0,0,0);}}
}
typedef __attribute__((address_space(3))) const char* lds_cptr;
typedef short v4i16_t __attribute__((ext_vector_type(4)));
__device__ __forceinline__ void kload8(bf16x8*kf,lds_cptr kp){
  kf[0]=*(const __attribute__((address_space(3))) bf16x8*)(kp);      kf[1]=*(const __attribute__((address_space(3))) bf16x8*)(kp+512);
  kf[2]=*(const __attribute__((address_space(3))) bf16x8*)(kp+2048); kf[3]=*(const __attribute__((address_space(3))) bf16x8*)(kp+2560);
  kf[4]=*(const __attribute__((address_space(3))) bf16x8*)(kp+4096); kf[5]=*(const __attribute__((address_space(3))) bf16x8*)(kp+4608);
  kf[6]=*(const __attribute__((address_space(3))) bf16x8*)(kp+6144); kf[7]=*(const __attribute__((address_space(3))) bf16x8*)(kp+6656);
}
__device__ __forceinline__ void kload2(bf16x8*kf,lds_cptr kp,int j){ kf[2*j]=*(const __attribute__((address_space(3))) bf16x8*)(kp+j*2048); kf[2*j+1]=*(const __attribute__((address_space(3))) bf16x8*)(kp+j*2048+512); }
__device__ __forceinline__ s16x4 vtr(lds_cptr p){ return __builtin_bit_cast(s16x4,__builtin_amdgcn_ds_read_tr16_b64_v4i16((__attribute__((address_space(3))) v4i16_t*)p)); }
__device__ __forceinline__ float rowmax(const f32x16&p0,const f32x16&p1){
  float a=max3f(p0[0],p0[1],p1[0]),b=max3f(p0[2],p0[3],p1[1]);a=max3f(a,p1[2],p1[3]);
  #pragma unroll
  for(int r=4;r<16;r+=4){a=max3f(a,p0[r],p0[r+1]);b=max3f(b,p0[r+2],p0[r+3]);a=max3f(a,p1[r],p1[r+1]);b=max3f(b,p1[r+2],p1[r+3]);}
  const float m=max2f(a,b);
  auto rr=__builtin_amdgcn_permlane32_swap(__float_as_uint(m),__float_as_uint(m),false,false);
  return max2f(__uint_as_float(rr[0]),__uint_as_float(rr[1]));
}
__device__ __forceinline__ void pv(f32x16*o,int vb,bf16x8 pa0,bf16x8 pa1,bf16x8 pa2,bf16x8 pa3){
  #pragma unroll
  for(int d0=0;d0<2;++d0){s16x4 lo[4],hi[4];
    #pragma unroll
    for(int ks=0;ks<4;++ks){
      asm volatile("ds_read_b64_tr_b16 %0,%1 offset:%c2":"=&v"(lo[ks]):"v"(vb),"i"(d0*4096+ks*1024):"memory");
      asm volatile("ds_read_b64_tr_b16 %0,%1 offset:%c2":"=&v"(hi[ks]):"v"(vb),"i"(d0*4096+ks*1024+512):"memory");}
    asm volatile("s_waitcnt lgkmcnt(0)":::"memory");SBAR();
    #define PK(k) (bf16x8){lo[k][0],lo[k][1],lo[k][2],lo[k][3],hi[k][0],hi[k][1],hi[k][2],hi[k][3]}
    o[d0]=__builtin_amdgcn_mfma_f32_32x32x16_bf16(pa0,PK(0),o[d0],0,0,0);
    o[d0]=__builtin_amdgcn_mfma_f32_32x32x16_bf16(pa1,PK(1),o[d0],0,0,0);
    o[d0]=__builtin_amdgcn_mfma_f32_32x32x16_bf16(pa2,PK(2),o[d0],0,0,0);
    o[d0]=__builtin_amdgcn_mfma_f32_32x32x16_bf16(pa3,PK(3),o[d0],0,0,0);
    #undef PK
  }
}

#ifndef ATTN_STORE16
#define ATTN_STORE16(p,v) (*(u32x4*)(p)=(v))
#endif
template<int THRL> __device__ __forceinline__ void attn_unit(int b,int cq,int cv,int qb,const bf16*Q,const bf16*__restrict__ K,const bf16*__restrict__ V,bf16*O,char*shm){
  int tid_=threadIdx.x; asm volatile("":"+v"(tid_)); const int tid=tid_,lane=tid&63,r32=lane&31,hi=lane>>5; const int wid=__builtin_amdgcn_readfirstlane(tid>>6);
  const long rowbase=(long)b*SEQ; const int q0=qb*QB;
  const bf16*Qw=Q+(rowbase+q0+wid*QBLK)*DM+cq;
  const bf16*Kh=K+rowbase*DM+cq,*Vh=V+rowbase*DM+cv;
  const unsigned lds0=(unsigned)(uintptr_t)shm;
  float*wsf=(float*)(shm+LDS_WS)+wid*64;
  const bf16*ksrc=Kh+(long)lane*DM+wid*8;
  const bf16*vsrc=Vh+(long)(16*(wid&3)+(lane>>2))*DM+(wid>>2)*32+(lane&3)*8;
  const unsigned kdst=lds0+LDS_K+wid*1024, vdst=lds0+LDS_V+wid*1024;
  #define DMA_K(t,slot) glds16(ksrc+(long)(t)*KVBLK*DM,(unsigned)__builtin_amdgcn_readfirstlane(kdst+(slot)))
  #define DMA_V(t,slot) glds16(vsrc+(long)(t)*KVBLK*DM,(unsigned)__builtin_amdgcn_readfirstlane(vdst+(slot)))
  const int vb0=(int)(lds0+LDS_V)+((lane>>4)&1)*32+(lane&3)*8+(4*hi+((lane&15)>>2))*64;
  const char*Kbase=shm+LDS_K; bf16x8 kf[8];
  const lds_cptr shm3=(lds_cptr)shm; const lds_cptr kp0=shm3+LDS_K+hi*1024+r32*16; const lds_cptr vp0=shm3+LDS_V+((lane>>4)&1)*32+(lane&3)*8+(4*hi+((lane&15)>>2))*64;
  const int NT=(q0+QB)/KVBLK;
  DMA_K(0,0);DMA_V(0,0);DMA_K(1,SLOTB);
  bf16x8 qr[4];
  #pragma unroll
  for(int d0=0;d0<4;++d0)qr[d0]=*reinterpret_cast<const bf16x8*>(&Qw[(long)r32*DM+d0*16+hi*8]);
  float mhat=0.f,l_reg=0.f;f32x16 o[2];o[0]=f32x16{};o[1]=f32x16{};f32x16 negm=f32x16{};asm volatile("":"+v"(negm));
  const int qrel=wid*QBLK+r32;
  #define CMASK(P0,P1,t) do{int jb_=(t)-(NT-4); if(jb_>=0)cmask(P0,P1,jb_,qrel,hi);}while(0)
  bool resc=false;
  #define START(P0,P1) do{ const float rm=rowmax(P0,P1); resc=false; \
    { const float dl=rm; mhat=fadd_s(mhat,dl); \
      _Pragma("unroll") for(int r=0;r<16;++r){P0[r]=fsub_s(P0[r],dl);P1[r]=fsub_s(P1[r],dl);} \
      _Pragma("unroll") for(int r=0;r<16;++r)negm[r]=-mhat; asm volatile("":"+v"(negm)); } \
    _Pragma("unroll") for(int r=0;r<16;++r)P0[r]=__builtin_amdgcn_exp2f(P0[r]); }while(0)
  #define RESC() do{ if(resc){ asm volatile("s_waitcnt lgkmcnt(0)":::"memory"); \
      _Pragma("unroll") for(int d_=0;d_<2;++d_) _Pragma("unroll") for(int r=0;r<16;++r)o[d_][r]*=wsf[crow(r,hi)]; } }while(0)
  f32x16 pA0,pA1,pB0,pB1;
  int sl_prev=0,sl_cur=0,sl_next=SLOTB;
  #define ROT() do{sl_prev=sl_cur;sl_cur=sl_next;sl_next=(sl_next==(NSLOT-1)*SLOTB)?0:sl_next+SLOTB;}while(0)
  DMA_K(2,2*SLOTB);
  WAIT_BAR(3);
  qkt(pA0,pA1,Kbase,qr,negm,r32,hi);asm volatile("s_nop 15\n\ts_nop 7":"+v"(pA0),"+v"(pA1));CMASK(pA0,pA1,0);
  START(pA0,pA1);
  _Pragma("unroll") for(int r=0;r<16;++r)pA1[r]=__builtin_amdgcn_exp2f(pA1[r]);
  WAIT_BAR(0);
  DMA_K(3,0);DMA_V(1,SLOTB);
  ROT();
  kload8(kf,kp0+sl_cur);
  WAIT_BAR(2);
  s16x4 vlo[8],vhi[8]; u32x4 pw0,pw1,pw2,pw3;
  #define PKW(P,B) cvtpk_s(P[B],P[B+1])
  #define PAF(k) __builtin_bit_cast(bf16x8,pw##k)
  #define VFR(i) (bf16x8){vlo[i][0],vlo[i][1],vlo[i][2],vlo[i][3],vhi[i][0],vhi[i][1],vhi[i][2],vhi[i][3]}
  #define PIN(x) asm volatile("":"+v"(x))
  #define MX3(a,b,c) __builtin_fmaxf(__builtin_fmaxf((a),(b)),(c))
  #define GAPA(MF,A0,A1,A2,A3,W0,W1,PW) do{ MF; sacc+=A0; sacc+=A1; sacc+=A2; sacc+=A3; PIN(sacc); W0; W1; PIN(PW); SBAR(); }while(0)
  #define EX(v) __builtin_amdgcn_exp2f(v)
  #define GAPB(MF,X,B) do{ MF; X[B]=EX(X[B]); X[B+1]=EX(X[B+1]); X[B+2]=EX(X[B+2]); X[B+3]=EX(X[B+3]); PIN(X); SBAR(); }while(0)
  #define VRD(i) do{ vlo[i]=vtr(vp_+(((i)>>2)*4096+((i)&3)*1024)); vhi[i]=vtr(vp_+(((i)>>2)*4096+((i)&3)*1024+512)); }while(0)
  #define KRD(G,j) do{ if(G){ kload2(kf,kp0+sl_next,j); SBAR(); } }while(0)
  #define STEP(C0,C1,P0,P1,t,GK,GV,GL) do{ SBAR(); \
    const lds_cptr vp_=vp0+sl_prev; \
    VRD(0); SBAR(); float sacc=(P0[0]+P0[1]); \
    GAPA(C0=__builtin_amdgcn_mfma_f32_32x32x16_bf16(kf[0],qr[0],negm,0,0,0), P0[2],P0[3],P0[4],P0[5],     pw0[0]=PKW(P0,0), pw0[1]=PKW(P0,2), pw0); \
    VRD(4); SBAR(); GAPA(C1=__builtin_amdgcn_mfma_f32_32x32x16_bf16(kf[1],qr[0],negm,0,0,0), P0[6],P0[7],P0[8],P0[9],     pw0[2]=PKW(P0,4), pw0[3]=PKW(P0,6), pw0); \
    VRD(1); SBAR(); GAPA(C0=__builtin_amdgcn_mfma_f32_32x32x16_bf16(kf[2],qr[1],C0,0,0,0),   P0[10],P0[11],P0[12],P0[13], pw1[0]=PKW(P0,8), pw1[1]=PKW(P0,10), pw1); \
    VRD(5); SBAR(); GAPA(C1=__builtin_amdgcn_mfma_f32_32x32x16_bf16(kf[3],qr[1],C1,0,0,0),   P0[14],P0[15],P1[0],P1[1],   pw1[2]=PKW(P0,12),pw1[3]=PKW(P0,14), pw1); \
    VRD(2); SBAR(); GAPA(C0=__builtin_amdgcn_mfma_f32_32x32x16_bf16(kf[4],qr[2],C0,0,0,0),   P1[2],P1[3],P1[4],P1[5],     pw2[0]=PKW(P1,0), pw2[1]=PKW(P1,2), pw2); \
    VRD(6); SBAR(); GAPA(C1=__builtin_amdgcn_mfma_f32_32x32x16_bf16(kf[5],qr[2],C1,0,0,0),   P1[6],P1[7],P1[8],P1[9],     pw2[2]=PKW(P1,4), pw2[3]=PKW(P1,6), pw2); \
    VRD(3); SBAR(); GAPA(C0=__builtin_amdgcn_mfma_f32_32x32x16_bf16(kf[6],qr[3],C0,0,0,0),   P1[10],P1[11],P1[12],P1[13], pw3[0]=PKW(P1,8), pw3[1]=PKW(P1,10), pw3); \
    VRD(7); SBAR(); GAPA(C1=__builtin_amdgcn_mfma_f32_32x32x16_bf16(kf[7],qr[3],C1,0,0,0),   P1[14],P1[15],0.f,0.f,       pw3[2]=PKW(P1,12),pw3[3]=PKW(P1,14), pw3); \
    l_reg+=sacc; \
    if(GK){DMA_K((t)+3,sl_cur);} if(GV){DMA_V((t)+1,sl_next);} \
    CMASK(C0,C1,t); \
    { float a=MX3(C0[0],C0[1],C1[0]),b=MX3(C0[2],C0[3],C1[1]); a=MX3(a,C1[2],C1[3]); \
      _Pragma("unroll") for(int r=4;r<16;r+=4){a=MX3(a,C0[r],C0[r+1]);b=MX3(b,C0[r+2],C0[r+3]);a=MX3(a,C1[r],C1[r+1]);b=MX3(b,C1[r+2],C1[r+3]);} \
      float rm=__builtin_fmaxf(a,b); { auto rr=__builtin_amdgcn_permlane32_swap(__float_as_uint(rm),__float_as_uint(rm),false,false); rm=__builtin_fmaxf(__uint_as_float(rr[0]),__uint_as_float(rr[1])); } \
      resc=false; \
      if(__builtin_expect(__any(rm>(float)THRL),0)){ const float dl=__builtin_fmaxf(rm,0.f); mhat+=dl; \
        _Pragma("unroll") for(int r=0;r<16;++r){C0[r]-=dl;C1[r]-=dl;} \
        _Pragma("unroll") for(int r=0;r<16;++r)negm[r]=-mhat; asm volatile("":"+v"(negm)); \
        const float f=__builtin_amdgcn_exp2f(-dl); l_reg*=f; if(hi==0)wsf[r32]=f; resc=true; } } \
    SBAR(); \
    GAPB(o[0]=__builtin_amdgcn_mfma_f32_32x32x16_bf16(PAF(0),VFR(0),o[0],0,0,0), C0,0); \
    GAPB(o[1]=__builtin_amdgcn_mfma_f32_32x32x16_bf16(PAF(0),VFR(4),o[1],0,0,0), C0,4); \
    KRD(GL,0); GAPB(o[0]=__builtin_amdgcn_mfma_f32_32x32x16_bf16(PAF(1),VFR(1),o[0],0,0,0), C0,8); \
    KRD(GL,1); GAPB(o[1]=__builtin_amdgcn_mfma_f32_32x32x16_bf16(PAF(1),VFR(5),o[1],0,0,0), C0,12); \
    KRD(GL,2); GAPB(o[0]=__builtin_amdgcn_mfma_f32_32x32x16_bf16(PAF(2),VFR(2),o[0],0,0,0), C1,0); \
    KRD(GL,3); GAPB(o[1]=__builtin_amdgcn_mfma_f32_32x32x16_bf16(PAF(2),VFR(6),o[1],0,0,0), C1,4); \
    GAPB(o[0]=__builtin_amdgcn_mfma_f32_32x32x16_bf16(PAF(3),VFR(3),o[0],0,0,0), C1,8); \
    GAPB(o[1]=__builtin_amdgcn_mfma_f32_32x32x16_bf16(PAF(3),VFR(7),o[1],0,0,0), C1,12); \
    }while(0)
  int t=1;
  #undef CMASK
  #define CMASK(P0,P1,t) do{}while(0)
  for(;t+5<NT;t+=2){
    STEP(pB0,pB1,pA0,pA1,t,true,true,true);     WAIT_BAR(2); RESC(); ROT();
    STEP(pA0,pA1,pB0,pB1,t+1,true,true,true);   WAIT_BAR(2); RESC(); ROT();
  }
  #undef CMASK
  #define CMASK(P0,P1,t) do{int jb_=(t)-(NT-4); if(jb_>=0)cmask(P0,P1,jb_,qrel,hi);}while(0)
  #define ENDW(tt) do{ if((tt)+3<NT){WAIT_BAR(2);} else if((tt)+2<NT){WAIT_BAR(1);} else {WAIT_BAR(0);} }while(0)
  for(;t+1<NT;t+=2){
    STEP(pB0,pB1,pA0,pA1,t,(t+3<NT),(t+1<NT),(t+1<NT));       ENDW(t);   RESC(); ROT();
    STEP(pA0,pA1,pB0,pB1,t+1,(t+4<NT),(t+2<NT),(t+2<NT));     ENDW(t+1); RESC(); ROT();
  }
  STEP(pB0,pB1,pA0,pA1,NT-1,false,false,false); RESC();
  { float sacc=pB0[0]+pB0[1]; _Pragma("unroll") for(int r=2;r<16;++r)sacc+=pB0[r]; _Pragma("unroll") for(int r=0;r<16;++r)sacc+=pB1[r]; l_reg+=sacc;
    pw0=(u32x4){PKW(pB0,0),PKW(pB0,2),PKW(pB0,4),PKW(pB0,6)};pw1=(u32x4){PKW(pB0,8),PKW(pB0,10),PKW(pB0,12),PKW(pB0,14)};pw2=(u32x4){PKW(pB1,0),PKW(pB1,2),PKW(pB1,4),PKW(pB1,6)};pw3=(u32x4){PKW(pB1,8),PKW(pB1,10),PKW(pB1,12),PKW(pB1,14)};
    SBAR(); pv(o,vb0+sl_cur,PAF(0),PAF(1),PAF(2),PAF(3)); }
  #undef PKW
  #undef PAF
  #undef VFR
  #undef PIN
  #undef MX3
  #undef GAPA
  #undef GAPB
  #undef EX
  #undef VRD
  #undef KRD
  #undef STEP
  #undef ENDW
  {auto rr=__builtin_amdgcn_permlane32_swap(__float_as_uint(l_reg),__float_as_uint(l_reg),false,false);l_reg=__uint_as_float(rr[0])+__uint_as_float(rr[1]);}
  if(hi==0)wsf[32+r32]=l_reg;asm volatile("s_waitcnt lgkmcnt(0)":::"memory");
  float rli[16];
  #pragma unroll
  for(int r=0;r<16;++r)rli[r]=__builtin_amdgcn_rcpf(wsf[32+crow(r,hi)]);
  bf16*Ow=O+(rowbase+q0+wid*QBLK)*DM+cv;
  { bf16*stg=(bf16*)(shm+LDS_OST)+wid*2048;
    #pragma unroll
    for(int r=0;r<16;++r){const int orow=crow(r,hi);
      #pragma unroll
      for(int d0=0;d0<2;++d0)stg[orow*64+d0*32+r32]=__float2bfloat16(o[d0][r]*rli[r]);}
    asm volatile("s_waitcnt lgkmcnt(0)":::"memory");
    #pragma unroll
    for(int i=0;i<4;++i){const int row=i*8+(lane>>3),ch=lane&7; const u32x4 v=*(const u32x4*)(stg+row*64+ch*8); ATTN_STORE16(Ow+(long)row*DM+ch*8,v);} }
  asm volatile("s_waitcnt lgkmcnt(0)\n\ts_barrier":::"memory");
  #undef DMA_K
  #undef DMA_V
  #undef CMASK
  #undef START
  #undef RESC
  #undef ROT
}
constexpr int ATTN_LDS_BYTES=LDS_BYTES;
struct AttnTensors { const bf16* Q; const bf16* K; const bf16* V; bf16* O0; bf16* O1; };
template<int THRL> __device__ __forceinline__ void attn_phase(char*lds,const AttnTensors&T,int vcu,int G){
  for(int v=vcu;v<256;v+=G){
    const int e=v>>2,s=v&3; const int b=e>>5,rem=e&31,h=rem>>2,m=(rem>>1)&1,vh=rem&1;
    const int cq=(2*h+m)*64,cv=(2*h+vh)*64; bf16*O=m?T.O1:T.O0;
    for(int i=0;i<16;++i){ const int j=i>>1; const int qb=(i&1)?(8*j+7-s):(8*j+s); attn_unit<THRL>(b,cq,cv,qb,T.Q,T.K,T.V,O,lds); }
  }
}
#undef SBAR
#undef WAIT_BAR
}

namespace attn128 {
constexpr int D = 128, PITCH = 1024, SEQ = 16384;
constexpr float THR = 8.f; constexpr bool WSKIP = false;
constexpr float SCALE = 0.125f;
constexpr int NW = 8, QBLK = 32, KVBLK = 64, QB = NW * QBLK;
constexpr int SHM_V = KVBLK * D * 2, SHM_K = KVBLK * 64 * 2;
constexpr int LDS_BYTES = 2 * SHM_V + 2 * SHM_K + NW * 64 * 4;
using bf16 = unsigned short;
typedef short bf16x8 __attribute__((ext_vector_type(8)));
typedef short s16x4 __attribute__((ext_vector_type(4)));
typedef float f32x16 __attribute__((ext_vector_type(16)));
typedef float f32x4 __attribute__((ext_vector_type(4)));
typedef unsigned u32x4 __attribute__((ext_vector_type(4)));
template <class A, class Bt> struct same_t { static constexpr bool v = false; };
template <class A> struct same_t<A, A> { static constexpr bool v = true; };

#define KSWZ(row, colB) ((row) * 128 + ((colB) ^ (((row) & 7) << 4)))
#define SBAR() __builtin_amdgcn_sched_barrier(0)
__device__ __forceinline__ int v_st(int k, int c) { const int kk = (k & ~0xC) | ((k & 4) << 1) | ((k & 8) >> 1); return ((kk >> 3) * 4 + (c >> 5)) * 512 + ((kk & 7) * 32 + (c & 31)) * 2; }
__device__ __forceinline__ int v_rd_base(int lane) { return ((lane & 3) << 3) | (((lane >> 2) & 3) << 6) | (((lane >> 4) & 1) << 5) | (((lane >> 5) & 1) << 8); }
constexpr int v_rd_off(int d0, int ks, int half) { return d0 * 512 + ks * 4096 + half * 2048; }
__device__ __forceinline__ int crow(int r, int hi) { return (r & 3) + 8 * (r >> 2) + 4 * hi; }
__device__ __forceinline__ unsigned cvtpk(float lo, float hi) {
    unsigned r; asm volatile("v_cvt_pk_bf16_f32 %0, %1, %2" : "=v"(r) : "v"(lo), "v"(hi)); return r;
}
__device__ __forceinline__ bf16x8 pack8(f32x4 a, f32x4 b) {
    u32x4 w = {cvtpk(a[0], a[1]), cvtpk(a[2], a[3]), cvtpk(b[0], b[1]), cvtpk(b[2], b[3])};
    return *reinterpret_cast<bf16x8*>(&w);
}
template <class T> __device__ __forceinline__ bf16x8 load8(const T* p) {
    if constexpr (same_t<T, float>::v) { return pack8(*(const f32x4*)p, *(const f32x4*)(p + 4)); }
    else { return *reinterpret_cast<const bf16x8*>(p); }
}
__device__ __forceinline__ void mask_tile(f32x16& p0, f32x16& p1, int dq, unsigned W) {
    const float NEG = -__builtin_inff();
#pragma unroll
    for (int r = 0; r < 16; ++r) {
        const int c = (r & 3) + 8 * (r >> 2);
        if ((unsigned)(dq - c) >= W) p0[r] = NEG;
        if ((unsigned)(dq - c - 32) >= W) p1[r] = NEG;
    }
}
__device__ __forceinline__ void partialSM(f32x16& p0, f32x16& p1, float& m_reg, float& mn, float& alpha) {
    float pmax = p0[0]; for (int r = 1; r < 16; ++r) pmax = fmaxf(pmax, p0[r]); for (int r = 0; r < 16; ++r) pmax = fmaxf(pmax, p1[r]);
    { auto rr = __builtin_amdgcn_permlane32_swap(__float_as_uint(pmax), __float_as_uint(pmax), false, false);
      pmax = fmaxf(__uint_as_float(rr[0]), __uint_as_float(rr[1])); }
    constexpr float C2 = 1.4426950408889634f * SCALE;
    if (__builtin_expect(__all((pmax - m_reg) * SCALE <= THR), 1)) { mn = m_reg; alpha = 1.f; }
    else { mn = fmaxf(m_reg, pmax); alpha = __builtin_amdgcn_exp2f((m_reg - mn) * C2); m_reg = mn; }
    const float mnL = -mn * C2;
    for (int r = 0; r < 16; ++r) p0[r] = fmaf(p0[r], C2, mnL); for (int r = 0; r < 16; ++r) p1[r] = fmaf(p1[r], C2, mnL);
    for (int r = 0; r < 16; ++r) p0[r] = __builtin_amdgcn_exp2f(p0[r]);
}
__device__ __forceinline__ void finishSM(f32x16& p0, f32x16& p1, float alpha, float& l_reg, bf16x8& pa0, bf16x8& pa1, bf16x8& pa2, bf16x8& pa3) {
    for (int r = 0; r < 16; ++r) p1[r] = __builtin_amdgcn_exp2f(p1[r]);
    float ps = 0; for (int r = 0; r < 16; ++r) ps += p0[r]; for (int r = 0; r < 16; ++r) ps += p1[r];
    { auto rr = __builtin_amdgcn_permlane32_swap(__float_as_uint(ps), __float_as_uint(ps), false, false);
      ps = __uint_as_float(rr[0]) + __uint_as_float(rr[1]); }
    l_reg = l_reg * alpha + ps;
#define PK4(P, B_, OUT) do { unsigned a0 = cvtpk(P[B_+0], P[B_+1]), a1 = cvtpk(P[B_+2], P[B_+3]);                          \
        unsigned b0 = cvtpk(P[B_+4], P[B_+5]), b1 = cvtpk(P[B_+6], P[B_+7]);                                             \
        auto r0 = __builtin_amdgcn_permlane32_swap(a0, b0, false, false); auto r1 = __builtin_amdgcn_permlane32_swap(a1, b1, false, false); \
        u32x4 w = {r0[0], r1[0], r0[1], r1[1]}; OUT = *reinterpret_cast<bf16x8*>(&w); } while (0)
    PK4(p0, 0, pa0); PK4(p0, 8, pa1); PK4(p1, 0, pa2); PK4(p1, 8, pa3);
#undef PK4
}
template <int KB, bool SK>
__device__ __forceinline__ void qkt(f32x16& p0, f32x16& p1, const char* K_lds, int r32, int hi, const bf16x8* qr, bool act, int kmo) {
    if (SK && !act) { const float NEG = -__builtin_inff();
#pragma unroll
        for (int r = 0; r < 16; ++r) { p0[r] = NEG; p1[r] = NEG; } return; }
    p0 = f32x16{}; p1 = f32x16{};
    const char* kb[4];
#pragma unroll
    for (int dd = 0; dd < 4; ++dd) kb[dd] = K_lds + KB * SHM_K + KSWZ(r32, (dd * 16 + hi * 8) * 2);
#pragma unroll
    for (int d0 = 0; d0 < 4; ++d0) { const char* a = kb[d0] + kmo;
        bf16x8 b0 = *reinterpret_cast<const bf16x8*>(a);
        bf16x8 b1 = *reinterpret_cast<const bf16x8*>(a + 32 * 128);
        p0 = __builtin_amdgcn_mfma_f32_32x32x16_bf16(b0, qr[d0], p0, 0, 0, 0);
        p1 = __builtin_amdgcn_mfma_f32_32x32x16_bf16(b1, qr[d0], p1, 0, 0, 0); }
}
template <int VB, bool SK>
__device__ __forceinline__ void pv_tile(f32x16* o, int vb0, bf16x8 pa0, bf16x8 pa1, bf16x8 pa2, bf16x8 pa3, bool act) {
    if (SK && !act) return;
#define TRRD(dst, off) asm volatile("ds_read_b64_tr_b16 %0, %1 offset:%2" : "=&v"(dst) : "v"(vb0), "i"(off) : "memory")
#define PV_D0(d0) do { s16x4 l0, l1, l2, l3, h0, h1, h2, h3; constexpr int b_ = VB * SHM_V + v_rd_off(d0, 0, 0);     \
        TRRD(l0, b_); TRRD(h0, b_ + 2048); TRRD(l1, b_ + 4096); TRRD(h1, b_ + 6144); TRRD(l2, b_ + 8192); TRRD(h2, b_ + 10240); TRRD(l3, b_ + 12288); TRRD(h3, b_ + 14336); \
        asm volatile("s_waitcnt lgkmcnt(0)" ::: "memory"); SBAR();                 \
        o[d0] = __builtin_amdgcn_mfma_f32_32x32x16_bf16(pa0, (bf16x8){l0[0], l0[1], l0[2], l0[3], h0[0], h0[1], h0[2], h0[3]}, o[d0], 0, 0, 0);   \
        o[d0] = __builtin_amdgcn_mfma_f32_32x32x16_bf16(pa1, (bf16x8){l1[0], l1[1], l1[2], l1[3], h1[0], h1[1], h1[2], h1[3]}, o[d0], 0, 0, 0);   \
        o[d0] = __builtin_amdgcn_mfma_f32_32x32x16_bf16(pa2, (bf16x8){l2[0], l2[1], l2[2], l2[3], h2[0], h2[1], h2[2], h2[3]}, o[d0], 0, 0, 0);   \
        o[d0] = __builtin_amdgcn_mfma_f32_32x32x16_bf16(pa3, (bf16x8){l3[0], l3[1], l3[2], l3[3], h3[0], h3[1], h3[2], h3[3]}, o[d0], 0, 0, 0); } while (0)
    PV_D0(0); PV_D0(1); PV_D0(2); PV_D0(3);
#undef PV_D0
#undef TRRD
}

template <class TIn, class TOut> struct BlockRef { const TIn* Q; const TIn* K; const TIn* V; TOut* O; int P0; int kmo; };
template <class TIn> struct Seam {
    bf16x8 qr[4];
    bf16x8 st_v0, st_v1, st_k0, st_k1; f32x4 sf0, sf1, sf2, sf3;
    f32x4 tq[1];
};
__device__ __forceinline__ int swa_jlo(int P0, int W) { const int lowk = P0 - W + 1; return lowk > 0 ? lowk / KVBLK : 0; }
#define ROW(p, k0, rr) ((p) + (size_t)((k0) + (rr)) * PITCH + sc)
#define VMW() asm volatile("s_waitcnt vmcnt(0)" ::: "memory")
#define VMWN(n) asm volatile("s_waitcnt vmcnt(%0)" :: "i"(n) : "memory")
#define SLOAD_H(Kp, Vp, k0) do { S.st_v0 = load8<TIn>(ROW(Vp, k0, sr)); S.st_v1 = load8<TIn>(ROW(Vp, k0, 32 + sr));              \
                         S.st_k0 = load8<TIn>((Kp) + (size_t)((k0) + krow) * PITCH + kcol); } while (0)
#define SWRITE_HK(bf) do { *(bf16x8*)(K_lds + (bf) * SHM_K + kws) = S.st_k0; } while (0)
#define SWRITE_HV(bf) do { *(bf16x8*)(V_lds + (bf) * SHM_V + vst0) = S.st_v0; *(bf16x8*)(V_lds + (bf) * SHM_V + vst1) = S.st_v1; } while (0)
#define SWRITE_H(bf) do { SWRITE_HV(bf); SWRITE_HK(bf); } while (0)
#define SLOAD_F(p, k0) do { S.sf0 = *(const f32x4*)ROW(p, k0, sr); S.sf1 = *(const f32x4*)(ROW(p, k0, sr) + 4);                \
                            S.sf2 = *(const f32x4*)ROW(p, k0, 32 + sr); S.sf3 = *(const f32x4*)(ROW(p, k0, 32 + sr) + 4); } while (0)
#define SWRITE_KF(bf) do { *(bf16x8*)(K_lds + (bf) * SHM_K + kws) = pack8(S.sf0, S.sf1); *(bf16x8*)(K_lds + (bf) * SHM_K + kws + 32 * 256) = pack8(S.sf2, S.sf3); } while (0)
#define SWRITE_VF(bf) do { *(bf16x8*)(V_lds + (bf) * SHM_V + vst0) = pack8(S.sf0, S.sf1); *(bf16x8*)(V_lds + (bf) * SHM_V + vst1) = pack8(S.sf2, S.sf3); } while (0)
template <class TIn, class TOut>
__device__ __forceinline__ void causal_swa_prime(const BlockRef<TIn, TOut>& cur, int W, char* lds, Seam<TIn>& S) {
    constexpr bool F32 = same_t<TIn, float>::v;
    int tid_ = threadIdx.x; asm volatile("" : "+v"(tid_)); const int tid = tid_, wid = __builtin_amdgcn_readfirstlane(tid >> 6), lane = tid & 63, r32 = lane & 31, hi = lane >> 5;
    const int sr = tid >> 4, sc = (tid & 15) * 8, krow = tid >> 3, kcol = (tid & 7) * 8, kws = KSWZ(krow, kcol * 2); char* K_lds = lds + 2 * SHM_V;
    const int kb0 = swa_jlo(cur.P0, W) * KVBLK;
    for (int d0 = 0; d0 < 4; ++d0) S.qr[d0] = load8<TIn>(cur.Q + (size_t)(wid * QBLK + r32) * PITCH + d0 * 16 + hi * 8);
    if constexpr (F32) { SLOAD_F((const float*)cur.K, kb0); VMW(); SWRITE_KF(0); SBAR(); SLOAD_F((const float*)cur.V, kb0); }
    else { SLOAD_H(cur.K, cur.V, kb0); VMW(); SWRITE_HK(0); }
    __syncthreads();
}
template <class TIn, class TOut>
__device__ __forceinline__ void causal_swa_block(const BlockRef<TIn, TOut>& cur, const BlockRef<TIn, TOut>& nxt, int skv, int W, char* lds, Seam<TIn>& S) {
    constexpr bool F32 = same_t<TIn, float>::v;
    int tid_ = threadIdx.x; asm volatile("" : "+v"(tid_)); const int tid = tid_, wid = __builtin_amdgcn_readfirstlane(tid >> 6), lane = tid & 63, r32 = lane & 31, hi = lane >> 5;
    const int j_lo = swa_jlo(cur.P0, W);
    int j_hi = (cur.P0 + QB - 1) / KVBLK + 1; if (j_hi > skv / KVBLK) j_hi = skv / KVBLK;
    const int NT = j_hi - j_lo;
    const int kbn = swa_jlo(nxt.P0, W) * KVBLK;
    const int qlo = cur.P0 + wid * QBLK, qm = qlo + r32 - 4 * hi;
    char* V_lds = lds; char* K_lds = lds + 2 * SHM_V;
    float* ws = (float*)(lds + 2 * SHM_V + 2 * SHM_K) + wid * 64; float* li_l = ws, * al_l = ws + 32;
    float m_reg = -1e30f, l_reg = 0; f32x16 o[4] = {};
    const int sr = tid >> 4, sc = (tid & 15) * 8, vst0 = v_st(sr, sc), vst1 = v_st(32 + sr, sc), krow = tid >> 3, kcol = (tid & 7) * 8, kws = KSWZ(krow, kcol * 2);
    const int vb0 = (int)(uintptr_t)V_lds + v_rd_base(lane);
    const TIn* Kh = cur.K; const TIn* Vh = cur.V;
#define RESC(a) do { if (__any((a) < 1.f)) { if (hi == 0) al_l[r32] = (a); asm volatile("s_waitcnt lgkmcnt(0)" ::: "memory");              \
                     for (int d_ = 0; d_ < 4; ++d_) for (int r = 0; r < 16; ++r) o[d_][r] *= al_l[crow(r, hi)]; } } while (0)
#define KBASE(t) ((j_lo + (t)) * KVBLK)
#define ACT(t) (KBASE(t) <= qlo + QBLK - 1 && KBASE(t) + KVBLK - 1 >= qlo - W + 1)
#define MASKT(P0_, P1_, t) do { const int kb_ = KBASE(t); if ((!SK || ACT(t)) && (kb_ + KVBLK - 1 > qlo || kb_ <= qlo + QBLK - 1 - W)) mask_tile(P0_, P1_, qm - kb_, (unsigned)W); } while (0)
    constexpr int NQL = F32 ? 16 : 4;
    constexpr bool SK = WSKIP && !F32;
#define SEAM_K0() do { VMWN(NQL); if constexpr (F32) { SWRITE_KF(0); SBAR(); SLOAD_F((const float*)nxt.V, kbn); } else { SWRITE_HK(0); } SBAR(); } while (0)
    f32x16 pA0, pA1, pB0, pB1; float mnA, mnB, alA, alB; bf16x8 pa0, pa1, pa2, pa3;
    if constexpr (F32) { VMW(); SWRITE_VF(0); SBAR(); } else { SWRITE_HV(0); SBAR(); }
    if (NT > 1) { if constexpr (F32) SLOAD_F((const float*)Kh, KBASE(1)); else SLOAD_H(Kh, Vh, KBASE(1)); }
    SBAR(); qkt<0, SK>(pA0, pA1, K_lds, r32, hi, S.qr, ACT(0), cur.kmo);
    if constexpr (F32) { if (NT > 1) { VMW(); SWRITE_KF(1); SBAR(); SLOAD_F((const float*)Vh, KBASE(1)); } }
    MASKT(pA0, pA1, 0); partialSM(pA0, pA1, m_reg, mnA, alA);
    if (NT > 1) { VMW(); if constexpr (F32) { SWRITE_VF(1); SBAR(); if (NT > 2) SLOAD_F((const float*)Kh, KBASE(2)); } else SWRITE_H(1); }
    __syncthreads();
#define HALF_STEP(PX0, PX1, mnX, alX, PY0, PY1, alY, t, KB, VB, SB) do {                                                      \
        SBAR(); qkt<KB, SK>(PX0, PX1, K_lds, r32, hi, S.qr, ACT(t), cur.kmo);                                             \
        finishSM(PY0, PY1, alY, l_reg, pa0, pa1, pa2, pa3); SBAR();                                                           \
        if ((t) + 1 < NT) { if constexpr (F32) { VMW(); SWRITE_KF(SB); SBAR(); SLOAD_F((const float*)Vh, KBASE((t) + 1)); }  \
                            else { SLOAD_H(Kh, Vh, KBASE((t) + 1)); } SBAR(); }                                               \
        pv_tile<VB, SK>(o, vb0, pa0, pa1, pa2, pa3, ACT((t) - 1)); MASKT(PX0, PX1, (t)); partialSM(PX0, PX1, m_reg, mnX, alX);                                        \
        __syncthreads();                                                                                                      \
        if ((t) + 1 < NT) { VMW(); if constexpr (F32) { SWRITE_VF(SB); SBAR(); if ((t) + 2 < NT) SLOAD_F((const float*)Kh, KBASE((t) + 2)); } \
                            else { SWRITE_H(SB); } }                                                                          \
        RESC(alX); __syncthreads(); } while (0)
    for (int t = 1; t + 1 < NT; t += 2) {
        HALF_STEP(pB0, pB1, mnB, alB, pA0, pA1, alA, t, 1, 0, 0);
        HALF_STEP(pA0, pA1, mnA, alA, pB0, pB1, alB, t + 1, 0, 1, 1);
    }
    const bool even = (NT & 1) == 0;
    if (even) { SBAR(); qkt<1, SK>(pB0, pB1, K_lds, r32, hi, S.qr, ACT(NT - 1), cur.kmo); SBAR(); }
#define QROW(e) (nxt.Q + (size_t)(wid * QBLK + r32) * D + ((e) >> 1) * 16 + hi * 8 + ((e) & 1) * 4)
    if constexpr (F32) { SLOAD_F((const float*)nxt.K, kbn); SBAR();
#pragma unroll
        for (int e = 0; e < 8; ++e) S.tq[e] = *(const f32x4*)QROW(e); }
    else { SLOAD_H(nxt.K, nxt.V, kbn); SBAR();
#pragma unroll
        for (int d0 = 0; d0 < 4; ++d0) S.qr[d0] = load8<TIn>(nxt.Q + (size_t)(wid * QBLK + r32) * PITCH + d0 * 16 + hi * 8); }
    SBAR();
    finishSM(pA0, pA1, alA, l_reg, pa0, pa1, pa2, pa3); SBAR();
    if constexpr (F32) {
#pragma unroll
        for (int e = 8; e < 16; ++e) S.tq[e] = *(const f32x4*)QROW(e); SBAR(); }
#undef QROW
    pv_tile<0, SK>(o, vb0, pa0, pa1, pa2, pa3, ACT(even ? NT - 2 : NT - 1));
    if (even) { MASKT(pB0, pB1, NT - 1); partialSM(pB0, pB1, m_reg, mnB, alB); __syncthreads(); RESC(alB);
        finishSM(pB0, pB1, alB, l_reg, pa0, pa1, pa2, pa3); SBAR(); pv_tile<1, SK>(o, vb0, pa0, pa1, pa2, pa3, ACT(NT - 1)); }
    SBAR(); SEAM_K0();
    if (hi == 0) li_l[r32] = l_reg; asm volatile("s_waitcnt lgkmcnt(0)" ::: "memory");
    float rli[16];
#pragma unroll
    for (int r = 0; r < 16; ++r) rli[r] = __builtin_amdgcn_rcpf(li_l[crow(r, hi)]);
    TOut* Ow = cur.O + (size_t)(wid * QBLK) * PITCH;
#pragma unroll
    for (int r = 0; r < 16; ++r) { const int orow = crow(r, hi);
#pragma unroll
        for (int d0 = 0; d0 < 4; ++d0) { const float v = o[d0][r] * rli[r];
            if constexpr (same_t<TOut, float>::v) { Ow[(size_t)orow * PITCH + d0 * 32 + r32] = v; }
            else { const float vn = __shfl_xor(v, 1);
                   if ((r32 & 1) == 0) *(unsigned*)(Ow + (size_t)orow * PITCH + d0 * 32 + r32) = cvtpk(v, vn); } } }
    if constexpr (F32) {
#pragma unroll
        for (int d0 = 0; d0 < 8; ++d0) S.qr[d0] = pack8(S.tq[2 * d0], S.tq[2 * d0 + 1]); }
    __syncthreads();
#undef RESC
#undef KBASE
#undef ACT
#undef MASKT
#undef SEAM_K0
#undef HALF_STEP
}
#undef ROW
#undef VMW
#undef VMWN
#undef SLOAD_H
#undef SWRITE_HK
#undef SWRITE_HV
#undef SWRITE_H
#undef SLOAD_F
#undef SWRITE_KF
#undef SWRITE_VF


struct AttnTensors { const bf16* Q; const bf16* K; const bf16* V; bf16* O0; bf16* O1; };
__device__ __forceinline__ BlockRef<bf16, bf16> blk_ref(const AttnTensors& T, int vcu, int G, int li) {
    const int v = vcu + (li >> 3) * G, i = li & 7, e = v >> 3, s = v & 7, b = e >> 4, h = (e >> 1) & 7, m = e & 1, j = i >> 1;
    const int qb = (i & 1) ? (16 * j + 15 - s) : (16 * j + s);
    BlockRef<bf16, bf16> r;
    r.Q = T.Q + ((size_t)b * SEQ + (size_t)qb * QB) * PITCH + h * 128 + m * 64;
    r.K = T.K + (size_t)b * SEQ * PITCH + h * 128 + m * 64; r.V = T.V + (size_t)b * SEQ * PITCH + h * 128;
    r.O = (m ? T.O1 : T.O0) + ((size_t)b * SEQ + (size_t)qb * QB) * PITCH + h * 128;
    r.P0 = qb * QB; r.kmo = 0;
    return r;
}
__device__ __forceinline__ void attn_phase(char* lds, const AttnTensors& T, int vcu, int G) {
    int nv = 0; for (int v = vcu; v < 256; v += G) ++nv;
    const int nblk = nv * 8; if (nblk == 0) return;
    Seam<bf16> S;
    BlockRef<bf16, bf16> cur = blk_ref(T, vcu, G, 0);
    causal_swa_prime<bf16, bf16>(cur, SEQ, lds, S);
    for (int li = 0; li < nblk; ++li) {
        const BlockRef<bf16, bf16> nxt = (li + 1 < nblk) ? blk_ref(T, vcu, G, li + 1) : cur;
        causal_swa_block<bf16, bf16>(cur, nxt, SEQ, SEQ, lds, S);
        cur = nxt;
    }
}
}

#define GAS __attribute__((address_space(1)))
#define LAS __attribute__((address_space(3)))
typedef unsigned short bf16;
typedef unsigned v4u __attribute__((ext_vector_type(4)));
typedef float f32x4 __attribute__((ext_vector_type(4)));
typedef short bf16x8 __attribute__((ext_vector_type(8)));
typedef GAS unsigned gu32;
typedef GAS unsigned long long gu64;
#define RLX_AGENT __ATOMIC_RELAXED, __HIP_MEMORY_SCOPE_AGENT
#define LDS_WAIT() asm volatile("s_waitcnt lgkmcnt(0)" ::: "memory")
#define VM_WAIT() asm volatile("s_waitcnt vmcnt(0)" ::: "memory")
__device__ __forceinline__ unsigned long long rt() { return __builtin_amdgcn_s_memrealtime(); }

#define XB_TMO      128
#define XB_XCNT(j)  (256  + 64 * (j))
#define XB_XSUB(j)  (1280 + 64 * (j))
#define XB_XGEN(j)  (2304 + 64 * (j))
#define XB_TOP      3328
#define XB_TOPGEN   3392
#define XCD_BAR_WORDS 3456
#define XB_SPIN_CAP (1u << 18)

__device__ __forceinline__ unsigned xb_ld(unsigned* p)              { return __hip_atomic_load(p, __ATOMIC_RELAXED, __HIP_MEMORY_SCOPE_AGENT); }
__device__ __forceinline__ unsigned xb_add(unsigned* p, unsigned v) { return __hip_atomic_fetch_add(p, v, __ATOMIC_RELAXED, __HIP_MEMORY_SCOPE_AGENT); }
__device__ __forceinline__ unsigned xb_xcc_id() { return (unsigned)__builtin_amdgcn_s_getreg((3 << 11) | 20) & 0xFu; }
#define XB_SPIN(cond, bar) do { unsigned _sp = 0; while (cond) { __builtin_amdgcn_s_sleep(1); \
    if ((++_sp & 255u) == 0u) { if (xb_ld(&(bar)[XB_TMO])) break; if (_sp > XB_SPIN_CAP) { atomicAdd(&(bar)[XB_TMO], 1u); break; } } } } while (0)

struct XcdBarrier {
    unsigned* bar; unsigned x;
    volatile LAS unsigned* st;
};

__device__ __forceinline__ XcdBarrier xcd_barrier_post(unsigned* bar, volatile LAS unsigned* st) {
    XcdBarrier b; b.bar = bar; b.x = xb_xcc_id(); b.st = st;
    if (threadIdx.x == 0) (void)xb_add(&bar[XB_XCNT(b.x)], 1u);
    return b;
}
__device__ __forceinline__ void xcd_barrier_complete(unsigned* bar, unsigned x, unsigned& nloc, unsigned& nx) {
    const unsigned G = gridDim.x * gridDim.y * gridDim.z;
    unsigned sum, cnt, mine, sp = 0u;
    for (;;) {
        sum = 0u; cnt = 0u; mine = 0u;
#pragma unroll
        for (unsigned j = 0; j < 16; ++j) { const unsigned c = xb_ld(&bar[XB_XCNT(j)]); sum += c; cnt += (c > 0u) ? 1u : 0u; mine = (j == x) ? c : mine; }
        if (sum == G) break;
        __builtin_amdgcn_s_sleep(1);
        if ((++sp & 255u) == 0u) { if (xb_ld(&bar[XB_TMO])) break; if (sp > XB_SPIN_CAP) { atomicAdd(&bar[XB_TMO], 1u); break; } }
    }
    nloc = mine > 0u ? mine : 1u; nx = cnt > 0u ? cnt : 1u;
}

__device__ __forceinline__ void xcd_barrier(const XcdBarrier& b) {
    asm volatile("s_waitcnt vmcnt(0)" ::: "memory");
    __syncthreads();
    if (threadIdx.x == 0) {
        unsigned* bar = b.bar;
        __builtin_amdgcn_s_waitcnt(0);
        unsigned nloc = b.st[0], nx = b.st[1];
        if (nloc == 0u) { xcd_barrier_complete(bar, b.x, nloc, nx); b.st[0] = nloc; b.st[1] = nx; }
        const unsigned old = xb_add(&bar[XB_XSUB(b.x)], 1u);
        const unsigned gen = old / nloc;
        if (old + 1u == (gen + 1u) * nloc) {
            __builtin_amdgcn_fence(__ATOMIC_RELEASE, "agent");
            asm volatile("s_waitcnt vmcnt(0)" ::: "memory");
            const unsigned og = xb_add(&bar[XB_TOP], 1u);
            const unsigned tg = og / nx;
            if (og + 1u == (tg + 1u) * nx) xb_add(&bar[XB_TOPGEN], 1u);
            else XB_SPIN(xb_ld(&bar[XB_TOPGEN]) == tg, bar);
            __builtin_amdgcn_fence(__ATOMIC_ACQUIRE, "agent");
            xb_add(&bar[XB_XGEN(b.x)], 1u);
            asm volatile("s_waitcnt vmcnt(0)" ::: "memory");
        } else {
            XB_SPIN(xb_ld(&bar[XB_XGEN(b.x)]) == gen, bar);
            __builtin_amdgcn_fence(__ATOMIC_ACQUIRE, "agent");
            asm volatile("s_waitcnt vmcnt(0)" ::: "memory");
        }
    }
    __syncthreads();
}
constexpr int NWAVES = 8;
#ifndef REP_SCAN
#define REP_SCAN 1
#endif
#ifndef REP_ATTN
#define REP_ATTN 1
#endif
#ifndef REP_PASS
#define REP_PASS 1
#endif
#ifndef REP_OG
#define REP_OG 1
#endif
#ifndef REP_SYNC
#define REP_SYNC 0
#endif
#ifndef REP_G1
#define REP_G1 1
#endif
constexpr int BATCH = 2, SEQ = 16384, D = 1024, M = BATCH * SEQ;
constexpr size_t MiB = 1u << 20;
constexpr size_t WS_ROPE_C = 1 * MiB, WS_ROPE_S = 2 * MiB, WS_S = 3 * MiB, WS_BIAS = 5 * MiB, WS_W = 6 * MiB, WS_U = 32 * MiB, UNIT = 64 * MiB, WS_H = WS_U + 7 * UNIT, WS_END = WS_H + 16 * MiB;
constexpr size_t W_RKVG = 0, W_DOWN = 8 * MiB, W_UP = 17 * MiB, W_OUT = 19 * MiB;
constexpr size_t W_PROJ = 0, W_BOUT = 8 * MiB;
constexpr int LDS_BYTES = 147456;
constexpr float C2F = 0.125f * 1.4426950408889634f;
#ifdef ATTN_D64
#define QSCALE_MASK0 0x4
#define QSCALE_MASK1 0x1
#else
#define QSCALE_MASK0 0x0
#define QSCALE_MASK1 0x0
#endif

typedef _Float16 h16x4 __attribute__((ext_vector_type(4)));
typedef unsigned u32x2 __attribute__((ext_vector_type(2)));
typedef float f32x2 __attribute__((ext_vector_type(2)));
__device__ __forceinline__ unsigned f2bf(float f) { unsigned u = __builtin_bit_cast(unsigned, f); return (u + 0x7fffu + ((u >> 16) & 1u)) >> 16; }
__device__ __forceinline__ unsigned pk2(float lo, float hi) { return f2bf(lo) | (f2bf(hi) << 16); }
__device__ __forceinline__ float bflo(unsigned w) { return __uint_as_float(w << 16); }
__device__ __forceinline__ float bfhi(unsigned w) { return __uint_as_float(w & 0xffff0000u); }
__device__ __forceinline__ float wave_sum(float v) {
#pragma unroll
    for (int o = 1; o < 64; o <<= 1) v += __shfl_xor(v, o);
    return v;
}
template <int CTRL> __device__ __forceinline__ float dpp_mov(float x) { return __builtin_bit_cast(float, __builtin_amdgcn_update_dpp(0, __builtin_bit_cast(int, x), CTRL, 0xf, 0xf, false)); }
__device__ __forceinline__ float allreduce16(float x) { x += dpp_mov<0x128>(x); x += dpp_mov<0x124>(x); x += dpp_mov<0x122>(x); x += dpp_mov<0x121>(x); return x; }

__device__ __forceinline__ void conv_tile(const float* src, int ldsrc, int k0s, int n0s, int kvalid, const float* sc, int smode, bf16* dst, int pitch, int n0d, int k0d, LAS float* scr, int lane) {
#pragma unroll 8
    for (int i = 0; i < 32; ++i) { const int kk = 2 * i + (lane >> 5), n = lane & 31; float v = 0.f;
        if (kk < kvalid) { v = src[(size_t)(k0s + kk) * ldsrc + n0s + n]; if (smode) { const float s = sc[k0s + kk]; v *= (smode == 1) ? s : (1.0f - s); } }
        scr[kk * 33 + n] = v; }
    LDS_WAIT(); asm volatile("" ::: "memory");
    const int c = lane & 7;
#pragma unroll
    for (int j = 0; j < 4; ++j) { const int n = (lane >> 3) + 8 * j; const LAS float* s = scr + (8 * c) * 33 + n;
        v4u o; o.x = pk2(s[0 * 33], s[1 * 33]); o.y = pk2(s[2 * 33], s[3 * 33]); o.z = pk2(s[4 * 33], s[5 * 33]); o.w = pk2(s[6 * 33], s[7 * 33]);
        *(v4u*)(dst + (size_t)(n0d + n) * pitch + k0d + 8 * c) = o; }
    LDS_WAIT(); asm volatile("" ::: "memory");
}

struct In {
    const float* x; const int* pos; const float *a_norm, *a_mu, *a_w_in, *a_w0, *a_w1, *a_w2, *a_a0, *a_a1, *a_a2, *a_v0, *a_v1, *a_v2, *a_k_k, *a_k_a, *a_r_k, *a_ln_w, *a_ln_b, *a_w_out;
    const float *kv_norm, *w_kv, *b_norm, *b_w_in, *b_lq1, *b_lk1, *b_lq2, *b_lk2, *b_subln, *b_w_out, *final_norm;
};

__device__ __forceinline__ void conv_rwkv(const In& I, int l, unsigned char* wreg, float* bias3, LAS float* scr, int gw, int NGW, int lane) {
    if (gw < 48) { const int i = gw * 64 + lane; const int t = i >> 10, c = i & 1023; bias3[i] = (t == 0) ? I.a_w0[l * 1024 + c] : (t == 1) ? I.a_a0[l * 1024 + c] : I.a_v0[c]; }
    bf16* Wq = (bf16*)(wreg + W_RKVG); bf16* Wd = (bf16*)(wreg + W_DOWN); bf16* Wu = (bf16*)(wreg + W_UP); bf16* Wo = (bf16*)(wreg + W_OUT);
    const int NUPB = (l == 0 ? 2048 : 3072) / 32;
    const int I_Q = 4 * 32 * 16, I_D = 8 * 32, I_F = I_Q + I_D, I_U = NUPB * 4, I_O = 32 * 16;
    for (int it = gw; it < I_F + I_U + I_O; it += NGW) {
        int r = it;
        if (r < I_Q) { const int p = r >> 9, nb = (r >> 4) & 31, kb = r & 15;
            conv_tile(I.a_w_in + (size_t)(l * 4 + p) * 1024 * 1024, 1024, kb * 64, nb * 32, 64, I.a_mu, 0, Wq + (size_t)p * 1024 * 1024, 1024, nb * 32, kb * 64, scr, lane); continue; }
        if (r < I_F) { const int rr = r - I_Q, nb = rr >> 5, kb = rr & 31; const int c0 = nb * 32, k0d = kb * 64, half = kb >> 4, k0s = (kb & 15) * 64;
            const float* mu = I.a_mu + (size_t)l * 6 * 1024;
            if (c0 < 64) conv_tile(I.a_w1 + (size_t)l * 1024 * 64, 64, k0s, c0, 64, mu + 4 * 1024, half ? 1 : 2, Wd, 2048, c0, k0d, scr, lane);
            else if (c0 < 128) conv_tile(I.a_a1 + (size_t)l * 1024 * 64, 64, k0s, c0 - 64, 64, mu + 5 * 1024, half ? 1 : 2, Wd, 2048, c0, k0d, scr, lane);
            else if (c0 < 160 && l == 1) conv_tile(I.a_v1, 32, k0s, 0, 64, mu + 2 * 1024, half ? 1 : 2, Wd, 2048, c0, k0d, scr, lane);
            else conv_tile(I.a_w1, 64, 0, 0, 0, mu, 0, Wd, 2048, c0, k0d, scr, lane);
            continue; }
        r -= I_F;
        if (r < I_U) { const int nb = r >> 2, kb = r & 3; const int n0d = nb * 32, k0d = kb * 64, t = n0d >> 10;
            if (kb == t) { if (t == 0) conv_tile(I.a_w2 + (size_t)l * 64 * 1024, 1024, 0, n0d, 64, I.a_mu, 0, Wu, 256, n0d, k0d, scr, lane);
                else if (t == 1) conv_tile(I.a_a2 + (size_t)l * 64 * 1024, 1024, 0, n0d - 1024, 64, I.a_mu, 0, Wu, 256, n0d, k0d, scr, lane);
                else conv_tile(I.a_v2, 1024, 0, n0d - 2048, 32, I.a_mu, 0, Wu, 256, n0d, k0d, scr, lane); }
            else conv_tile(I.a_w2, 1024, 0, 0, 0, I.a_mu, 0, Wu, 256, n0d, k0d, scr, lane);
            continue; }
        r -= I_U;
        { const int nb = r >> 4, kb = r & 15; conv_tile(I.a_w_out + (size_t)l * 1024 * 1024, 1024, kb * 64, nb * 32, 64, I.a_mu, 0, Wo, 1024, nb * 32, kb * 64, scr, lane); }
    }
}
__device__ __forceinline__ void conv_attn(const In& I, int j, unsigned char* wreg, LAS float* scr, int gw, int NGW, int lane) {
    bf16* Wp = (bf16*)(wreg + W_PROJ); bf16* Wo = (bf16*)(wreg + W_BOUT);
    const int NPB = (j == 0 ? 4096 : 2048) / 32;
    const int I_P = NPB * 16, I_O = 32 * 16;
    for (int it = gw; it < I_P + I_O; it += NGW) {
        int r = it;
        if (r < I_P) { const int nb = r >> 4, kb = r & 15; const int n0d = nb * 32, k0 = kb * 64;
            if (j == 0) { if (n0d < 2048) conv_tile(I.w_kv, 2048, k0, n0d, 64, I.kv_norm, 1, Wp, 1024, n0d, k0, scr, lane);
                else conv_tile(I.b_w_in, 2048, k0, n0d - 2048, 64, I.b_norm, 1, Wp, 1024, n0d, k0, scr, lane); }
            else conv_tile(I.b_w_in + (size_t)1024 * 2048, 2048, k0, n0d, 64, I.b_norm + 1024, 1, Wp, 1024, n0d, k0, scr, lane);
            continue; }
        r -= I_P;
        { const int nb = r >> 4, kb = r & 15; conv_tile(I.b_w_out + (size_t)j * 1024 * 1024, 1024, kb * 64, nb * 32, 64, I.kv_norm, 0, Wo, 1024, nb * 32, kb * 64, scr, lane); }
    }
}

__device__ __forceinline__ void rope_tables(const int* pos, float* rc, float* rs, int gtid, int nthr) {
    for (int idx = gtid; idx < M * 8; idx += nthr) { const int m = idx >> 3, i = idx & 7;
        const float inv = (i == 0) ? 1.0f : (i == 1) ? 0.1939227432012558f : (i == 2) ? 0.03760603070259094f : (i == 3) ? 0.007292664609849453f : (i == 4) ? 0.0014142135623842478f : (i == 5) ? 0.00027424818836152554f : (i == 6) ? 5.3182957344688475e-05f : 1.0313385246263351e-05f;
        const float ang = (float)pos[m] * inv;
        const double x = (double)ang; const double k = __builtin_rint(x * 0.15915494309189535); const double r = x - k * 6.283185307179586476925;
        const double r2 = r * r; double sn = 0.0, cs = 0.0;
#pragma unroll
        for (int t = 12; t >= 1; --t) { sn = (1.0 - sn) * r2 / (double)((2 * t) * (2 * t + 1)); cs = (1.0 - cs) * r2 / (double)((2 * t - 1) * (2 * t)); }
        rs[idx] = (float)(r * (1.0 - sn)); rc[idx] = (float)(1.0 - cs); }
}

__device__ __forceinline__ void pre_rwkv(const float* x, const float* g, const float* mu, bf16* XM, size_t xm_stride, bf16* XN2, int gw, int NGW, int lane) {
    f32x4 gv[4], mv[4][4];
#pragma unroll
    for (int j = 0; j < 4; ++j) { gv[j] = *((const f32x4*)g + lane + 64 * j);
#pragma unroll
        for (int p = 0; p < 4; ++p) mv[p][j] = *((const f32x4*)(mu + p * 1024) + lane + 64 * j); }
    for (int c = gw; c < M / 16; c += NGW) { const int m0 = c * 16;
        f32x4 prev[4];
#pragma unroll
        for (int j = 0; j < 4; ++j) prev[j] = (f32x4){0.f, 0.f, 0.f, 0.f};
        if ((m0 % SEQ) != 0) { const f32x4* xr = (const f32x4*)(x + (size_t)(m0 - 1) * D) + lane; f32x4 v[4]; float s = 0.f;
#pragma unroll
            for (int j = 0; j < 4; ++j) { v[j] = xr[64 * j]; s += (v[j].x * v[j].x + v[j].y * v[j].y) + (v[j].z * v[j].z + v[j].w * v[j].w); }
            const float rstd = 1.0f / sqrtf(wave_sum(s) * (1.0f / D) + 1e-6f);
#pragma unroll
            for (int j = 0; j < 4; ++j) prev[j] = v[j] * rstd * gv[j]; }
        for (int r = 0; r < 16; ++r) { const int m = m0 + r; const f32x4* xr = (const f32x4*)(x + (size_t)m * D) + lane; f32x4 v[4]; float s = 0.f;
#pragma unroll
            for (int j = 0; j < 4; ++j) { v[j] = xr[64 * j]; s += (v[j].x * v[j].x + v[j].y * v[j].y) + (v[j].z * v[j].z + v[j].w * v[j].w); }
            const float rstd = 1.0f / sqrtf(wave_sum(s) * (1.0f / D) + 1e-6f);
            unsigned long long* o8 = (unsigned long long*)(XN2 + (size_t)m * 2048) + lane;
#pragma unroll
            for (int j = 0; j < 4; ++j) { const f32x4 xn = v[j] * rstd * gv[j]; const f32x4 xx = prev[j] - xn;
                o8[64 * j] = (unsigned long long)pk2(xn.x, xn.y) | ((unsigned long long)pk2(xn.z, xn.w) << 32);
                o8[256 + 64 * j] = (unsigned long long)pk2(prev[j].x, prev[j].y) | ((unsigned long long)pk2(prev[j].z, prev[j].w) << 32);
#pragma unroll
                for (int p = 0; p < 4; ++p) { const f32x4 xm = xn + xx * mv[p][j];
                    ((unsigned long long*)(XM + (size_t)p * xm_stride + (size_t)m * D) + lane)[64 * j] = (unsigned long long)pk2(xm.x, xm.y) | ((unsigned long long)pk2(xm.z, xm.w) << 32); }
                prev[j] = xn; } }
    }
}
__device__ __forceinline__ void pre_attn(const float* x, bf16* XH, int gw, int NGW, int lane) {
    for (int m = gw; m < M; m += NGW) { const f32x4* xr = (const f32x4*)(x + (size_t)m * D) + lane; f32x4 v[4]; float s = 0.f;
#pragma unroll
        for (int j = 0; j < 4; ++j) { v[j] = xr[64 * j]; s += (v[j].x * v[j].x + v[j].y * v[j].y) + (v[j].z * v[j].z + v[j].w * v[j].w); }
        const float rstd = 1.0f / sqrtf(wave_sum(s) * (1.0f / D) + 1e-6f);
        unsigned long long* o8 = (unsigned long long*)(XH + (size_t)m * D) + lane;
#pragma unroll
        for (int j = 0; j < 4; ++j) o8[64 * j] = (unsigned long long)pk2(v[j].x * rstd, v[j].y * rstd) | ((unsigned long long)pk2(v[j].z * rstd, v[j].w * rstd) << 32); }
}
__device__ __forceinline__ void final_norm_rows(const float* x, const float* g, float* out, int gw, int NGW, int lane) {
    f32x4 gv[4];
#pragma unroll
    for (int j = 0; j < 4; ++j) gv[j] = *((const f32x4*)g + lane + 64 * j);
    for (int m = gw; m < M; m += NGW) { const f32x4* xr = (const f32x4*)(x + (size_t)m * D) + lane; f32x4 v[4]; float s = 0.f;
#pragma unroll
        for (int j = 0; j < 4; ++j) { v[j] = xr[64 * j]; s += (v[j].x * v[j].x + v[j].y * v[j].y) + (v[j].z * v[j].z + v[j].w * v[j].w); }
        const float rstd = 1.0f / sqrtf(wave_sum(s) * (1.0f / D) + 1e-6f);
        f32x4* o = (f32x4*)(out + (size_t)m * D) + lane;
#pragma unroll
        for (int j = 0; j < 4; ++j) o[64 * j] = v[j] * rstd * gv[j]; }
}

__device__ __forceinline__ void ld16bf(const bf16* p, float (&f)[16]) { const v4u a = *(const v4u*)p, b = *(const v4u*)(p + 8);
    f[0] = bflo(a.x); f[1] = bfhi(a.x); f[2] = bflo(a.y); f[3] = bfhi(a.y); f[4] = bflo(a.z); f[5] = bfhi(a.z); f[6] = bflo(a.w); f[7] = bfhi(a.w);
    f[8] = bflo(b.x); f[9] = bfhi(b.x); f[10] = bflo(b.y); f[11] = bfhi(b.y); f[12] = bflo(b.z); f[13] = bfhi(b.z); f[14] = bflo(b.w); f[15] = bfhi(b.w); }
__device__ __forceinline__ void st16bf(bf16* p, const float (&f)[16]) { v4u a, b;
    a.x = pk2(f[0], f[1]); a.y = pk2(f[2], f[3]); a.z = pk2(f[4], f[5]); a.w = pk2(f[6], f[7]); b.x = pk2(f[8], f[9]); b.y = pk2(f[10], f[11]); b.z = pk2(f[12], f[13]); b.w = pk2(f[14], f[15]);
    *(v4u*)p = a; *(v4u*)(p + 8) = b; }

__device__ __forceinline__ void post_rwkv(const bf16* Y, const float* S, const bf16* V, const bf16* G, const float* ln_w, const float* ln_b, bf16* O, int gw, int NGW, int lane) {
    float lw[16], lb[16];
#pragma unroll
    for (int i = 0; i < 16; ++i) { lw[i] = ln_w[lane * 16 + i]; lb[i] = ln_b[lane * 16 + i]; }
    for (int m = gw; m < M; m += NGW) { const size_t off = (size_t)m * D + lane * 16;
        float y[16], v[16], g[16], o[16]; ld16bf(Y + off, y); ld16bf(V + off, v); ld16bf(G + off, g);
        const float sb = S[(size_t)m * 16 + (lane >> 2)];
        float sum = 0.f;
#pragma unroll
        for (int i = 0; i < 16; ++i) sum += y[i];
        sum += __shfl_xor(sum, 1); sum += __shfl_xor(sum, 2);
        const float mean = sum * (1.0f / 64.0f); float q = 0.f;
#pragma unroll
        for (int i = 0; i < 16; ++i) { const float d = y[i] - mean; q += d * d; }
        q += __shfl_xor(q, 1); q += __shfl_xor(q, 2);
        const float rstd = 1.0f / sqrtf(q * (1.0f / 64.0f) + 64e-5f);
#pragma unroll
        for (int i = 0; i < 16; ++i) { const float yn = (y[i] - mean) * rstd * lw[i] + lb[i]; o[i] = (yn + sb * v[i]) * (g[i] / (1.0f + __expf(-g[i]))); }
        st16bf(O + off, o); }
}
__device__ __forceinline__ void post_attn(const bf16* O0, const bf16* O1, const bf16* GT, const float* subln, float lam, float lam_init, bf16* O, int gw, int NGW, int lane) {
    float sw[16];
#pragma unroll
    for (int i = 0; i < 16; ++i) sw[i] = subln[(lane & 7) * 16 + i] * (1.0f - lam_init);
    for (int m = gw; m < M; m += NGW) { const size_t off = (size_t)m * D + lane * 16;
        float a[16], b[16], g[16], o[16]; ld16bf(O0 + off, a); ld16bf(O1 + off, b); ld16bf(GT + off, g);
        float q = 0.f;
#pragma unroll
        for (int i = 0; i < 16; ++i) { o[i] = a[i] - lam * b[i]; q += o[i] * o[i]; }
        q += __shfl_xor(q, 1); q += __shfl_xor(q, 2); q += __shfl_xor(q, 4);
        const float rstd = 1.0f / sqrtf(q * (1.0f / 128.0f) + 1e-5f);
#pragma unroll
        for (int i = 0; i < 16; ++i) o[i] = o[i] * rstd * sw[i] * (g[i] / (1.0f + __expf(-g[i])));
        st16bf(O + off, o); }
}

constexpr int SC_T = 32, SC_NB = SEQ / SC_T, SC_OPS = SC_T * 320, SC_TP = SC_T + 4, SC_VB = SC_TP * 8, SC_YP = SC_TP * 128;
struct ScRaw { u32x2 r, k, w, a; };
__device__ __forceinline__ void scan_phase(LAS unsigned char* lds, const bf16* R, const bf16* K, const bf16* V, const _Float16* W, const _Float16* A, const float* k_k, const float* k_a, const float* r_k,
                                           bf16* Y, float* S, int vcu, int G, int tid, int wave, int lane) {
    LAS float* OPS = (LAS float*)lds;
    LAS float* VB = (LAS float*)(lds + 2 * SC_OPS * 4);
    LAS float* YP = (LAS float*)(lds + 2 * SC_OPS * 4 + 2 * SC_VB * 4);
    for (int u = vcu; u < 256; u += G) {
        const int bh = u >> 3, rg = u & 7, b = bh >> 4, h = bh & 15;
        const size_t rowbase = (size_t)b * SEQ; const int cb = h * 64;
        const int pw = (wave == 2) ? 0 : (wave == 3) ? 1 : (wave == 6) ? 2 : 3;
        const int p = pw * 64 + lane, ptt = p >> 4, c4 = (p & 15) * 4;
        f32x4 kkw = {0.f, 0.f, 0.f, 0.f}, kaw = kkw, rkw = kkw;
        ScRaw rawA0, rawA1, rawB0, rawB1; rawA0.r = (u32x2){0u, 0u}; rawA0.k = rawA0.r; rawA0.w = rawA0.r; rawA0.a = rawA0.r; rawA1 = rawA0; rawB0 = rawA0; rawB1 = rawA0;
        v4u rawvA = {0u, 0u, 0u, 0u}, rawvB = rawvA;
        const bool prod = (wave == 2 || wave == 3 || wave == 6 || wave == 7), vld = (wave == 2 && lane < 32), ywr = (wave == 7), cons = (wave < 2);
        if (prod) { kkw = *(const f32x4*)(k_k + cb + c4); kaw = *(const f32x4*)(k_a + cb + c4); rkw = *(const f32x4*)(r_k + cb + c4); }
        const int jq = lane & 15, rl = wave * 4 + (lane >> 4);
        f32x2 S01 = {0.f, 0.f}, S23 = {0.f, 0.f};
#define SC_LOAD1(raw, nblk, tt_) do { const size_t o_ = (rowbase + (size_t)(nblk) * SC_T + (tt_)) * D + cb + c4; raw.r = *(const u32x2*)(R + o_); raw.k = *(const u32x2*)(K + o_); raw.w = *(const u32x2*)(W + o_); raw.a = *(const u32x2*)(A + o_); } while (0)
#define SC_LOAD(raw0, raw1, rawv, nblk) do { if (prod) { SC_LOAD1(raw0, nblk, ptt); SC_LOAD1(raw1, nblk, ptt + 16); } \
        if (vld) { rawv = *(const v4u*)(V + (rowbase + (size_t)(nblk) * SC_T + lane) * D + cb + rg * 8); } } while (0)
#define SC_DERIVE1(raw, nblk, buf, tt_) do { \
            const float r0 = bflo(raw.r.x), r1 = bfhi(raw.r.x), r2 = bflo(raw.r.y), r3 = bfhi(raw.r.y); \
            const float k0 = bflo(raw.k.x), k1 = bfhi(raw.k.x), k2 = bflo(raw.k.y), k3 = bfhi(raw.k.y); \
            const h16x4 wh = __builtin_bit_cast(h16x4, raw.w), ah = __builtin_bit_cast(h16x4, raw.a); \
            const float a0 = (float)ah[0], a1 = (float)ah[1], a2 = (float)ah[2], a3 = (float)ah[3]; \
            const float x0 = k0 * kkw.x, x1 = k1 * kkw.y, x2 = k2 * kkw.z, x3 = k3 * kkw.w; \
            const float ss = allreduce16((x0 * x0 + x1 * x1) + (x2 * x2 + x3 * x3)); \
            const float inv = 1.0f / fmaxf(sqrtf(ss), 1e-12f); \
            const f32x4 kn = {x0 * inv, x1 * inv, x2 * inv, x3 * inv}; \
            const f32x4 km = {k0 * (1.0f + (a0 - 1.0f) * kaw.x), k1 * (1.0f + (a1 - 1.0f) * kaw.y), k2 * (1.0f + (a2 - 1.0f) * kaw.z), k3 * (1.0f + (a3 - 1.0f) * kaw.w)}; \
            const float sp = allreduce16((r0 * km.x * rkw.x + r1 * km.y * rkw.y) + (r2 * km.z * rkw.z + r3 * km.w * rkw.w)); \
            LAS float* op_ = OPS + (buf) * SC_OPS + (tt_) * 320 + c4; \
            *(LAS f32x4*)(op_) = -kn; \
            *(LAS f32x4*)(op_ + 64) = (f32x4){kn.x * a0, kn.y * a1, kn.z * a2, kn.w * a3}; \
            *(LAS f32x4*)(op_ + 128) = (f32x4){__expf(-__expf((float)wh[0])), __expf(-__expf((float)wh[1])), __expf(-__expf((float)wh[2])), __expf(-__expf((float)wh[3]))}; \
            *(LAS f32x4*)(op_ + 192) = km; \
            *(LAS f32x4*)(op_ + 256) = (f32x4){r0, r1, r2, r3}; \
            if (rg == 0 && c4 == 0) S[(rowbase + (size_t)(nblk) * SC_T + (tt_)) * 16 + h] = sp; } while (0)
#define SC_DERIVE(raw0, raw1, rawv, nblk, buf) do { if (prod) { SC_DERIVE1(raw0, nblk, buf, ptt); SC_DERIVE1(raw1, nblk, buf, ptt + 16); } \
        if (vld) { LAS float* vb_ = VB + (buf) * SC_VB + lane; \
            vb_[0] = bflo(rawv.x); vb_[SC_TP] = bfhi(rawv.x); vb_[2 * SC_TP] = bflo(rawv.y); vb_[3 * SC_TP] = bfhi(rawv.y); vb_[4 * SC_TP] = bflo(rawv.z); vb_[5 * SC_TP] = bfhi(rawv.z); vb_[6 * SC_TP] = bflo(rawv.w); vb_[7 * SC_TP] = bfhi(rawv.w); } } while (0)
#define SC_YOUT1(nblk, buf, tt_) do { const int rp_ = lane & 3; const LAS float* yp_ = YP + (buf) * SC_YP + (2 * rp_) * 16 * SC_TP + (tt_); \
            float y0_ = 0.f, y1_ = 0.f; \
            _Pragma("unroll") for (int j_ = 0; j_ < 16; ++j_) { y0_ += yp_[j_ * SC_TP]; y1_ += yp_[(16 + j_) * SC_TP]; } \
            *(unsigned*)(Y + (rowbase + (size_t)(nblk) * SC_T + (tt_)) * D + cb + rg * 8 + 2 * rp_) = pk2(y0_, y1_); } while (0)
#define SC_YOUT(nblk, buf) do { SC_YOUT1(nblk, buf, lane >> 2); SC_YOUT1(nblk, buf, (lane >> 2) + 16); } while (0)
#define SC_BAR() asm volatile("s_waitcnt lgkmcnt(0)\n\ts_barrier" ::: "memory")
#define SC_LDOPS(N, B, W_, K_, R_, t) do { const LAS float* o_ = ops + (t) * 320; N = *(const LAS f32x4*)(o_); B = *(const LAS f32x4*)(o_ + 64); W_ = *(const LAS f32x4*)(o_ + 128); K_ = *(const LAS f32x4*)(o_ + 192); R_ = *(const LAS f32x4*)(o_ + 256); } while (0)
#define SC_CONSUME(buf) do { const LAS float* ops = OPS + (buf) * SC_OPS + 4 * jq; const LAS float* vb = VB + (buf) * SC_VB + rl * SC_TP; LAS float* yp = YP + (buf) * SC_YP + (rl * 16 + jq) * SC_TP; \
            f32x4 nk, bb, dw, km, rr, nk2, bb2, dw2, km2, rr2; SC_LDOPS(nk, bb, dw, km, rr, 0); SC_LDOPS(nk2, bb2, dw2, km2, rr2, 1); \
            f32x4 v4 = *(const LAS f32x4*)(vb), v4n = *(const LAS f32x4*)(vb + 4), yacc = {0.f, 0.f, 0.f, 0.f}; \
            _Pragma("unroll") for (int tt = 0; tt < SC_T; ++tt) { \
                f32x4 nk3 = nk2, bb3 = bb2, dw3 = dw2, km3 = km2, rr3 = rr2; \
                if (tt + 2 < SC_T) SC_LDOPS(nk3, bb3, dw3, km3, rr3, tt + 2); \
                asm volatile("" ::: "memory"); \
                const float vi = v4[tt & 3]; \
                const f32x2 t_ = S01 * nk.lo + S23 * nk.hi; \
                const f32x2 P01 = S01 * dw.lo + km.lo * vi, P23 = S23 * dw.hi + km.hi * vi; \
                const float sa = allreduce16(t_.x + t_.y); \
                S01 = P01 + bb.lo * sa; S23 = P23 + bb.hi * sa; \
                const f32x2 y_ = S01 * rr.lo + S23 * rr.hi; \
                yacc[tt & 3] = y_.x + y_.y; \
                if ((tt & 3) == 3) { *(LAS f32x4*)(yp + (tt - 3)) = yacc; v4 = v4n; if (tt + 5 < SC_T) v4n = *(const LAS f32x4*)(vb + tt + 5); } \
                nk = nk2; bb = bb2; dw = dw2; km = km2; rr = rr2; nk2 = nk3; bb2 = bb3; dw2 = dw3; km2 = km3; rr2 = rr3; } } while (0)
        SC_LOAD(rawA0, rawA1, rawvA, 0); SC_DERIVE(rawA0, rawA1, rawvA, 0, 0); SC_LOAD(rawB0, rawB1, rawvB, 1); SC_LOAD(rawA0, rawA1, rawvA, 2);
        __syncthreads();
        for (int n = 0; n < SC_NB; n += 2) {
            if (cons) { SC_CONSUME(0); }
            else { SC_DERIVE(rawB0, rawB1, rawvB, n + 1, 1); if (n + 3 < SC_NB) SC_LOAD(rawB0, rawB1, rawvB, n + 3);
                if (ywr && n >= 1) SC_YOUT(n - 1, 1); }
            SC_BAR();
            if (cons) { SC_CONSUME(1); }
            else { if (n + 2 < SC_NB) { SC_DERIVE(rawA0, rawA1, rawvA, n + 2, 0); if (n + 4 < SC_NB) SC_LOAD(rawA0, rawA1, rawvA, n + 4); }
                if (ywr) SC_YOUT(n, 0); }
            SC_BAR();
        }
        if (ywr) SC_YOUT(SC_NB - 1, 1);
        __syncthreads();
#undef SC_LOAD1
#undef SC_LOAD
#undef SC_DERIVE1
#undef SC_DERIVE
#undef SC_YOUT1
#undef SC_YOUT
#undef SC_CONSUME
#undef SC_LDOPS
#undef SC_BAR
    }
}

struct Args { const void* in[31]; float* out; unsigned char* ws; };
__global__ void __launch_bounds__(NWAVES * 64, 2) mk_fwd(Args args) {
    extern __shared__ __attribute__((aligned(16))) unsigned char lds[];
    cg::grid_group grid = cg::this_grid();
    LAS unsigned char* L = (LAS unsigned char*)lds;
    const int G = gridDim.x; const int bx = blockIdx.x; const int vcu = (G % 8 == 0) ? (bx % 8) * (G / 8) + bx / 8 : bx;
    const int NGW = G * NWAVES;
    { volatile LAS unsigned* st0 = (volatile LAS unsigned*)(L + 131072 + 1024); if (threadIdx.x < 2) st0[threadIdx.x] = 0u; __syncthreads(); }
    const XcdBarrier xbar = xcd_barrier_post((unsigned*)args.ws, (volatile LAS unsigned*)(L + 131072 + 1024));
#define PH_IDS() int tid_ = threadIdx.x; asm volatile("" : "+v"(tid_)); const int tid = tid_, lane = tid & 63, wave = __builtin_amdgcn_readfirstlane(tid >> 6); const int gw = vcu * NWAVES + wave; LAS float* scr = (LAS float*)(L + wave * 16384); (void)scr; (void)gw; (void)lane
    typedef const void* cvp_t; typedef const __attribute__((address_space(4))) cvp_t* kargp_t;
#define KP_(k) (((kargp_t)kp_)[k])
#define PH_PTRS() const __attribute__((address_space(4))) char* kp_ = (const __attribute__((address_space(4))) char*)__builtin_amdgcn_kernarg_segment_ptr(); asm volatile("" : "+s"(kp_)); \
    In I; I.x = (const float*)KP_(0); I.pos = (const int*)KP_(1); I.a_norm = (const float*)KP_(2); I.a_mu = (const float*)KP_(3); I.a_w_in = (const float*)KP_(4); I.a_w0 = (const float*)KP_(5); I.a_w1 = (const float*)KP_(6); I.a_w2 = (const float*)KP_(7); I.a_a0 = (const float*)KP_(8); I.a_a1 = (const float*)KP_(9); I.a_a2 = (const float*)KP_(10); I.a_v0 = (const float*)KP_(11); I.a_v1 = (const float*)KP_(12); I.a_v2 = (const float*)KP_(13); I.a_k_k = (const float*)KP_(14); I.a_k_a = (const float*)KP_(15); I.a_r_k = (const float*)KP_(16); I.a_ln_w = (const float*)KP_(17); I.a_ln_b = (const float*)KP_(18); I.a_w_out = (const float*)KP_(19); I.kv_norm = (const float*)KP_(20); I.w_kv = (const float*)KP_(21); I.b_norm = (const float*)KP_(22); I.b_w_in = (const float*)KP_(23); I.b_lq1 = (const float*)KP_(24); I.b_lk1 = (const float*)KP_(25); I.b_lq2 = (const float*)KP_(26); I.b_lk2 = (const float*)KP_(27); I.b_subln = (const float*)KP_(28); I.b_w_out = (const float*)KP_(29); I.final_norm = (const float*)KP_(30); \
    float* XS = (float*)KP_(31); unsigned char* ws = (unsigned char*)KP_(32); \
    float* rc = (float*)(ws + WS_ROPE_C); float* rs = (float*)(ws + WS_ROPE_S); float* SB = (float*)(ws + WS_S); unsigned char* wreg = ws + WS_W; \
    bf16* U0 = (bf16*)(ws + WS_U); bf16* U1 = (bf16*)(ws + WS_U + UNIT); bf16* U2 = (bf16*)(ws + WS_U + 2 * UNIT); bf16* U3 = (bf16*)(ws + WS_U + 3 * UNIT); \
    bf16* U4 = (bf16*)(ws + WS_U + 4 * UNIT); bf16* U5 = (bf16*)(ws + WS_U + 5 * UNIT); bf16* U6 = (bf16*)(ws + WS_U + 6 * UNIT); bf16* HB = (bf16*)(ws + WS_H); \
    (void)I; (void)XS; (void)rc; (void)rs; (void)SB; (void)wreg; (void)U0; (void)U1; (void)U2; (void)U3; (void)U4; (void)U5; (void)U6; (void)HB

    for (int rp = 0; rp < REP_PASS; ++rp) { PH_IDS(); PH_PTRS(); rope_tables(I.pos, rc, rs, vcu * 512 + tid, G * 512);
    conv_rwkv(I, 0, wreg, (float*)(ws + WS_BIAS), scr, gw, NGW, lane);
    pre_rwkv(I.x, I.a_norm, I.a_mu, U0, UNIT / 2, U4, gw, NGW, lane); }
    grid.sync();

    for (int rp = 0; rp < REP_SYNC; ++rp) xcd_barrier(xbar);
#pragma nounroll
    for (int l = 0; l < 2; ++l) {
#pragma nounroll
        for (int ph = 0; ph < 3; ++ph) {
            const int nq = (ph == 0) ? 1 : 2;
#pragma nounroll
            for (int q = 0; q < nq; ++q) {
                PH_PTRS();
                const int gi = (ph == 0) ? 4 : (ph - 1) * 2 + q;
                const bf16* Ag = (gi == 4) ? U4 : (const bf16*)(ws + WS_U + (size_t)gi * UNIT);
                const bf16* Bg = (gi == 4) ? (const bf16*)(wreg + W_DOWN) : (const bf16*)(wreg + W_RKVG) + (size_t)gi * 1024 * 1024;
                bf16* Dg = (gi == 0) ? U4 : (gi == 1) ? U5 : (gi == 2) ? ((l == 0) ? U6 : U0) : U1;
                const int Ng = (gi == 4) ? 256 : 1024, Kg = (gi == 4) ? 2048 : 1024;
                pg8::Gemm g{Ag, Bg, M, Ng, Kg}; pg8::StaticOrder S; S.init(M, Ng, G, bx);
                pg8::EpiFold E{Dg, HB, (gi == 4) ? 1 : 0};
                pg8::gemm_phase<pg8::EpiFold, pg8::StaticOrder, true, true>(L, g, S, E);
            }
            if (ph < 2) xcd_barrier(xbar);
        }
        xcd_barrier(xbar);
        {
            PH_PTRS(); bf16* Vl = (l == 0) ? U6 : U0;
            const int NUP = (l == 0) ? 2048 : 3072;
            pg8::Gemm g{HB, (const bf16*)(wreg + W_UP), M, NUP, 256}; pg8::StaticOrder S; S.init(M, NUP, G, bx);
            pg8::EpiLoraUp E{(const float*)(ws + WS_BIAS), (_Float16*)U2, (_Float16*)U3, Vl, U6};
            pg8::gemm_phase<pg8::EpiLoraUp, pg8::StaticOrder, true, false>(L, g, S, E);
        }
        xcd_barrier(xbar);
#pragma nounroll
        for (int rp = 0; rp < REP_SCAN; ++rp) { if (rp) xcd_barrier(xbar); PH_IDS(); PH_PTRS(); bf16* Vl = (l == 0) ? U6 : U0; bf16* Yl = (l == 0) ? U0 : U6; scan_phase(L, U4, U5, Vl, (const _Float16*)U2, (const _Float16*)U3, I.a_k_k + l * 1024, I.a_k_a + l * 1024, I.a_r_k + l * 1024, Yl, SB, vcu, G, tid, wave, lane); }
        xcd_barrier(xbar);
        for (int rp = 0; rp < REP_PASS; ++rp) { PH_IDS(); PH_PTRS(); bf16* Vl = (l == 0) ? U6 : U0; bf16* Yl = (l == 0) ? U0 : U6; post_rwkv(Yl, SB, Vl, U1, I.a_ln_w + l * 1024, I.a_ln_b + l * 1024, U4, gw, NGW, lane); }
        xcd_barrier(xbar);
        {
            PH_PTRS(); const float* xin = (l == 0) ? I.x : XS;
            pg8::Gemm g{U4, (const bf16*)(wreg + W_OUT), M, 1024, 1024}; pg8::StaticOrder S; S.init(M, 1024, G, bx);
            pg8::EpiResid E{xin, XS};
            pg8::gemm_phase<pg8::EpiResid, pg8::StaticOrder, true, true>(L, g, S, E);
        }
        xcd_barrier(xbar);
        for (int rp = 0; rp < REP_PASS; ++rp) { PH_IDS(); PH_PTRS(); if (l == 0) { conv_rwkv(I, 1, wreg, (float*)(ws + WS_BIAS), scr, gw, NGW, lane); pre_rwkv(XS, I.a_norm + 1024, I.a_mu + 6 * 1024, U0, UNIT / 2, U4, gw, NGW, lane); }
        else { conv_attn(I, 0, wreg, scr, gw, NGW, lane); pre_attn(XS, U0, gw, NGW, lane); } }
        xcd_barrier(xbar);
    }

#pragma nounroll
    for (int j = 0; j < 2; ++j) {
        {
            PH_PTRS();
            const int NP = (j == 0) ? 4096 : 2048;
            pg8::Gemm g{U0, (const bf16*)(wreg + W_PROJ), M, NP, 1024}; pg8::StaticOrder S; S.init(M, NP, G, bx);
            pg8::EpiProj E;
            if (j == 0) { E.d0 = U1; E.d1 = U2; E.d2 = U3; E.d3 = U4; E.ropemask = 0x5; E.scalemask = QSCALE_MASK0; }
            else { E.d0 = U3; E.d1 = U4; E.d2 = U3; E.d3 = U4; E.ropemask = 0x1; E.scalemask = QSCALE_MASK1; }
            E.sc = C2F; E.rc = rc; E.rs = rs;
            pg8::gemm_phase<pg8::EpiProj, pg8::StaticOrder, true, true>(L, g, S, E);
        }
        xcd_barrier(xbar);
#pragma nounroll
        for (int rp = 0; rp < REP_ATTN; ++rp) {
            if (rp) xcd_barrier(xbar);
            PH_PTRS();
#ifdef ATTN_D64
            const attn_body::AttnTensors AT{(const attn_body::bf16*)U3, (const attn_body::bf16*)U1, (const attn_body::bf16*)U2, (attn_body::bf16*)U5, (attn_body::bf16*)U6};
            attn_body::attn_phase<8>((char*)lds, AT, vcu, G);
#else
            const attn128::AttnTensors AT{U3, U1, U2, U5, U6};
            attn128::attn_phase((char*)lds, AT, vcu, G);
#endif
        }
        xcd_barrier(xbar);
        for (int rp = 0; rp < REP_PASS; ++rp) {
            PH_IDS(); PH_PTRS();
            const float e1 = __expf(wave_sum(I.b_lq1[j * 64 + lane] * I.b_lk1[j * 64 + lane])), e2 = __expf(wave_sum(I.b_lq2[j * 64 + lane] * I.b_lk2[j * 64 + lane]));
            const float lam_init = (j == 0) ? 0.4707130183435842f : 0.5560582041556406f;
            post_attn(U5, U6, U4, I.b_subln + j * 128, e1 - e2 + lam_init, lam_init, U0, gw, NGW, lane);
        }
        xcd_barrier(xbar);
        {
            PH_PTRS();
            pg8::Gemm g{U0, (const bf16*)(wreg + W_BOUT), M, 1024, 1024}; pg8::StaticOrder S; S.init(M, 1024, G, bx);
            pg8::EpiResid E{XS, XS};
            pg8::gemm_phase<pg8::EpiResid, pg8::StaticOrder, true, true>(L, g, S, E);
        }
        xcd_barrier(xbar);
        if (j == 0) { for (int rp = 0; rp < REP_PASS; ++rp) { PH_IDS(); PH_PTRS(); conv_attn(I, 1, wreg, scr, gw, NGW, lane); pre_attn(XS, U0, gw, NGW, lane); } xcd_barrier(xbar); }
    }
    { PH_IDS(); PH_PTRS(); final_norm_rows(XS, I.final_norm, XS, gw, NGW, lane); }
}

extern "C" void kernel_launch(void* const* d_in, const int* in_sizes, int n_in, void* d_out, int out_size, void* d_ws, size_t ws_size, hipStream_t stream) {
    static int grid = 0;
    if (grid == 0) {
        if (n_in != 31 || in_sizes[0] != M * D || out_size != M * D || ws_size < WS_END) { fprintf(stderr, "kernel_launch: unexpected shapes (n_in %d, in0 %d, out %d, ws %zu < %zu)\n", n_in, n_in > 0 ? in_sizes[0] : -1, out_size, ws_size, (size_t)WS_END); grid = -1; return; }
        int dev = 0, cus = 0, per_cu = 0;
        hipGetDevice(&dev); hipDeviceGetAttribute(&cus, hipDeviceAttributeMultiprocessorCount, dev);
        if (hipFuncSetAttribute((const void*)mk_fwd, hipFuncAttributeMaxDynamicSharedMemorySize, LDS_BYTES) != hipSuccess) { fprintf(stderr, "kernel_launch: hipFuncSetAttribute failed\n"); grid = -1; return; }
        if (hipOccupancyMaxActiveBlocksPerMultiprocessor(&per_cu, (const void*)mk_fwd, NWAVES * 64, LDS_BYTES) != hipSuccess || per_cu < 1) { fprintf(stderr, "kernel_launch: occupancy query says %d\n", per_cu); per_cu = 1; }
        (void)hipGetLastError();
        grid = cus;
    }
    if (grid < 0) return;
    if (hipMemsetAsync(d_ws, 0, 16384, stream) != hipSuccess) { fprintf(stderr, "kernel_launch: memset of the barrier words failed\n"); return; }
    Args a{};
    for (int i = 0; i < 31; ++i) a.in[i] = d_in[i];
    a.out = (float*)d_out; a.ws = (unsigned char*)d_ws;
    void* kargs[] = {&a};
    hipError_t e = hipLaunchCooperativeKernel((const void*)mk_fwd, dim3(grid), dim3(NWAVES * 64), kargs, LDS_BYTES, stream);
    if (e != hipSuccess) fprintf(stderr, "kernel_launch: cooperative launch failed: %s (grid %d)\n", hipGetErrorString(e), grid);
}
```

```cpp
#include <hip/hip_runtime.h>
#include <hip/hip_cooperative_groups.h>
#include <cstdio>
#include <cstdint>
namespace cg = cooperative_groups;
namespace pg8 {
#define PG8_LAS __attribute__((address_space(3)))
typedef unsigned short bf16_t;
typedef short bf16x8 __attribute__((ext_vector_type(8)));
typedef float f32x4 __attribute__((ext_vector_type(4)));
typedef unsigned u32x4 __attribute__((ext_vector_type(4)));
constexpr int BM = 256, BK = 64, HALF = 128, HTB = HALF * BK * 2  , STAGE_BYTES = 8 * HTB, NXCD = 8, WGM = 8;

__host__ __device__ __forceinline__ int lds_byte(int r, int c) { const int st = (r >> 4) * 2 + (c >> 5), rr = r & 15, cc = c & 31, ob = rr * 64 + cc * 2; return st * 1024 + (ob ^ (((ob >> 9) & 1) << 5)); }
__host__ __device__ __forceinline__ void stage_rc(int b, int& R, int& C) { const int st = b / 1024, sb = b % 1024, swz = sb ^ (((sb >> 9) & 1) << 5); R = (st >> 1) * 16 + swz / 64; C = (st & 1) * 32 + (swz % 64) / 2; }
__host__ __device__ __forceinline__ int perm32(int rho) { const int n = rho >> 4, i = rho & 15; return 8 * (i >> 2) + 4 * n + (i & 3); }

struct Unit { int pm, pn; };
struct Gemm { const bf16_t* A; const bf16_t* Bt; int M, N, K; };

struct StaticOrder {
    int nM, nN, nwg, G, c;
    __host__ __device__ void init(int M, int N, int G_, int c_) { nM = M / BM; nN = N / BM; nwg = nM * nN; G = G_; c = c_; }
    __host__ __device__ bool next(int i, Unit& u) const {
        const long L = (long)i * G + c; if (L >= nwg) return false;
        int wgid = (int)L; { const int q = nwg / NXCD, r = nwg % NXCD, xcd = wgid % NXCD, off = wgid / NXCD; wgid = (xcd < r ? xcd * (q + 1) : r * (q + 1) + (xcd - r) * q) + off; }
        const int nig = WGM * nN, gid = wgid / nig, fm = gid * WGM, gsz = (nM - fm) < WGM ? (nM - fm) : WGM;
        u.pm = fm + ((wgid % nig) % gsz); u.pn = (wgid % nig) / gsz; return true;
    }
    __device__ __forceinline__ void a_ready(const Unit&) const {}
    __device__ __forceinline__ void done(const Unit&) const {}
};

__device__ __forceinline__ unsigned cvt_pk_bf16(float lo, float hi) { unsigned r; asm volatile("v_cvt_pk_bf16_f32 %0, %1, %2" : "=v"(r) : "v"(lo), "v"(hi)); return r; }
typedef float f32x2 __attribute__((ext_vector_type(2)));
typedef _Float16 h16x4 __attribute__((ext_vector_type(4)));
typedef unsigned u32x2 __attribute__((ext_vector_type(2)));
__device__ __forceinline__ float sigmoidf_(float z) { return 1.0f / (1.0f + __expf(-z)); }
__device__ __forceinline__ float tanhf_(float x) { const float t = __expf(-2.0f * fabsf(x)); const float r = (1.0f - t) / (1.0f + t); return x < 0.f ? -r : r; }
__device__ __forceinline__ float bf_lo(unsigned w) { return __uint_as_float(w << 16); }
__device__ __forceinline__ float bf_hi(unsigned w) { return __uint_as_float(w & 0xffff0000u); }

struct EpiFold {
    static constexpr bool PERM = true, AFTER_DRAIN = false;
    bf16_t *R, *H; int hmode;
    __device__ __forceinline__ void operator()(const f32x4 (&acc)[2][2][4][2], const Unit& u, int wr, int wc, int fr, int fq) const {
        const int row0 = u.pm * BM + wr * 64 + fr;
        bf16_t* base = hmode ? H : R; const int ldc = hmode ? 256 : 1024;
        const int col0 = u.pn * 256 + wc * 32 + 8 * fq;
        const bool th = (hmode != 0) && (wc < 2);
#pragma unroll
        for (int ai = 0; ai < 2; ++ai)
#pragma unroll
            for (int m = 0; m < 4; ++m) { bf16_t* rowp = base + (size_t)(row0 + ai * HALF + m * 16) * ldc + col0;
#pragma unroll
                for (int bj = 0; bj < 2; ++bj) { f32x4 v0 = acc[ai][bj][m][0], v1 = acc[ai][bj][m][1];
                    if (th && bj == 0) {
#pragma unroll
                        for (int i = 0; i < 4; ++i) { v0[i] = tanhf_(v0[i]); v1[i] = tanhf_(v1[i]); } }
                    u32x4 w; w.x = cvt_pk_bf16(v0[0], v0[1]); w.y = cvt_pk_bf16(v0[2], v0[3]); w.z = cvt_pk_bf16(v1[0], v1[1]); w.w = cvt_pk_bf16(v1[2], v1[3]);
                    *(u32x4*)(rowp + bj * HALF) = w; }
                asm volatile("" ::: "memory"); }
    }
};

struct EpiLoraUp {
    static constexpr bool PERM = false, AFTER_DRAIN = false;
    const float* bias3; _Float16 *Wb, *Ab; bf16_t* Vb; const bf16_t* Vf;
    __device__ __forceinline__ void operator()(const f32x4 (&acc)[2][2][4][2], const Unit& u, int wr, int wc, int fr_unused, int fq_unused) const {
        int t_ = threadIdx.x; asm volatile("" : "+v"(t_)); const int fr = t_ & 15, fq = (t_ >> 4) & 3;
        const int row0 = u.pm * BM + wr * 64 + fr;
        const int t = u.pn >> 2;
        const int cc0 = (u.pn & 3) * 256 + wc * 32 + 4 * fq;
        const float* bias = bias3 + t * 1024;
#pragma unroll
        for (int bj = 0; bj < 2; ++bj)
#pragma unroll
            for (int n = 0; n < 2; ++n) { const int c = cc0 + bj * HALF + n * 16; const f32x4 bv = *(const f32x4*)(bias + c);
#pragma unroll
                for (int ai = 0; ai < 2; ++ai)
#pragma unroll
                    for (int m = 0; m < 4; ++m) { const size_t off = (size_t)(row0 + ai * HALF + m * 16) * 1024 + c; const f32x4 z = acc[ai][bj][m][n] + bv;
                        if (t == 0) { h16x4 o;
#pragma unroll
                            for (int i = 0; i < 4; ++i) { const float zz = -z[i]; const float sp = fmaxf(zz, 0.f) + __logf(1.0f + __expf(-fabsf(zz))); o[i] = (_Float16)(-sp - 0.5f); }
                            *(h16x4*)(Wb + off) = o; }
                        else if (t == 1) { h16x4 o;
#pragma unroll
                            for (int i = 0; i < 4; ++i) o[i] = (_Float16)sigmoidf_(z[i]);
                            *(h16x4*)(Ab + off) = o; }
                        else { const u32x2 vv = *(const u32x2*)(Vb + off), vf = *(const u32x2*)(Vf + off);
                            const float v_0 = bf_lo(vv.x), v_1 = bf_hi(vv.x), v_2 = bf_lo(vv.y), v_3 = bf_hi(vv.y);
                            const float f_0 = bf_lo(vf.x), f_1 = bf_hi(vf.x), f_2 = bf_lo(vf.y), f_3 = bf_hi(vf.y);
                            u32x2 o; o.x = cvt_pk_bf16(v_0 + (f_0 - v_0) * sigmoidf_(z[0]), v_1 + (f_1 - v_1) * sigmoidf_(z[1]));
                            o.y = cvt_pk_bf16(v_2 + (f_2 - v_2) * sigmoidf_(z[2]), v_3 + (f_3 - v_3) * sigmoidf_(z[3]));
                            *(u32x2*)(Vb + off) = o; }
                        asm volatile("" ::: "memory"); } }
    }
};

struct EpiProj {
    static constexpr bool PERM = true, AFTER_DRAIN = false;
    bf16_t *d0, *d1, *d2, *d3; int ropemask, scalemask; float sc; const float* rc; const float* rs;
    __device__ __forceinline__ void operator()(const f32x4 (&acc)[2][2][4][2], const Unit& u, int wr, int wc, int fr, int fq) const {
        const int row0 = u.pm * BM + wr * 64 + fr;
        const int t = u.pn >> 2;
        bf16_t* base = (t == 0) ? d0 : (t == 1) ? d1 : (t == 2) ? d2 : d3;
        const int col0 = (u.pn & 3) * 256 + wc * 32 + 8 * fq;
        const bool rope = (((ropemask >> t) & 1) != 0) && ((wc & 1) == 0);
        const float s = ((scalemask >> t) & 1) ? sc : 1.0f;
        const float sgn = (fq == 0) ? -1.0f : 1.0f;
#pragma unroll
        for (int ai = 0; ai < 2; ++ai)
#pragma unroll
            for (int m = 0; m < 4; ++m) { const int row = row0 + ai * HALF + m * 16; bf16_t* rowp = base + (size_t)row * 1024 + col0;
                f32x4 c0 = {1.f, 1.f, 1.f, 1.f}, c1 = c0, s0 = {0.f, 0.f, 0.f, 0.f}, s1 = s0;
                if (rope) { c0 = *(const f32x4*)(rc + (size_t)row * 8); c1 = *(const f32x4*)(rc + (size_t)row * 8 + 4); s0 = *(const f32x4*)(rs + (size_t)row * 8); s1 = *(const f32x4*)(rs + (size_t)row * 8 + 4); }
#pragma unroll
                for (int bj = 0; bj < 2; ++bj) { f32x4 v0 = acc[ai][bj][m][0], v1 = acc[ai][bj][m][1];
                    if (rope) { f32x4 p0, p1;
#pragma unroll
                        for (int i = 0; i < 4; ++i) { p0[i] = __shfl_xor(v0[i], 16); p1[i] = __shfl_xor(v1[i], 16); }
                        if (fq < 2) { v0 = v0 * c0 + (p0 * s0) * sgn; v1 = v1 * c1 + (p1 * s1) * sgn; } }
                    v0 = v0 * s; v1 = v1 * s;
                    u32x4 w; w.x = cvt_pk_bf16(v0[0], v0[1]); w.y = cvt_pk_bf16(v0[2], v0[3]); w.z = cvt_pk_bf16(v1[0], v1[1]); w.w = cvt_pk_bf16(v1[2], v1[3]);
                    *(u32x4*)(rowp + bj * HALF) = w; }
                asm volatile("" ::: "memory"); }
    }
};

struct EpiResid {
    static constexpr bool PERM = false, AFTER_DRAIN = false;
    const float* base; float* out;
    __device__ __forceinline__ void operator()(const f32x4 (&acc)[2][2][4][2], const Unit& u, int wr, int wc, int fr, int fq) const {
        const int row0 = u.pm * BM + wr * 64 + fr;
        const int col0 = u.pn * BM + wc * 32 + 4 * fq;
#pragma unroll
        for (int ai = 0; ai < 2; ++ai)
#pragma unroll
            for (int m = 0; m < 4; ++m) { const size_t off = (size_t)(row0 + ai * HALF + m * 16) * 1024 + col0;
#pragma unroll
                for (int bj = 0; bj < 2; ++bj)
#pragma unroll
                    for (int n = 0; n < 2; ++n) { const f32x4 b = *(const f32x4*)(base + off + bj * HALF + n * 16); *(f32x4*)(out + off + bj * HALF + n * 16) = b + acc[ai][bj][m][n]; }
                asm volatile("" ::: "memory"); }
    }
};
template <class Epi, class Sched, bool ALIGN_EPI = false, bool SP2 = false>
__device__ __forceinline__ void gemm_phase(PG8_LAS unsigned char* lds, const Gemm g, const Sched& S, const Epi& E) {
    int tid_ = threadIdx.x; asm volatile("" : "+v"(tid_));
    const int tid = tid_, wid = __builtin_amdgcn_readfirstlane(tid >> 6), lane = tid & 63, wr = wid >> 2, wc = wid & 3, fr = lane & 15, fq = lane >> 4;
    const int K = g.K, nt = K / BK;
    unsigned voffA[2], voffB[2];
#pragma unroll
    for (int i = 0; i < 2; ++i) { int R, C; stage_rc(tid * 16 + i * 8192, R, C); const int Rb = Epi::PERM ? ((R & ~31) + perm32(R & 31)) : R;
        voffA[i] = (unsigned)(R * K + C) * 2u; voffB[i] = (unsigned)(Rb * K + C) * 2u; }
    const size_t kstep = (size_t)(BK * 2);
    const size_t hstep = (size_t)HALF * K * 2;
    const size_t tstep = 2 * hstep;
    const unsigned ldsw = (unsigned)wid * 1024u;
    const int aoff = lds_byte(wr * 64 + fr, fq * 8), boff = lds_byte(wc * 32 + fr, fq * 8);
#define PG8_SA(b, h) (((b) * 2 + (h)) * HTB)
#define PG8_SB(b, h) ((4 + (b) * 2 + (h)) * HTB)
#define PG8_STAGE(bufoff, gbase, voff) do { _Pragma("unroll") for (int _i = 0; _i < 2; ++_i) \
        __builtin_amdgcn_global_load_lds((const unsigned*)((const char*)(gbase) + (voff)[_i]), (PG8_LAS unsigned*)(lds + (bufoff) + ldsw + _i * 8192), 16, 0, 0); } while (0)
#define PG8_LDA(dst, b, h) do { _Pragma("unroll") for (int m = 0; m < 4; ++m) _Pragma("unroll") for (int k = 0; k < 2; ++k) dst[m][k] = *(const PG8_LAS bf16x8*)(lds + PG8_SA(b, h) + aoff + m * 2048 + k * 1024); } while (0)
#define PG8_LDB(dst, b, h) do { _Pragma("unroll") for (int n = 0; n < 2; ++n) _Pragma("unroll") for (int k = 0; k < 2; ++k) dst[n][k] = *(const PG8_LAS bf16x8*)(lds + PG8_SB(b, h) + boff + n * 2048 + k * 1024); } while (0)
#define PG8_MMA(ai, bj, At, Bt) do { __builtin_amdgcn_s_setprio(1); _Pragma("unroll") for (int m = 0; m < 4; ++m) _Pragma("unroll") for (int n = 0; n < 2; ++n) _Pragma("unroll") for (int k = 0; k < 2; ++k) \
        acc[ai][bj][m][n] = __builtin_amdgcn_mfma_f32_16x16x32_bf16(Bt[n][k], At[m][k], acc[ai][bj][m][n], 0, 0, 0); __builtin_amdgcn_s_setprio(0); } while (0)
#define PG8_WAIT_V(n) asm volatile("s_waitcnt vmcnt(" #n ")" ::: "memory")
#define PG8_WAIT_L(n) asm volatile("s_waitcnt lgkmcnt(" #n ")" ::: "memory")
#define PG8_BAR __builtin_amdgcn_s_barrier()
#define PG8_SCHED __builtin_amdgcn_sched_barrier(0)
    Unit cur, nxt; int ui = 0;
    if (!S.next(0, cur)) return;
    f32x4 acc[2][2][4][2];
#pragma unroll
    for (int a = 0; a < 2; ++a)
#pragma unroll
        for (int b = 0; b < 2; ++b)
#pragma unroll
            for (int m = 0; m < 4; ++m)
#pragma unroll
                for (int n = 0; n < 2; ++n) acc[a][b][m][n] = (f32x4){0.f, 0.f, 0.f, 0.f};
    bf16x8 At[4][2], B0[2][2], B1[2][2];
    const char* cA = (const char*)g.A + (size_t)cur.pm * tstep; const char* cB = (const char*)g.Bt + (size_t)cur.pn * tstep;
    S.a_ready(cur);
    if constexpr (SP2) {
        PG8_STAGE(PG8_SB(0, 0), cB, voffB); PG8_STAGE(PG8_SB(0, 1), cB + hstep, voffB); PG8_STAGE(PG8_SA(0, 0), cA, voffA); PG8_STAGE(PG8_SA(0, 1), cA + hstep, voffA);
        if (wr == 1) PG8_BAR;
        PG8_WAIT_V(2); PG8_BAR;
        PG8_STAGE(PG8_SB(1, 0), cB + kstep, voffB); PG8_STAGE(PG8_SA(1, 0), cA + kstep, voffA); PG8_STAGE(PG8_SB(1, 1), cB + hstep + kstep, voffB);
        PG8_WAIT_V(6); PG8_BAR;
    } else {
        PG8_STAGE(PG8_SB(0, 0), cB, voffB); PG8_STAGE(PG8_SA(0, 0), cA, voffA); PG8_STAGE(PG8_SB(0, 1), cB + hstep, voffB); PG8_STAGE(PG8_SA(0, 1), cA + hstep, voffA);
        if (wr == 1) PG8_BAR;
        PG8_WAIT_V(4); PG8_BAR;
        PG8_STAGE(PG8_SB(1, 0), cB + kstep, voffB); PG8_STAGE(PG8_SA(1, 0), cA + kstep, voffA); PG8_STAGE(PG8_SB(1, 1), cB + hstep + kstep, voffB);
        PG8_WAIT_V(6); PG8_BAR;
    }
    for (;;) {
        const bool has_next = S.next(ui + 1, nxt);
        const char* nA = has_next ? (const char*)g.A + (size_t)nxt.pm * tstep : cA; const char* nB = has_next ? (const char*)g.Bt + (size_t)nxt.pn * tstep : cB;
        for (int t = 0; t < nt; t += 2) {
            const bool last = (t == nt - 2);
            const char* a1 = cA + (size_t)(t + 1) * kstep;
            const char* a2 = last ? nA : cA + (size_t)(t + 2) * kstep; const char* b2 = last ? nB : cB + (size_t)(t + 2) * kstep;
            const char* a3 = a2 + kstep; const char* b3 = b2 + kstep;
            if (last && has_next) S.a_ready(nxt);
            if constexpr (SP2) {
            PG8_LDB(B0, 0, 0); PG8_LDB(B1, 0, 1); PG8_SCHED; PG8_LDA(At, 0, 0); PG8_STAGE(PG8_SA(1, 1), a1 + hstep, voffA);
            PG8_WAIT_V(8); PG8_WAIT_L(0); PG8_BAR; PG8_MMA(0, 0, At, B0); PG8_MMA(0, 1, At, B1); PG8_BAR; PG8_SCHED;
            PG8_LDA(At, 0, 1); PG8_STAGE(PG8_SB(0, 0), b2, voffB); PG8_STAGE(PG8_SB(0, 1), b2 + hstep, voffB); PG8_STAGE(PG8_SA(0, 0), a2, voffA);
            PG8_WAIT_V(8); PG8_WAIT_L(0); PG8_BAR; PG8_MMA(1, 0, At, B0); PG8_MMA(1, 1, At, B1); PG8_BAR; PG8_SCHED;
            PG8_LDB(B0, 1, 0); PG8_LDB(B1, 1, 1); PG8_SCHED; PG8_LDA(At, 1, 0); PG8_STAGE(PG8_SA(0, 1), a2 + hstep, voffA);
            PG8_WAIT_V(8); PG8_WAIT_L(0); PG8_BAR; PG8_MMA(0, 0, At, B0); PG8_MMA(0, 1, At, B1); PG8_BAR; PG8_SCHED;
            PG8_LDA(At, 1, 1); PG8_STAGE(PG8_SB(1, 0), b3, voffB); PG8_STAGE(PG8_SB(1, 1), b3 + hstep, voffB); PG8_STAGE(PG8_SA(1, 0), a3, voffA);
            PG8_WAIT_V(8); PG8_WAIT_L(0); PG8_BAR; PG8_MMA(1, 0, At, B0); PG8_MMA(1, 1, At, B1); PG8_BAR; PG8_SCHED;
            } else {
            PG8_LDB(B0, 0, 0); PG8_SCHED; PG8_LDA(At, 0, 0); PG8_STAGE(PG8_SA(1, 1), a1 + hstep, voffA);
            PG8_WAIT_L(8); PG8_BAR; PG8_WAIT_L(0); PG8_MMA(0, 0, At, B0); PG8_BAR; PG8_SCHED;
            PG8_LDB(B1, 0, 1); PG8_STAGE(PG8_SB(0, 0), b2, voffB);
            PG8_BAR; PG8_WAIT_L(0); PG8_MMA(0, 1, At, B1); PG8_BAR;
            PG8_LDA(At, 0, 1); PG8_STAGE(PG8_SA(0, 0), a2, voffA);
            PG8_BAR; PG8_WAIT_L(0); PG8_MMA(1, 0, At, B0); PG8_BAR; PG8_SCHED;
            PG8_STAGE(PG8_SB(0, 1), b2 + hstep, voffB);
            PG8_WAIT_V(6); PG8_BAR; PG8_MMA(1, 1, At, B1); PG8_BAR;
            PG8_LDB(B0, 1, 0); PG8_SCHED; PG8_LDA(At, 1, 0); PG8_STAGE(PG8_SA(0, 1), a2 + hstep, voffA);
            PG8_WAIT_L(8); PG8_BAR; PG8_WAIT_L(0); PG8_MMA(0, 0, At, B0); PG8_BAR; PG8_SCHED;
            PG8_LDB(B1, 1, 1); PG8_STAGE(PG8_SB(1, 0), b3, voffB);
            PG8_BAR; PG8_WAIT_L(0); PG8_MMA(0, 1, At, B1); PG8_BAR;
            PG8_LDA(At, 1, 1); PG8_STAGE(PG8_SA(1, 0), a3, voffA);
            PG8_BAR; PG8_WAIT_L(0); PG8_MMA(1, 0, At, B0); PG8_BAR; PG8_SCHED;
            PG8_STAGE(PG8_SB(1, 1), b3 + hstep, voffB);
            PG8_WAIT_V(6); PG8_BAR; PG8_MMA(1, 1, At, B1); PG8_BAR;
            }
        }
        if constexpr (ALIGN_EPI) { if (wr == 0) PG8_BAR; }
        if constexpr (!Epi::AFTER_DRAIN) { E(acc, cur, wr, wc, fr, fq); S.done(cur); }
        if (!has_next) break;
#pragma unroll
        for (int a = 0; a < 2; ++a)
#pragma unroll
            for (int b = 0; b < 2; ++b)
#pragma unroll
                for (int m = 0; m < 4; ++m)
#pragma unroll
                    for (int n = 0; n < 2; ++n) acc[a][b][m][n] = (f32x4){0.f, 0.f, 0.f, 0.f};
        cur = nxt; cA = nA; cB = nB; ++ui;
        if constexpr (ALIGN_EPI) { if (wr == 1) PG8_BAR; }
    }
    PG8_WAIT_V(0);
    if constexpr (!ALIGN_EPI) { if (wr == 0) PG8_BAR; }
    PG8_BAR;
    if constexpr (Epi::AFTER_DRAIN) { E.fused(acc, cur, wr, wc, fr, fq, lds, wid, lane); S.done(cur); }
#undef PG8_SA
#undef PG8_SB
#undef PG8_STAGE
#undef PG8_LDA
#undef PG8_LDB
#undef PG8_MMA
#undef PG8_WAIT_V
#undef PG8_WAIT_L
#undef PG8_BAR
#undef PG8_SCHED
}
}

#include <hip/hip_bf16.h>
#include <cmath>
namespace attn_body {
using bf16=__hip_bfloat16;
using bf16x8=__attribute__((ext_vector_type(8)))short;
using s16x4=__attribute__((ext_vector_type(4)))short;
using f32x16=__attribute__((ext_vector_type(16)))float;
using u32x4=__attribute__((ext_vector_type(4)))unsigned;
constexpr int BATCH=2,NHEAD=16,SEQ=16384,D=64,DM=NHEAD*D;
constexpr int NW=8,QBLK=32,QB=QBLK*NW,KVBLK=64,NQB=SEQ/QB;
constexpr int ATTN_PITCH=DM, ATTN_UNIT_ROWS=QB;
__device__ __forceinline__ int crow(int r,int hi){return (r&3)+8*(r>>2)+4*hi;}
#define SBAR() __builtin_amdgcn_sched_barrier(0)
__device__ __forceinline__ void cmask(f32x16&p0,f32x16&p1,int jb,int qrel,int hi){
  const float NEG=-INFINITY; int kb=64*jb+4*hi;
  #pragma unroll
  for(int r=0;r<16;++r){int kv=kb+(r&3)+8*(r>>2); if(kv>qrel)p0[r]=NEG; if(kv+32>qrel)p1[r]=NEG;}
}

constexpr int NSLOT=3, SLOTB=8192;
constexpr int LDS_K=0, LDS_V=NSLOT*SLOTB, LDS_WS=2*NSLOT*SLOTB, LDS_OST=LDS_WS+NW*64*4, LDS_BYTES=LDS_OST+NW*4096;
constexpr float C2=0.125f*1.4426950408889634f;
__device__ __forceinline__ void glds16(const void*gsrc,unsigned lds_dst){unsigned keep;
  asm volatile("s_mov_b32 %0, m0\n\ts_mov_b32 m0, %2\n\ts_nop 0\n\tglobal_load_lds_dwordx4 %1, off\n\ts_mov_b32 m0, %0":"=&s"(keep):"v"(gsrc),"s"(lds_dst):"memory");}
__device__ __forceinline__ float max3f(float a,float b,float c){float r;asm("v_max3_f32 %0, %1, %2, %3":"=v"(r):"v"(a),"v"(b),"v"(c));return r;}
__device__ __forceinline__ float max2f(float a,float b){float r;asm("v_max_f32_e32 %0, %1, %2":"=v"(r):"v"(a),"v"(b));return r;}
__device__ __forceinline__ float fadd_s(float a,float b){float r;asm("v_add_f32_e32 %0, %1, %2":"=v"(r):"v"(a),"v"(b));return r;}
__device__ __forceinline__ float fsub_s(float a,float b){float r;asm("v_sub_f32_e32 %0, %1, %2":"=v"(r):"v"(a),"v"(b));return r;}
typedef float f32x2_t __attribute__((ext_vector_type(2))); typedef __bf16 bf16x2_t __attribute__((ext_vector_type(2)));
__device__ __forceinline__ unsigned cvtpk_s(float lo,float hi){f32x2_t v={lo,hi};bf16x2_t b=__builtin_convertvector(v,bf16x2_t);return __builtin_bit_cast(unsigned,b);}
#define WAIT_BAR(N) asm volatile("s_waitcnt vmcnt(" #N ") lgkmcnt(0)\n\ts_barrier":::"memory")

__device__ __forceinline__ void qkt(f32x16&p0,f32x16&p1,const char*Kslot,const bf16x8*qr,const f32x16&negm,int r32,int hi){
  const char*kb=Kslot+hi*1024+r32*16;
  #pragma unroll
  for(int d0=0;d0<4;++d0){
    const bf16x8 b0=*reinterpret_cast<const bf16x8*>(kb+d0*2048);
    const bf16x8 b1=*reinterpret_cast<const bf16x8*>(kb+d0*2048+512);
    if(d0==0){p0=__builtin_amdgcn_mfma_f32_32x32x16_bf16(b0,qr[0],negm,0,0,0);p1=__builtin_amdgcn_mfma_f32_32x32x16_bf16(b1,qr[0],negm,0,0,0);}
    else{p0=__builtin_amdgcn_mfma_f32_32x32x16_bf16(b0,qr[d0],p0,0,0,0);p1=__builtin_amdgcn_mfma_f32_32x32x16_bf16(b1,qr[d0],p1,0,0,0);}}
}
typedef __attribute__((address_space(3))) const char* lds_cptr;
typedef short v4i16_t __attribute__((ext_vector_type(4)));
__device__ __forceinline__ void kload8(bf16x8*kf,lds_cptr kp){
  kf[0]=*(const __attribute__((address_space(3))) bf16x8*)(kp);      kf[1]=*(const __attribute__((address_space(3))) bf16x8*)(kp+512);
  kf[2]=*(const __attribute__((address_space(3))) bf16x8*)(kp+2048); kf[3]=*(const __attribute__((address_space(3))) bf16x8*)(kp+2560);
  kf[4]=*(const __attribute__((address_space(3))) bf16x8*)(kp+4096); kf[5]=*(const __attribute__((address_space(3))) bf16x8*)(kp+4608);
  kf[6]=*(const __attribute__((address_space(3))) bf16x8*)(kp+6144); kf[7]=*(const __attribute__((address_space(3))) bf16x8*)(kp+6656);
}
__device__ __forceinline__ void kload2(bf16x8*kf,lds_cptr kp,int j){ kf[2*j]=*(const __attribute__((address_space(3))) bf16x8*)(kp+j*2048); kf[2*j+1]=*(const __attribute__((address_space(3))) bf16x8*)(kp+j*2048+512); }
__device__ __forceinline__ s16x4 vtr(lds_cptr p){ return __builtin_bit_cast(s16x4,__builtin_amdgcn_ds_read_tr16_b64_v4i16((__attribute__((address_space(3))) v4i16_t*)p)); }
__device__ __forceinline__ float rowmax(const f32x16&p0,const f32x16&p1){
  float a=max3f(p0[0],p0[1],p1[0]),b=max3f(p0[2],p0[3],p1[1]);a=max3f(a,p1[2],p1[3]);
  #pragma unroll
  for(int r=4;r<16;r+=4){a=max3f(a,p0[r],p0[r+1]);b=max3f(b,p0[r+2],p0[r+3]);a=max3f(a,p1[r],p1[r+1]);b=max3f(b,p1[r+2],p1[r+3]);}
  const float m=max2f(a,b);
  auto rr=__builtin_amdgcn_permlane32_swap(__float_as_uint(m),__float_as_uint(m),false,false);
  return max2f(__uint_as_float(rr[0]),__uint_as_float(rr[1]));
}
__device__ __forceinline__ void pv(f32x16*o,int vb,bf16x8 pa0,bf16x8 pa1,bf16x8 pa2,bf16x8 pa3){
  #pragma unroll
  for(int d0=0;d0<2;++d0){s16x4 lo[4],hi[4];
    #pragma unroll
    for(int ks=0;ks<4;++ks){
      asm volatile("ds_read_b64_tr_b16 %0,%1 offset:%c2":"=&v"(lo[ks]):"v"(vb),"i"(d0*4096+ks*1024):"memory");
      asm volatile("ds_read_b64_tr_b16 %0,%1 offset:%c2":"=&v"(hi[ks]):"v"(vb),"i"(d0*4096+ks*1024+512):"memory");}
    asm volatile("s_waitcnt lgkmcnt(0)":::"memory");SBAR();
    #define PK(k) (bf16x8){lo[k][0],lo[k][1],lo[k][2],lo[k][3],hi[k][0],hi[k][1],hi[k][2],hi[k][3]}
    o[d0]=__builtin_amdgcn_mfma_f32_32x32x16_bf16(pa0,PK(0),o[d0],0,0,0);
    o[d0]=__builtin_amdgcn_mfma_f32_32x32x16_bf16(pa1,PK(1),o[d0],0,0,0);
    o[d0]=__builtin_amdgcn_mfma_f32_32x32x16_bf16(pa2,PK(2),o[d0],0,0,0);
    o[d0]=__builtin_amdgcn_mfma_f32_32x32x16_bf16(pa3,PK(3),o[d0],0,0,0);
    #undef PK
  }
}

#ifndef ATTN_STORE16
#define ATTN_STORE16(p,v) (*(u32x4*)(p)=(v))
#endif
template<int THRL> __device__ __forceinline__ void attn_unit(int b,int cq,int cv,int qb,const bf16*Q,const bf16*__restrict__ K,const bf16*__restrict__ V,bf16*O,char*shm){
  int tid_=threadIdx.x; asm volatile("":"+v"(tid_)); const int tid=tid_,lane=tid&63,r32=lane&31,hi=lane>>5; const int wid=__builtin_amdgcn_readfirstlane(tid>>6);
  const long rowbase=(long)b*SEQ; const int q0=qb*QB;
  const bf16*Qw=Q+(rowbase+q0+wid*QBLK)*DM+cq;
  const bf16*Kh=K+rowbase*DM+cq,*Vh=V+rowbase*DM+cv;
  const unsigned lds0=(unsigned)(uintptr_t)shm;
  float*wsf=(float*)(shm+LDS_WS)+wid*64;
  const bf16*ksrc=Kh+(long)lane*DM+wid*8;
  const bf16*vsrc=Vh+(long)(16*(wid&3)+(lane>>2))*DM+(wid>>2)*32+(lane&3)*8;
  const unsigned kdst=lds0+LDS_K+wid*1024, vdst=lds0+LDS_V+wid*1024;
  #define DMA_K(t,slot) glds16(ksrc+(long)(t)*KVBLK*DM,(unsigned)__builtin_amdgcn_readfirstlane(kdst+(slot)))
  #define DMA_V(t,slot) glds16(vsrc+(long)(t)*KVBLK*DM,(unsigned)__builtin_amdgcn_readfirstlane(vdst+(slot)))
  const int vb0=(int)(lds0+LDS_V)+((lane>>4)&1)*32+(lane&3)*8+(4*hi+((lane&15)>>2))*64;
  const char*Kbase=shm+LDS_K; bf16x8 kf[8];
  const lds_cptr shm3=(lds_cptr)shm; const lds_cptr kp0=shm3+LDS_K+hi*1024+r32*16; const lds_cptr vp0=shm3+LDS_V+((lane>>4)&1)*32+(lane&3)*8+(4*hi+((lane&15)>>2))*64;
  const int NT=(q0+QB)/KVBLK;
  DMA_K(0,0);DMA_V(0,0);DMA_K(1,SLOTB);
  bf16x8 qr[4];
  #pragma unroll
  for(int d0=0;d0<4;++d0)qr[d0]=*reinterpret_cast<const bf16x8*>(&Qw[(long)r32*DM+d0*16+hi*8]);
  float mhat=0.f,l_reg=0.f;f32x16 o[2];o[0]=f32x16{};o[1]=f32x16{};f32x16 negm=f32x16{};asm volatile("":"+v"(negm));
  const int qrel=wid*QBLK+r32;
  #define CMASK(P0,P1,t) do{int jb_=(t)-(NT-4); if(jb_>=0)cmask(P0,P1,jb_,qrel,hi);}while(0)
  bool resc=false;
  #define START(P0,P1) do{ const float rm=rowmax(P0,P1); resc=false; \
    { const float dl=rm; mhat=fadd_s(mhat,dl); \
      _Pragma("unroll") for(int r=0;r<16;++r){P0[r]=fsub_s(P0[r],dl);P1[r]=fsub_s(P1[r],dl);} \
      _Pragma("unroll") for(int r=0;r<16;++r)negm[r]=-mhat; asm volatile("":"+v"(negm)); } \
    _Pragma("unroll") for(int r=0;r<16;++r)P0[r]=__builtin_amdgcn_exp2f(P0[r]); }while(0)
  #define RESC() do{ if(resc){ asm volatile("s_waitcnt lgkmcnt(0)":::"memory"); \
      _Pragma("unroll") for(int d_=0;d_<2;++d_) _Pragma("unroll") for(int r=0;r<16;++r)o[d_][r]*=wsf[crow(r,hi)]; } }while(0)
  f32x16 pA0,pA1,pB0,pB1;
  int sl_prev=0,sl_cur=0,sl_next=SLOTB;
  #define ROT() do{sl_prev=sl_cur;sl_cur=sl_next;sl_next=(sl_next==(NSLOT-1)*SLOTB)?0:sl_next+SLOTB;}while(0)
  DMA_K(2,2*SLOTB);
  WAIT_BAR(3);
  qkt(pA0,pA1,Kbase,qr,negm,r32,hi);asm volatile("s_nop 15\n\ts_nop 7":"+v"(pA0),"+v"(pA1));CMASK(pA0,pA1,0);
  START(pA0,pA1);
  _Pragma("unroll") for(int r=0;r<16;++r)pA1[r]=__builtin_amdgcn_exp2f(pA1[r]);
  WAIT_BAR(0);
  DMA_K(3,0);DMA_V(1,SLOTB);
  ROT();
  kload8(kf,kp0+sl_cur);
  WAIT_BAR(2);
  s16x4 vlo[8],vhi[8]; u32x4 pw0,pw1,pw2,pw3;
  #define PKW(P,B) cvtpk_s(P[B],P[B+1])
  #define PAF(k) __builtin_bit_cast(bf16x8,pw##k)
  #define VFR(i) (bf16x8){vlo[i][0],vlo[i][1],vlo[i][2],vlo[i][3],vhi[i][0],vhi[i][1],vhi[i][2],vhi[i][3]}
  #define PIN(x) asm volatile("":"+v"(x))
  #define MX3(a,b,c) __builtin_fmaxf(__builtin_fmaxf((a),(b)),(c))
  #define GAPA(MF,A0,A1,A2,A3,W0,W1,PW) do{ MF; sacc+=A0; sacc+=A1; sacc+=A2; sacc+=A3; PIN(sacc); W0; W1; PIN(PW); SBAR(); }while(0)
  #define EX(v) __builtin_amdgcn_exp2f(v)
  #define GAPB(MF,X,B) do{ MF; X[B]=EX(X[B]); X[B+1]=EX(X[B+1]); X[B+2]=EX(X[B+2]); X[B+3]=EX(X[B+3]); PIN(X); SBAR(); }while(0)
  #define VRD(i) do{ vlo[i]=vtr(vp_+(((i)>>2)*4096+((i)&3)*1024)); vhi[i]=vtr(vp_+(((i)>>2)*4096+((i)&3)*1024+512)); }while(0)
  #define KRD(G,j) do{ if(G){ kload2(kf,kp0+sl_next,j); SBAR(); } }while(0)
  #define STEP(C0,C1,P0,P1,t,GK,GV,GL) do{ SBAR(); \
    const lds_cptr vp_=vp0+sl_prev; \
    VRD(0); SBAR(); float sacc=(P0[0]+P0[1]); \
    GAPA(C0=__builtin_amdgcn_mfma_f32_32x32x16_bf16(kf[0],qr[0],negm,0,0,0), P0[2],P0[3],P0[4],P0[5],     pw0[0]=PKW(P0,0), pw0[1]=PKW(P0,2), pw0); \
    VRD(4); SBAR(); GAPA(C1=__builtin_amdgcn_mfma_f32_32x32x16_bf16(kf[1],qr[0],negm,0,0,0), P0[6],P0[7],P0[8],P0[9],     pw0[2]=PKW(P0,4), pw0[3]=PKW(P0,6), pw0); \
    VRD(1); SBAR(); GAPA(C0=__builtin_amdgcn_mfma_f32_32x32x16_bf16(kf[2],qr[1],C0,0,0,0),   P0[10],P0[11],P0[12],P0[13], pw1[0]=PKW(P0,8), pw1[1]=PKW(P0,10), pw1); \
    VRD(5); SBAR(); GAPA(C1=__builtin_amdgcn_mfma_f32_32x32x16_bf16(kf[3],qr[1],C1,0,0,0),   P0[14],P0[15],P1[0],P1[1],   pw1[2]=PKW(P0,12),pw1[3]=PKW(P0,14), pw1); \
    VRD(2); SBAR(); GAPA(C0=__builtin_amdgcn_mfma_f32_32x32x16_bf16(kf[4],qr[2],C0,0,0,0),   P1[2],P1[3],P1[4],P1[5],     pw2[0]=PKW(P1,0), pw2[1]=PKW(P1,2), pw2); \
    VRD(6); SBAR(); GAPA(C1=__builtin_amdgcn_mfma_f32_32x32x16_bf16(kf[5],qr[2],C1,0,0,0),   P1[6],P1[7],P1[8],P1[9],     pw2[2]=PKW(P1,4), pw2[3]=PKW(P1,6), pw2); \
    VRD(3); SBAR(); GAPA(C0=__builtin_amdgcn_mfma_f32_32x32x16_bf16(kf[6],qr[3],C0,0,0,0),   P1[10],P1[11],P1[12],P1[13], pw3[0]=PKW(P1,8), pw3[1]=PKW(P1,10), pw3); \
    VRD(7); SBAR(); GAPA(C1=__builtin_amdgcn_mfma_f32_32x32x16_bf16(kf[7],qr[3],C1,0,0,0),   P1[14],P1[15],0.f,0.f,       pw3[2]=PKW(P1,12),pw3[3]=PKW(P1,14), pw3); \
    l_reg+=sacc; \
    if(GK){DMA_K((t)+3,sl_cur);} if(GV){DMA_V((t)+1,sl_next);} \
    CMASK(C0,C1,t); \
    { float a=MX3(C0[0],C0[1],C1[0]),b=MX3(C0[2],C0[3],C1[1]); a=MX3(a,C1[2],C1[3]); \
      _Pragma("unroll") for(int r=4;r<16;r+=4){a=MX3(a,C0[r],C0[r+1]);b=MX3(b,C0[r+2],C0[r+3]);a=MX3(a,C1[r],C1[r+1]);b=MX3(b,C1[r+2],C1[r+3]);} \
      float rm=__builtin_fmaxf(a,b); { auto rr=__builtin_amdgcn_permlane32_swap(__float_as_uint(rm),__float_as_uint(rm),false,false); rm=__builtin_fmaxf(__uint_as_float(rr[0]),__uint_as_float(rr[1])); } \
      resc=false; \
      if(__builtin_expect(__any(rm>(float)THRL),0)){ const float dl=__builtin_fmaxf(rm,0.f); mhat+=dl; \
        _Pragma("unroll") for(int r=0;r<16;++r){C0[r]-=dl;C1[r]-=dl;} \
        _Pragma("unroll") for(int r=0;r<16;++r)negm[r]=-mhat; asm volatile("":"+v"(negm)); \
        const float f=__builtin_amdgcn_exp2f(-dl); l_reg*=f; if(hi==0)wsf[r32]=f; resc=true; } } \
    SBAR(); \
    GAPB(o[0]=__builtin_amdgcn_mfma_f32_32x32x16_bf16(PAF(0),VFR(0),o[0],0,0,0), C0,0); \
    GAPB(o[1]=__builtin_amdgcn_mfma_f32_32x32x16_bf16(PAF(0),VFR(4),o[1],0,0,0), C0,4); \
    KRD(GL,0); GAPB(o[0]=__builtin_amdgcn_mfma_f32_32x32x16_bf16(PAF(1),VFR(1),o[0],0,0,0), C0,8); \
    KRD(GL,1); GAPB(o[1]=__builtin_amdgcn_mfma_f32_32x32x16_bf16(PAF(1),VFR(5),o[1],0,0,0), C0,12); \
    KRD(GL,2); GAPB(o[0]=__builtin_amdgcn_mfma_f32_32x32x16_bf16(PAF(2),VFR(2),o[0],0,0,0), C1,0); \
    KRD(GL,3); GAPB(o[1]=__builtin_amdgcn_mfma_f32_32x32x16_bf16(PAF(2),VFR(6),o[1],0,0,0), C1,4); \
    GAPB(o[0]=__builtin_amdgcn_mfma_f32_32x32x16_bf16(PAF(3),VFR(3),o[0],0,0,0), C1,8); \
    GAPB(o[1]=__builtin_amdgcn_mfma_f32_32x32x16_bf16(PAF(3),VFR(7),o[1],0,0,0), C1,12); \
    }while(0)
  int t=1;
  #undef CMASK
  #define CMASK(P0,P1,t) do{}while(0)
  for(;t+5<NT;t+=2){
    STEP(pB0,pB1,pA0,pA1,t,true,true,true);     WAIT_BAR(2); RESC(); ROT();
    STEP(pA0,pA1,pB0,pB1,t+1,true,true,true);   WAIT_BAR(2); RESC(); ROT();
  }
  #undef CMASK
  #define CMASK(P0,P1,t) do{int jb_=(t)-(NT-4); if(jb_>=0)cmask(P0,P1,jb_,qrel,hi);}while(0)
  #define ENDW(tt) do{ if((tt)+3<NT){WAIT_BAR(2);} else if((tt)+2<NT){WAIT_BAR(1);} else {WAIT_BAR(0);} }while(0)
  for(;t+1<NT;t+=2){
    STEP(pB0,pB1,pA0,pA1,t,(t+3<NT),(t+1<NT),(t+1<NT));       ENDW(t);   RESC(); ROT();
    STEP(pA0,pA1,pB0,pB1,t+1,(t+4<NT),(t+2<NT),(t+2<NT));     ENDW(t+1); RESC(); ROT();
  }
  STEP(pB0,pB1,pA0,pA1,NT-1,false,false,false); RESC();
  { float sacc=pB0[0]+pB0[1]; _Pragma("unroll") for(int r=2;r<16;++r)sacc+=pB0[r]; _Pragma("unroll") for(int r=0;r<16;++r)sacc+=pB1[r]; l_reg+=sacc;
    pw0=(u32x4){PKW(pB0,0),PKW(pB0,2),PKW(pB0,4),PKW(pB0,6)};pw1=(u32x4){PKW(pB0,8),PKW(pB0,10),PKW(pB0,12),PKW(pB0,14)};pw2=(u32x4){PKW(pB1,0),PKW(pB1,2),PKW(pB1,4),PKW(pB1,6)};pw3=(u32x4){PKW(pB1,8),PKW(pB1,10),PKW(pB1,12),PKW(pB1,14)};
    SBAR(); pv(o,vb0+sl_cur,PAF(0),PAF(1),PAF(2),PAF(3)); }
  #undef PKW
  #undef PAF
  #undef VFR
  #undef PIN
  #undef MX3
  #undef GAPA
  #undef GAPB
  #undef EX
  #undef VRD
  #undef KRD
  #undef STEP
  #undef ENDW
  {auto rr=__builtin_amdgcn_permlane32_swap(__float_as_uint(l_reg),__float_as_uint(l_reg),false,false);l_reg=__uint_as_float(rr[0])+__uint_as_float(rr[1]);}
  if(hi==0)wsf[32+r32]=l_reg;asm volatile("s_waitcnt lgkmcnt(0)":::"memory");
  float rli[16];
  #pragma unroll
  for(int r=0;r<16;++r)rli[r]=__builtin_amdgcn_rcpf(wsf[32+crow(r,hi)]);
  bf16*Ow=O+(rowbase+q0+wid*QBLK)*DM+cv;
  { bf16*stg=(bf16*)(shm+LDS_OST)+wid*2048;
    #pragma unroll
    for(int r=0;r<16;++r){const int orow=crow(r,hi);
      #pragma unroll
      for(int d0=0;d0<2;++d0)stg[orow*64+d0*32+r32]=__float2bfloat16(o[d0][r]*rli[r]);}
    asm volatile("s_waitcnt lgkmcnt(0)":::"memory");
    #pragma unroll
    for(int i=0;i<4;++i){const int row=i*8+(lane>>3),ch=lane&7; const u32x4 v=*(const u32x4*)(stg+row*64+ch*8); ATTN_STORE16(Ow+(long)row*DM+ch*8,v);} }
  asm volatile("s_waitcnt lgkmcnt(0)\n\ts_barrier":::"memory");
  #undef DMA_K
  #undef DMA_V
  #undef CMASK
  #undef START
  #undef RESC
  #undef ROT
}
constexpr int ATTN_LDS_BYTES=LDS_BYTES;
struct AttnTensors { const bf16* Q; const bf16* K; const bf16* V; bf16* O0; bf16* O1; };
template<int THRL> __device__ __forceinline__ void attn_phase(char*lds,const AttnTensors&T,int vcu,int G){
  for(int v=vcu;v<256;v+=G){
    const int e=v>>2,s=v&3; const int b=e>>5,rem=e&31,h=rem>>2,m=(rem>>1)&1,vh=rem&1;
    const int cq=(2*h+m)*64,cv=(2*h+vh)*64; bf16*O=m?T.O1:T.O0;
    for(int i=0;i<16;++i){ const int j=i>>1; const int qb=(i&1)?(8*j+7-s):(8*j+s); attn_unit<THRL>(b,cq,cv,qb,T.Q,T.K,T.V,O,lds); }
  }
}
#undef SBAR
#undef WAIT_BAR
}

namespace attn128 {
constexpr int D = 128, PITCH = 1024, SEQ = 16384;
constexpr float THR = 8.f; constexpr bool WSKIP = false;
constexpr float SCALE = 0.125f;
constexpr int NW = 8, QBLK = 32, KVBLK = 64, QB = NW * QBLK;
constexpr int SHM_V = KVBLK * D * 2, SHM_K = KVBLK * 64 * 2;
constexpr int LDS_BYTES = 2 * SHM_V + 2 * SHM_K + NW * 64 * 4;
using bf16 = unsigned short;
typedef short bf16x8 __attribute__((ext_vector_type(8)));
typedef short s16x4 __attribute__((ext_vector_type(4)));
typedef float f32x16 __attribute__((ext_vector_type(16)));
typedef float f32x4 __attribute__((ext_vector_type(4)));
typedef unsigned u32x4 __attribute__((ext_vector_type(4)));
template <class A, class Bt> struct same_t { static constexpr bool v = false; };
template <class A> struct same_t<A, A> { static constexpr bool v = true; };

#define KSWZ(row, colB) ((row) * 128 + ((colB) ^ (((row) & 7) << 4)))
#define SBAR() __builtin_amdgcn_sched_barrier(0)
__device__ __forceinline__ int v_st(int k, int c) { const int kk = (k & ~0xC) | ((k & 4) << 1) | ((k & 8) >> 1); return ((kk >> 3) * 4 + (c >> 5)) * 512 + ((kk & 7) * 32 + (c & 31)) * 2; }
__device__ __forceinline__ int v_rd_base(int lane) { return ((lane & 3) << 3) | (((lane >> 2) & 3) << 6) | (((lane >> 4) & 1) << 5) | (((lane >> 5) & 1) << 8); }
constexpr int v_rd_off(int d0, int ks, int half) { return d0 * 512 + ks * 4096 + half * 2048; }
__device__ __forceinline__ int crow(int r, int hi) { return (r & 3) + 8 * (r >> 2) + 4 * hi; }
__device__ __forceinline__ unsigned cvtpk(float lo, float hi) {
    unsigned r; asm volatile("v_cvt_pk_bf16_f32 %0, %1, %2" : "=v"(r) : "v"(lo), "v"(hi)); return r;
}
__device__ __forceinline__ bf16x8 pack8(f32x4 a, f32x4 b) {
    u32x4 w = {cvtpk(a[0], a[1]), cvtpk(a[2], a[3]), cvtpk(b[0], b[1]), cvtpk(b[2], b[3])};
    return *reinterpret_cast<bf16x8*>(&w);
}
template <class T> __device__ __forceinline__ bf16x8 load8(const T* p) {
    if constexpr (same_t<T, float>::v) { return pack8(*(const f32x4*)p, *(const f32x4*)(p + 4)); }
    else { return *reinterpret_cast<const bf16x8*>(p); }
}
__device__ __forceinline__ void mask_tile(f32x16& p0, f32x16& p1, int dq, unsigned W) {
    const float NEG = -__builtin_inff();
#pragma unroll
    for (int r = 0; r < 16; ++r) {
        const int c = (r & 3) + 8 * (r >> 2);
        if ((unsigned)(dq - c) >= W) p0[r] = NEG;
        if ((unsigned)(dq - c - 32) >= W) p1[r] = NEG;
    }
}
template <bool FIRST> __device__ __forceinline__ void partialSM(f32x16& p0, f32x16& p1, float& m_reg, float& mn, float& alpha, f32x16& negm) {
    float pmax = p0[0]; for (int r = 1; r < 16; ++r) pmax = fmaxf(pmax, p0[r]); for (int r = 0; r < 16; ++r) pmax = fmaxf(pmax, p1[r]);
    { auto rr = __builtin_amdgcn_permlane32_swap(__float_as_uint(pmax), __float_as_uint(pmax), false, false);
      pmax = fmaxf(__uint_as_float(rr[0]), __uint_as_float(rr[1])); }
    constexpr float THR2 = THR * 1.4426950408889634f;
    if (!FIRST && __builtin_expect(__all(pmax <= THR2), 1)) { alpha = 1.f; }
    else { const float d = FIRST ? pmax : fmaxf(pmax, 0.f); m_reg += d; alpha = FIRST ? 1.f : __builtin_amdgcn_exp2f(-d);
        for (int r = 0; r < 16; ++r) { p0[r] -= d; p1[r] -= d; }
        for (int r = 0; r < 16; ++r) negm[r] = -m_reg;
        asm volatile("" : "+v"(negm)); }
    mn = m_reg;
    for (int r = 0; r < 16; ++r) p0[r] = __builtin_amdgcn_exp2f(p0[r]);
}
__device__ __forceinline__ void finishSM(f32x16& p0, f32x16& p1, float alpha, float& l_reg, bf16x8& pa0, bf16x8& pa1, bf16x8& pa2, bf16x8& pa3) {
    for (int r = 0; r < 16; ++r) p1[r] = __builtin_amdgcn_exp2f(p1[r]);
    float ps = 0; for (int r = 0; r < 16; ++r) ps += p0[r]; for (int r = 0; r < 16; ++r) ps += p1[r];
    { auto rr = __builtin_amdgcn_permlane32_swap(__float_as_uint(ps), __float_as_uint(ps), false, false);
      ps = __uint_as_float(rr[0]) + __uint_as_float(rr[1]); }
    l_reg = l_reg * alpha + ps;
#define PK4(P, B_, OUT) do { unsigned a0 = cvtpk(P[B_+0], P[B_+1]), a1 = cvtpk(P[B_+2], P[B_+3]);                          \
        unsigned b0 = cvtpk(P[B_+4], P[B_+5]), b1 = cvtpk(P[B_+6], P[B_+7]);                                             \
        auto r0 = __builtin_amdgcn_permlane32_swap(a0, b0, false, false); auto r1 = __builtin_amdgcn_permlane32_swap(a1, b1, false, false); \
        u32x4 w = {r0[0], r1[0], r0[1], r1[1]}; OUT = *reinterpret_cast<bf16x8*>(&w); } while (0)
    PK4(p0, 0, pa0); PK4(p0, 8, pa1); PK4(p1, 0, pa2); PK4(p1, 8, pa3);
#undef PK4
}
template <int KB, bool SK>
__device__ __forceinline__ void qkt(f32x16& p0, f32x16& p1, const char* K_lds, int r32, int hi, const bf16x8* qr, bool act, int kmo, const f32x16& negm) {
    if (SK && !act) { const float NEG = -__builtin_inff();
#pragma unroll
        for (int r = 0; r < 16; ++r) { p0[r] = NEG; p1[r] = NEG; } return; }
    const char* kb[4];
#pragma unroll
    for (int dd = 0; dd < 4; ++dd) kb[dd] = K_lds + KB * SHM_K + KSWZ(r32, (dd * 16 + hi * 8) * 2);
#pragma unroll
    for (int d0 = 0; d0 < 4; ++d0) { const char* a = kb[d0] + kmo;
        bf16x8 b0 = *reinterpret_cast<const bf16x8*>(a);
        bf16x8 b1 = *reinterpret_cast<const bf16x8*>(a + 32 * 128);
        if (d0 == 0) { p0 = __builtin_amdgcn_mfma_f32_32x32x16_bf16(b0, qr[0], negm, 0, 0, 0); p1 = __builtin_amdgcn_mfma_f32_32x32x16_bf16(b1, qr[0], negm, 0, 0, 0); }
        else { p0 = __builtin_amdgcn_mfma_f32_32x32x16_bf16(b0, qr[d0], p0, 0, 0, 0);
        p1 = __builtin_amdgcn_mfma_f32_32x32x16_bf16(b1, qr[d0], p1, 0, 0, 0); } }
}
template <int VB, bool SK>
__device__ __forceinline__ void pv_tile(f32x16* o, int vb0, bf16x8 pa0, bf16x8 pa1, bf16x8 pa2, bf16x8 pa3, bool act) {
    if (SK && !act) return;
#define TRRD(dst, off) asm volatile("ds_read_b64_tr_b16 %0, %1 offset:%2" : "=&v"(dst) : "v"(vb0), "i"(off) : "memory")
#define PV_D0(d0) do { s16x4 l0, l1, l2, l3, h0, h1, h2, h3; constexpr int b_ = VB * SHM_V + v_rd_off(d0, 0, 0);     \
        TRRD(l0, b_); TRRD(h0, b_ + 2048); TRRD(l1, b_ + 4096); TRRD(h1, b_ + 6144); TRRD(l2, b_ + 8192); TRRD(h2, b_ + 10240); TRRD(l3, b_ + 12288); TRRD(h3, b_ + 14336); \
        asm volatile("s_waitcnt lgkmcnt(0)" ::: "memory"); SBAR();                 \
        o[d0] = __builtin_amdgcn_mfma_f32_32x32x16_bf16(pa0, (bf16x8){l0[0], l0[1], l0[2], l0[3], h0[0], h0[1], h0[2], h0[3]}, o[d0], 0, 0, 0);   \
        o[d0] = __builtin_amdgcn_mfma_f32_32x32x16_bf16(pa1, (bf16x8){l1[0], l1[1], l1[2], l1[3], h1[0], h1[1], h1[2], h1[3]}, o[d0], 0, 0, 0);   \
        o[d0] = __builtin_amdgcn_mfma_f32_32x32x16_bf16(pa2, (bf16x8){l2[0], l2[1], l2[2], l2[3], h2[0], h2[1], h2[2], h2[3]}, o[d0], 0, 0, 0);   \
        o[d0] = __builtin_amdgcn_mfma_f32_32x32x16_bf16(pa3, (bf16x8){l3[0], l3[1], l3[2], l3[3], h3[0], h3[1], h3[2], h3[3]}, o[d0], 0, 0, 0); } while (0)
    PV_D0(0); PV_D0(1); PV_D0(2); PV_D0(3);
#undef PV_D0
#undef TRRD
}

template <class TIn, class TOut> struct BlockRef { const TIn* Q; const TIn* K; const TIn* V; TOut* O; int P0; int kmo; };
template <class TIn> struct Seam {
    bf16x8 qr[4];
    bf16x8 st_v0, st_v1, st_k0, st_k1; f32x4 sf0, sf1, sf2, sf3;
    f32x4 tq[1];
};
__device__ __forceinline__ int swa_jlo(int P0, int W) { const int lowk = P0 - W + 1; return lowk > 0 ? lowk / KVBLK : 0; }
#define ROW(p, k0, rr) ((p) + (size_t)((k0) + (rr)) * PITCH + sc)
#define VMW() asm volatile("s_waitcnt vmcnt(0)" ::: "memory")
#define VMWN(n) asm volatile("s_waitcnt vmcnt(%0)" :: "i"(n) : "memory")
#define SLOAD_H(Kp, Vp, k0) do { S.st_v0 = load8<TIn>(ROW(Vp, k0, sr)); S.st_v1 = load8<TIn>(ROW(Vp, k0, 32 + sr));              \
                         S.st_k0 = load8<TIn>((Kp) + (size_t)((k0) + krow) * PITCH + kcol); } while (0)
#define SWRITE_HK(bf) do { *(bf16x8*)(K_lds + (bf) * SHM_K + kws) = S.st_k0; } while (0)
#define SWRITE_HV(bf) do { *(bf16x8*)(V_lds + (bf) * SHM_V + vst0) = S.st_v0; *(bf16x8*)(V_lds + (bf) * SHM_V + vst1) = S.st_v1; } while (0)
#define SWRITE_H(bf) do { SWRITE_HV(bf); SWRITE_HK(bf); } while (0)
#define SLOAD_F(p, k0) do { S.sf0 = *(const f32x4*)ROW(p, k0, sr); S.sf1 = *(const f32x4*)(ROW(p, k0, sr) + 4);                \
                            S.sf2 = *(const f32x4*)ROW(p, k0, 32 + sr); S.sf3 = *(const f32x4*)(ROW(p, k0, 32 + sr) + 4); } while (0)
#define SWRITE_KF(bf) do { *(bf16x8*)(K_lds + (bf) * SHM_K + kws) = pack8(S.sf0, S.sf1); *(bf16x8*)(K_lds + (bf) * SHM_K + kws + 32 * 256) = pack8(S.sf2, S.sf3); } while (0)
#define SWRITE_VF(bf) do { *(bf16x8*)(V_lds + (bf) * SHM_V + vst0) = pack8(S.sf0, S.sf1); *(bf16x8*)(V_lds + (bf) * SHM_V + vst1) = pack8(S.sf2, S.sf3); } while (0)
template <class TIn, class TOut>
__device__ __forceinline__ void causal_swa_prime(const BlockRef<TIn, TOut>& cur, int W, char* lds, Seam<TIn>& S) {
    constexpr bool F32 = same_t<TIn, float>::v;
    int tid_ = threadIdx.x; asm volatile("" : "+v"(tid_)); const int tid = tid_, wid = __builtin_amdgcn_readfirstlane(tid >> 6), lane = tid & 63, r32 = lane & 31, hi = lane >> 5;
    const int sr = tid >> 4, sc = (tid & 15) * 8, krow = tid >> 3, kcol = (tid & 7) * 8, kws = KSWZ(krow, kcol * 2); char* K_lds = lds + 2 * SHM_V;
    const int kb0 = swa_jlo(cur.P0, W) * KVBLK;
    for (int d0 = 0; d0 < 4; ++d0) S.qr[d0] = load8<TIn>(cur.Q + (size_t)(wid * QBLK + r32) * PITCH + d0 * 16 + hi * 8);
    if constexpr (F32) { SLOAD_F((const float*)cur.K, kb0); VMW(); SWRITE_KF(0); SBAR(); SLOAD_F((const float*)cur.V, kb0); }
    else { SLOAD_H(cur.K, cur.V, kb0); VMW(); SWRITE_HK(0); }
    __syncthreads();
}
template <class TIn, class TOut>
__device__ __forceinline__ void causal_swa_block(const BlockRef<TIn, TOut>& cur, const BlockRef<TIn, TOut>& nxt, int skv, int W, char* lds, Seam<TIn>& S) {
    constexpr bool F32 = same_t<TIn, float>::v;
    int tid_ = threadIdx.x; asm volatile("" : "+v"(tid_)); const int tid = tid_, wid = __builtin_amdgcn_readfirstlane(tid >> 6), lane = tid & 63, r32 = lane & 31, hi = lane >> 5;
    const int j_lo = swa_jlo(cur.P0, W);
    int j_hi = (cur.P0 + QB - 1) / KVBLK + 1; if (j_hi > skv / KVBLK) j_hi = skv / KVBLK;
    const int NT = j_hi - j_lo;
    const int kbn = swa_jlo(nxt.P0, W) * KVBLK;
    const int qlo = cur.P0 + wid * QBLK, qm = qlo + r32 - 4 * hi;
    char* V_lds = lds; char* K_lds = lds + 2 * SHM_V;
    float* ws = (float*)(lds + 2 * SHM_V + 2 * SHM_K) + wid * 64; float* li_l = ws, * al_l = ws + 32;
    float m_reg = 0.f, l_reg = 0; f32x16 o[4] = {}; f32x16 negm = {}; asm volatile("" : "+v"(negm));
    const int sr = tid >> 4, sc = (tid & 15) * 8, vst0 = v_st(sr, sc), vst1 = v_st(32 + sr, sc), krow = tid >> 3, kcol = (tid & 7) * 8, kws = KSWZ(krow, kcol * 2);
    const int vb0 = (int)(uintptr_t)V_lds + v_rd_base(lane);
    const TIn* Kh = cur.K; const TIn* Vh = cur.V;
#define RESC(a) do { if (__any((a) < 1.f)) { if (hi == 0) al_l[r32] = (a); asm volatile("s_waitcnt lgkmcnt(0)" ::: "memory");              \
                     for (int d_ = 0; d_ < 4; ++d_) for (int r = 0; r < 16; ++r) o[d_][r] *= al_l[crow(r, hi)]; } } while (0)
#define KBASE(t) ((j_lo + (t)) * KVBLK)
#define ACT(t) (KBASE(t) <= qlo + QBLK - 1 && KBASE(t) + KVBLK - 1 >= qlo - W + 1)
#define MASKT(P0_, P1_, t) do { const int kb_ = KBASE(t); if ((!SK || ACT(t)) && (kb_ + KVBLK - 1 > qlo || kb_ <= qlo + QBLK - 1 - W)) mask_tile(P0_, P1_, qm - kb_, (unsigned)W); } while (0)
    constexpr int NQL = F32 ? 16 : 4;
    constexpr bool SK = WSKIP && !F32;
#define SEAM_K0() do { VMWN(NQL); if constexpr (F32) { SWRITE_KF(0); SBAR(); SLOAD_F((const float*)nxt.V, kbn); } else { SWRITE_HK(0); } SBAR(); } while (0)
    f32x16 pA0, pA1, pB0, pB1; float mnA, mnB, alA, alB; bf16x8 pa0, pa1, pa2, pa3;
    if constexpr (F32) { VMW(); SWRITE_VF(0); SBAR(); } else { SWRITE_HV(0); SBAR(); }
    if (NT > 1) { if constexpr (F32) SLOAD_F((const float*)Kh, KBASE(1)); else SLOAD_H(Kh, Vh, KBASE(1)); }
    SBAR(); qkt<0, SK>(pA0, pA1, K_lds, r32, hi, S.qr, ACT(0), cur.kmo, negm);
    if constexpr (F32) { if (NT > 1) { VMW(); SWRITE_KF(1); SBAR(); SLOAD_F((const float*)Vh, KBASE(1)); } }
    MASKT(pA0, pA1, 0); partialSM<true>(pA0, pA1, m_reg, mnA, alA, negm);
    if (NT > 1) { VMW(); if constexpr (F32) { SWRITE_VF(1); SBAR(); if (NT > 2) SLOAD_F((const float*)Kh, KBASE(2)); } else SWRITE_H(1); }
    __syncthreads();
#define HALF_STEP(PX0, PX1, mnX, alX, PY0, PY1, alY, t, KB, VB, SB) do {                                                      \
        SBAR(); qkt<KB, SK>(PX0, PX1, K_lds, r32, hi, S.qr, ACT(t), cur.kmo, negm);                                             \
        finishSM(PY0, PY1, alY, l_reg, pa0, pa1, pa2, pa3); SBAR();                                                           \
        if ((t) + 1 < NT) { if constexpr (F32) { VMW(); SWRITE_KF(SB); SBAR(); SLOAD_F((const float*)Vh, KBASE((t) + 1)); }  \
                            else { SLOAD_H(Kh, Vh, KBASE((t) + 1)); } SBAR(); }                                               \
        pv_tile<VB, SK>(o, vb0, pa0, pa1, pa2, pa3, ACT((t) - 1)); MASKT(PX0, PX1, (t)); partialSM<false>(PX0, PX1, m_reg, mnX, alX, negm);                                        \
        __syncthreads();                                                                                                      \
        if ((t) + 1 < NT) { VMW(); if constexpr (F32) { SWRITE_VF(SB); SBAR(); if ((t) + 2 < NT) SLOAD_F((const float*)Kh, KBASE((t) + 2)); } \
                            else { SWRITE_H(SB); } }                                                                          \
        RESC(alX); __syncthreads(); } while (0)
    for (int t = 1; t + 1 < NT; t += 2) {
        HALF_STEP(pB0, pB1, mnB, alB, pA0, pA1, alA, t, 1, 0, 0);
        HALF_STEP(pA0, pA1, mnA, alA, pB0, pB1, alB, t + 1, 0, 1, 1);
    }
    const bool even = (NT & 1) == 0;
    if (even) { SBAR(); qkt<1, SK>(pB0, pB1, K_lds, r32, hi, S.qr, ACT(NT - 1), cur.kmo, negm); SBAR(); }
#define QROW(e) (nxt.Q + (size_t)(wid * QBLK + r32) * D + ((e) >> 1) * 16 + hi * 8 + ((e) & 1) * 4)
    if constexpr (F32) { SLOAD_F((const float*)nxt.K, kbn); SBAR();
#pragma unroll
        for (int e = 0; e < 8; ++e) S.tq[e] = *(const f32x4*)QROW(e); }
    else { SLOAD_H(nxt.K, nxt.V, kbn); SBAR();
#pragma unroll
        for (int d0 = 0; d0 < 4; ++d0) S.qr[d0] = load8<TIn>(nxt.Q + (size_t)(wid * QBLK + r32) * PITCH + d0 * 16 + hi * 8); }
    SBAR();
    finishSM(pA0, pA1, alA, l_reg, pa0, pa1, pa2, pa3); SBAR();
    if constexpr (F32) {
#pragma unroll
        for (int e = 8; e < 16; ++e) S.tq[e] = *(const f32x4*)QROW(e); SBAR(); }
#undef QROW
    pv_tile<0, SK>(o, vb0, pa0, pa1, pa2, pa3, ACT(even ? NT - 2 : NT - 1));
    if (even) { MASKT(pB0, pB1, NT - 1); partialSM<false>(pB0, pB1, m_reg, mnB, alB, negm); __syncthreads(); RESC(alB);
        finishSM(pB0, pB1, alB, l_reg, pa0, pa1, pa2, pa3); SBAR(); pv_tile<1, SK>(o, vb0, pa0, pa1, pa2, pa3, ACT(NT - 1)); }
    SBAR(); SEAM_K0();
    if (hi == 0) li_l[r32] = l_reg; asm volatile("s_waitcnt lgkmcnt(0)" ::: "memory");
    float rli[16];
#pragma unroll
    for (int r = 0; r < 16; ++r) rli[r] = __builtin_amdgcn_rcpf(li_l[crow(r, hi)]);
    TOut* Ow = cur.O + (size_t)(wid * QBLK) * PITCH;
#pragma unroll
    for (int r = 0; r < 16; ++r) { const int orow = crow(r, hi);
#pragma unroll
        for (int d0 = 0; d0 < 4; ++d0) { const float v = o[d0][r] * rli[r];
            if constexpr (same_t<TOut, float>::v) { Ow[(size_t)orow * PITCH + d0 * 32 + r32] = v; }
            else { const float vn = __shfl_xor(v, 1);
                   if ((r32 & 1) == 0) *(unsigned*)(Ow + (size_t)orow * PITCH + d0 * 32 + r32) = cvtpk(v, vn); } } }
    if constexpr (F32) {
#pragma unroll
        for (int d0 = 0; d0 < 8; ++d0) S.qr[d0] = pack8(S.tq[2 * d0], S.tq[2 * d0 + 1]); }
    __syncthreads();
#undef RESC
#undef KBASE
#undef ACT
#undef MASKT
#undef SEAM_K0
#undef HALF_STEP
}
#undef ROW
#undef VMW
#undef VMWN
#undef SLOAD_H
#undef SWRITE_HK
#undef SWRITE_HV
#undef SWRITE_H
#undef SLOAD_F
#undef SWRITE_KF
#undef SWRITE_VF


struct AttnTensors { const bf16* Q; const bf16* K; const bf16* V; bf16* O0; bf16* O1; };
__device__ __forceinline__ BlockRef<bf16, bf16> blk_ref(const AttnTensors& T, int vcu, int G, int li) {
    const int v = vcu + (li >> 3) * G, i = li & 7, e = v >> 3, s = v & 7, b = e >> 4, h = (e >> 1) & 7, m = e & 1, j = i >> 1;
    const int qb = (i & 1) ? (16 * j + 15 - s) : (16 * j + s);
    BlockRef<bf16, bf16> r;
    r.Q = T.Q + ((size_t)b * SEQ + (size_t)qb * QB) * PITCH + h * 128 + m * 64;
    r.K = T.K + (size_t)b * SEQ * PITCH + h * 128 + m * 64; r.V = T.V + (size_t)b * SEQ * PITCH + h * 128;
    r.O = (m ? T.O1 : T.O0) + ((size_t)b * SEQ + (size_t)qb * QB) * PITCH + h * 128;
    r.P0 = qb * QB; r.kmo = 0;
    return r;
}
__device__ __forceinline__ void attn_phase(char* lds, const AttnTensors& T, int vcu, int G) {
    int nv = 0; for (int v = vcu; v < 256; v += G) ++nv;
    const int nblk = nv * 8; if (nblk == 0) return;
    Seam<bf16> S;
    BlockRef<bf16, bf16> cur = blk_ref(T, vcu, G, 0);
    causal_swa_prime<bf16, bf16>(cur, SEQ, lds, S);
    for (int li = 0; li < nblk; ++li) {
        const BlockRef<bf16, bf16> nxt = (li + 1 < nblk) ? blk_ref(T, vcu, G, li + 1) : cur;
        causal_swa_block<bf16, bf16>(cur, nxt, SEQ, SEQ, lds, S);
        cur = nxt;
    }
}
}

#define GAS __attribute__((address_space(1)))
#define LAS __attribute__((address_space(3)))
typedef unsigned short bf16;
typedef unsigned v4u __attribute__((ext_vector_type(4)));
typedef float f32x4 __attribute__((ext_vector_type(4)));
typedef short bf16x8 __attribute__((ext_vector_type(8)));
typedef GAS unsigned gu32;
typedef GAS unsigned long long gu64;
#define RLX_AGENT __ATOMIC_RELAXED, __HIP_MEMORY_SCOPE_AGENT
#define LDS_WAIT() asm volatile("s_waitcnt lgkmcnt(0)" ::: "memory")
#define VM_WAIT() asm volatile("s_waitcnt vmcnt(0)" ::: "memory")
__device__ __forceinline__ unsigned long long rt() { return __builtin_amdgcn_s_memrealtime(); }

#define XB_TMO      128
#define XB_XCNT(j)  (256  + 64 * (j))
#define XB_XSUB(j)  (1280 + 64 * (j))
#define XB_XGEN(j)  (2304 + 64 * (j))
#define XB_TOP      3328
#define XB_TOPGEN   3392
#define XCD_BAR_WORDS 3456
#define XB_SPIN_CAP (1u << 18)

__device__ __forceinline__ unsigned xb_ld(unsigned* p)              { return __hip_atomic_load(p, __ATOMIC_RELAXED, __HIP_MEMORY_SCOPE_AGENT); }
__device__ __forceinline__ unsigned xb_add(unsigned* p, unsigned v) { return __hip_atomic_fetch_add(p, v, __ATOMIC_RELAXED, __HIP_MEMORY_SCOPE_AGENT); }
__device__ __forceinline__ unsigned xb_xcc_id() { return (unsigned)__builtin_amdgcn_s_getreg((3 << 11) | 20) & 0xFu; }
#define XB_SPIN(cond, bar) do { unsigned _sp = 0; while (cond) { __builtin_amdgcn_s_sleep(1); \
    if ((++_sp & 255u) == 0u) { if (xb_ld(&(bar)[XB_TMO])) break; if (_sp > XB_SPIN_CAP) { atomicAdd(&(bar)[XB_TMO], 1u); break; } } } } while (0)

struct XcdBarrier {
    unsigned* bar; unsigned x;
    volatile LAS unsigned* st;
};

__device__ __forceinline__ XcdBarrier xcd_barrier_post(unsigned* bar, volatile LAS unsigned* st) {
    XcdBarrier b; b.bar = bar; b.x = xb_xcc_id(); b.st = st;
    if (threadIdx.x == 0) (void)xb_add(&bar[XB_XCNT(b.x)], 1u);
    return b;
}
__device__ __forceinline__ void xcd_barrier_complete(unsigned* bar, unsigned x, unsigned& nloc, unsigned& nx) {
    const unsigned G = gridDim.x * gridDim.y * gridDim.z;
    unsigned sum, cnt, mine, sp = 0u;
    for (;;) {
        sum = 0u; cnt = 0u; mine = 0u;
#pragma unroll
        for (unsigned j = 0; j < 16; ++j) { const unsigned c = xb_ld(&bar[XB_XCNT(j)]); sum += c; cnt += (c > 0u) ? 1u : 0u; mine = (j == x) ? c : mine; }
        if (sum == G) break;
        __builtin_amdgcn_s_sleep(1);
        if ((++sp & 255u) == 0u) { if (xb_ld(&bar[XB_TMO])) break; if (sp > XB_SPIN_CAP) { atomicAdd(&bar[XB_TMO], 1u); break; } }
    }
    nloc = mine > 0u ? mine : 1u; nx = cnt > 0u ? cnt : 1u;
}

__device__ __forceinline__ void xcd_barrier(const XcdBarrier& b) {
    asm volatile("s_waitcnt vmcnt(0)" ::: "memory");
    __syncthreads();
    if (threadIdx.x == 0) {
        unsigned* bar = b.bar;
        __builtin_amdgcn_s_waitcnt(0);
        unsigned nloc = b.st[0], nx = b.st[1];
        if (nloc == 0u) { xcd_barrier_complete(bar, b.x, nloc, nx); b.st[0] = nloc; b.st[1] = nx; }
        const unsigned old = xb_add(&bar[XB_XSUB(b.x)], 1u);
        const unsigned gen = old / nloc;
        if (old + 1u == (gen + 1u) * nloc) {
            __builtin_amdgcn_fence(__ATOMIC_RELEASE, "agent");
            asm volatile("s_waitcnt vmcnt(0)" ::: "memory");
            const unsigned og = xb_add(&bar[XB_TOP], 1u);
            const unsigned tg = og / nx;
            if (og + 1u == (tg + 1u) * nx) xb_add(&bar[XB_TOPGEN], 1u);
            else XB_SPIN(xb_ld(&bar[XB_TOPGEN]) == tg, bar);
            __builtin_amdgcn_fence(__ATOMIC_ACQUIRE, "agent");
            xb_add(&bar[XB_XGEN(b.x)], 1u);
            asm volatile("s_waitcnt vmcnt(0)" ::: "memory");
        } else {
            XB_SPIN(xb_ld(&bar[XB_XGEN(b.x)]) == gen, bar);
            __builtin_amdgcn_fence(__ATOMIC_ACQUIRE, "agent");
            asm volatile("s_waitcnt vmcnt(0)" ::: "memory");
        }
    }
    __syncthreads();
}
constexpr int NWAVES = 8;
#ifndef REP_SCAN
#define REP_SCAN 1
#endif
#ifndef REP_ATTN
#define REP_ATTN 1
#endif
#ifndef REP_PASS
#define REP_PASS 1
#endif
#ifndef REP_OG
#define REP_OG 1
#endif
#ifndef REP_SYNC
#define REP_SYNC 0
#endif
#ifndef REP_G1
#define REP_G1 1
#endif
constexpr int BATCH = 2, SEQ = 16384, D = 1024, M = BATCH * SEQ;
constexpr size_t MiB = 1u << 20;
constexpr size_t WS_ROPE_C = 1 * MiB, WS_ROPE_S = 2 * MiB, WS_S = 3 * MiB, WS_BIAS = 5 * MiB, WS_W = 6 * MiB, WS_U = 32 * MiB, UNIT = 64 * MiB, WS_H = WS_U + 7 * UNIT, WS_END = WS_H + 16 * MiB;
constexpr size_t W_RKVG = 0, W_DOWN = 8 * MiB, W_UP = 17 * MiB, W_OUT = 19 * MiB;
constexpr size_t W_PROJ = 0, W_BOUT = 8 * MiB;
constexpr int LDS_BYTES = 147456;
constexpr float C2F = 0.125f * 1.4426950408889634f;
#ifdef ATTN_D64
#define QSCALE_MASK0 0x4
#define QSCALE_MASK1 0x1
#else
#define QSCALE_MASK0 0x4
#define QSCALE_MASK1 0x1
#endif

typedef _Float16 h16x4 __attribute__((ext_vector_type(4)));
typedef unsigned u32x2 __attribute__((ext_vector_type(2)));
typedef float f32x2 __attribute__((ext_vector_type(2)));
__device__ __forceinline__ unsigned f2bf(float f) { unsigned u = __builtin_bit_cast(unsigned, f); return (u + 0x7fffu + ((u >> 16) & 1u)) >> 16; }
__device__ __forceinline__ unsigned pk2(float lo, float hi) { return f2bf(lo) | (f2bf(hi) << 16); }
__device__ __forceinline__ float bflo(unsigned w) { return __uint_as_float(w << 16); }
__device__ __forceinline__ float bfhi(unsigned w) { return __uint_as_float(w & 0xffff0000u); }
__device__ __forceinline__ float wave_sum(float v) {
#pragma unroll
    for (int o = 1; o < 64; o <<= 1) v += __shfl_xor(v, o);
    return v;
}
template <int CTRL> __device__ __forceinline__ float dpp_mov(float x) { return __builtin_bit_cast(float, __builtin_amdgcn_update_dpp(0, __builtin_bit_cast(int, x), CTRL, 0xf, 0xf, false)); }
__device__ __forceinline__ float allreduce16(float x) { x += dpp_mov<0x128>(x); x += dpp_mov<0x124>(x); x += dpp_mov<0x122>(x); x += dpp_mov<0x121>(x); return x; }

__device__ __forceinline__ void conv_tile(const float* src, int ldsrc, int k0s, int n0s, int kvalid, const float* sc, int smode, bf16* dst, int pitch, int n0d, int k0d, LAS float* scr, int lane) {
#pragma unroll 8
    for (int i = 0; i < 32; ++i) { const int kk = 2 * i + (lane >> 5), n = lane & 31; float v = 0.f;
        if (kk < kvalid) { v = src[(size_t)(k0s + kk) * ldsrc + n0s + n]; if (smode) { const float s = sc[k0s + kk]; v *= (smode == 1) ? s : (1.0f - s); } }
        scr[kk * 33 + n] = v; }
    LDS_WAIT(); asm volatile("" ::: "memory");
    const int c = lane & 7;
#pragma unroll
    for (int j = 0; j < 4; ++j) { const int n = (lane >> 3) + 8 * j; const LAS float* s = scr + (8 * c) * 33 + n;
        v4u o; o.x = pk2(s[0 * 33], s[1 * 33]); o.y = pk2(s[2 * 33], s[3 * 33]); o.z = pk2(s[4 * 33], s[5 * 33]); o.w = pk2(s[6 * 33], s[7 * 33]);
        *(v4u*)(dst + (size_t)(n0d + n) * pitch + k0d + 8 * c) = o; }
    LDS_WAIT(); asm volatile("" ::: "memory");
}

struct In {
    const float* x; const int* pos; const float *a_norm, *a_mu, *a_w_in, *a_w0, *a_w1, *a_w2, *a_a0, *a_a1, *a_a2, *a_v0, *a_v1, *a_v2, *a_k_k, *a_k_a, *a_r_k, *a_ln_w, *a_ln_b, *a_w_out;
    const float *kv_norm, *w_kv, *b_norm, *b_w_in, *b_lq1, *b_lk1, *b_lq2, *b_lk2, *b_subln, *b_w_out, *final_norm;
};

__device__ __forceinline__ void conv_rwkv(const In& I, int l, unsigned char* wreg, float* bias3, LAS float* scr, int gw, int NGW, int lane) {
    if (gw < 48) { const int i = gw * 64 + lane; const int t = i >> 10, c = i & 1023; bias3[i] = (t == 0) ? I.a_w0[l * 1024 + c] : (t == 1) ? I.a_a0[l * 1024 + c] : I.a_v0[c]; }
    bf16* Wq = (bf16*)(wreg + W_RKVG); bf16* Wd = (bf16*)(wreg + W_DOWN); bf16* Wu = (bf16*)(wreg + W_UP); bf16* Wo = (bf16*)(wreg + W_OUT);
    const int NUPB = (l == 0 ? 2048 : 3072) / 32;
    const int I_Q = 4 * 32 * 16, I_D = 8 * 32, I_F = I_Q + I_D, I_U = NUPB * 4, I_O = 32 * 16;
    for (int it = gw; it < I_F + I_U + I_O; it += NGW) {
        int r = it;
        if (r < I_Q) { const int p = r >> 9, nb = (r >> 4) & 31, kb = r & 15;
            conv_tile(I.a_w_in + (size_t)(l * 4 + p) * 1024 * 1024, 1024, kb * 64, nb * 32, 64, I.a_mu, 0, Wq + (size_t)p * 1024 * 1024, 1024, nb * 32, kb * 64, scr, lane); continue; }
        if (r < I_F) { const int rr = r - I_Q, nb = rr >> 5, kb = rr & 31; const int c0 = nb * 32, k0d = kb * 64, half = kb >> 4, k0s = (kb & 15) * 64;
            const float* mu = I.a_mu + (size_t)l * 6 * 1024;
            if (c0 < 64) conv_tile(I.a_w1 + (size_t)l * 1024 * 64, 64, k0s, c0, 64, mu + 4 * 1024, half ? 1 : 2, Wd, 2048, c0, k0d, scr, lane);
            else if (c0 < 128) conv_tile(I.a_a1 + (size_t)l * 1024 * 64, 64, k0s, c0 - 64, 64, mu + 5 * 1024, half ? 1 : 2, Wd, 2048, c0, k0d, scr, lane);
            else if (c0 < 160 && l == 1) conv_tile(I.a_v1, 32, k0s, 0, 64, mu + 2 * 1024, half ? 1 : 2, Wd, 2048, c0, k0d, scr, lane);
            else conv_tile(I.a_w1, 64, 0, 0, 0, mu, 0, Wd, 2048, c0, k0d, scr, lane);
            continue; }
        r -= I_F;
        if (r < I_U) { const int nb = r >> 2, kb = r & 3; const int n0d = nb * 32, k0d = kb * 64, t = n0d >> 10;
            if (kb == t) { if (t == 0) conv_tile(I.a_w2 + (size_t)l * 64 * 1024, 1024, 0, n0d, 64, I.a_mu, 0, Wu, 256, n0d, k0d, scr, lane);
                else if (t == 1) conv_tile(I.a_a2 + (size_t)l * 64 * 1024, 1024, 0, n0d - 1024, 64, I.a_mu, 0, Wu, 256, n0d, k0d, scr, lane);
                else conv_tile(I.a_v2, 1024, 0, n0d - 2048, 32, I.a_mu, 0, Wu, 256, n0d, k0d, scr, lane); }
            else conv_tile(I.a_w2, 1024, 0, 0, 0, I.a_mu, 0, Wu, 256, n0d, k0d, scr, lane);
            continue; }
        r -= I_U;
        { const int nb = r >> 4, kb = r & 15; conv_tile(I.a_w_out + (size_t)l * 1024 * 1024, 1024, kb * 64, nb * 32, 64, I.a_mu, 0, Wo, 1024, nb * 32, kb * 64, scr, lane); }
    }
}
__device__ __forceinline__ void conv_attn(const In& I, int j, unsigned char* wreg, LAS float* scr, int gw, int NGW, int lane) {
    bf16* Wp = (bf16*)(wreg + W_PROJ); bf16* Wo = (bf16*)(wreg + W_BOUT);
    const int NPB = (j == 0 ? 4096 : 2048) / 32;
    const int I_P = NPB * 16, I_O = 32 * 16;
    for (int it = gw; it < I_P + I_O; it += NGW) {
        int r = it;
        if (r < I_P) { const int nb = r >> 4, kb = r & 15; const int n0d = nb * 32, k0 = kb * 64;
            if (j == 0) { if (n0d < 2048) conv_tile(I.w_kv, 2048, k0, n0d, 64, I.kv_norm, 1, Wp, 1024, n0d, k0, scr, lane);
                else conv_tile(I.b_w_in, 2048, k0, n0d - 2048, 64, I.b_norm, 1, Wp, 1024, n0d, k0, scr, lane); }
            else conv_tile(I.b_w_in + (size_t)1024 * 2048, 2048, k0, n0d, 64, I.b_norm + 1024, 1, Wp, 1024, n0d, k0, scr, lane);
            continue; }
        r -= I_P;
        { const int nb = r >> 4, kb = r & 15; conv_tile(I.b_w_out + (size_t)j * 1024 * 1024, 1024, kb * 64, nb * 32, 64, I.kv_norm, 0, Wo, 1024, nb * 32, kb * 64, scr, lane); }
    }
}

__device__ __forceinline__ void rope_tables(const int* pos, float* rc, float* rs, int gtid, int nthr) {
    for (int idx = gtid; idx < M * 8; idx += nthr) { const int m = idx >> 3, i = idx & 7;
        const float inv = (i == 0) ? 1.0f : (i == 1) ? 0.1939227432012558f : (i == 2) ? 0.03760603070259094f : (i == 3) ? 0.007292664609849453f : (i == 4) ? 0.0014142135623842478f : (i == 5) ? 0.00027424818836152554f : (i == 6) ? 5.3182957344688475e-05f : 1.0313385246263351e-05f;
        const float ang = (float)pos[m] * inv;
        const double x = (double)ang; const double k = __builtin_rint(x * 0.15915494309189535); const double r = x - k * 6.283185307179586476925;
        const double r2 = r * r; double sn = 0.0, cs = 0.0;
#pragma unroll
        for (int t = 12; t >= 1; --t) { sn = (1.0 - sn) * r2 / (double)((2 * t) * (2 * t + 1)); cs = (1.0 - cs) * r2 / (double)((2 * t - 1) * (2 * t)); }
        rs[idx] = (float)(r * (1.0 - sn)); rc[idx] = (float)(1.0 - cs); }
}

__device__ __forceinline__ void pre_rwkv(const float* x, const float* g, const float* mu, bf16* XM, size_t xm_stride, bf16* XN2, int gw, int NGW, int lane) {
    f32x4 gv[4], mv[4][4];
#pragma unroll
    for (int j = 0; j < 4; ++j) { gv[j] = *((const f32x4*)g + lane + 64 * j);
#pragma unroll
        for (int p = 0; p < 4; ++p) mv[p][j] = *((const f32x4*)(mu + p * 1024) + lane + 64 * j); }
    for (int c = gw; c < M / 16; c += NGW) { const int m0 = c * 16;
        f32x4 prev[4];
#pragma unroll
        for (int j = 0; j < 4; ++j) prev[j] = (f32x4){0.f, 0.f, 0.f, 0.f};
        if ((m0 % SEQ) != 0) { const f32x4* xr = (const f32x4*)(x + (size_t)(m0 - 1) * D) + lane; f32x4 v[4]; float s = 0.f;
#pragma unroll
            for (int j = 0; j < 4; ++j) { v[j] = xr[64 * j]; s += (v[j].x * v[j].x + v[j].y * v[j].y) + (v[j].z * v[j].z + v[j].w * v[j].w); }
            const float rstd = 1.0f / sqrtf(wave_sum(s) * (1.0f / D) + 1e-6f);
#pragma unroll
            for (int j = 0; j < 4; ++j) prev[j] = v[j] * rstd * gv[j]; }
        for (int r = 0; r < 16; ++r) { const int m = m0 + r; const f32x4* xr = (const f32x4*)(x + (size_t)m * D) + lane; f32x4 v[4]; float s = 0.f;
#pragma unroll
            for (int j = 0; j < 4; ++j) { v[j] = xr[64 * j]; s += (v[j].x * v[j].x + v[j].y * v[j].y) + (v[j].z * v[j].z + v[j].w * v[j].w); }
            const float rstd = 1.0f / sqrtf(wave_sum(s) * (1.0f / D) + 1e-6f);
            unsigned long long* o8 = (unsigned long long*)(XN2 + (size_t)m * 2048) + lane;
#pragma unroll
            for (int j = 0; j < 4; ++j) { const f32x4 xn = v[j] * rstd * gv[j]; const f32x4 xx = prev[j] - xn;
                o8[64 * j] = (unsigned long long)pk2(xn.x, xn.y) | ((unsigned long long)pk2(xn.z, xn.w) << 32);
                o8[256 + 64 * j] = (unsigned long long)pk2(prev[j].x, prev[j].y) | ((unsigned long long)pk2(prev[j].z, prev[j].w) << 32);
#pragma unroll
                for (int p = 0; p < 4; ++p) { const f32x4 xm = xn + xx * mv[p][j];
                    ((unsigned long long*)(XM + (size_t)p * xm_stride + (size_t)m * D) + lane)[64 * j] = (unsigned long long)pk2(xm.x, xm.y) | ((unsigned long long)pk2(xm.z, xm.w) << 32); }
                prev[j] = xn; } }
    }
}
__device__ __forceinline__ void pre_attn(const float* x, bf16* XH, int gw, int NGW, int lane) {
    for (int m = gw; m < M; m += NGW) { const f32x4* xr = (const f32x4*)(x + (size_t)m * D) + lane; f32x4 v[4]; float s = 0.f;
#pragma unroll
        for (int j = 0; j < 4; ++j) { v[j] = xr[64 * j]; s += (v[j].x * v[j].x + v[j].y * v[j].y) + (v[j].z * v[j].z + v[j].w * v[j].w); }
        const float rstd = 1.0f / sqrtf(wave_sum(s) * (1.0f / D) + 1e-6f);
        unsigned long long* o8 = (unsigned long long*)(XH + (size_t)m * D) + lane;
#pragma unroll
        for (int j = 0; j < 4; ++j) o8[64 * j] = (unsigned long long)pk2(v[j].x * rstd, v[j].y * rstd) | ((unsigned long long)pk2(v[j].z * rstd, v[j].w * rstd) << 32); }
}
__device__ __forceinline__ void final_norm_rows(const float* x, const float* g, float* out, int gw, int NGW, int lane) {
    f32x4 gv[4];
#pragma unroll
    for (int j = 0; j < 4; ++j) gv[j] = *((const f32x4*)g + lane + 64 * j);
    for (int m = gw; m < M; m += NGW) { const f32x4* xr = (const f32x4*)(x + (size_t)m * D) + lane; f32x4 v[4]; float s = 0.f;
#pragma unroll
        for (int j = 0; j < 4; ++j) { v[j] = xr[64 * j]; s += (v[j].x * v[j].x + v[j].y * v[j].y) + (v[j].z * v[j].z + v[j].w * v[j].w); }
        const float rstd = 1.0f / sqrtf(wave_sum(s) * (1.0f / D) + 1e-6f);
        f32x4* o = (f32x4*)(out + (size_t)m * D) + lane;
#pragma unroll
        for (int j = 0; j < 4; ++j) o[64 * j] = v[j] * rstd * gv[j]; }
}

__device__ __forceinline__ void ld16bf(const bf16* p, float (&f)[16]) { const v4u a = *(const v4u*)p, b = *(const v4u*)(p + 8);
    f[0] = bflo(a.x); f[1] = bfhi(a.x); f[2] = bflo(a.y); f[3] = bfhi(a.y); f[4] = bflo(a.z); f[5] = bfhi(a.z); f[6] = bflo(a.w); f[7] = bfhi(a.w);
    f[8] = bflo(b.x); f[9] = bfhi(b.x); f[10] = bflo(b.y); f[11] = bfhi(b.y); f[12] = bflo(b.z); f[13] = bfhi(b.z); f[14] = bflo(b.w); f[15] = bfhi(b.w); }
__device__ __forceinline__ void st16bf(bf16* p, const float (&f)[16]) { v4u a, b;
    a.x = pk2(f[0], f[1]); a.y = pk2(f[2], f[3]); a.z = pk2(f[4], f[5]); a.w = pk2(f[6], f[7]); b.x = pk2(f[8], f[9]); b.y = pk2(f[10], f[11]); b.z = pk2(f[12], f[13]); b.w = pk2(f[14], f[15]);
    *(v4u*)p = a; *(v4u*)(p + 8) = b; }

__device__ __forceinline__ void post_rwkv(const bf16* Y, const float* S, const bf16* V, const bf16* G, const float* ln_w, const float* ln_b, bf16* O, int gw, int NGW, int lane) {
    float lw[16], lb[16];
#pragma unroll
    for (int i = 0; i < 16; ++i) { lw[i] = ln_w[lane * 16 + i]; lb[i] = ln_b[lane * 16 + i]; }
    for (int m = gw; m < M; m += NGW) { const size_t off = (size_t)m * D + lane * 16;
        float y[16], v[16], g[16], o[16]; ld16bf(Y + off, y); ld16bf(V + off, v); ld16bf(G + off, g);
        const float sb = S[(size_t)m * 16 + (lane >> 2)];
        float sum = 0.f;
#pragma unroll
        for (int i = 0; i < 16; ++i) sum += y[i];
        sum += __shfl_xor(sum, 1); sum += __shfl_xor(sum, 2);
        const float mean = sum * (1.0f / 64.0f); float q = 0.f;
#pragma unroll
        for (int i = 0; i < 16; ++i) { const float d = y[i] - mean; q += d * d; }
        q += __shfl_xor(q, 1); q += __shfl_xor(q, 2);
        const float rstd = 1.0f / sqrtf(q * (1.0f / 64.0f) + 64e-5f);
#pragma unroll
        for (int i = 0; i < 16; ++i) { const float yn = (y[i] - mean) * rstd * lw[i] + lb[i]; o[i] = (yn + sb * v[i]) * (g[i] / (1.0f + __expf(-g[i]))); }
        st16bf(O + off, o); }
}
__device__ __forceinline__ void post_attn(const bf16* O0, const bf16* O1, const bf16* GT, const float* subln, float lam, float lam_init, bf16* O, int gw, int NGW, int lane) {
    float sw[16];
#pragma unroll
    for (int i = 0; i < 16; ++i) sw[i] = subln[(lane & 7) * 16 + i] * (1.0f - lam_init);
    for (int m = gw; m < M; m += NGW) { const size_t off = (size_t)m * D + lane * 16;
        float a[16], b[16], g[16], o[16]; ld16bf(O0 + off, a); ld16bf(O1 + off, b); ld16bf(GT + off, g);
        float q = 0.f;
#pragma unroll
        for (int i = 0; i < 16; ++i) { o[i] = a[i] - lam * b[i]; q += o[i] * o[i]; }
        q += __shfl_xor(q, 1); q += __shfl_xor(q, 2); q += __shfl_xor(q, 4);
        const float rstd = 1.0f / sqrtf(q * (1.0f / 128.0f) + 1e-5f);
#pragma unroll
        for (int i = 0; i < 16; ++i) o[i] = o[i] * rstd * sw[i] * (g[i] / (1.0f + __expf(-g[i])));
        st16bf(O + off, o); }
}

constexpr int SC_T = 32, SC_NB = SEQ / SC_T, SC_OPS = SC_T * 320, SC_TP = SC_T + 4, SC_VB = SC_TP * 8, SC_YP = SC_TP * 128;
struct ScRaw { u32x2 r, k, w, a; };
__device__ __forceinline__ void scan_phase(LAS unsigned char* lds, const bf16* R, const bf16* K, const bf16* V, const _Float16* W, const _Float16* A, const float* k_k, const float* k_a, const float* r_k,
                                           bf16* Y, float* S, int vcu, int G, int tid, int wave, int lane) {
    LAS float* OPS = (LAS float*)lds;
    LAS float* VB = (LAS float*)(lds + 2 * SC_OPS * 4);
    LAS float* YP = (LAS float*)(lds + 2 * SC_OPS * 4 + 2 * SC_VB * 4);
    for (int u = vcu; u < 256; u += G) {
        const int bh = u >> 3, rg = u & 7, b = bh >> 4, h = bh & 15;
        const size_t rowbase = (size_t)b * SEQ; const int cb = h * 64;
        const int pw = (wave == 2) ? 0 : (wave == 3) ? 1 : (wave == 6) ? 2 : 3;
        const int p = pw * 64 + lane, ptt = p >> 4, c4 = (p & 15) * 4;
        f32x4 kkw = {0.f, 0.f, 0.f, 0.f}, kaw = kkw, rkw = kkw;
        ScRaw rawA0, rawA1, rawB0, rawB1; rawA0.r = (u32x2){0u, 0u}; rawA0.k = rawA0.r; rawA0.w = rawA0.r; rawA0.a = rawA0.r; rawA1 = rawA0; rawB0 = rawA0; rawB1 = rawA0;
        v4u rawvA = {0u, 0u, 0u, 0u}, rawvB = rawvA;
        const bool prod = (wave == 2 || wave == 3 || wave == 6 || wave == 7), vld = (wave == 2 && lane < 32), ywr = (wave == 7), cons = (wave < 2);
        if (prod) { kkw = *(const f32x4*)(k_k + cb + c4); kaw = *(const f32x4*)(k_a + cb + c4); rkw = *(const f32x4*)(r_k + cb + c4); }
        const int jq = lane & 15, rl = wave * 4 + (lane >> 4);
        f32x2 S01 = {0.f, 0.f}, S23 = {0.f, 0.f};
#define SC_LOAD1(raw, nblk, tt_) do { const size_t o_ = (rowbase + (size_t)(nblk) * SC_T + (tt_)) * D + cb + c4; raw.r = *(const u32x2*)(R + o_); raw.k = *(const u32x2*)(K + o_); raw.w = *(const u32x2*)(W + o_); raw.a = *(const u32x2*)(A + o_); } while (0)
#define SC_LOAD(raw0, raw1, rawv, nblk) do { if (prod) { SC_LOAD1(raw0, nblk, ptt); SC_LOAD1(raw1, nblk, ptt + 16); } \
        if (vld) { rawv = *(const v4u*)(V + (rowbase + (size_t)(nblk) * SC_T + lane) * D + cb + rg * 8); } } while (0)
#define SC_DERIVE1(raw, nblk, buf, tt_) do { \
            const float r0 = bflo(raw.r.x), r1 = bfhi(raw.r.x), r2 = bflo(raw.r.y), r3 = bfhi(raw.r.y); \
            const float k0 = bflo(raw.k.x), k1 = bfhi(raw.k.x), k2 = bflo(raw.k.y), k3 = bfhi(raw.k.y); \
            const h16x4 wh = __builtin_bit_cast(h16x4, raw.w), ah = __builtin_bit_cast(h16x4, raw.a); \
            const float a0 = (float)ah[0], a1 = (float)ah[1], a2 = (float)ah[2], a3 = (float)ah[3]; \
            const float x0 = k0 * kkw.x, x1 = k1 * kkw.y, x2 = k2 * kkw.z, x3 = k3 * kkw.w; \
            const float ss = allreduce16((x0 * x0 + x1 * x1) + (x2 * x2 + x3 * x3)); \
            const float inv = 1.0f / fmaxf(sqrtf(ss), 1e-12f); \
            const f32x4 kn = {x0 * inv, x1 * inv, x2 * inv, x3 * inv}; \
            const f32x4 km = {k0 * (1.0f + (a0 - 1.0f) * kaw.x), k1 * (1.0f + (a1 - 1.0f) * kaw.y), k2 * (1.0f + (a2 - 1.0f) * kaw.z), k3 * (1.0f + (a3 - 1.0f) * kaw.w)}; \
            const float sp = allreduce16((r0 * km.x * rkw.x + r1 * km.y * rkw.y) + (r2 * km.z * rkw.z + r3 * km.w * rkw.w)); \
            LAS float* op_ = OPS + (buf) * SC_OPS + (tt_) * 320 + c4; \
            *(LAS f32x4*)(op_) = -kn; \
            *(LAS f32x4*)(op_ + 64) = (f32x4){kn.x * a0, kn.y * a1, kn.z * a2, kn.w * a3}; \
            *(LAS f32x4*)(op_ + 128) = (f32x4){__expf(-__expf((float)wh[0])), __expf(-__expf((float)wh[1])), __expf(-__expf((float)wh[2])), __expf(-__expf((float)wh[3]))}; \
            *(LAS f32x4*)(op_ + 192) = km; \
            *(LAS f32x4*)(op_ + 256) = (f32x4){r0, r1, r2, r3}; \
            if (rg == 0 && c4 == 0) S[(rowbase + (size_t)(nblk) * SC_T + (tt_)) * 16 + h] = sp; } while (0)
#define SC_DERIVE(raw0, raw1, rawv, nblk, buf) do { if (prod) { SC_DERIVE1(raw0, nblk, buf, ptt); SC_DERIVE1(raw1, nblk, buf, ptt + 16); } \
        if (vld) { LAS float* vb_ = VB + (buf) * SC_VB + lane; \
            vb_[0] = bflo(rawv.x); vb_[SC_TP] = bfhi(rawv.x); vb_[2 * SC_TP] = bflo(rawv.y); vb_[3 * SC_TP] = bfhi(rawv.y); vb_[4 * SC_TP] = bflo(rawv.z); vb_[5 * SC_TP] = bfhi(rawv.z); vb_[6 * SC_TP] = bflo(rawv.w); vb_[7 * SC_TP] = bfhi(rawv.w); } } while (0)
#define SC_YOUT1(nblk, buf, tt_) do { const int rp_ = lane & 3; const LAS float* yp_ = YP + (buf) * SC_YP + (2 * rp_) * 16 * SC_TP + (tt_); \
            float y0_ = 0.f, y1_ = 0.f; \
            _Pragma("unroll") for (int j_ = 0; j_ < 16; ++j_) { y0_ += yp_[j_ * SC_TP]; y1_ += yp_[(16 + j_) * SC_TP]; } \
            *(unsigned*)(Y + (rowbase + (size_t)(nblk) * SC_T + (tt_)) * D + cb + rg * 8 + 2 * rp_) = pk2(y0_, y1_); } while (0)
#define SC_YOUT(nblk, buf) do { SC_YOUT1(nblk, buf, lane >> 2); SC_YOUT1(nblk, buf, (lane >> 2) + 16); } while (0)
#define SC_BAR() asm volatile("s_waitcnt lgkmcnt(0)\n\ts_barrier" ::: "memory")
#define SC_LDOPS(N, B, W_, K_, R_, t) do { const LAS float* o_ = ops + (t) * 320; N = *(const LAS f32x4*)(o_); B = *(const LAS f32x4*)(o_ + 64); W_ = *(const LAS f32x4*)(o_ + 128); K_ = *(const LAS f32x4*)(o_ + 192); R_ = *(const LAS f32x4*)(o_ + 256); } while (0)
#define SC_CONSUME(buf) do { const LAS float* ops = OPS + (buf) * SC_OPS + 4 * jq; const LAS float* vb = VB + (buf) * SC_VB + rl * SC_TP; LAS float* yp = YP + (buf) * SC_YP + (rl * 16 + jq) * SC_TP; \
            f32x4 nk, bb, dw, km, rr, nk2, bb2, dw2, km2, rr2; SC_LDOPS(nk, bb, dw, km, rr, 0); SC_LDOPS(nk2, bb2, dw2, km2, rr2, 1); \
            f32x4 v4 = *(const LAS f32x4*)(vb), v4n = *(const LAS f32x4*)(vb + 4), yacc = {0.f, 0.f, 0.f, 0.f}; \
            _Pragma("unroll") for (int tt = 0; tt < SC_T; ++tt) { \
                f32x4 nk3 = nk2, bb3 = bb2, dw3 = dw2, km3 = km2, rr3 = rr2; \
                if (tt + 2 < SC_T) SC_LDOPS(nk3, bb3, dw3, km3, rr3, tt + 2); \
                asm volatile("" ::: "memory"); \
                const float vi = v4[tt & 3]; \
                const f32x2 t_ = S01 * nk.lo + S23 * nk.hi; \
                const f32x2 P01 = S01 * dw.lo + km.lo * vi, P23 = S23 * dw.hi + km.hi * vi; \
                const float sa = allreduce16(t_.x + t_.y); \
                S01 = P01 + bb.lo * sa; S23 = P23 + bb.hi * sa; \
                const f32x2 y_ = S01 * rr.lo + S23 * rr.hi; \
                yacc[tt & 3] = y_.x + y_.y; \
                if ((tt & 3) == 3) { *(LAS f32x4*)(yp + (tt - 3)) = yacc; v4 = v4n; if (tt + 5 < SC_T) v4n = *(const LAS f32x4*)(vb + tt + 5); } \
                nk = nk2; bb = bb2; dw = dw2; km = km2; rr = rr2; nk2 = nk3; bb2 = bb3; dw2 = dw3; km2 = km3; rr2 = rr3; } } while (0)
        SC_LOAD(rawA0, rawA1, rawvA, 0); SC_DERIVE(rawA0, rawA1, rawvA, 0, 0); SC_LOAD(rawB0, rawB1, rawvB, 1); SC_LOAD(rawA0, rawA1, rawvA, 2);
        __syncthreads();
        for (int n = 0; n < SC_NB; n += 2) {
            if (cons) { SC_CONSUME(0); }
            else { SC_DERIVE(rawB0, rawB1, rawvB, n + 1, 1); if (n + 3 < SC_NB) SC_LOAD(rawB0, rawB1, rawvB, n + 3);
                if (ywr && n >= 1) SC_YOUT(n - 1, 1); }
            SC_BAR();
            if (cons) { SC_CONSUME(1); }
            else { if (n + 2 < SC_NB) { SC_DERIVE(rawA0, rawA1, rawvA, n + 2, 0); if (n + 4 < SC_NB) SC_LOAD(rawA0, rawA1, rawvA, n + 4); }
                if (ywr) SC_YOUT(n, 0); }
            SC_BAR();
        }
        if (ywr) SC_YOUT(SC_NB - 1, 1);
        __syncthreads();
#undef SC_LOAD1
#undef SC_LOAD
#undef SC_DERIVE1
#undef SC_DERIVE
#undef SC_YOUT1
#undef SC_YOUT
#undef SC_CONSUME
#undef SC_LDOPS
#undef SC_BAR
    }
}

struct Args { const void* in[31]; float* out; unsigned char* ws; };
__global__ void __launch_bounds__(NWAVES * 64, 2) mk_fwd(Args args) {
    extern __shared__ __attribute__((aligned(16))) unsigned char lds[];
    cg::grid_group grid = cg::this_grid();
    LAS unsigned char* L = (LAS unsigned char*)lds;
    const int G = gridDim.x; const int bx = blockIdx.x; const int vcu = (G % 8 == 0) ? (bx % 8) * (G / 8) + bx / 8 : bx;
    const int NGW = G * NWAVES;
    { volatile LAS unsigned* st0 = (volatile LAS unsigned*)(L + 131072 + 1024); if (threadIdx.x < 2) st0[threadIdx.x] = 0u; __syncthreads(); }
    const XcdBarrier xbar = xcd_barrier_post((unsigned*)args.ws, (volatile LAS unsigned*)(L + 131072 + 1024));
#define PH_IDS() int tid_ = threadIdx.x; asm volatile("" : "+v"(tid_)); const int tid = tid_, lane = tid & 63, wave = __builtin_amdgcn_readfirstlane(tid >> 6); const int gw = vcu * NWAVES + wave; LAS float* scr = (LAS float*)(L + wave * 16384); (void)scr; (void)gw; (void)lane
    typedef const void* cvp_t; typedef const __attribute__((address_space(4))) cvp_t* kargp_t;
#define KP_(k) (((kargp_t)kp_)[k])
#define PH_PTRS() const __attribute__((address_space(4))) char* kp_ = (const __attribute__((address_space(4))) char*)__builtin_amdgcn_kernarg_segment_ptr(); asm volatile("" : "+s"(kp_)); \
    In I; I.x = (const float*)KP_(0); I.pos = (const int*)KP_(1); I.a_norm = (const float*)KP_(2); I.a_mu = (const float*)KP_(3); I.a_w_in = (const float*)KP_(4); I.a_w0 = (const float*)KP_(5); I.a_w1 = (const float*)KP_(6); I.a_w2 = (const float*)KP_(7); I.a_a0 = (const float*)KP_(8); I.a_a1 = (const float*)KP_(9); I.a_a2 = (const float*)KP_(10); I.a_v0 = (const float*)KP_(11); I.a_v1 = (const float*)KP_(12); I.a_v2 = (const float*)KP_(13); I.a_k_k = (const float*)KP_(14); I.a_k_a = (const float*)KP_(15); I.a_r_k = (const float*)KP_(16); I.a_ln_w = (const float*)KP_(17); I.a_ln_b = (const float*)KP_(18); I.a_w_out = (const float*)KP_(19); I.kv_norm = (const float*)KP_(20); I.w_kv = (const float*)KP_(21); I.b_norm = (const float*)KP_(22); I.b_w_in = (const float*)KP_(23); I.b_lq1 = (const float*)KP_(24); I.b_lk1 = (const float*)KP_(25); I.b_lq2 = (const float*)KP_(26); I.b_lk2 = (const float*)KP_(27); I.b_subln = (const float*)KP_(28); I.b_w_out = (const float*)KP_(29); I.final_norm = (const float*)KP_(30); \
    float* XS = (float*)KP_(31); unsigned char* ws = (unsigned char*)KP_(32); \
    float* rc = (float*)(ws + WS_ROPE_C); float* rs = (float*)(ws + WS_ROPE_S); float* SB = (float*)(ws + WS_S); unsigned char* wreg = ws + WS_W; \
    bf16* U0 = (bf16*)(ws + WS_U); bf16* U1 = (bf16*)(ws + WS_U + UNIT); bf16* U2 = (bf16*)(ws + WS_U + 2 * UNIT); bf16* U3 = (bf16*)(ws + WS_U + 3 * UNIT); \
    bf16* U4 = (bf16*)(ws + WS_U + 4 * UNIT); bf16* U5 = (bf16*)(ws + WS_U + 5 * UNIT); bf16* U6 = (bf16*)(ws + WS_U + 6 * UNIT); bf16* HB = (bf16*)(ws + WS_H); \
    (void)I; (void)XS; (void)rc; (void)rs; (void)SB; (void)wreg; (void)U0; (void)U1; (void)U2; (void)U3; (void)U4; (void)U5; (void)U6; (void)HB

    for (int rp = 0; rp < REP_PASS; ++rp) { PH_IDS(); PH_PTRS(); rope_tables(I.pos, rc, rs, vcu * 512 + tid, G * 512);
    conv_rwkv(I, 0, wreg, (float*)(ws + WS_BIAS), scr, gw, NGW, lane);
    pre_rwkv(I.x, I.a_norm, I.a_mu, U0, UNIT / 2, U4, gw, NGW, lane); }
    grid.sync();

    for (int rp = 0; rp < REP_SYNC; ++rp) xcd_barrier(xbar);
#pragma nounroll
    for (int l = 0; l < 2; ++l) {
#pragma nounroll
        for (int ph = 0; ph < 3; ++ph) {
            const int nq = (ph == 0) ? 1 : 2;
#pragma nounroll
            for (int q = 0; q < nq; ++q) {
                PH_PTRS();
                const int gi = (ph == 0) ? 4 : (ph - 1) * 2 + q;
                const bf16* Ag = (gi == 4) ? U4 : (const bf16*)(ws + WS_U + (size_t)gi * UNIT);
                const bf16* Bg = (gi == 4) ? (const bf16*)(wreg + W_DOWN) : (const bf16*)(wreg + W_RKVG) + (size_t)gi * 1024 * 1024;
                bf16* Dg = (gi == 0) ? U4 : (gi == 1) ? U5 : (gi == 2) ? ((l == 0) ? U6 : U0) : U1;
                const int Ng = (gi == 4) ? 256 : 1024, Kg = (gi == 4) ? 2048 : 1024;
                pg8::Gemm g{Ag, Bg, M, Ng, Kg}; pg8::StaticOrder S; S.init(M, Ng, G, bx);
                pg8::EpiFold E{Dg, HB, (gi == 4) ? 1 : 0};
                pg8::gemm_phase<pg8::EpiFold, pg8::StaticOrder, true, true>(L, g, S, E);
            }
            if (ph < 2) xcd_barrier(xbar);
        }
        xcd_barrier(xbar);
        {
            PH_PTRS(); bf16* Vl = (l == 0) ? U6 : U0;
            const int NUP = (l == 0) ? 2048 : 3072;
            pg8::Gemm g{HB, (const bf16*)(wreg + W_UP), M, NUP, 256}; pg8::StaticOrder S; S.init(M, NUP, G, bx);
            pg8::EpiLoraUp E{(const float*)(ws + WS_BIAS), (_Float16*)U2, (_Float16*)U3, Vl, U6};
            pg8::gemm_phase<pg8::EpiLoraUp, pg8::StaticOrder, true, false>(L, g, S, E);
        }
        xcd_barrier(xbar);
#pragma nounroll
        for (int rp = 0; rp < REP_SCAN; ++rp) { if (rp) xcd_barrier(xbar); PH_IDS(); PH_PTRS(); bf16* Vl = (l == 0) ? U6 : U0; bf16* Yl = (l == 0) ? U0 : U6; scan_phase(L, U4, U5, Vl, (const _Float16*)U2, (const _Float16*)U3, I.a_k_k + l * 1024, I.a_k_a + l * 1024, I.a_r_k + l * 1024, Yl, SB, vcu, G, tid, wave, lane); }
        xcd_barrier(xbar);
        for (int rp = 0; rp < REP_PASS; ++rp) { PH_IDS(); PH_PTRS(); bf16* Vl = (l == 0) ? U6 : U0; bf16* Yl = (l == 0) ? U0 : U6; post_rwkv(Yl, SB, Vl, U1, I.a_ln_w + l * 1024, I.a_ln_b + l * 1024, U4, gw, NGW, lane); }
        xcd_barrier(xbar);
        {
            PH_PTRS(); const float* xin = (l == 0) ? I.x : XS;
            pg8::Gemm g{U4, (const bf16*)(wreg + W_OUT), M, 1024, 1024}; pg8::StaticOrder S; S.init(M, 1024, G, bx);
            pg8::EpiResid E{xin, XS};
            pg8::gemm_phase<pg8::EpiResid, pg8::StaticOrder, true, true>(L, g, S, E);
        }
        xcd_barrier(xbar);
        for (int rp = 0; rp < REP_PASS; ++rp) { PH_IDS(); PH_PTRS(); if (l == 0) { conv_rwkv(I, 1, wreg, (float*)(ws + WS_BIAS), scr, gw, NGW, lane); pre_rwkv(XS, I.a_norm + 1024, I.a_mu + 6 * 1024, U0, UNIT / 2, U4, gw, NGW, lane); }
        else { conv_attn(I, 0, wreg, scr, gw, NGW, lane); pre_attn(XS, U0, gw, NGW, lane); } }
        xcd_barrier(xbar);
    }

#pragma nounroll
    for (int j = 0; j < 2; ++j) {
        {
            PH_PTRS();
            const int NP = (j == 0) ? 4096 : 2048;
            pg8::Gemm g{U0, (const bf16*)(wreg + W_PROJ), M, NP, 1024}; pg8::StaticOrder S; S.init(M, NP, G, bx);
            pg8::EpiProj E;
            if (j == 0) { E.d0 = U1; E.d1 = U2; E.d2 = U3; E.d3 = U4; E.ropemask = 0x5; E.scalemask = QSCALE_MASK0; }
            else { E.d0 = U3; E.d1 = U4; E.d2 = U3; E.d3 = U4; E.ropemask = 0x1; E.scalemask = QSCALE_MASK1; }
            E.sc = C2F; E.rc = rc; E.rs = rs;
            pg8::gemm_phase<pg8::EpiProj, pg8::StaticOrder, true, true>(L, g, S, E);
        }
        xcd_barrier(xbar);
#pragma nounroll
        for (int rp = 0; rp < REP_ATTN; ++rp) {
            if (rp) xcd_barrier(xbar);
            PH_PTRS();
#ifdef ATTN_D64
            const attn_body::AttnTensors AT{(const attn_body::bf16*)U3, (const attn_body::bf16*)U1, (const attn_body::bf16*)U2, (attn_body::bf16*)U5, (attn_body::bf16*)U6};
            attn_body::attn_phase<8>((char*)lds, AT, vcu, G);
#else
            const attn128::AttnTensors AT{U3, U1, U2, U5, U6};
            attn128::attn_phase((char*)lds, AT, vcu, G);
#endif
        }
        xcd_barrier(xbar);
        for (int rp = 0; rp < REP_PASS; ++rp) {
            PH_IDS(); PH_PTRS();
            const float e1 = __expf(wave_sum(I.b_lq1[j * 64 + lane] * I.b_lk1[j * 64 + lane])), e2 = __expf(wave_sum(I.b_lq2[j * 64 + lane] * I.b_lk2[j * 64 + lane]));
            const float lam_init = (j == 0) ? 0.4707130183435842f : 0.5560582041556406f;
            post_attn(U5, U6, U4, I.b_subln + j * 128, e1 - e2 + lam_init, lam_init, U0, gw, NGW, lane);
        }
        xcd_barrier(xbar);
        {
            PH_PTRS();
            pg8::Gemm g{U0, (const bf16*)(wreg + W_BOUT), M, 1024, 1024}; pg8::StaticOrder S; S.init(M, 1024, G, bx);
            pg8::EpiResid E{XS, XS};
            pg8::gemm_phase<pg8::EpiResid, pg8::StaticOrder, true, true>(L, g, S, E);
        }
        xcd_barrier(xbar);
        if (j == 0) { for (int rp = 0; rp < REP_PASS; ++rp) { PH_IDS(); PH_PTRS(); conv_attn(I, 1, wreg, scr, gw, NGW, lane); pre_attn(XS, U0, gw, NGW, lane); } xcd_barrier(xbar); }
    }
    { PH_IDS(); PH_PTRS(); final_norm_rows(XS, I.final_norm, XS, gw, NGW, lane); }
}

extern "C" void kernel_launch(void* const* d_in, const int* in_sizes, int n_in, void* d_out, int out_size, void* d_ws, size_t ws_size, hipStream_t stream) {
    static int grid = 0;
    if (grid == 0) {
        if (n_in != 31 || in_sizes[0] != M * D || out_size != M * D || ws_size < WS_END) { fprintf(stderr, "kernel_launch: unexpected shapes (n_in %d, in0 %d, out %d, ws %zu < %zu)\n", n_in, n_in > 0 ? in_sizes[0] : -1, out_size, ws_size, (size_t)WS_END); grid = -1; return; }
        int dev = 0, cus = 0, per_cu = 0;
        hipGetDevice(&dev); hipDeviceGetAttribute(&cus, hipDeviceAttributeMultiprocessorCount, dev);
        if (hipFuncSetAttribute((const void*)mk_fwd, hipFuncAttributeMaxDynamicSharedMemorySize, LDS_BYTES) != hipSuccess) { fprintf(stderr, "kernel_launch: hipFuncSetAttribute failed\n"); grid = -1; return; }
        if (hipOccupancyMaxActiveBlocksPerMultiprocessor(&per_cu, (const void*)mk_fwd, NWAVES * 64, LDS_BYTES) != hipSuccess || per_cu < 1) { fprintf(stderr, "kernel_launch: occupancy query says %d\n", per_cu); per_cu = 1; }
        (void)hipGetLastError();
        grid = cus;
    }
    if (grid < 0) return;
    if (hipMemsetAsync(d_ws, 0, 16384, stream) != hipSuccess) { fprintf(stderr, "kernel_launch: memset of the barrier words failed\n"); return; }
    Args a{};
    for (int i = 0; i < 31; ++i) a.in[i] = d_in[i];
    a.out = (float*)d_out; a.ws = (unsigned char*)d_ws;
    void* kargs[] = {&a};
    hipError_t e = hipLaunchCooperativeKernel((const void*)mk_fwd, dim3(grid), dim3(NWAVES * 64), kargs, LDS_BYTES, stream);
    if (e != hipSuccess) fprintf(stderr, "kernel_launch: cooperative launch failed: %s (grid %d)\n", hipGetErrorString(e), grid);
}
```
